# Optimizing an MI355X kernel written in HIP

```python
import jax, jax.numpy as jnp
from jax import lax
import numpy as np

D_MODEL = 1024
BATCH = 8
SEQ = 8192
DEPTH = 4

CHUNK = 64
Q_BLOCK = 128
NORM_EPS = 1e-6

BRANCH_W = 512
N_BRANCH = 3

GLA_HEADS = 4
GLA_DK = 64
GLA_DV = 128
GLA_GATE_RANK = 16
GLA_TAU = 16.0

DSA_HEADS = 8
DSA_Q_RANK = 256
DSA_LAT = 128
DSA_DV = 64
IDX_HEADS = 4
IDX_DIM = 64
DSA_TOPK_MAX = 256

RWKV_HEADS = 8
RWKV_HEAD = 64
RWKV_W_RANK = 64
RWKV_A_RANK = 64
RWKV_G_RANK = 128
RWKV_LN_EPS = 64e-5
RWKV_SIZES = (RWKV_HEADS * RWKV_HEAD, RWKV_HEADS * RWKV_HEAD, RWKV_HEADS * RWKV_HEAD, RWKV_W_RANK, RWKV_A_RANK, RWKV_G_RANK)
RWKV_WIDTH = 3 * RWKV_HEADS * RWKV_HEAD + RWKV_W_RANK + RWKV_A_RANK + RWKV_G_RANK

IN_SIZES = (GLA_HEADS * GLA_DK, GLA_HEADS * GLA_DK, GLA_HEADS * GLA_DV, GLA_GATE_RANK, GLA_HEADS * GLA_DV,
            DSA_Q_RANK, DSA_LAT, IDX_DIM, IDX_HEADS,
            RWKV_WIDTH,
            N_BRANCH * D_MODEL)
IN_WIDTH = (2 * GLA_HEADS * GLA_DK + 2 * GLA_HEADS * GLA_DV + GLA_GATE_RANK
            + DSA_Q_RANK + DSA_LAT + IDX_DIM + IDX_HEADS + RWKV_WIDTH + N_BRANCH * D_MODEL)

PEER_HEADS = 8
PEER_NKEYS = 128
PEER_N = PEER_NKEYS * PEER_NKEYS
PEER_QDIM = 128
PEER_TOPK = 16
PEER_BLOCK = 128

kernel_name = 'hybrid_gla_dsa_rwkv7_peer_adaln'


def _rms(x, g, eps=NORM_EPS):
    xf = x.astype(jnp.float32)
    y = xf * lax.rsqrt(jnp.mean(xf * xf, axis=-1, keepdims=True) + eps)
    return (y * g).astype(x.dtype)


def _split(p, sizes):
    cuts = [int(s) for s in np.cumsum(sizes)[:-1]]
    return jnp.split(p, cuts, axis=-1)


def _shift(p):
    return jnp.pad(p, ((0, 0), (1, 0), (0, 0)))[:, :-1]


def _gla(q, k, v, a_lr, r, w_a2, b_a, g_o):
    f32 = jnp.float32
    B, S, _ = q.shape
    nc = S // CHUNK
    H, dk, dv = GLA_HEADS, GLA_DK, GLA_DV
    q = q.astype(f32).reshape(B, nc, CHUNK, H, dk) * (dk ** -0.5)
    k = k.astype(f32).reshape(B, nc, CHUNK, H, dk)
    v = v.astype(f32).reshape(B, nc, CHUNK, H, dv)
    log_a = jax.nn.log_sigmoid((a_lr @ w_a2 + b_a).astype(f32)) / GLA_TAU
    log_a = log_a.reshape(B, nc, CHUNK, H, dk)
    cum = jnp.cumsum(log_a, axis=2)
    tot = cum[:, :, -1]
    k_dec = k * jnp.exp(tot[:, :, None] - cum)
    upd = jnp.einsum('bnchk,bnchv->nbhkv', k_dec, v)
    chunk_decay = jnp.exp(tot).transpose(1, 0, 2, 3)

    def step(state, inp):
        d, u = inp
        state = d[..., None] * state + u
        return state, state

    _, states = lax.scan(step, jnp.zeros((B, H, dk, dv), f32), (chunk_decay, upd))
    o = jnp.einsum('bnchk,nbhkv->bnchv', q, states).reshape(B, S, H, dv)
    o = _rms(o, g_o).reshape(B, S, H * dv) * jax.nn.silu(r.astype(f32))
    return o


def _dsa(qc, kvc, idx_k, idx_w, g_qc, w_uq, w_iq, g_kv, w_uv):
    f32 = jnp.float32
    B, S, _ = kvc.shape
    topk = min(DSA_TOPK_MAX, S // 4)
    nb = S // Q_BLOCK
    qc = _rms(qc, g_qc)
    q = (qc @ w_uq).reshape(B, nb, Q_BLOCK, DSA_HEADS, DSA_LAT).transpose(1, 0, 2, 3, 4)
    qi = (qc @ w_iq).reshape(B, nb, Q_BLOCK, IDX_HEADS, IDX_DIM).transpose(1, 0, 2, 3, 4)
    wi = idx_w.reshape(B, nb, Q_BLOCK, IDX_HEADS).transpose(1, 0, 2, 3)
    kv = _rms(kvc, g_kv)
    key_chunk = jnp.arange(S) // CHUNK

    def block(args):
        bi, qb, qib, wb = args
        q_chunk = (bi * Q_BLOCK + jnp.arange(Q_BLOCK)) // CHUNK
        admissible = key_chunk[None, :] <= q_chunk[:, None]
        s_idx = jax.nn.relu(jnp.einsum('bthd,bsd->bths', qib, idx_k))
        score = jnp.einsum('bths,bth->bts', s_idx, wb).astype(f32)
        score = jnp.where(admissible[None], score, -jnp.inf)
        top_val, top_idx = lax.top_k(score, topk)
        valid = top_val > -jnp.inf
        kv_sel = jax.vmap(lambda kvb, ib: kvb[ib])(kv, top_idx)
        logits = jnp.einsum('bthd,btkd->bthk', qb, kv_sel).astype(f32) * (DSA_LAT ** -0.5)
        logits = jnp.where(valid[:, :, None, :], logits, -jnp.inf)
        p = jax.nn.softmax(logits, axis=-1).astype(kv.dtype)
        return jnp.einsum('bthk,btkd->bthd', p, kv_sel)

    o = lax.map(block, (jnp.arange(nb), q, qi, wi))
    o = o.transpose(1, 0, 2, 3, 4).reshape(B, S, DSA_HEADS, DSA_LAT)
    o = jnp.einsum('bshd,hde->bshe', o, w_uv).reshape(B, S, DSA_HEADS * DSA_DV)
    return o.astype(f32)


def _rwkv7(p, mu, w0, w_w2, a0, w_a2, w_g2, k_k, k_a, r_k, ln_g, ln_b):
    f32 = jnp.float32
    B, S, _ = p.shape
    H, N = RWKV_HEADS, RWKV_HEAD
    p = p.astype(f32)
    p = p + (_shift(p) - p) * mu
    r, k, v, w_lr, a_lr, g_lr = _split(p, RWKV_SIZES)
    log_w = -jax.nn.softplus(-(w0 + jnp.tanh(w_lr) @ w_w2)) - 0.5
    decay = jnp.exp(-jnp.exp(log_w))
    a = jax.nn.sigmoid(a0 + a_lr @ w_a2)
    g = jax.nn.sigmoid(g_lr) @ w_g2
    kk = (k * k_k).reshape(B, S, H, N)
    kk = kk * lax.rsqrt(jnp.sum(kk * kk, axis=-1, keepdims=True) + 1e-12)
    k = k * (1.0 + (a - 1.0) * k_a)
    r_h, k_h, v_h, a_h, w_h = [t.reshape(B, S, H, N) for t in (r, k, v, a, decay)]

    def step(state, inp):
        r_t, w_t, k_t, v_t, a_t, b_t = inp
        sa = jnp.einsum('bhij,bhj->bhi', state, a_t)
        state = (state * w_t[:, :, None, :] + sa[..., None] * b_t[:, :, None, :]
                 + v_t[..., None] * k_t[:, :, None, :])
        return state, jnp.einsum('bhij,bhj->bhi', state, r_t)

    xs = tuple(jnp.swapaxes(t, 0, 1) for t in (r_h, w_h, k_h, v_h, -kk, kk * a_h))
    _, y = lax.scan(step, jnp.zeros((B, H, N, N), f32), xs)
    y = jnp.swapaxes(y, 0, 1)
    mean = jnp.mean(y, axis=-1, keepdims=True)
    var = jnp.mean(jnp.square(y - mean), axis=-1, keepdims=True)
    yn = ((y - mean) * lax.rsqrt(var + RWKV_LN_EPS)).reshape(B, S, H * N) * ln_g + ln_b
    bonus = (jnp.sum(r_h * k_h * r_k, axis=-1, keepdims=True) * v_h).reshape(B, S, H * N)
    return (yn + bonus) * g


def _peer(h, w_q, sub_keys, u, v):
    f32 = jnp.float32
    B, S, D = h.shape
    nb = (B * S) // PEER_BLOCK
    hb = h.reshape(nb, PEER_BLOCK, D)

    def block(xb):
        q = (xb @ w_q).reshape(PEER_BLOCK, PEER_HEADS, 2, PEER_QDIM // 2)
        s = jnp.einsum('thpd,hpnd->thpn', q, sub_keys).astype(f32)
        s1, i1 = lax.top_k(s[:, :, 0], PEER_TOPK)
        s2, i2 = lax.top_k(s[:, :, 1], PEER_TOPK)
        cand = (s1[..., :, None] + s2[..., None, :]).reshape(PEER_BLOCK, PEER_HEADS, PEER_TOPK * PEER_TOPK)
        cand_idx = (i1[..., :, None] * PEER_NKEYS + i2[..., None, :]).reshape(PEER_BLOCK, PEER_HEADS, PEER_TOPK * PEER_TOPK)
        top_s, pos = lax.top_k(cand, PEER_TOPK)
        e_idx = jnp.take_along_axis(cand_idx, pos, axis=-1)
        gate = jax.nn.softmax(top_s, axis=-1)
        u_sel = u[e_idx]
        v_sel = v[e_idx]
        act = jax.nn.gelu(jnp.einsum('thkd,td->thk', u_sel, xb).astype(f32), approximate=False)
        return jnp.einsum('thk,thkd->td', (gate * act).astype(xb.dtype), v_sel)

    return lax.map(block, hb).reshape(B, S, D)


def setup_inputs(seed: int = 0) -> dict:
    key = jax.random.key(seed)
    ks = iter(jax.random.split(key, 48))
    L, D = DEPTH, D_MODEL
    Wr = RWKV_HEADS * RWKV_HEAD

    def nrm(shape, scale):
        return jax.random.normal(next(ks), shape, jnp.float32) * scale

    def gain(shape):
        return 1.0 + nrm(shape, 0.02)

    return {
        'x': nrm((BATCH, SEQ, D), 1.0),
        'c': nrm((BATCH, D), 1.0),
        'w_ada': nrm((L, D, 6 * D), 0.5 * D ** -0.5),
        'b_ada': nrm((L, 6 * D), 0.01),
        'g_norm_mix': gain((L, D)),
        'g_norm_ffn': gain((L, D)),
        'w_in': nrm((L, D, IN_WIDTH), D ** -0.5),
        'gla_w_a2': nrm((L, GLA_GATE_RANK, GLA_HEADS * GLA_DK), GLA_GATE_RANK ** -0.5),
        'gla_b_a': nrm((L, GLA_HEADS * GLA_DK), 0.01),
        'gla_g_o': gain((L, GLA_DV)),
        'dsa_g_qc': gain((L, DSA_Q_RANK)),
        'dsa_w_uq': nrm((L, DSA_Q_RANK, DSA_HEADS * DSA_LAT), DSA_Q_RANK ** -0.5),
        'dsa_w_iq': nrm((L, DSA_Q_RANK, IDX_HEADS * IDX_DIM), DSA_Q_RANK ** -0.5),
        'dsa_g_kv': gain((L, DSA_LAT)),
        'dsa_w_uv': nrm((L, DSA_HEADS, DSA_LAT, DSA_DV), DSA_LAT ** -0.5),
        'rwkv_mu': jax.random.uniform(next(ks), (L, RWKV_WIDTH), jnp.float32, 0.2, 0.8),
        'rwkv_w0': nrm((L, Wr), 0.5),
        'rwkv_w_w2': nrm((L, RWKV_W_RANK, Wr), RWKV_W_RANK ** -0.5),
        'rwkv_a0': nrm((L, Wr), 0.1),
        'rwkv_w_a2': nrm((L, RWKV_A_RANK, Wr), RWKV_A_RANK ** -0.5),
        'rwkv_w_g2': nrm((L, RWKV_G_RANK, Wr), RWKV_G_RANK ** -0.5),
        'rwkv_k_k': 0.85 + nrm((L, Wr), 0.02),
        'rwkv_k_a': gain((L, Wr)),
        'rwkv_r_k': nrm((L, RWKV_HEADS, RWKV_HEAD), 0.1),
        'rwkv_ln_g': gain((L, Wr)),
        'rwkv_ln_b': nrm((L, Wr), 0.01),
        'w_branch': nrm((L, N_BRANCH, BRANCH_W, D), BRANCH_W ** -0.5),
        'w_out': nrm((L, D, D), D ** -0.5),
        'peer_w_q': nrm((L, D, PEER_HEADS * PEER_QDIM), D ** -0.5),
        'peer_keys': nrm((L, PEER_HEADS, 2, PEER_NKEYS, PEER_QDIM // 2), (PEER_QDIM // 2) ** -0.5),
        'peer_u': nrm((L, PEER_N, D), D ** -0.5),
        'peer_v': nrm((L, PEER_N, D), 0.5),
        'g_final': gain((D,)),
    }


def reference(x, c, w_ada, b_ada, g_norm_mix, g_norm_ffn, w_in, gla_w_a2, gla_b_a, gla_g_o,
              dsa_g_qc, dsa_w_uq, dsa_w_iq, dsa_g_kv, dsa_w_uv,
              rwkv_mu, rwkv_w0, rwkv_w_w2, rwkv_a0, rwkv_w_a2, rwkv_w_g2, rwkv_k_k, rwkv_k_a, rwkv_r_k,
              rwkv_ln_g, rwkv_ln_b, w_branch, w_out, peer_w_q, peer_keys, peer_u, peer_v, g_final):
    B, S, D = x.shape
    cond = jax.nn.silu(c)
    for l in range(DEPTH):
        mod = cond @ w_ada[l] + b_ada[l]
        sh_m, sc_m, gt_m, sh_f, sc_f, gt_f = [m[:, None, :] for m in jnp.split(mod, 6, axis=-1)]
        h = _rms(x, g_norm_mix[l]) * (1.0 + sc_m) + sh_m
        gq, gk, gv, galr, gr, qc, kvc, ik, iw, prw, gates = _split(h @ w_in[l], IN_SIZES)
        y_a = _gla(gq, gk, gv, galr, gr, gla_w_a2[l], gla_b_a[l], gla_g_o[l])
        y_b = _dsa(qc, kvc, ik, iw, dsa_g_qc[l], dsa_w_uq[l], dsa_w_iq[l], dsa_g_kv[l], dsa_w_uv[l])
        y_c = _rwkv7(prw, rwkv_mu[l], rwkv_w0[l], rwkv_w_w2[l], rwkv_a0[l], rwkv_w_a2[l], rwkv_w_g2[l],
                     rwkv_k_k[l], rwkv_k_a[l], rwkv_r_k[l], rwkv_ln_g[l], rwkv_ln_b[l])
        g_a, g_b, g_c = jnp.split(jax.nn.sigmoid(gates), N_BRANCH, axis=-1)
        merged = (g_a * (y_a.astype(x.dtype) @ w_branch[l, 0])
                  + g_b * (y_b.astype(x.dtype) @ w_branch[l, 1])
                  + g_c * (y_c.astype(x.dtype) @ w_branch[l, 2]))
        x = x + gt_m * (merged @ w_out[l])
        h2 = _rms(x, g_norm_ffn[l]) * (1.0 + sc_f) + sh_f
        x = x + gt_f * _peer(h2, peer_w_q[l], peer_keys[l], peer_u[l], peer_v[l])
    return _rms(x, g_final)
```

```cpp
#include <hip/hip_runtime.h>
#include <stdint.h>
#include <stdio.h>
#include <string.h>

#ifndef MK_ONE_LAUNCH
#define MK_ONE_LAUNCH 0
#endif

typedef unsigned short bf16_t;
typedef short bf16x8 __attribute__((ext_vector_type(8)));
typedef float f32x4 __attribute__((ext_vector_type(4)));
typedef float f32x2 __attribute__((ext_vector_type(2)));
typedef unsigned u32x4 __attribute__((ext_vector_type(4)));
typedef unsigned u32x2 __attribute__((ext_vector_type(2)));

#define XB_TMO      128
#define XB_XCNT(j)  (256  + 64 * (j))
#define XB_XSUB(j)  (1280 + 64 * (j))
#define XB_XGEN(j)  (2304 + 64 * (j))
#define XB_TOP      3328
#define XB_TOPGEN   3392
#define XCD_BAR_WORDS 3456
#define XB_SPIN_CAP (1u << 24)
#define LAS __attribute__((address_space(3)))

__device__ __forceinline__ unsigned xb_ld(unsigned* p)              { return __hip_atomic_load(p, __ATOMIC_RELAXED, __HIP_MEMORY_SCOPE_AGENT); }
__device__ __forceinline__ unsigned xb_add(unsigned* p, unsigned v) { return __hip_atomic_fetch_add(p, v, __ATOMIC_RELAXED, __HIP_MEMORY_SCOPE_AGENT); }
__device__ __forceinline__ unsigned xb_xcc_id() { return (unsigned)__builtin_amdgcn_s_getreg((3 << 11) | 20) & 0xFu; }
#define XB_SPIN(cond, bar) do { unsigned _sp = 0; while (cond) { __builtin_amdgcn_s_sleep(1); \
    if ((++_sp & 255u) == 0u) { if (xb_ld(&(bar)[XB_TMO])) break; if (_sp > XB_SPIN_CAP) { atomicAdd(&(bar)[XB_TMO], 1u); break; } } } } while (0)

struct XcdBarrier {
    unsigned* bar; unsigned x;
    volatile LAS unsigned* st;
};

__device__ __forceinline__ XcdBarrier xcd_barrier_post(unsigned* bar, volatile LAS unsigned* st) {
    XcdBarrier b; b.bar = bar; b.x = xb_xcc_id(); b.st = st;
    if (threadIdx.x == 0) (void)xb_add(&bar[XB_XCNT(b.x)], 1u);
    return b;
}
__device__ __forceinline__ void xcd_barrier_complete(unsigned* bar, unsigned x, unsigned& nloc, unsigned& nx) {
    const unsigned G = gridDim.x * gridDim.y * gridDim.z;
    unsigned sum, cnt, mine, sp = 0u;
    for (;;) {
        sum = 0u; cnt = 0u; mine = 0u;
#pragma unroll
        for (unsigned j = 0; j < 16; ++j) { const unsigned c = xb_ld(&bar[XB_XCNT(j)]); sum += c; cnt += (c > 0u) ? 1u : 0u; mine = (j == x) ? c : mine; }
        if (sum == G) break;
        __builtin_amdgcn_s_sleep(1);
        if ((++sp & 255u) == 0u) { if (xb_ld(&bar[XB_TMO])) break; if (sp > XB_SPIN_CAP) { atomicAdd(&bar[XB_TMO], 1u); break; } }
    }
    nloc = mine > 0u ? mine : 1u; nx = cnt > 0u ? cnt : 1u;
}

__device__ __forceinline__ void xcd_barrier(const XcdBarrier& b) {
    asm volatile("s_waitcnt vmcnt(0)" ::: "memory");
    __syncthreads();
    if (threadIdx.x == 0) {
        unsigned* bar = b.bar;
        __builtin_amdgcn_s_waitcnt(0);
        unsigned nloc = b.st[0], nx = b.st[1];
        if (nloc == 0u) { xcd_barrier_complete(bar, b.x, nloc, nx); b.st[0] = nloc; b.st[1] = nx; }
        const unsigned old = xb_add(&bar[XB_XSUB(b.x)], 1u);
        const unsigned gen = old / nloc;
        if (old + 1u == (gen + 1u) * nloc) {
            __builtin_amdgcn_fence(__ATOMIC_RELEASE, "agent");
            asm volatile("s_waitcnt vmcnt(0)" ::: "memory");
            const unsigned og = xb_add(&bar[XB_TOP], 1u);
            const unsigned tg = og / nx;
            if (og + 1u == (tg + 1u) * nx) xb_add(&bar[XB_TOPGEN], 1u);
            else XB_SPIN(xb_ld(&bar[XB_TOPGEN]) == tg, bar);
            __builtin_amdgcn_fence(__ATOMIC_ACQUIRE, "agent");
            xb_add(&bar[XB_XGEN(b.x)], 1u);
            asm volatile("s_waitcnt vmcnt(0)" ::: "memory");
        } else {
            XB_SPIN(xb_ld(&bar[XB_XGEN(b.x)]) == gen, bar);
            __builtin_amdgcn_fence(__ATOMIC_ACQUIRE, "agent");
            asm volatile("s_waitcnt vmcnt(0)" ::: "memory");
        }
    }
    __syncthreads();
}
namespace pg8 {
#define PG8_LAS __attribute__((address_space(3)))
typedef unsigned short bf16_t;
typedef short bf16x8 __attribute__((ext_vector_type(8)));
typedef float f32x4 __attribute__((ext_vector_type(4)));
typedef unsigned u32x4 __attribute__((ext_vector_type(4)));
constexpr int BM = 256, BK = 64, HALF = 128, HTB = HALF * BK * 2  , STAGE_BYTES = 8 * HTB, NXCD = 8, WGM = 8;

__host__ __device__ __forceinline__ int lds_byte(int r, int c) { const int st = (r >> 4) * 2 + (c >> 5), rr = r & 15, cc = c & 31, ob = rr * 64 + cc * 2; return st * 1024 + (ob ^ (((ob >> 9) & 1) << 5)); }
__host__ __device__ __forceinline__ void stage_rc(int b, int& R, int& C) { const int st = b / 1024, sb = b % 1024, swz = sb ^ (((sb >> 9) & 1) << 5); R = (st >> 1) * 16 + swz / 64; C = (st & 1) * 32 + (swz % 64) / 2; }
__host__ __device__ __forceinline__ int perm32(int rho) { const int n = rho >> 4, i = rho & 15; return 8 * (i >> 2) + 4 * n + (i & 3); }

struct Unit { int pm, pn; };
struct Gemm { const bf16_t* A; const bf16_t* Bt; int M, N, K; };

struct StaticOrder {
    int nM, nN, nwg, G, c;
    __host__ __device__ void init(int M, int N, int G_, int c_) { nM = M / BM; nN = N / BM; nwg = nM * nN; G = G_; c = c_; }
    __host__ __device__ bool next(int i, Unit& u) const {
        const long L = (long)i * G + c; if (L >= nwg) return false;
        int wgid = (int)L; { const int q = nwg / NXCD, r = nwg % NXCD, xcd = wgid % NXCD, off = wgid / NXCD; wgid = (xcd < r ? xcd * (q + 1) : r * (q + 1) + (xcd - r) * q) + off; }
        const int nig = WGM * nN, gid = wgid / nig, fm = gid * WGM, gsz = (nM - fm) < WGM ? (nM - fm) : WGM;
        u.pm = fm + ((wgid % nig) % gsz); u.pn = (wgid % nig) / gsz; return true;
    }
    __device__ __forceinline__ void a_ready(const Unit&) const {}
    __device__ __forceinline__ void done(const Unit&) const {}
};
struct CountedOrder : StaticOrder {
    const unsigned* ready; unsigned need; unsigned* tmo;
    __device__ __forceinline__ void a_ready(const Unit& u) const {
        if (threadIdx.x < 64) {
            const unsigned long long t0 = __builtin_amdgcn_s_memrealtime(); unsigned polls = 0;
            while ((unsigned)__builtin_amdgcn_readfirstlane(__hip_atomic_load(ready + 64 * u.pm, __ATOMIC_RELAXED, __HIP_MEMORY_SCOPE_AGENT)) < need) {
                if ((++polls & 255u) == 0u && __builtin_amdgcn_readfirstlane(__hip_atomic_load(tmo, __ATOMIC_RELAXED, __HIP_MEMORY_SCOPE_AGENT)) != 0u) break;
                if (__builtin_amdgcn_s_memrealtime() - t0 > 2000000ull) {
                    if (threadIdx.x == 0) { unsigned expect = 0u; __hip_atomic_compare_exchange_strong(tmo + 1, &expect, 0x600u | (unsigned)(u.pm & 0xff), __ATOMIC_RELAXED, __ATOMIC_RELAXED, __HIP_MEMORY_SCOPE_AGENT); __hip_atomic_store(tmo, 1u, __ATOMIC_RELAXED, __HIP_MEMORY_SCOPE_AGENT); }
                    break; }
                __builtin_amdgcn_s_sleep(2); }
            __builtin_amdgcn_fence(__ATOMIC_ACQUIRE, "agent");
            asm volatile("s_waitcnt vmcnt(0)" ::: "memory");
        }
#if !defined(BROKEN_HOOK_NO_BARRIER)
        asm volatile("" ::: "memory"); __builtin_amdgcn_s_barrier(); asm volatile("" ::: "memory");
#endif
    }
};

typedef __bf16 bf16x2_t __attribute__((ext_vector_type(2)));
__device__ __forceinline__ unsigned cvt_pk_bf16(float lo, float hi) { typedef float f2_t __attribute__((ext_vector_type(2))); const f2_t v = {lo, hi}; const bf16x2_t b = __builtin_convertvector(v, bf16x2_t); return __builtin_bit_cast(unsigned, b); }
typedef float f32x2 __attribute__((ext_vector_type(2)));
__device__ __forceinline__ f32x2 gelu_pk(f32x2 v) {
    const f32x2 av = __builtin_elementwise_abs(v), d = av * 0.2316418882f + 1.0f;
    f32x2 t; t.x = __builtin_amdgcn_rcpf(d.x); t.y = __builtin_amdgcn_rcpf(d.y);
    f32x2 q = t * 0.5307027145f + (-0.7265760135f); q = q * t + 0.7107068705f; q = q * t + (-0.142248368f); q = q * t + 0.127414796f; q = q * t;
    const f32x2 s = (v * v) * (-0.72134752044f);
    f32x2 e; e.x = __builtin_amdgcn_exp2f(s.x); e.y = __builtin_amdgcn_exp2f(s.y);
    const f32x2 m = v * (q * e), r = v - m;
    f32x2 o; o.x = v.x < 0.f ? m.x : r.x; o.y = v.y < 0.f ? m.y : r.y; return o;
}

struct EpiF32 {
    static constexpr bool PERM = false, AFTER_DRAIN = false;
    float* C; int ldc; const float* bias;
    __device__ __forceinline__ void operator()(const f32x4 (&acc)[2][2][4][2], const Unit& u, int wr, int wc, int fr, int fq) const {
        const int row0 = u.pm * BM + wr * 64 + fr, col0 = u.pn * BM + wc * 32 + 4 * fq;
        f32x4 bv[2][2];
#pragma unroll
        for (int bj = 0; bj < 2; ++bj)
#pragma unroll
            for (int n = 0; n < 2; ++n) bv[bj][n] = bias ? *(const f32x4*)(bias + col0 + bj * HALF + n * 16) : (f32x4){0.f, 0.f, 0.f, 0.f};
#pragma unroll
        for (int ai = 0; ai < 2; ++ai)
#pragma unroll
            for (int m = 0; m < 4; ++m) { float* rowp = C + (size_t)(row0 + ai * HALF + m * 16) * ldc + col0;
#pragma unroll
                for (int bj = 0; bj < 2; ++bj)
#pragma unroll
                    for (int n = 0; n < 2; ++n) *(f32x4*)(rowp + bj * HALF + n * 16) = acc[ai][bj][m][n] + bv[bj][n]; }
    }
};
template <int ACT  > struct EpiBf16 {
    static constexpr bool PERM = true, AFTER_DRAIN = false;
    bf16_t* O; int ldc; const float* bias; int split_cols; size_t split_stride;
    __device__ __forceinline__ void operator()(const f32x4 (&acc)[2][2][4][2], const Unit& u, int wr, int wc, int fr, int fq) const {
        const int row0 = u.pm * BM + wr * 64 + fr; int colt = u.pn * BM; bf16_t* base = O;
        if (split_cols) { const int t = colt / split_cols; base += (size_t)t * split_stride; colt -= t * split_cols; }
        const int col0 = colt + wc * 32 + 8 * fq, bcol0 = u.pn * BM + wc * 32 + 8 * fq;
        f32x4 bv[2][2];
#pragma unroll
        for (int bj = 0; bj < 2; ++bj)
#pragma unroll
            for (int n = 0; n < 2; ++n) bv[bj][n] = bias ? *(const f32x4*)(bias + bcol0 + bj * HALF + 4 * n) : (f32x4){0.f, 0.f, 0.f, 0.f};
#pragma unroll
        for (int ai = 0; ai < 2; ++ai)
#pragma unroll
            for (int m = 0; m < 4; ++m) { bf16_t* rowp = base + (size_t)(row0 + ai * HALF + m * 16) * ldc + col0;
#pragma unroll
                for (int bj = 0; bj < 2; ++bj) { f32x4 v0 = acc[ai][bj][m][0] + bv[bj][0], v1 = acc[ai][bj][m][1] + bv[bj][1];
                    if (ACT == 1) { f32x2 a = gelu_pk((f32x2){v0[0], v0[1]}), b = gelu_pk((f32x2){v0[2], v0[3]}), c = gelu_pk((f32x2){v1[0], v1[1]}), d = gelu_pk((f32x2){v1[2], v1[3]});
                        v0 = (f32x4){a.x, a.y, b.x, b.y}; v1 = (f32x4){c.x, c.y, d.x, d.y}; }
                    if (ACT == 2) {
#pragma unroll
                        for (int j = 0; j < 4; ++j) { v0[j] = 0.5f * v0[j] * (1.0f + erff(v0[j] * 0.70710678f)); v1[j] = 0.5f * v1[j] * (1.0f + erff(v1[j] * 0.70710678f)); } }
                    u32x4 w; w.x = cvt_pk_bf16(v0[0], v0[1]); w.y = cvt_pk_bf16(v0[2], v0[3]); w.z = cvt_pk_bf16(v1[0], v1[1]); w.w = cvt_pk_bf16(v1[2], v1[3]);
                    *(u32x4*)(rowp + bj * HALF) = w; } }
    }
};
template <class Epi, class Sched, bool STAMP = false>
__device__ __forceinline__ void gemm_phase(PG8_LAS unsigned char* lds, const Gemm g, const Sched& S, const Epi& E, unsigned long long* stamps) {
    const int tid = threadIdx.x, wid = __builtin_amdgcn_readfirstlane(tid >> 6), lane = tid & 63, wr = wid >> 2, wc = wid & 3, fr = lane & 15, fq = lane >> 4;
    const int K = g.K, nt = K / BK;
    int ts_lo = 0, ts_hi = 0, nts = 0; const unsigned long long rt_entry = STAMP ? (unsigned long long)wall_clock64() : 0ull;
#define PG8_STAMP() do { if (STAMP && wid == 0 && nts < 64) { const unsigned long long _c = (unsigned long long)clock64(); \
        ts_lo = (lane == nts) ? (int)(unsigned)_c : ts_lo; ts_hi = (lane == nts) ? (int)(unsigned)(_c >> 32) : ts_hi; ++nts; } } while (0)
    PG8_STAMP();
    unsigned voffA[2], voffB[2];
#pragma unroll
    for (int i = 0; i < 2; ++i) { int R, C; stage_rc(tid * 16 + i * 8192, R, C); const int Rb = Epi::PERM ? ((R & ~31) + perm32(R & 31)) : R;
        voffA[i] = (unsigned)(R * K + C) * 2u; voffB[i] = (unsigned)(Rb * K + C) * 2u; }
    const size_t kstep = (size_t)(BK * 2);
    const size_t hstep = (size_t)HALF * K * 2;
    const size_t tstep = 2 * hstep;
    const unsigned ldsw = (unsigned)wid * 1024u;
    const int aoff = lds_byte(wr * 64 + fr, fq * 8), boff = lds_byte(wc * 32 + fr, fq * 8);
#define PG8_SA(b, h) (((b) * 2 + (h)) * HTB)
#define PG8_SB(b, h) ((4 + (b) * 2 + (h)) * HTB)
#define PG8_STAGE(bufoff, gbase, voff) do { _Pragma("unroll") for (int _i = 0; _i < 2; ++_i) \
        __builtin_amdgcn_global_load_lds((const unsigned*)((const char*)(gbase) + (voff)[_i]), (PG8_LAS unsigned*)(lds + (bufoff) + ldsw + _i * 8192), 16, 0, 0); } while (0)
#define PG8_LDA(dst, b, h) do { _Pragma("unroll") for (int m = 0; m < 4; ++m) _Pragma("unroll") for (int k = 0; k < 2; ++k) dst[m][k] = *(const PG8_LAS bf16x8*)(lds + PG8_SA(b, h) + aoff + m * 2048 + k * 1024); } while (0)
#define PG8_LDB(dst, b, h) do { _Pragma("unroll") for (int n = 0; n < 2; ++n) _Pragma("unroll") for (int k = 0; k < 2; ++k) dst[n][k] = *(const PG8_LAS bf16x8*)(lds + PG8_SB(b, h) + boff + n * 2048 + k * 1024); } while (0)
#define PG8_MMA(ai, bj, At, Bt) do { __builtin_amdgcn_s_setprio(1); _Pragma("unroll") for (int m = 0; m < 4; ++m) _Pragma("unroll") for (int n = 0; n < 2; ++n) _Pragma("unroll") for (int k = 0; k < 2; ++k) \
        acc[ai][bj][m][n] = __builtin_amdgcn_mfma_f32_16x16x32_bf16(Bt[n][k], At[m][k], acc[ai][bj][m][n], 0, 0, 0); __builtin_amdgcn_s_setprio(0); } while (0)
#define PG8_WAIT_V(n) asm volatile("s_waitcnt vmcnt(" #n ")" ::: "memory")
#define PG8_WAIT_L(n) asm volatile("s_waitcnt lgkmcnt(" #n ")" ::: "memory")
#define PG8_BAR __builtin_amdgcn_s_barrier()
#define PG8_SCHED __builtin_amdgcn_sched_barrier(0)
    Unit cur, nxt; int ui = 0;
    if (!S.next(0, cur)) return;
    f32x4 acc[2][2][4][2];
#pragma unroll
    for (int a = 0; a < 2; ++a)
#pragma unroll
        for (int b = 0; b < 2; ++b)
#pragma unroll
            for (int m = 0; m < 4; ++m)
#pragma unroll
                for (int n = 0; n < 2; ++n) acc[a][b][m][n] = (f32x4){0.f, 0.f, 0.f, 0.f};
    bf16x8 At[4][2], B0[2][2], B1[2][2];
    const char* cA = (const char*)g.A + (size_t)cur.pm * tstep; const char* cB = (const char*)g.Bt + (size_t)cur.pn * tstep;
    S.a_ready(cur);
    PG8_STAGE(PG8_SB(0, 0), cB, voffB); PG8_STAGE(PG8_SA(0, 0), cA, voffA); PG8_STAGE(PG8_SB(0, 1), cB + hstep, voffB); PG8_STAGE(PG8_SA(0, 1), cA + hstep, voffA);
    if (wr == 1) PG8_BAR;
    PG8_WAIT_V(4); PG8_BAR;
    PG8_STAGE(PG8_SB(1, 0), cB + kstep, voffB); PG8_STAGE(PG8_SA(1, 0), cA + kstep, voffA); PG8_STAGE(PG8_SB(1, 1), cB + hstep + kstep, voffB);
    PG8_WAIT_V(6); PG8_BAR;
    PG8_STAMP();
    for (;;) {
        const bool has_next = S.next(ui + 1, nxt);
        const char* nA = has_next ? (const char*)g.A + (size_t)nxt.pm * tstep : cA; const char* nB = has_next ? (const char*)g.Bt + (size_t)nxt.pn * tstep : cB;
        for (int t = 0; t < nt; t += 2) {
            const bool last = (t == nt - 2);
            const char* a1 = cA + (size_t)(t + 1) * kstep;
            const char* a2 = last ? nA : cA + (size_t)(t + 2) * kstep; const char* b2 = last ? nB : cB + (size_t)(t + 2) * kstep;
            const char* a3 = a2 + kstep; const char* b3 = b2 + kstep;
            if (last && has_next) S.a_ready(nxt);
            PG8_LDB(B0, 0, 0); PG8_SCHED; PG8_LDA(At, 0, 0); PG8_STAGE(PG8_SA(1, 1), a1 + hstep, voffA);
            PG8_WAIT_L(8); PG8_BAR; PG8_WAIT_L(0); PG8_MMA(0, 0, At, B0); PG8_BAR; PG8_SCHED;
            PG8_LDB(B1, 0, 1); PG8_STAGE(PG8_SB(0, 0), b2, voffB);
            PG8_BAR; PG8_WAIT_L(0); PG8_MMA(0, 1, At, B1); PG8_BAR;
            PG8_LDA(At, 0, 1); PG8_STAGE(PG8_SA(0, 0), a2, voffA);
            PG8_BAR; PG8_WAIT_L(0); PG8_MMA(1, 0, At, B0); PG8_BAR; PG8_SCHED;
            PG8_STAGE(PG8_SB(0, 1), b2 + hstep, voffB);
            PG8_WAIT_V(6); PG8_BAR; PG8_MMA(1, 1, At, B1); PG8_BAR;
            PG8_LDB(B0, 1, 0); PG8_SCHED; PG8_LDA(At, 1, 0); PG8_STAGE(PG8_SA(0, 1), a2 + hstep, voffA);
            PG8_WAIT_L(8); PG8_BAR; PG8_WAIT_L(0); PG8_MMA(0, 0, At, B0); PG8_BAR; PG8_SCHED;
            PG8_LDB(B1, 1, 1); PG8_STAGE(PG8_SB(1, 0), b3, voffB);
            PG8_BAR; PG8_WAIT_L(0); PG8_MMA(0, 1, At, B1); PG8_BAR;
            PG8_LDA(At, 1, 1); PG8_STAGE(PG8_SA(1, 0), a3, voffA);
            PG8_BAR; PG8_WAIT_L(0); PG8_MMA(1, 0, At, B0); PG8_BAR; PG8_SCHED;
            PG8_STAGE(PG8_SB(1, 1), b3 + hstep, voffB);
            PG8_WAIT_V(6); PG8_BAR; PG8_MMA(1, 1, At, B1); PG8_BAR;
        }
        PG8_STAMP();
        if constexpr (!Epi::AFTER_DRAIN) { E(acc, cur, wr, wc, fr, fq); S.done(cur); }
        PG8_STAMP();
        if (!has_next) break;
#pragma unroll
        for (int a = 0; a < 2; ++a)
#pragma unroll
            for (int b = 0; b < 2; ++b)
#pragma unroll
                for (int m = 0; m < 4; ++m)
#pragma unroll
                    for (int n = 0; n < 2; ++n) acc[a][b][m][n] = (f32x4){0.f, 0.f, 0.f, 0.f};
        cur = nxt; cA = nA; cB = nB; ++ui;
    }
    PG8_WAIT_V(0);
    if (wr == 0) PG8_BAR;
    PG8_BAR;
    if constexpr (Epi::AFTER_DRAIN) { E.fused(acc, cur, wr, wc, fr, fq, lds, wid, lane); S.done(cur); }
    PG8_STAMP();
    if (STAMP && wid == 0) { stamps[lane] = lane < nts ? (((unsigned long long)(unsigned)ts_hi << 32) | (unsigned)ts_lo) : 0ull;
        if (lane == 62) stamps[62] = rt_entry; if (lane == 63) stamps[63] = (unsigned long long)wall_clock64(); }
#undef PG8_STAMP
#undef PG8_SA
#undef PG8_SB
#undef PG8_STAGE
#undef PG8_LDA
#undef PG8_LDB
#undef PG8_MMA
#undef PG8_WAIT_V
#undef PG8_WAIT_L
#undef PG8_BAR
#undef PG8_SCHED
}
}

constexpr int NB = 8, SEQ = 8192, DM = 1024, NTOK = NB * SEQ, NLAYER = 4, NCHUNK = 128;
constexpr int IN_W = 6868;
constexpr int NTHR = 512;
constexpr int LDS_BYTES = 160 * 1024;
constexpr int LDS_BAR_OFF = LDS_BYTES - 16;
#define LASP __attribute__((address_space(3)))

constexpr int PB_QC = 0, PB_KVC = 256, PB_IK = 384, PB_GALR = 448, PB_IW = 464, PB_LD = 512;
constexpr int PC_R = 0, PC_K = 512, PC_V = 1024, PC_WLR = 1536, PC_ALR = 1600, PC_GLR = 1664, PC_LD = 1792;

struct Params {
    const float *x, *c, *w_ada, *b_ada, *g_mix, *g_ffn, *w_in, *gla_w_a2, *gla_b_a, *gla_g_o, *dsa_g_qc, *dsa_w_uq, *dsa_w_iq, *dsa_g_kv, *dsa_w_uv;
    const float *rw_mu, *rw_w0, *rw_w_w2, *rw_a0, *rw_w_a2, *rw_w_g2, *rw_k_k, *rw_k_a, *rw_r_k, *rw_ln_g, *rw_ln_b, *w_branch, *w_out, *peer_w_q, *peer_keys, *peer_u, *peer_v, *g_final;
    float* out;
    unsigned* bar;
    float* mod;
    bf16_t *win_t, *wg_t, *wb_t, *wo_t, *wq_t, *wuq_t, *wiq_t, *wuv_t, *pkeys, *ww2_t, *wa2_t, *wg2_t;
    bf16_t *hbuf, *GQ, *GK, *GR, *GS, *GV, *PB, *PC, *yb, *yc, *kvn;
    float* gdec;
    bf16_t *qd, *qi, *qn, *ya, *Gtmp, *merged, *qp, *tu, *tv;
    unsigned short* pe_idx; float* pe_gate;
};

typedef __bf16 bf16x2_t __attribute__((ext_vector_type(2)));
__device__ __forceinline__ unsigned pk_bf16(float lo, float hi) { const f32x2 v = {lo, hi}; const bf16x2_t b = __builtin_convertvector(v, bf16x2_t); return __builtin_bit_cast(unsigned, b); }
__device__ __forceinline__ bf16_t f2bf(float f) { return (bf16_t)(pk_bf16(f, 0.f) & 0xffffu); }
__device__ __forceinline__ float bf2f(bf16_t v) { return __uint_as_float(((unsigned)v) << 16); }
__device__ __forceinline__ float bflo(unsigned u) { return __uint_as_float(u << 16); }
__device__ __forceinline__ float bfhi(unsigned u) { return __uint_as_float(u & 0xffff0000u); }
__device__ __forceinline__ float sigmoidf_(float x) { return 1.0f / (1.0f + __expf(-x)); }
__device__ __forceinline__ float siluf_(float x) { return x / (1.0f + __expf(-x)); }
__device__ __forceinline__ float softplusf_(float x) { return fmaxf(x, 0.f) + log1pf(__expf(-fabsf(x))); }
__device__ __forceinline__ float wave_sum(float v) {
#pragma unroll
    for (int o = 32; o >= 1; o >>= 1) v += __shfl_xor(v, o);
    return v;
}
template <int CTRL> __device__ __forceinline__ float dppf(float v) { return __int_as_float(__builtin_amdgcn_update_dpp(0, __float_as_int(v), CTRL, 0xF, 0xF, true)); }
template <int CTRL> __device__ __forceinline__ unsigned dppu(unsigned v) { return (unsigned)__builtin_amdgcn_update_dpp(0, (int)v, CTRL, 0xF, 0xF, true); }
__device__ __forceinline__ float row16_sum(float v) { v += dppf<0xB1>(v); v += dppf<0x4E>(v); v += dppf<0x141>(v); v += dppf<0x140>(v); return v; }
__device__ __forceinline__ float row16_max(float v) { v = fmaxf(v, dppf<0xB1>(v)); v = fmaxf(v, dppf<0x4E>(v)); v = fmaxf(v, dppf<0x141>(v)); v = fmaxf(v, dppf<0x140>(v)); return v; }
__device__ __forceinline__ unsigned row16_maxu(unsigned v) { unsigned t; t = dppu<0xB1>(v); v = v > t ? v : t; t = dppu<0x4E>(v); v = v > t ? v : t; t = dppu<0x141>(v); v = v > t ? v : t; t = dppu<0x140>(v); v = v > t ? v : t; return v; }
__device__ __forceinline__ unsigned fkey(float f) { unsigned u = __float_as_uint(f); if (f == 0.f) u = 0u; return (u & 0x80000000u) ? ~u : (u | 0x80000000u); }
__device__ __forceinline__ float fkey_inv(unsigned k) { const unsigned u = (k & 0x80000000u) ? (k & 0x7fffffffu) : ~k; return __uint_as_float(u); }

__device__ __forceinline__ bf16x8 ld_frag_g(const bf16_t* p) { return *(const bf16x8*)p; }
#define MFMA16(a, b, c) __builtin_amdgcn_mfma_f32_16x16x32_bf16((a), (b), (c), 0, 0, 0)

namespace pg8 {
struct EpiP {
    static constexpr bool PERM = true, AFTER_DRAIN = false;
    bf16_t *GQ, *GK, *GV, *GR, *PB, *PC;
    __device__ __forceinline__ void operator()(const f32x4 (&acc)[2][2][4][2], const Unit& u, int wr, int wc, int fr, int fq) const {
        const int pn = u.pn; bf16_t* base; int ldc, cb;
        if (pn == 0) { base = GQ; ldc = 256; cb = 0; } else if (pn == 1) { base = GK; ldc = 256; cb = 0; }
        else if (pn < 4) { base = GV; ldc = 512; cb = (pn - 2) * 256; } else if (pn < 6) { base = GR; ldc = 512; cb = (pn - 4) * 256; }
        else if (pn < 8) { base = PB; ldc = 512; cb = (pn - 6) * 256; } else { base = PC; ldc = 1792; cb = (pn - 8) * 256; }
        const int row0 = u.pm * BM + wr * 64 + fr, col0 = cb + wc * 32 + 8 * fq;
#pragma unroll
        for (int ai = 0; ai < 2; ++ai)
#pragma unroll
            for (int m = 0; m < 4; ++m) { bf16_t* rowp = base + (size_t)(row0 + ai * HALF + m * 16) * ldc + col0;
#pragma unroll
                for (int bj = 0; bj < 2; ++bj) { const f32x4 v0 = acc[ai][bj][m][0], v1 = acc[ai][bj][m][1];
                    u32x4 w; w.x = cvt_pk_bf16(v0[0], v0[1]); w.y = cvt_pk_bf16(v0[2], v0[3]); w.z = cvt_pk_bf16(v1[0], v1[1]); w.w = cvt_pk_bf16(v1[2], v1[3]);
                    *(u32x4*)(rowp + bj * HALF) = w; } }
    }
};
template <int SIG> struct EpiStore {
    static constexpr bool PERM = true, AFTER_DRAIN = false;
    bf16_t* O; int ldc;
    __device__ __forceinline__ void operator()(const f32x4 (&acc)[2][2][4][2], const Unit& u, int wr, int wc, int fr, int fq) const {
        const int row0 = u.pm * BM + wr * 64 + fr, col0 = u.pn * BM + wc * 32 + 8 * fq;
#pragma unroll
        for (int ai = 0; ai < 2; ++ai)
#pragma unroll
            for (int m = 0; m < 4; ++m) { bf16_t* rowp = O + (size_t)(row0 + ai * HALF + m * 16) * ldc + col0;
#pragma unroll
                for (int bj = 0; bj < 2; ++bj) { f32x4 v0 = acc[ai][bj][m][0], v1 = acc[ai][bj][m][1];
                    if (SIG) {
#pragma unroll
                        for (int j = 0; j < 4; ++j) { v0[j] = 1.0f / (1.0f + __expf(-v0[j])); v1[j] = 1.0f / (1.0f + __expf(-v1[j])); } }
                    u32x4 w; w.x = cvt_pk_bf16(v0[0], v0[1]); w.y = cvt_pk_bf16(v0[2], v0[3]); w.z = cvt_pk_bf16(v1[0], v1[1]); w.w = cvt_pk_bf16(v1[2], v1[3]);
                    *(u32x4*)(rowp + bj * HALF) = w; } }
    }
};
template <int FIRST> struct EpiMerge {
    static constexpr bool PERM = true, AFTER_DRAIN = false;
    const bf16_t* G; bf16_t* O; int ldc;
    __device__ __forceinline__ void operator()(const f32x4 (&acc)[2][2][4][2], const Unit& u, int wr, int wc, int fr, int fq) const {
        const int row0 = u.pm * BM + wr * 64 + fr, col0 = u.pn * BM + wc * 32 + 8 * fq;
#pragma unroll
        for (int ai = 0; ai < 2; ++ai)
#pragma unroll
            for (int m = 0; m < 4; ++m) { const size_t off = (size_t)(row0 + ai * HALF + m * 16) * ldc + col0;
#pragma unroll
                for (int bj = 0; bj < 2; ++bj) { const f32x4 v0 = acc[ai][bj][m][0], v1 = acc[ai][bj][m][1];
                    const u32x4 g = *(const u32x4*)(G + off + bj * HALF);
                    float o[8];
                    o[0] = __uint_as_float(g.x << 16) * v0[0]; o[1] = __uint_as_float(g.x & 0xffff0000u) * v0[1]; o[2] = __uint_as_float(g.y << 16) * v0[2]; o[3] = __uint_as_float(g.y & 0xffff0000u) * v0[3];
                    o[4] = __uint_as_float(g.z << 16) * v1[0]; o[5] = __uint_as_float(g.z & 0xffff0000u) * v1[1]; o[6] = __uint_as_float(g.w << 16) * v1[2]; o[7] = __uint_as_float(g.w & 0xffff0000u) * v1[3];
                    if (!FIRST) { const u32x4 p = *(const u32x4*)(O + off + bj * HALF);
                        o[0] += __uint_as_float(p.x << 16); o[1] += __uint_as_float(p.x & 0xffff0000u); o[2] += __uint_as_float(p.y << 16); o[3] += __uint_as_float(p.y & 0xffff0000u);
                        o[4] += __uint_as_float(p.z << 16); o[5] += __uint_as_float(p.z & 0xffff0000u); o[6] += __uint_as_float(p.w << 16); o[7] += __uint_as_float(p.w & 0xffff0000u); }
                    u32x4 w; w.x = cvt_pk_bf16(o[0], o[1]); w.y = cvt_pk_bf16(o[2], o[3]); w.z = cvt_pk_bf16(o[4], o[5]); w.w = cvt_pk_bf16(o[6], o[7]);
                    *(u32x4*)(O + off + bj * HALF) = w; } }
    }
};
struct EpiResid {
    static constexpr bool PERM = false, AFTER_DRAIN = false;
    const float* xin; float* xout; const float* gate;
    __device__ __forceinline__ void operator()(const f32x4 (&acc)[2][2][4][2], const Unit& u, int wr, int wc, int fr, int fq) const {
        const int row0 = u.pm * BM + wr * 64 + fr, col0 = u.pn * BM + wc * 32 + 4 * fq;
        const float* gp = gate + (size_t)((u.pm * BM) >> 13) * 6144;
        f32x4 gv[2][2];
#pragma unroll
        for (int bj = 0; bj < 2; ++bj)
#pragma unroll
            for (int n = 0; n < 2; ++n) gv[bj][n] = *(const f32x4*)(gp + col0 + bj * HALF + n * 16);
#pragma unroll
        for (int ai = 0; ai < 2; ++ai)
#pragma unroll
            for (int m = 0; m < 4; ++m) { const size_t off = (size_t)(row0 + ai * HALF + m * 16) * 1024 + col0;
#pragma unroll
                for (int bj = 0; bj < 2; ++bj)
#pragma unroll
                    for (int n = 0; n < 2; ++n) { const f32x4 xi = *(const f32x4*)(xin + off + bj * HALF + n * 16);
                        *(f32x4*)(xout + off + bj * HALF + n * 16) = xi + gv[bj][n] * acc[ai][bj][m][n]; } }
    }
};
}

template <class Epi> __device__ __forceinline__ void run_gemm(LASP unsigned char* lds, const bf16_t* A, const bf16_t* Bt, int M, int N, int K, const Epi& E, int wg, int nwg) {
    pg8::Gemm g; g.A = A; g.Bt = Bt; g.M = M; g.N = N; g.K = K;
    pg8::StaticOrder S; S.init(M, N, nwg, wg);
    pg8::gemm_phase<Epi, pg8::StaticOrder, false>(lds, g, S, E, nullptr);
    __syncthreads();
}

__device__ __forceinline__ int pmap(int n) {
    if (n < 1024) return n;
    if (n < 1536) return 1040 + (n - 1024);
    if (n < 1792) return 1552 + (n - 1536);
    if (n < 1920) return 1808 + (n - 1792);
    if (n < 1984) return 1936 + (n - 1920);
    if (n < 2000) return 1024 + (n - 1984);
    if (n < 2004) return 2000 + (n - 2000);
    if (n < 2048) return -1;
    return 2004 + (n - 2048);
}
__device__ __forceinline__ void tcvt_tile(const float* src, int ldsrc, bf16_t* dst, int K, int n0, int k0, int mode, LASP float* tile) {
    const int tid = threadIdx.x, j = tid & 63, i = tid >> 6;
    const int n = n0 + j; const int c = mode == 0 ? n : (mode == 1 ? pmap(n) : n + 3796);
#pragma unroll
    for (int ii = 0; ii < 8; ++ii) { const int kk = ii * 8 + i; tile[kk * 65 + j] = c >= 0 ? src[(size_t)(k0 + kk) * ldsrc + c] : 0.f; }
    __syncthreads();
#pragma unroll
    for (int it = 0; it < 8; ++it) { const int jj = it * 8 + (tid >> 6), kk = tid & 63; dst[(size_t)(n0 + jj) * K + k0 + kk] = f2bf(tile[kk * 65 + jj]); }
    __syncthreads();
}
constexpr int W_TILES_L = 960 + 768 + 384 + 256 + 256 + 64 + 16 + 16 + 8 + 8 + 16;
constexpr int W_TILES = W_TILES_L * NLAYER, W_MOD_UNITS = 384, W_PK_UNITS = 128;
__device__ void phase_weights(const Params& p, LASP unsigned char* lds, int wg, int nwg) {
    LASP float* tile = (LASP float*)lds;
    const int tid = threadIdx.x;
    for (int id = wg; id < W_TILES; id += nwg) {
        const int l = id / W_TILES_L; int t = id % W_TILES_L;
        if (t < 960) { tcvt_tile(p.w_in + (size_t)l * 1024 * IN_W, IN_W, p.win_t + (size_t)l * 3840 * 1024, 1024, (t % 60) * 64, (t / 60) * 64, 1, tile); continue; } t -= 960;
        if (t < 768) { tcvt_tile(p.w_in + (size_t)l * 1024 * IN_W, IN_W, p.wg_t + (size_t)l * 3072 * 1024, 1024, (t % 48) * 64, (t / 48) * 64, 2, tile); continue; } t -= 768;
        if (t < 384) { const int j = t / 128, r = t % 128; tcvt_tile(p.w_branch + (size_t)(l * 3 + j) * 512 * 1024, 1024, p.wb_t + (size_t)(l * 3 + j) * 1024 * 512, 512, (r % 16) * 64, (r / 16) * 64, 0, tile); continue; } t -= 384;
        if (t < 256) { tcvt_tile(p.w_out + (size_t)l * 1024 * 1024, 1024, p.wo_t + (size_t)l * 1024 * 1024, 1024, (t % 16) * 64, (t / 16) * 64, 0, tile); continue; } t -= 256;
        if (t < 256) { tcvt_tile(p.peer_w_q + (size_t)l * 1024 * 1024, 1024, p.wq_t + (size_t)l * 1024 * 1024, 1024, (t % 16) * 64, (t / 16) * 64, 0, tile); continue; } t -= 256;
        if (t < 64) { tcvt_tile(p.dsa_w_uq + (size_t)l * 256 * 1024, 1024, p.wuq_t + (size_t)l * 1024 * 256, 256, (t % 16) * 64, (t / 16) * 64, 0, tile); continue; } t -= 64;
        if (t < 16) { tcvt_tile(p.dsa_w_iq + (size_t)l * 256 * 256, 256, p.wiq_t + (size_t)l * 256 * 256, 256, (t % 4) * 64, (t / 4) * 64, 0, tile); continue; } t -= 16;
        if (t < 16) { const int h = t / 2, kt = t % 2; tcvt_tile(p.dsa_w_uv + (size_t)(l * 8 + h) * 128 * 64, 64, p.wuv_t + (size_t)(l * 8 + h) * 64 * 128, 128, 0, kt * 64, 0, tile); continue; } t -= 16;
        if (t < 8) { tcvt_tile(p.rw_w_w2 + (size_t)l * 64 * 512, 512, p.ww2_t + (size_t)l * 512 * 64, 64, t * 64, 0, 0, tile); continue; } t -= 8;
        if (t < 8) { tcvt_tile(p.rw_w_a2 + (size_t)l * 64 * 512, 512, p.wa2_t + (size_t)l * 512 * 64, 64, t * 64, 0, 0, tile); continue; } t -= 8;
        tcvt_tile(p.rw_w_g2 + (size_t)l * 128 * 512, 512, p.wg2_t + (size_t)l * 512 * 128, 128, (t % 8) * 64, (t / 8) * 64, 0, tile);
    }
    for (int u = wg; u < W_PK_UNITS; u += nwg) {
        const size_t e = (size_t)u * 4096 + (size_t)tid * 8;
        const f32x4 a = *(const f32x4*)(p.peer_keys + e), b = *(const f32x4*)(p.peer_keys + e + 4);
        u32x4 w; w.x = pk_bf16(a[0], a[1]); w.y = pk_bf16(a[2], a[3]); w.z = pk_bf16(b[0], b[1]); w.w = pk_bf16(b[2], b[3]);
        *(u32x4*)(p.pkeys + e) = w;
    }
    bool have = false;
    for (int u = wg; u < W_MOD_UNITS; u += nwg) {
        LASP float* cond = (LASP float*)lds;
        LASP float* red = (LASP float*)(lds + 32768);
        if (!have) { for (int i = tid; i < 8 * 1024; i += NTHR) cond[i] = siluf_(p.c[i]); have = true; }
        __syncthreads();
        const int l = u / 96, cb = u % 96, col = cb * 64 + (tid & 63), ks = tid >> 6;
        float acc[8];
#pragma unroll
        for (int b = 0; b < 8; ++b) acc[b] = 0.f;
        const float* wp = p.w_ada + (size_t)l * 1024 * 6144 + col;
        for (int k = ks * 128; k < ks * 128 + 128; ++k) { const float w = wp[(size_t)k * 6144];
#pragma unroll
            for (int b = 0; b < 8; ++b) acc[b] = fmaf(w, cond[b * 1024 + k], acc[b]); }
#pragma unroll
        for (int b = 0; b < 8; ++b) red[(ks * 8 + b) * 64 + (tid & 63)] = acc[b];
        __syncthreads();
        { const int b = tid >> 6, cc = tid & 63; float s = 0.f;
#pragma unroll
          for (int k2 = 0; k2 < 8; ++k2) s += red[(k2 * 8 + b) * 64 + cc];
          p.mod[((size_t)l * 8 + b) * 6144 + cb * 64 + cc] = s + p.b_ada[(size_t)l * 6144 + cb * 64 + cc]; }
        __syncthreads();
    }
}

__device__ void phase_adaln(const float* x, const float* g, const float* modl  , int sh_off, int sc_off, bf16_t* h, int wg, int nwg) {
    const int lane = threadIdx.x & 63, wave = threadIdx.x >> 6;
    for (int tok = wg * 8 + wave; tok < NTOK; tok += nwg * 8) {
        const f32x4* xr = (const f32x4*)(x + (size_t)tok * 1024);
        f32x4 v[4]; float ss = 0.f;
#pragma unroll
        for (int i = 0; i < 4; ++i) { v[i] = xr[lane + 64 * i]; ss += v[i][0] * v[i][0] + v[i][1] * v[i][1] + v[i][2] * v[i][2] + v[i][3] * v[i][3]; }
        ss = wave_sum(ss);
        const float rstd = rsqrtf(ss * (1.0f / 1024.0f) + 1e-6f);
        const float* mb = modl + (size_t)(tok >> 13) * 6144;
#pragma unroll
        for (int i = 0; i < 4; ++i) { const int col = 4 * (lane + 64 * i);
            const f32x4 gg = *(const f32x4*)(g + col), sc = *(const f32x4*)(mb + sc_off + col), sh = *(const f32x4*)(mb + sh_off + col);
            f32x4 o = (v[i] * rstd) * gg; o = o * (sc + 1.0f) + sh;
            u32x2 w; w.x = pk_bf16(o[0], o[1]); w.y = pk_bf16(o[2], o[3]);
            *(u32x2*)(h + (size_t)tok * 1024 + col) = w; }
    }
}
__device__ void phase_final(float* x, const float* g, int wg, int nwg) {
    const int lane = threadIdx.x & 63, wave = threadIdx.x >> 6;
    for (int tok = wg * 8 + wave; tok < NTOK; tok += nwg * 8) {
        f32x4* xr = (f32x4*)(x + (size_t)tok * 1024);
        f32x4 v[4]; float ss = 0.f;
#pragma unroll
        for (int i = 0; i < 4; ++i) { v[i] = xr[lane + 64 * i]; ss += v[i][0] * v[i][0] + v[i][1] * v[i][1] + v[i][2] * v[i][2] + v[i][3] * v[i][3]; }
        ss = wave_sum(ss);
        const float rstd = rsqrtf(ss * (1.0f / 1024.0f) + 1e-6f);
#pragma unroll
        for (int i = 0; i < 4; ++i) { const f32x4 gg = *(const f32x4*)(g + 4 * (lane + 64 * i)); xr[lane + 64 * i] = (v[i] * rstd) * gg; }
    }
}

__device__ void phase_gla1(const Params& p, int l, LASP unsigned char* lds, int wg, int nwg) {
    LASP float* alr = (LASP float*)lds;
    LASP float* part = (LASP float*)(lds + 4096);
    LASP bf16_t* kdT = (LASP bf16_t*)(lds + 8192);
    LASP bf16_t* vT = (LASP bf16_t*)(lds + 8192 + 9216);
    const int tid = threadIdx.x, lane = tid & 63, wave = tid >> 6;
    for (int u = wg; u < NB * NCHUNK * 4; u += nwg) {
        const int h = u & 3, c = (u >> 2) & 127, b = u >> 9; const size_t t0 = (size_t)b * SEQ + (size_t)c * 64;
        for (int i = tid; i < 64 * 16; i += NTHR) alr[i] = bf2f(p.PB[(t0 + (i >> 4)) * PB_LD + PB_GALR + (i & 15)]);
        { const int t = tid >> 3, vq = tid & 7; const bf16_t* vp = p.GV + (t0 + t) * 512 + h * 128 + vq * 16;
          const u32x4 a = *(const u32x4*)vp, bq = *(const u32x4*)(vp + 8);
          const unsigned w[8] = {a.x, a.y, a.z, a.w, bq.x, bq.y, bq.z, bq.w};
#pragma unroll
          for (int j = 0; j < 8; ++j) { vT[(vq * 16 + 2 * j) * 72 + t] = (bf16_t)(w[j] & 0xffffu); vT[(vq * 16 + 2 * j + 1) * 72 + t] = (bf16_t)(w[j] >> 16); } }
        const int k = tid & 63, tq = tid >> 6;
        float wa[16];
#pragma unroll
        for (int r = 0; r < 16; ++r) wa[r] = p.gla_w_a2[((size_t)l * 16 + r) * 256 + h * 64 + k];
        const float ba = p.gla_b_a[(size_t)l * 256 + h * 64 + k];
        __syncthreads();
        float cum[8]; float run = 0.f;
#pragma unroll
        for (int i = 0; i < 8; ++i) { const int t = tq * 8 + i; float g = ba;
#pragma unroll
            for (int r = 0; r < 16; ++r) g = fmaf(alr[t * 16 + r], wa[r], g);
            const float ls = fminf(g, 0.f) - log1pf(__expf(-fabsf(g)));
            run += ls * (1.0f / 16.0f); cum[i] = run; }
        part[tq * 64 + k] = run;
        __syncthreads();
        float off = 0.f, tot = 0.f;
#pragma unroll
        for (int q = 0; q < 8; ++q) { const float v = part[q * 64 + k]; tot += v; if (q < tq) off += v; }
#pragma unroll
        for (int i = 0; i < 8; ++i) { const int t = tq * 8 + i; const float kv = bf2f(p.GK[(t0 + t) * 256 + h * 64 + k]);
            kdT[k * 72 + t] = f2bf(kv * __expf(tot - (off + cum[i]))); }
        if (tq == 0) p.gdec[(size_t)u * 64 + k] = __expf(tot);
        __syncthreads();
        { const int fr = lane & 15, fq = lane >> 4;
          bf16x8 bfr[2];
#pragma unroll
          for (int ks = 0; ks < 2; ++ks) bfr[ks] = *(const LASP bf16x8*)(vT + (wave * 16 + fr) * 72 + ks * 32 + fq * 8);
          bf16_t* gs = p.GS + (size_t)u * 8192 + (size_t)(wave * 16 + fr) * 64;
#pragma unroll
          for (int mt = 0; mt < 4; ++mt) { f32x4 acc = {0.f, 0.f, 0.f, 0.f};
#pragma unroll
              for (int ks = 0; ks < 2; ++ks) { const bf16x8 afr = *(const LASP bf16x8*)(kdT + (mt * 16 + fr) * 72 + ks * 32 + fq * 8); acc = MFMA16(afr, bfr[ks], acc); }
              u32x2 w; w.x = pk_bf16(acc[0], acc[1]); w.y = pk_bf16(acc[2], acc[3]);
              *(u32x2*)(gs + mt * 16 + fq * 4) = w; } }
        __syncthreads();
    }
}
__device__ void phase_gla2(const Params& p, int wg, int nwg) {
    for (int e = wg * NTHR + threadIdx.x; e < NB * 4 * 128 * 32; e += nwg * NTHR) {
        const int kp = e & 31, v = (e >> 5) & 127, h = (e >> 12) & 3, b = e >> 14;
        float s0 = 0.f, s1 = 0.f;
        for (int c0 = 0; c0 < NCHUNK; c0 += 4) {
            unsigned uv[4]; f32x2 dv[4];
#pragma unroll
            for (int j = 0; j < 4; ++j) { const size_t u = ((size_t)b * NCHUNK + c0 + j) * 4 + h; uv[j] = *(const unsigned*)(p.GS + u * 8192 + v * 64 + 2 * kp); dv[j] = *(const f32x2*)(p.gdec + u * 64 + 2 * kp); }
#pragma unroll
            for (int j = 0; j < 4; ++j) { const size_t u = ((size_t)b * NCHUNK + c0 + j) * 4 + h;
                s0 = fmaf(dv[j][0], s0, bflo(uv[j])); s1 = fmaf(dv[j][1], s1, bfhi(uv[j]));
                *(unsigned*)(p.GS + u * 8192 + v * 64 + 2 * kp) = pk_bf16(s0, s1); }
        }
    }
}
__device__ void phase_gla3(const Params& p, int l, LASP unsigned char* lds, int wg, int nwg) {
    LASP float* ssq = (LASP float*)lds;
    const int tid = threadIdx.x, lane = tid & 63, wave = tid >> 6, fr = lane & 15, fq = lane >> 4;
    const int nt = wave & 3, vh = wave >> 2;
    for (int u = wg; u < NB * NCHUNK * 4; u += nwg) {
        const int h = u & 3, c = (u >> 2) & 127, b = u >> 9; const size_t t0 = (size_t)b * SEQ + (size_t)c * 64;
        bf16x8 bq[2];
#pragma unroll
        for (int ks = 0; ks < 2; ++ks) bq[ks] = ld_frag_g(p.GQ + (t0 + nt * 16 + fr) * 256 + h * 64 + ks * 32 + fq * 8);
        f32x4 acc[4];
#pragma unroll
        for (int mi = 0; mi < 4; ++mi) { acc[mi] = (f32x4){0.f, 0.f, 0.f, 0.f};
#pragma unroll
            for (int ks = 0; ks < 2; ++ks) { const bf16x8 a = ld_frag_g(p.GS + (size_t)u * 8192 + (size_t)((vh * 4 + mi) * 16 + fr) * 64 + ks * 32 + fq * 8); acc[mi] = MFMA16(a, bq[ks], acc[mi]); } }
        float ss = 0.f;
#pragma unroll
        for (int mi = 0; mi < 4; ++mi) ss += acc[mi][0] * acc[mi][0] + acc[mi][1] * acc[mi][1] + acc[mi][2] * acc[mi][2] + acc[mi][3] * acc[mi][3];
        ss += __shfl_xor(ss, 16); ss += __shfl_xor(ss, 32);
        if (fq == 0) ssq[vh * 64 + nt * 16 + fr] = ss;
        __syncthreads();
        const float tot = ssq[nt * 16 + fr] + ssq[64 + nt * 16 + fr];
        const float sc = 0.125f * rsqrtf(tot * (1.0f / 8192.0f) + 1e-6f);
        const size_t trow = t0 + nt * 16 + fr;
#pragma unroll
        for (int mi = 0; mi < 4; ++mi) { const int v0 = (vh * 4 + mi) * 16 + fq * 4;
            const u32x2 rr = *(const u32x2*)(p.GR + trow * 512 + h * 128 + v0);
            const f32x4 go = *(const f32x4*)(p.gla_g_o + (size_t)l * 128 + v0);
            const float o0 = acc[mi][0] * sc * go[0] * siluf_(bflo(rr.x)), o1 = acc[mi][1] * sc * go[1] * siluf_(bfhi(rr.x));
            const float o2 = acc[mi][2] * sc * go[2] * siluf_(bflo(rr.y)), o3 = acc[mi][3] * sc * go[3] * siluf_(bfhi(rr.y));
            u32x2 w; w.x = pk_bf16(o0, o1); w.y = pk_bf16(o2, o3);
            *(u32x2*)(p.ya + trow * 512 + h * 128 + v0) = w; }
        __syncthreads();
    }
}

__device__ void phase_dsa1(const Params& p, int l, int wg, int nwg) {
    const int lane = threadIdx.x & 63, wave = threadIdx.x >> 6;
    for (int tok = wg * 8 + wave; tok < NTOK; tok += nwg * 8) {
        const bf16_t* row = p.PB + (size_t)tok * PB_LD;
        const u32x2 q = *(const u32x2*)(row + PB_QC + 4 * lane);
        const unsigned kv = *(const unsigned*)(row + PB_KVC + 2 * lane);
        const float q0 = bflo(q.x), q1 = bfhi(q.x), q2 = bflo(q.y), q3 = bfhi(q.y), k0 = bflo(kv), k1 = bfhi(kv);
        const float sq = wave_sum(q0 * q0 + q1 * q1 + q2 * q2 + q3 * q3), sk = wave_sum(k0 * k0 + k1 * k1);
        const float rq = rsqrtf(sq * (1.0f / 256.0f) + 1e-6f), rk = rsqrtf(sk * (1.0f / 128.0f) + 1e-6f);
        const f32x4 gq = *(const f32x4*)(p.dsa_g_qc + (size_t)l * 256 + 4 * lane); const f32x2 gk = *(const f32x2*)(p.dsa_g_kv + (size_t)l * 128 + 2 * lane);
        u32x2 w; w.x = pk_bf16(q0 * rq * gq[0], q1 * rq * gq[1]); w.y = pk_bf16(q2 * rq * gq[2], q3 * rq * gq[3]);
        *(u32x2*)(p.qn + (size_t)tok * 256 + 4 * lane) = w;
        *(unsigned*)(p.kvn + (size_t)tok * 128 + 2 * lane) = pk_bf16(k0 * rk * gk[0], k1 * rk * gk[1]);
    }
}

constexpr int D_HIST = 0, D_SEL = 65536, D_OT = 73728, D_CTL = 106752, D_OT_LD = 1032;
__device__ __forceinline__ unsigned lds_add(LASP unsigned* p, unsigned v) { return __hip_atomic_fetch_add(p, v, __ATOMIC_RELAXED, __HIP_MEMORY_SCOPE_WORKGROUP); }
struct DsaQ { bf16x8 qa[4][2]; float wq[4][4]; };

__device__ __forceinline__ void dsa_score_tile(const DsaQ& Q, const bf16_t* ikbase  , int fr, int fq, float (&sc)[4]) {
    const bf16_t* kp = ikbase + (size_t)fr * PB_LD + fq * 8;
    const bf16x8 kb0 = ld_frag_g(kp), kb1 = ld_frag_g(kp + 32);
    sc[0] = 0.f; sc[1] = 0.f; sc[2] = 0.f; sc[3] = 0.f;
#pragma unroll
    for (int hh = 0; hh < 4; ++hh) { f32x4 d = {0.f, 0.f, 0.f, 0.f}; d = MFMA16(Q.qa[hh][0], kb0, d); d = MFMA16(Q.qa[hh][1], kb1, d);
#pragma unroll
        for (int r = 0; r < 4; ++r) sc[r] = fmaf(Q.wq[r][hh], fmaxf(d[r], 0.f), sc[r]); }
}
__device__ __forceinline__ void wave_find_bin(const LASP unsigned* hist, unsigned need, int lane, unsigned& bin_out, unsigned& above_out, unsigned& inbin_out) {
    unsigned loc = 0;
#pragma unroll
    for (int j = 0; j < 16; ++j) { const unsigned w = hist[1023 - 16 * lane - j]; loc += (w & 0xffffu) + (w >> 16); }
    unsigned incl = loc;
#pragma unroll
    for (int o = 1; o < 64; o <<= 1) { const unsigned t = __shfl_up(incl, o); if (lane >= o) incl += t; }
    const unsigned excl = incl - loc;
    const bool mine = (excl < need) && (incl >= need);
    const unsigned long long m = __ballot(mine);
    const int L = m ? (int)__builtin_ctzll(m) : 63;
    const unsigned base = (unsigned)__shfl((int)excl, L);
    unsigned c2 = 0; const unsigned bin = 2047u - 32u * (unsigned)L - (unsigned)(lane & 31);
    { const unsigned w = hist[bin >> 1]; c2 = (bin & 1u) ? (w >> 16) : (w & 0xffffu); if (lane >= 32) c2 = 0; }
    unsigned inc2 = c2;
#pragma unroll
    for (int o = 1; o < 64; o <<= 1) { const unsigned t = __shfl_up(inc2, o); if (lane >= o) inc2 += t; }
    const unsigned ex2 = inc2 - c2;
    const bool mine2 = (lane < 32) && (base + ex2 < need) && (base + inc2 >= need);
    const unsigned long long m2 = __ballot(mine2);
    const int L2 = m2 ? (int)__builtin_ctzll(m2) : 31;
    bin_out = 2047u - 32u * (unsigned)L - (unsigned)L2;
    above_out = base + (unsigned)__shfl((int)ex2, L2);
    inbin_out = (unsigned)__shfl((int)c2, L2);
}

__device__ void phase_dsa34(const Params& p, int l, LASP unsigned char* lds, int wg, int nwg) {
    LASP unsigned* hist = (LASP unsigned*)(lds + D_HIST);
    LASP unsigned short* sel = (LASP unsigned short*)(lds + D_SEL);
    LASP bf16_t* Ot = (LASP bf16_t*)(lds + D_OT);
    LASP unsigned* ctl = (LASP unsigned*)(lds + D_CTL);
    const int tid = threadIdx.x, lane = tid & 63, wave = tid >> 6, fr = lane & 15, fq = lane >> 4;
    for (int pos = wg; pos < 4096; pos += nwg) {
        const int blk = 7 - (pos >> 9), qq = pos & 511; const int uid = blk * 512 + (qq < 256 ? qq : 767 - qq);
        const int sub = uid & 3, b = (uid >> 2) & 7, c = uid >> 5;
        const int n = 64 * (c + 1); const size_t krow0 = (size_t)b * SEQ; const size_t t0 = krow0 + (size_t)c * 64 + sub * 16;
        if (tid < 128) ctl[tid] = 0u;
        if (n <= 256) {
            for (int i = tid; i < 16 * 256; i += NTHR) sel[i] = (unsigned short)(i & 255);
            __syncthreads();
            if (tid < 16) ctl[tid] = (unsigned)n;
            __syncthreads();
        } else {
            DsaQ Q;
#pragma unroll
            for (int hh = 0; hh < 4; ++hh)
#pragma unroll
                for (int ks = 0; ks < 2; ++ks) Q.qa[hh][ks] = ld_frag_g(p.qi + (t0 + fr) * 256 + hh * 64 + ks * 32 + fq * 8);
#pragma unroll
            for (int r = 0; r < 4; ++r) { const u32x2 w = *(const u32x2*)(p.PB + (t0 + fq * 4 + r) * PB_LD + PB_IW);
                Q.wq[r][0] = bflo(w.x); Q.wq[r][1] = bfhi(w.x); Q.wq[r][2] = bflo(w.y); Q.wq[r][3] = bfhi(w.y); }
            const bf16_t* ik0 = p.PB + krow0 * PB_LD + PB_IK;
            const int ntile = n >> 4;
            for (int pass = 0; pass < 3; ++pass) {
                for (int i = tid; i < 16 * 1024; i += NTHR) hist[i] = 0u;
                __syncthreads();
                for (int kt = wave; kt < ntile; kt += 8) {
                    float sc[4]; dsa_score_tile(Q, ik0 + (size_t)kt * 16 * PB_LD, fr, fq, sc);
#pragma unroll
                    for (int r = 0; r < 4; ++r) { const int q = fq * 4 + r; const unsigned key = fkey(sc[r]); unsigned bin; bool on;
                        if (pass == 0) { bin = key >> 21; on = true; }
                        else if (pass == 1) { bin = (key >> 10) & 0x7ffu; on = (key >> 21) == ctl[16 + q]; }
                        else { bin = key & 0x3ffu; on = (key >> 10) == ctl[16 + q]; }
                        if (on) lds_add(&hist[q * 1024 + (bin >> 1)], (bin & 1u) ? 65536u : 1u); }
                }
                __syncthreads();
#pragma unroll
                for (int qi2 = 0; qi2 < 2; ++qi2) { const int q = wave * 2 + qi2;
                    const unsigned need = pass == 0 ? 256u : ctl[32 + q];
                    unsigned bin, above, inbin; wave_find_bin(hist + q * 1024, need, lane, bin, above, inbin);
                    if (lane == 0) { const unsigned pre = pass == 0 ? 0u : ctl[16 + q];
                        ctl[16 + q] = pass == 0 ? bin : (pass == 1 ? ((pre << 11) | bin) : ((pre << 10) | bin));
                        ctl[32 + q] = need - above;
                        if (pass == 2) { const unsigned fl = (need - above < inbin) ? 1u : 0u; ctl[48 + q] = fl; if (fl) ctl[96] = 1u; } } }
                __syncthreads();
            }
            if (ctl[96]) {
                for (int i = tid; i < 16 * 1024; i += NTHR) hist[i] = 0u;
                __syncthreads();
                for (int kt = wave; kt < ntile; kt += 8) {
                    float sc[4]; dsa_score_tile(Q, ik0 + (size_t)kt * 16 * PB_LD, fr, fq, sc);
#pragma unroll
                    for (int r = 0; r < 4; ++r) { const int q = fq * 4 + r; const unsigned key = fkey(sc[r]);
                        if (ctl[48 + q] && key == ctl[16 + q]) { const unsigned s = (unsigned)(kt * 16 + fr); const unsigned bin = 2047u - (s >> 2); lds_add(&hist[q * 1024 + (bin >> 1)], (bin & 1u) ? 65536u : 1u); } }
                }
                __syncthreads();
#pragma unroll
                for (int qi2 = 0; qi2 < 2; ++qi2) { const int q = wave * 2 + qi2;
                    if (ctl[48 + q]) { unsigned bin, above, inbin; wave_find_bin(hist + q * 1024, ctl[32 + q], lane, bin, above, inbin);
                        if (lane == 0) { ctl[64 + q] = bin; ctl[80 + q] = ctl[32 + q] - above; } } }
                __syncthreads();
            }
            LASP unsigned short* msk = (LASP unsigned short*)(lds + D_OT);
            for (int kt = wave; kt < ntile; kt += 8) {
                float sc[4]; dsa_score_tile(Q, ik0 + (size_t)kt * 16 * PB_LD, fr, fq, sc);
#pragma unroll
                for (int r = 0; r < 4; ++r) { const int q = fq * 4 + r; const unsigned key = fkey(sc[r]); const unsigned thr = ctl[16 + q];
                    const unsigned s = (unsigned)(kt * 16 + fr);
                    bool take = key > thr; const bool eq = key == thr; const bool fl = ctl[48 + q] != 0u;
                    if (!fl) take = take || eq;
                    const unsigned ibin = 2047u - (s >> 2), tb = ctl[64 + q];
                    const bool eqb = eq && fl && (ibin == tb);
                    const unsigned long long em = __ballot(eqb);
                    if (eq && fl) {
                        if (ibin > tb) take = true;
                        else if (ibin == tb) { const unsigned long long low = em & (((1ull << lane) - 1ull) & ~((1ull << (lane & ~3)) - 1ull)); take = (unsigned)__popcll(low) < ctl[80 + q]; } }
                    const unsigned long long tm = __ballot(take);
                    if (fr == 0) msk[q * 512 + kt] = (unsigned short)((tm >> (16 * fq)) & 0xffffull); }
            }
            __syncthreads();
#pragma unroll 1
            for (int qi2 = 0; qi2 < 2; ++qi2) { const int q = wave * 2 + qi2;
                unsigned c8 = 0;
#pragma unroll
                for (int i = 0; i < 8; ++i) { const int kt = lane * 8 + i; const unsigned m = kt < ntile ? (unsigned)msk[q * 512 + kt] : 0u; c8 += (unsigned)__popc(m); }
                unsigned incl = c8;
#pragma unroll
                for (int o = 1; o < 64; o <<= 1) { const unsigned t = __shfl_up(incl, o); if (lane >= o) incl += t; }
                unsigned pos2 = incl - c8;
#pragma unroll 1
                for (int i = 0; i < 8; ++i) { const int kt = lane * 8 + i; unsigned m = kt < ntile ? (unsigned)msk[q * 512 + kt] : 0u;
                    while (m) { const unsigned bb = (unsigned)__builtin_ctz(m); m &= m - 1u; if (pos2 < 256u) sel[q * 256 + pos2] = (unsigned short)(kt * 16 + bb); ++pos2; } }
                if (lane == 63) ctl[q] = incl > 256u ? 256u : incl; }
            __syncthreads();
        }
        LASP float* Pw = (LASP float*)(lds + D_HIST) + wave * 2048;
#pragma unroll 1
        for (int qi2 = 0; qi2 < 2; ++qi2) {
            const int q = wave * 2 + qi2; const size_t trow = t0 + q;
            unsigned cnt = ctl[q]; cnt = cnt > 256u ? 256u : cnt;
            bf16x8 qa[4];
#pragma unroll
            for (int ks = 0; ks < 4; ++ks) qa[ks] = ld_frag_g(p.qd + trow * 1024 + (fr & 7) * 128 + ks * 32 + fq * 8);
            float lg[16][4];
#pragma unroll
            for (int jt = 0; jt < 16; ++jt) {
                if ((unsigned)(jt * 16) < cnt) {
                    const unsigned j = (unsigned)(jt * 16 + fr); const unsigned idx = j < cnt ? (unsigned)sel[q * 256 + j] : 0u;
                    const bf16_t* kr = p.kvn + (krow0 + idx) * 128 + fq * 8;
                    f32x4 d = {0.f, 0.f, 0.f, 0.f};
#pragma unroll
                    for (int ks = 0; ks < 4; ++ks) d = MFMA16(qa[ks], ld_frag_g(kr + ks * 32), d);
#pragma unroll
                    for (int r = 0; r < 4; ++r) lg[jt][r] = j < cnt ? d[r] * 0.08838834764831845f : -INFINITY;
                } else {
#pragma unroll
                    for (int r = 0; r < 4; ++r) lg[jt][r] = -INFINITY;
                }
            }
            float mx[4], sm[4];
#pragma unroll
            for (int r = 0; r < 4; ++r) { float m = lg[0][r];
#pragma unroll
                for (int jt = 1; jt < 16; ++jt) m = fmaxf(m, lg[jt][r]);
                mx[r] = row16_max(m); sm[r] = 0.f; }
#pragma unroll
            for (int jt = 0; jt < 16; ++jt)
#pragma unroll
                for (int r = 0; r < 4; ++r) { const float e = __expf(lg[jt][r] - mx[r]); lg[jt][r] = e; sm[r] += e; }
#pragma unroll
            for (int r = 0; r < 4; ++r) sm[r] = 1.0f / row16_sum(sm[r]);
            if (fq < 2) {
#pragma unroll
                for (int jt = 0; jt < 16; ++jt) { f32x4 pv; pv[0] = lg[jt][0] * sm[0]; pv[1] = lg[jt][1] * sm[1]; pv[2] = lg[jt][2] * sm[2]; pv[3] = lg[jt][3] * sm[3];
                    *(LASP f32x4*)(Pw + (jt * 16 + fr) * 8 + fq * 4) = pv; }
            }
            asm volatile("s_waitcnt lgkmcnt(0)" ::: "memory");
            float o0[8], o1[8];
#pragma unroll
            for (int hh = 0; hh < 8; ++hh) { o0[hh] = 0.f; o1[hh] = 0.f; }
            for (unsigned j0 = 0; j0 < cnt; j0 += 4) {
                unsigned kvw[4];
#pragma unroll
                for (int jj = 0; jj < 4; ++jj) { const unsigned j = j0 + jj; const unsigned idx = j < cnt ? (unsigned)sel[q * 256 + j] : 0u; kvw[jj] = *(const unsigned*)(p.kvn + (krow0 + idx) * 128 + 2 * lane); }
#pragma unroll
                for (int jj = 0; jj < 4; ++jj) { const unsigned j = j0 + jj;
                    if (j < cnt) { const f32x4 pa = *(const LASP f32x4*)(Pw + j * 8), pb = *(const LASP f32x4*)(Pw + j * 8 + 4); const float lo = bflo(kvw[jj]), hi = bfhi(kvw[jj]);
#pragma unroll
                        for (int hh = 0; hh < 4; ++hh) { o0[hh] = fmaf(pa[hh], lo, o0[hh]); o1[hh] = fmaf(pa[hh], hi, o1[hh]); o0[4 + hh] = fmaf(pb[hh], lo, o0[4 + hh]); o1[4 + hh] = fmaf(pb[hh], hi, o1[4 + hh]); } } }
            }
#pragma unroll
            for (int hh = 0; hh < 8; ++hh) *(LASP unsigned*)(Ot + q * D_OT_LD + hh * 128 + 2 * lane) = pk_bf16(o0[hh], o1[hh]);
        }
        __syncthreads();
        { const bf16_t* wu = p.wuv_t + ((size_t)l * 8 + wave) * 64 * 128;
          bf16x8 oa[4];
#pragma unroll
          for (int ks = 0; ks < 4; ++ks) oa[ks] = *(const LASP bf16x8*)(Ot + fr * D_OT_LD + wave * 128 + ks * 32 + fq * 8);
#pragma unroll
          for (int nt = 0; nt < 4; ++nt) { f32x4 d = {0.f, 0.f, 0.f, 0.f};
#pragma unroll
              for (int ks = 0; ks < 4; ++ks) d = MFMA16(oa[ks], ld_frag_g(wu + (size_t)(nt * 16 + fr) * 128 + ks * 32 + fq * 8), d);
#pragma unroll
              for (int r = 0; r < 4; ++r) p.yb[(t0 + fq * 4 + r) * 512 + wave * 64 + nt * 16 + fr] = f2bf(d[r]); } }
        __syncthreads();
    }
}

constexpr int R_W = 0, R_A = 8192, R_B = 16384, R_K2 = 24576, R_R = 32768, R_V = 40960, R_Y = 43008, R_KT = 45056, R_PW = 53248, R_PA = 57856;
__device__ __forceinline__ f32x4 lerp4(u32x2 cur, u32x2 prv, f32x4 mu) {
    f32x4 c = {bflo(cur.x), bfhi(cur.x), bflo(cur.y), bfhi(cur.y)}, q = {bflo(prv.x), bfhi(prv.x), bflo(prv.y), bfhi(prv.y)};
    return c + (q - c) * mu;
}
__device__ void phase_rwkv_scan(const Params& p, int l, LASP unsigned char* lds, int wg, int nwg) {
    LASP float* sW = (LASP float*)(lds + R_W); LASP float* sA = (LASP float*)(lds + R_A); LASP float* sB = (LASP float*)(lds + R_B);
    LASP float* sK2 = (LASP float*)(lds + R_K2); LASP float* sR = (LASP float*)(lds + R_R); LASP float* sV = (LASP float*)(lds + R_V);
    LASP float* sY = (LASP float*)(lds + R_Y); LASP float* sKt = (LASP float*)(lds + R_KT);
    LASP bf16_t* sPw = (LASP bf16_t*)(lds + R_PW); LASP bf16_t* sPa = (LASP bf16_t*)(lds + R_PA);
    const int tid = threadIdx.x, lane = tid & 63, wave = tid >> 6, fr = lane & 15, fq = lane >> 4;
    for (int u = wg; u < NB * 8 * 4; u += nwg) {
        const int rg = u & 3, h = (u >> 2) & 7, b = u >> 5;
        const size_t row0 = (size_t)b * SEQ;
        const int pt = tid >> 4, cq = tid & 15;
        const float* mu = p.rw_mu + (size_t)l * 1792;
        const f32x4 mu_r = *(const f32x4*)(mu + PC_R + h * 64 + 4 * cq), mu_k = *(const f32x4*)(mu + PC_K + h * 64 + 4 * cq);
        const f32x4 mu_w = *(const f32x4*)(mu + PC_WLR + 4 * cq), mu_a = *(const f32x4*)(mu + PC_ALR + 4 * cq);
        const f32x4 mu_v = *(const f32x4*)(mu + PC_V + h * 64 + 16 * rg + 4 * (cq & 3));
        const f32x4 kk4 = *(const f32x4*)(p.rw_k_k + (size_t)l * 512 + h * 64 + 4 * cq), ka4 = *(const f32x4*)(p.rw_k_a + (size_t)l * 512 + h * 64 + 4 * cq);
        const int mt = wave & 1, ntl = wave >> 1, jcol = ntl * 16 + fr;
        bf16x8 bw[2], ba[2];
#pragma unroll
        for (int ks = 0; ks < 2; ++ks) { bw[ks] = ld_frag_g(p.ww2_t + ((size_t)l * 512 + h * 64 + jcol) * 64 + ks * 32 + fq * 8); ba[ks] = ld_frag_g(p.wa2_t + ((size_t)l * 512 + h * 64 + jcol) * 64 + ks * 32 + fq * 8); }
        const float w0j = p.rw_w0[(size_t)l * 512 + h * 64 + jcol], a0j = p.rw_a0[(size_t)l * 512 + h * 64 + jcol];
        float s0 = 0.f, s1 = 0.f, s2 = 0.f, s3 = 0.f;
        for (int blk = 0; blk < SEQ / 32; ++blk) {
            const int tb = blk * 32;
            { const size_t tr = row0 + tb + pt; const bf16_t* cur = p.PC + tr * PC_LD; const bf16_t* prv = cur - PC_LD; const bool hasp = (tb + pt) > 0;
              const u32x2 z2 = {0u, 0u};
              const u32x2 cr = *(const u32x2*)(cur + PC_R + h * 64 + 4 * cq), ck = *(const u32x2*)(cur + PC_K + h * 64 + 4 * cq), cw = *(const u32x2*)(cur + PC_WLR + 4 * cq), ca = *(const u32x2*)(cur + PC_ALR + 4 * cq);
              const u32x2 pr = hasp ? *(const u32x2*)(prv + PC_R + h * 64 + 4 * cq) : z2, pk = hasp ? *(const u32x2*)(prv + PC_K + h * 64 + 4 * cq) : z2;
              const u32x2 pw = hasp ? *(const u32x2*)(prv + PC_WLR + 4 * cq) : z2, pa = hasp ? *(const u32x2*)(prv + PC_ALR + 4 * cq) : z2;
              const f32x4 r4 = lerp4(cr, pr, mu_r), k4 = lerp4(ck, pk, mu_k), w4 = lerp4(cw, pw, mu_w), a4 = lerp4(ca, pa, mu_a);
              *(LASP f32x4*)(sR + pt * 64 + 4 * cq) = r4; *(LASP f32x4*)(sKt + pt * 64 + 4 * cq) = k4;
              u32x2 tw; tw.x = pk_bf16(tanhf(w4[0]), tanhf(w4[1])); tw.y = pk_bf16(tanhf(w4[2]), tanhf(w4[3])); *(LASP u32x2*)(sPw + pt * 72 + 4 * cq) = tw;
              u32x2 ta; ta.x = pk_bf16(a4[0], a4[1]); ta.y = pk_bf16(a4[2], a4[3]); *(LASP u32x2*)(sPa + pt * 72 + 4 * cq) = ta;
              if (cq < 4) { const u32x2 cv = *(const u32x2*)(cur + PC_V + h * 64 + 16 * rg + 4 * cq); const u32x2 pv = hasp ? *(const u32x2*)(prv + PC_V + h * 64 + 16 * rg + 4 * cq) : z2;
                  *(LASP f32x4*)(sV + pt * 16 + 4 * cq) = lerp4(cv, pv, mu_v); } }
            __syncthreads();
            { f32x4 dz = {0.f, 0.f, 0.f, 0.f}, da = {0.f, 0.f, 0.f, 0.f};
#pragma unroll
              for (int ks = 0; ks < 2; ++ks) { const bf16x8 aw = *(const LASP bf16x8*)(sPw + (mt * 16 + fr) * 72 + ks * 32 + fq * 8); dz = MFMA16(aw, bw[ks], dz);
                  const bf16x8 aa = *(const LASP bf16x8*)(sPa + (mt * 16 + fr) * 72 + ks * 32 + fq * 8); da = MFMA16(aa, ba[ks], da); }
#pragma unroll
              for (int r = 0; r < 4; ++r) { const int t = mt * 16 + fq * 4 + r;
                  const float lw = -softplusf_(-(w0j + dz[r])) - 0.5f;
                  sW[t * 64 + jcol] = __expf(-__expf(lw));
                  sB[t * 64 + jcol] = sigmoidf_(a0j + da[r]); } }
            __syncthreads();
            { const f32x4 k4 = *(const LASP f32x4*)(sKt + pt * 64 + 4 * cq); const f32x4 ar = *(const LASP f32x4*)(sB + pt * 64 + 4 * cq);
              const f32x4 kk = k4 * kk4; float ss = kk[0] * kk[0] + kk[1] * kk[1] + kk[2] * kk[2] + kk[3] * kk[3];
              ss = row16_sum(ss);
              const float rinv = rsqrtf(ss + 1e-12f);
              const f32x4 kn = kk * rinv;
              *(LASP f32x4*)(sA + pt * 64 + 4 * cq) = -kn;
              *(LASP f32x4*)(sB + pt * 64 + 4 * cq) = kn * ar;
              *(LASP f32x4*)(sK2 + pt * 64 + 4 * cq) = k4 * ((ar - 1.0f) * ka4 + 1.0f); }
            __syncthreads();
            if (wave < 4) {
                const int rl = wave * 4 + fq;
#pragma unroll 4
                for (int tt = 0; tt < 32; ++tt) {
                    const f32x4 w4 = *(const LASP f32x4*)(sW + tt * 64 + 4 * fr), a4 = *(const LASP f32x4*)(sA + tt * 64 + 4 * fr), b4 = *(const LASP f32x4*)(sB + tt * 64 + 4 * fr);
                    const f32x4 k4 = *(const LASP f32x4*)(sK2 + tt * 64 + 4 * fr), r4 = *(const LASP f32x4*)(sR + tt * 64 + 4 * fr);
                    const float v = sV[tt * 16 + rl];
                    float sa = s0 * a4[0] + s1 * a4[1] + s2 * a4[2] + s3 * a4[3];
                    sa = row16_sum(sa);
                    s0 = fmaf(sa, b4[0], fmaf(s0, w4[0], v * k4[0])); s1 = fmaf(sa, b4[1], fmaf(s1, w4[1], v * k4[1]));
                    s2 = fmaf(sa, b4[2], fmaf(s2, w4[2], v * k4[2])); s3 = fmaf(sa, b4[3], fmaf(s3, w4[3], v * k4[3]));
                    float y = s0 * r4[0] + s1 * r4[1] + s2 * r4[2] + s3 * r4[3];
                    y = row16_sum(y);
                    if (fr == 0) sY[tt * 16 + rl] = y;
                }
            }
            __syncthreads();
            p.yc[(row0 + tb + pt) * 512 + h * 64 + 16 * rg + cq] = f2bf(sY[pt * 16 + cq]);
        }
        __syncthreads();
    }
}

constexpr int R3_A = 0, R3_G = 65536, R3_PA = 131072, R3_PG = 135680;
__device__ void phase_rwkv_post(const Params& p, int l, LASP unsigned char* lds, int wg, int nwg) {
    LASP float* sAr = (LASP float*)(lds + R3_A); LASP float* sG = (LASP float*)(lds + R3_G);
    LASP bf16_t* sPa = (LASP bf16_t*)(lds + R3_PA); LASP bf16_t* sPg = (LASP bf16_t*)(lds + R3_PG);
    const int tid = threadIdx.x, lane = tid & 63, wave = tid >> 6, fr = lane & 15, fq = lane >> 4;
    const float* mu = p.rw_mu + (size_t)l * 1792;
    for (int u = wg; u < NTOK / 32; u += nwg) {
        const size_t tr0 = (size_t)u * 32;
        const int pt = tid >> 4, cq = tid & 15;
        const size_t tr = tr0 + pt; const bool hasp = (tr & (SEQ - 1)) != 0;
        const bf16_t* cur = p.PC + tr * PC_LD; const bf16_t* prv = cur - PC_LD; const u32x2 z2 = {0u, 0u};
        { const u32x2 ca = *(const u32x2*)(cur + PC_ALR + 4 * cq), pa = hasp ? *(const u32x2*)(prv + PC_ALR + 4 * cq) : z2;
          const f32x4 a4 = lerp4(ca, pa, *(const f32x4*)(mu + PC_ALR + 4 * cq));
          u32x2 ta; ta.x = pk_bf16(a4[0], a4[1]); ta.y = pk_bf16(a4[2], a4[3]); *(LASP u32x2*)(sPa + pt * 72 + 4 * cq) = ta;
#pragma unroll
          for (int g2 = 0; g2 < 2; ++g2) { const int col = 8 * cq + 4 * g2;
              const u32x2 cg = *(const u32x2*)(cur + PC_GLR + col), pg = hasp ? *(const u32x2*)(prv + PC_GLR + col) : z2;
              const f32x4 g4 = lerp4(cg, pg, *(const f32x4*)(mu + PC_GLR + col));
              u32x2 tg; tg.x = pk_bf16(sigmoidf_(g4[0]), sigmoidf_(g4[1])); tg.y = pk_bf16(sigmoidf_(g4[2]), sigmoidf_(g4[3])); *(LASP u32x2*)(sPg + pt * 136 + col) = tg; } }
        __syncthreads();
        { bf16x8 aa[2][2], ag[2][4];
#pragma unroll
          for (int m2 = 0; m2 < 2; ++m2) {
#pragma unroll
              for (int ks = 0; ks < 2; ++ks) aa[m2][ks] = *(const LASP bf16x8*)(sPa + (m2 * 16 + fr) * 72 + ks * 32 + fq * 8);
#pragma unroll
              for (int ks = 0; ks < 4; ++ks) ag[m2][ks] = *(const LASP bf16x8*)(sPg + (m2 * 16 + fr) * 136 + ks * 32 + fq * 8); }
#pragma unroll
          for (int ni = 0; ni < 4; ++ni) { const int n = (wave + 8 * ni) * 16 + fr;
              bf16x8 bwa[2], bwg[4];
#pragma unroll
              for (int ks = 0; ks < 2; ++ks) bwa[ks] = ld_frag_g(p.wa2_t + ((size_t)l * 512 + n) * 64 + ks * 32 + fq * 8);
#pragma unroll
              for (int ks = 0; ks < 4; ++ks) bwg[ks] = ld_frag_g(p.wg2_t + ((size_t)l * 512 + n) * 128 + ks * 32 + fq * 8);
              const float a0n = p.rw_a0[(size_t)l * 512 + n];
#pragma unroll
              for (int m2 = 0; m2 < 2; ++m2) { f32x4 da = {0.f, 0.f, 0.f, 0.f}, dg = {0.f, 0.f, 0.f, 0.f};
#pragma unroll
                  for (int ks = 0; ks < 2; ++ks) da = MFMA16(aa[m2][ks], bwa[ks], da);
#pragma unroll
                  for (int ks = 0; ks < 4; ++ks) dg = MFMA16(ag[m2][ks], bwg[ks], dg);
#pragma unroll
                  for (int r = 0; r < 4; ++r) { const int t = m2 * 16 + fq * 4 + r; sAr[t * 512 + n] = sigmoidf_(a0n + da[r]); sG[t * 512 + n] = dg[r]; } } } }
        __syncthreads();
#pragma unroll 1
        for (int h = 0; h < 8; ++h) { const int col = h * 64 + 4 * cq;
            const u32x2 cr = *(const u32x2*)(cur + PC_R + col), ck = *(const u32x2*)(cur + PC_K + col), cv = *(const u32x2*)(cur + PC_V + col);
            const u32x2 pr = hasp ? *(const u32x2*)(prv + PC_R + col) : z2, pk = hasp ? *(const u32x2*)(prv + PC_K + col) : z2, pv = hasp ? *(const u32x2*)(prv + PC_V + col) : z2;
            const f32x4 r4 = lerp4(cr, pr, *(const f32x4*)(mu + PC_R + col)), k4 = lerp4(ck, pk, *(const f32x4*)(mu + PC_K + col)), v4 = lerp4(cv, pv, *(const f32x4*)(mu + PC_V + col));
            const f32x4 ar = *(const LASP f32x4*)(sAr + pt * 512 + col), g4 = *(const LASP f32x4*)(sG + pt * 512 + col);
            const f32x4 ka4 = *(const f32x4*)(p.rw_k_a + (size_t)l * 512 + col), rk4 = *(const f32x4*)(p.rw_r_k + (size_t)l * 512 + col);
            const f32x4 k2 = k4 * ((ar - 1.0f) * ka4 + 1.0f);
            const f32x4 bt = r4 * k2 * rk4; float bonus = row16_sum(bt[0] + bt[1] + bt[2] + bt[3]);
            const u32x2 yw = *(const u32x2*)(p.yc + tr * 512 + col);
            const f32x4 y4 = {bflo(yw.x), bfhi(yw.x), bflo(yw.y), bfhi(yw.y)};
            const float mean = row16_sum(y4[0] + y4[1] + y4[2] + y4[3]) * (1.0f / 64.0f);
            const f32x4 dy = y4 - mean; const float var = row16_sum(dy[0] * dy[0] + dy[1] * dy[1] + dy[2] * dy[2] + dy[3] * dy[3]) * (1.0f / 64.0f);
            const float rstd = rsqrtf(var + 64e-5f);
            const f32x4 lg4 = *(const f32x4*)(p.rw_ln_g + (size_t)l * 512 + col), lb4 = *(const f32x4*)(p.rw_ln_b + (size_t)l * 512 + col);
            const f32x4 o = ((dy * rstd) * lg4 + lb4 + v4 * bonus) * g4;
            u32x2 w; w.x = pk_bf16(o[0], o[1]); w.y = pk_bf16(o[2], o[3]);
            *(u32x2*)(p.yc + tr * 512 + col) = w; }
        __syncthreads();
    }
}

__device__ void phase_peer_tables(const Params& p, int l, int wg, int nwg) {
    const size_t n8 = (size_t)16384 * 1024 / 8;
    const float* su = p.peer_u + (size_t)l * 16384 * 1024; const float* sv = p.peer_v + (size_t)l * 16384 * 1024;
    for (size_t i = (size_t)wg * NTHR + threadIdx.x; i < 2 * n8; i += (size_t)nwg * NTHR) {
        const bool second = i >= n8; const size_t e = (second ? i - n8 : i) * 8; const float* s = (second ? sv : su) + e;
        const f32x4 a = *(const f32x4*)s, b = *(const f32x4*)(s + 4);
        u32x4 w; w.x = pk_bf16(a[0], a[1]); w.y = pk_bf16(a[2], a[3]); w.z = pk_bf16(b[0], b[1]); w.w = pk_bf16(b[2], b[3]);
        *(u32x4*)((second ? p.tv : p.tu) + e) = w;
    }
}
__device__ __forceinline__ float pk_val(unsigned key) { return fkey_inv(key & 0xffffff80u); }
__device__ void phase_peer_select(const Params& p, int l, LASP unsigned char* lds, int wg, int nwg) {
    LASP unsigned* top = (LASP unsigned*)lds;
    const int tid = threadIdx.x, lane = tid & 63, wave = tid >> 6, fr = lane & 15, fq = lane >> 4;
    int ca, cb; bool cvalid = lane < 50;
    { const int c = lane;
      if (c < 16) { ca = 0; cb = c; } else if (c < 24) { ca = 1; cb = c - 16; } else if (c < 29) { ca = 2; cb = c - 24; } else if (c < 33) { ca = 3; cb = c - 29; }
      else if (c < 36) { ca = 4; cb = c - 33; } else if (c < 38) { ca = 5; cb = c - 36; } else if (c < 40) { ca = 6; cb = c - 38; } else if (c < 42) { ca = 7; cb = c - 40; }
      else if (c < 50) { ca = c - 42 + 8; cb = 0; } else { ca = 0; cb = 0; } }
    for (int u = wg; u < NTOK / 64; u += nwg) {
        const size_t t0 = (size_t)u * 64;
#pragma unroll 1
        for (int pi = 0; pi < 2; ++pi) { const int hp = wave * 2 + pi;
            const bf16_t* kb = p.pkeys + ((size_t)l * 16 + hp) * 128 * 64;
            bf16x8 bk[8][2];
#pragma unroll
            for (int nt = 0; nt < 8; ++nt)
#pragma unroll
                for (int ks = 0; ks < 2; ++ks) bk[nt][ks] = ld_frag_g(kb + (size_t)(nt * 16 + fr) * 64 + ks * 32 + fq * 8);
#pragma unroll 1
            for (int mt = 0; mt < 4; ++mt) {
                bf16x8 qa[2];
#pragma unroll
                for (int ks = 0; ks < 2; ++ks) qa[ks] = ld_frag_g(p.qp + (t0 + mt * 16 + fr) * 1024 + hp * 64 + ks * 32 + fq * 8);
                unsigned key[8][4];
#pragma unroll
                for (int nt = 0; nt < 8; ++nt) { f32x4 d = {0.f, 0.f, 0.f, 0.f}; d = MFMA16(qa[0], bk[nt][0], d); d = MFMA16(qa[1], bk[nt][1], d);
#pragma unroll
                    for (int r = 0; r < 4; ++r) key[nt][r] = (fkey(d[r]) & 0xffffff80u) | (unsigned)(127 - (nt * 16 + fr)); }
                unsigned mine[4] = {0u, 0u, 0u, 0u};
#pragma unroll 1
                for (int it = 0; it < 16; ++it) {
#pragma unroll
                    for (int r = 0; r < 4; ++r) { unsigned m = key[0][r];
#pragma unroll
                        for (int nt = 1; nt < 8; ++nt) m = m > key[nt][r] ? m : key[nt][r];
                        m = row16_maxu(m);
                        if (fr == it) mine[r] = m;
#pragma unroll
                        for (int nt = 0; nt < 8; ++nt) key[nt][r] = key[nt][r] == m ? 0u : key[nt][r]; }
                }
#pragma unroll
                for (int r = 0; r < 4; ++r) top[((mt * 16 + fq * 4 + r) * 16 + hp) * 16 + fr] = mine[r];
            }
        }
        __syncthreads();
#pragma unroll 1
        for (int it2 = 0; it2 < 64; ++it2) { const int item = wave * 64 + it2; const int t = item >> 3, h = item & 7;
            const unsigned k1 = top[(t * 16 + h * 2) * 16 + ca], k2 = top[(t * 16 + h * 2 + 1) * 16 + cb];
            const float s = pk_val(k1) + pk_val(k2);
            const unsigned eidx = ((127u - (k1 & 127u)) << 7) | (127u - (k2 & 127u));
            unsigned ck = cvalid ? ((fkey(s) & 0xffffffc0u) | (unsigned)(63 - lane)) : 0u;
            unsigned mine = 0u;
#pragma unroll 1
            for (int it = 0; it < 16; ++it) { unsigned m = row16_maxu(ck);
                const unsigned m0 = (unsigned)__builtin_amdgcn_readlane((int)m, 0), m1 = (unsigned)__builtin_amdgcn_readlane((int)m, 16), m2 = (unsigned)__builtin_amdgcn_readlane((int)m, 32), m3 = (unsigned)__builtin_amdgcn_readlane((int)m, 48);
                const unsigned a = m0 > m1 ? m0 : m1, b2 = m2 > m3 ? m2 : m3; m = a > b2 ? a : b2;
                if (lane == it) mine = m;
                ck = ck == m ? 0u : ck; }
            const int src = 63 - (int)(mine & 63u);
            const unsigned e = (unsigned)__shfl((int)eidx, src);
            const float sv = fkey_inv(mine & 0xffffffc0u);
            const float s0 = __shfl(sv, 0);
            float ex = lane < 16 ? __expf(sv - s0) : 0.f;
            const float den = row16_sum(ex);
            if (lane < 16) { const size_t o = (t0 + t) * 128 + h * 16 + lane; p.pe_idx[o] = (unsigned short)e; p.pe_gate[o] = ex / den; }
        }
        __syncthreads();
    }
}
__device__ void phase_peer_gather(const Params& p, int l, int wg, int nwg) {
    const int lane = threadIdx.x & 63, wave = threadIdx.x >> 6;
    const float* gate = p.mod + (size_t)l * 8 * 6144 + 5120;
    for (int tok = wg * 8 + wave; tok < NTOK; tok += nwg * 8) {
        float xv[16];
        { const u32x4 a = *(const u32x4*)(p.hbuf + (size_t)tok * 1024 + 8 * lane), b = *(const u32x4*)(p.hbuf + (size_t)tok * 1024 + 512 + 8 * lane);
          xv[0] = bflo(a.x); xv[1] = bfhi(a.x); xv[2] = bflo(a.y); xv[3] = bfhi(a.y); xv[4] = bflo(a.z); xv[5] = bfhi(a.z); xv[6] = bflo(a.w); xv[7] = bfhi(a.w);
          xv[8] = bflo(b.x); xv[9] = bfhi(b.x); xv[10] = bflo(b.y); xv[11] = bfhi(b.y); xv[12] = bflo(b.z); xv[13] = bfhi(b.z); xv[14] = bflo(b.w); xv[15] = bfhi(b.w); }
        const unsigned e_lo = p.pe_idx[(size_t)tok * 128 + lane], e_hi = p.pe_idx[(size_t)tok * 128 + 64 + lane];
        const float g_lo = p.pe_gate[(size_t)tok * 128 + lane], g_hi = p.pe_gate[(size_t)tok * 128 + 64 + lane];
        float d_lo = 0.f, d_hi = 0.f;
#pragma unroll 1
        for (int i0 = 0; i0 < 128; i0 += 8) {
            u32x4 ua[8], ub[8];
#pragma unroll
            for (int j = 0; j < 8; ++j) { const int i = i0 + j; const unsigned e = (unsigned)__builtin_amdgcn_readlane((int)(i0 < 64 ? e_lo : e_hi), i & 63);
                const bf16_t* r = p.tu + (size_t)e * 1024; ua[j] = *(const u32x4*)(r + 8 * lane); ub[j] = *(const u32x4*)(r + 512 + 8 * lane); }
#pragma unroll
            for (int j = 0; j < 8; ++j) { const int i = i0 + j;
                float s = bflo(ua[j].x) * xv[0]; s = fmaf(bfhi(ua[j].x), xv[1], s); s = fmaf(bflo(ua[j].y), xv[2], s); s = fmaf(bfhi(ua[j].y), xv[3], s);
                s = fmaf(bflo(ua[j].z), xv[4], s); s = fmaf(bfhi(ua[j].z), xv[5], s); s = fmaf(bflo(ua[j].w), xv[6], s); s = fmaf(bfhi(ua[j].w), xv[7], s);
                s = fmaf(bflo(ub[j].x), xv[8], s); s = fmaf(bfhi(ub[j].x), xv[9], s); s = fmaf(bflo(ub[j].y), xv[10], s); s = fmaf(bfhi(ub[j].y), xv[11], s);
                s = fmaf(bflo(ub[j].z), xv[12], s); s = fmaf(bfhi(ub[j].z), xv[13], s); s = fmaf(bflo(ub[j].w), xv[14], s); s = fmaf(bfhi(ub[j].w), xv[15], s);
                s = wave_sum(s);
                if (i0 < 64) { if (lane == (i & 63)) d_lo = s; } else { if (lane == (i & 63)) d_hi = s; } }
        }
        const float w_lo = g_lo * 0.5f * d_lo * (1.0f + erff(d_lo * 0.70710678118654752f)), w_hi = g_hi * 0.5f * d_hi * (1.0f + erff(d_hi * 0.70710678118654752f));
        float ov[16];
#pragma unroll
        for (int j = 0; j < 16; ++j) ov[j] = 0.f;
#pragma unroll 1
        for (int i0 = 0; i0 < 128; i0 += 8) {
            u32x4 va[8], vb[8]; float ww[8];
#pragma unroll
            for (int j = 0; j < 8; ++j) { const int i = i0 + j; const unsigned e = (unsigned)__builtin_amdgcn_readlane((int)(i0 < 64 ? e_lo : e_hi), i & 63);
                ww[j] = __int_as_float(__builtin_amdgcn_readlane(__float_as_int(i0 < 64 ? w_lo : w_hi), i & 63));
                const bf16_t* r = p.tv + (size_t)e * 1024; va[j] = *(const u32x4*)(r + 8 * lane); vb[j] = *(const u32x4*)(r + 512 + 8 * lane); }
#pragma unroll
            for (int j = 0; j < 8; ++j) { const float w = ww[j];
                ov[0] = fmaf(w, bflo(va[j].x), ov[0]); ov[1] = fmaf(w, bfhi(va[j].x), ov[1]); ov[2] = fmaf(w, bflo(va[j].y), ov[2]); ov[3] = fmaf(w, bfhi(va[j].y), ov[3]);
                ov[4] = fmaf(w, bflo(va[j].z), ov[4]); ov[5] = fmaf(w, bfhi(va[j].z), ov[5]); ov[6] = fmaf(w, bflo(va[j].w), ov[6]); ov[7] = fmaf(w, bfhi(va[j].w), ov[7]);
                ov[8] = fmaf(w, bflo(vb[j].x), ov[8]); ov[9] = fmaf(w, bfhi(vb[j].x), ov[9]); ov[10] = fmaf(w, bflo(vb[j].y), ov[10]); ov[11] = fmaf(w, bfhi(vb[j].y), ov[11]);
                ov[12] = fmaf(w, bflo(vb[j].z), ov[12]); ov[13] = fmaf(w, bfhi(vb[j].z), ov[13]); ov[14] = fmaf(w, bflo(vb[j].w), ov[14]); ov[15] = fmaf(w, bfhi(vb[j].w), ov[15]); }
        }
        const float* gp = gate + (size_t)(tok >> 13) * 6144; float* xr = p.out + (size_t)tok * 1024;
#pragma unroll
        for (int hf = 0; hf < 2; ++hf)
#pragma unroll
            for (int q4 = 0; q4 < 2; ++q4) { const int col = hf * 512 + 8 * lane + 4 * q4;
                const f32x4 gg = *(const f32x4*)(gp + col); f32x4 xx = *(const f32x4*)(xr + col);
                xx[0] = fmaf(gg[0], ov[hf * 8 + q4 * 4 + 0], xx[0]); xx[1] = fmaf(gg[1], ov[hf * 8 + q4 * 4 + 1], xx[1]); xx[2] = fmaf(gg[2], ov[hf * 8 + q4 * 4 + 2], xx[2]); xx[3] = fmaf(gg[3], ov[hf * 8 + q4 * 4 + 3], xx[3]);
                *(f32x4*)(xr + col) = xx; }
    }
}

enum { PH_W = 0, PH_A1, PH_A2, PH_G1, PH_G2, PH_G3, PH_D1, PH_D2, PH_D34, PH_R2, PH_R3, PH_M, PH_O, PH_A1F, PH_E1, PH_E2, PH_E3, PH_FIN, PH_COUNT };

template <int PH> __device__ __forceinline__ void run_phase(const Params& p, int l, LASP unsigned char* lds, int wg, int nwg) {
    const float* modl = p.mod + (size_t)l * 8 * 6144;
    const float* xin = l == 0 ? p.x : p.out;
    if constexpr (PH == PH_W) phase_weights(p, lds, wg, nwg);
    else if constexpr (PH == PH_A1) phase_adaln(xin, p.g_mix + (size_t)l * 1024, modl, 0, 1024, p.hbuf, wg, nwg);
    else if constexpr (PH == PH_A2) { pg8::EpiP E; E.GQ = p.GQ; E.GK = p.GK; E.GV = p.GV; E.GR = p.GR; E.PB = p.PB; E.PC = p.PC;
        run_gemm(lds, p.hbuf, p.win_t + (size_t)l * 3840 * 1024, NTOK, 3840, 1024, E, wg, nwg); }
    else if constexpr (PH == PH_G1) phase_gla1(p, l, lds, wg, nwg);
    else if constexpr (PH == PH_G2) phase_gla2(p, wg, nwg);
    else if constexpr (PH == PH_G3) phase_gla3(p, l, lds, wg, nwg);
    else if constexpr (PH == PH_D1) phase_dsa1(p, l, wg, nwg);
    else if constexpr (PH == PH_D2) { pg8::EpiStore<0> E; E.O = p.qd; E.ldc = 1024; run_gemm(lds, p.qn, p.wuq_t + (size_t)l * 1024 * 256, NTOK, 1024, 256, E, wg, nwg);
        pg8::EpiStore<0> E2; E2.O = p.qi; E2.ldc = 256; run_gemm(lds, p.qn, p.wiq_t + (size_t)l * 256 * 256, NTOK, 256, 256, E2, wg, nwg); }
    else if constexpr (PH == PH_D34) phase_dsa34(p, l, lds, wg, nwg);
    else if constexpr (PH == PH_R2) phase_rwkv_scan(p, l, lds, wg, nwg);
    else if constexpr (PH == PH_R3) phase_rwkv_post(p, l, lds, wg, nwg);
    else if constexpr (PH == PH_M) {
        pg8::EpiStore<1> EG; EG.O = p.Gtmp; EG.ldc = 1024;
        const bf16_t* wg_l = p.wg_t + (size_t)l * 3072 * 1024; const bf16_t* wb_l = p.wb_t + (size_t)l * 3 * 1024 * 512;
        run_gemm(lds, p.hbuf, wg_l, NTOK, 1024, 1024, EG, wg, nwg);
        { pg8::EpiMerge<1> EM; EM.G = p.Gtmp; EM.O = p.merged; EM.ldc = 1024; run_gemm(lds, p.ya, wb_l, NTOK, 1024, 512, EM, wg, nwg); }
        run_gemm(lds, p.hbuf, wg_l + (size_t)1024 * 1024, NTOK, 1024, 1024, EG, wg, nwg);
        { pg8::EpiMerge<0> EM; EM.G = p.Gtmp; EM.O = p.merged; EM.ldc = 1024; run_gemm(lds, p.yb, wb_l + (size_t)1024 * 512, NTOK, 1024, 512, EM, wg, nwg); }
        run_gemm(lds, p.hbuf, wg_l + (size_t)2 * 1024 * 1024, NTOK, 1024, 1024, EG, wg, nwg);
        { pg8::EpiMerge<0> EM; EM.G = p.Gtmp; EM.O = p.merged; EM.ldc = 1024; run_gemm(lds, p.yc, wb_l + (size_t)2 * 1024 * 512, NTOK, 1024, 512, EM, wg, nwg); } }
    else if constexpr (PH == PH_O) { pg8::EpiResid E; E.xin = xin; E.xout = p.out; E.gate = modl + 2048; run_gemm(lds, p.merged, p.wo_t + (size_t)l * 1024 * 1024, NTOK, 1024, 1024, E, wg, nwg); }
    else if constexpr (PH == PH_A1F) { phase_adaln(p.out, p.g_ffn + (size_t)l * 1024, modl, 3072, 4096, p.hbuf, wg, nwg); phase_peer_tables(p, l, wg, nwg); }
    else if constexpr (PH == PH_E1) { pg8::EpiStore<0> E; E.O = p.qp; E.ldc = 1024; run_gemm(lds, p.hbuf, p.wq_t + (size_t)l * 1024 * 1024, NTOK, 1024, 1024, E, wg, nwg); }
    else if constexpr (PH == PH_E2) phase_peer_select(p, l, lds, wg, nwg);
    else if constexpr (PH == PH_E3) phase_peer_gather(p, l, wg, nwg);
    else if constexpr (PH == PH_FIN) phase_final(p.out, p.g_final, wg, nwg);
}

extern __shared__ __attribute__((aligned(16))) unsigned char smem_dyn[];
#ifndef DBG_MODE
#define DBG_MODE 0
#endif
#ifndef DBG_LAYERS
#define DBG_LAYERS NLAYER
#endif
__global__ void __launch_bounds__(NTHR, 2) k_dbg_copy(const float* x, float* out) {
    for (size_t i = (size_t)blockIdx.x * NTHR + threadIdx.x; i < (size_t)NTOK * 1024 / 4; i += (size_t)gridDim.x * NTHR) ((f32x4*)out)[i] = ((const f32x4*)x)[i];
}

__global__ void __launch_bounds__(NTHR, 2) k_dbg_dump(const bf16_t* buf, size_t n, float* out) {
    const size_t NOUT = (size_t)NTOK * 1024;
    for (size_t i = (size_t)blockIdx.x * NTHR + threadIdx.x; i < NOUT; i += (size_t)gridDim.x * NTHR) {
        float s = 0.f; if (n >= NOUT) { for (size_t j = i; j < n; j += NOUT) s += bf2f(buf[j]); } else s = bf2f(buf[i % n]);
        out[i] = s; }
}
#ifndef DBG_A2BUF
#define DBG_A2BUF p.PC
#define DBG_A2N 1792
#endif
#ifndef DBG_G1BUF
#define DBG_G1BUF p.GS
#define DBG_G1N ((size_t)NTOK * 512)
#endif
#ifndef DBG_STOP
#define DBG_STOP PH_O
#endif
#if MK_ONE_LAUNCH
__global__ void __launch_bounds__(NTHR, 2) mega_fwd(Params p) {
    LASP unsigned char* lds = (LASP unsigned char*)smem_dyn;
    if (threadIdx.x == 0) *(LASP uint4*)(lds + LDS_BAR_OFF) = make_uint4(0u, 0u, 0u, 0u);
    __syncthreads();
    const XcdBarrier bar = xcd_barrier_post(p.bar, (volatile LAS unsigned*)(lds + LDS_BAR_OFF));
    const int wg = blockIdx.x, nwg = gridDim.x;
    run_phase<PH_W>(p, 0, lds, wg, nwg); xcd_barrier(bar);
    for (int l = 0; l < NLAYER; ++l) {
        run_phase<PH_A1>(p, l, lds, wg, nwg); xcd_barrier(bar);
        run_phase<PH_A2>(p, l, lds, wg, nwg); xcd_barrier(bar);
        run_phase<PH_G1>(p, l, lds, wg, nwg); xcd_barrier(bar);
        run_phase<PH_G2>(p, l, lds, wg, nwg); xcd_barrier(bar);
        run_phase<PH_G3>(p, l, lds, wg, nwg); xcd_barrier(bar);
        run_phase<PH_D1>(p, l, lds, wg, nwg); xcd_barrier(bar);
        run_phase<PH_D2>(p, l, lds, wg, nwg); xcd_barrier(bar);
        run_phase<PH_D34>(p, l, lds, wg, nwg); xcd_barrier(bar);
        run_phase<PH_R2>(p, l, lds, wg, nwg); xcd_barrier(bar);
        run_phase<PH_R3>(p, l, lds, wg, nwg); xcd_barrier(bar);
        run_phase<PH_M>(p, l, lds, wg, nwg); xcd_barrier(bar);
        run_phase<PH_O>(p, l, lds, wg, nwg); xcd_barrier(bar);
        run_phase<PH_A1F>(p, l, lds, wg, nwg); xcd_barrier(bar);
        run_phase<PH_E1>(p, l, lds, wg, nwg); xcd_barrier(bar);
        run_phase<PH_E2>(p, l, lds, wg, nwg); xcd_barrier(bar);
        run_phase<PH_E3>(p, l, lds, wg, nwg); xcd_barrier(bar);
    }
    run_phase<PH_FIN>(p, 0, lds, wg, nwg);
}
#else
template <int PH> __global__ void __launch_bounds__(NTHR, 2) k_phase(Params p, int l) {
    LASP unsigned char* lds = (LASP unsigned char*)smem_dyn;
    run_phase<PH>(p, l, lds, blockIdx.x, gridDim.x);
}
template <int PH> static void launch_phase(const Params& p, int l, int grid, hipStream_t stream) {
    static bool attr = false;
    if (!attr) { hipFuncSetAttribute((const void*)k_phase<PH>, hipFuncAttributeMaxDynamicSharedMemorySize, LDS_BYTES); attr = true; }
    hipLaunchKernelGGL(k_phase<PH>, dim3(grid), dim3(NTHR), LDS_BYTES, stream, p, l);
}
#endif

static size_t carve(size_t& off, size_t bytes) { const size_t o = off; off += (bytes + 255) & ~(size_t)255; return o; }

extern "C" void kernel_launch(void* const* d_in, const int* in_sizes, int n_in, void* d_out, int out_size, void* d_ws, size_t ws_size, hipStream_t stream) {
    (void)in_sizes; (void)out_size;
    if (n_in != 33) { fprintf(stderr, "kernel_launch: expected 33 inputs, got %d\n", n_in); return; }
    Params p; memset(&p, 0, sizeof(p));
    const float* const* in = (const float* const*)d_in;
    p.x = in[0]; p.c = in[1]; p.w_ada = in[2]; p.b_ada = in[3]; p.g_mix = in[4]; p.g_ffn = in[5]; p.w_in = in[6]; p.gla_w_a2 = in[7]; p.gla_b_a = in[8]; p.gla_g_o = in[9];
    p.dsa_g_qc = in[10]; p.dsa_w_uq = in[11]; p.dsa_w_iq = in[12]; p.dsa_g_kv = in[13]; p.dsa_w_uv = in[14];
    p.rw_mu = in[15]; p.rw_w0 = in[16]; p.rw_w_w2 = in[17]; p.rw_a0 = in[18]; p.rw_w_a2 = in[19]; p.rw_w_g2 = in[20]; p.rw_k_k = in[21]; p.rw_k_a = in[22]; p.rw_r_k = in[23];
    p.rw_ln_g = in[24]; p.rw_ln_b = in[25]; p.w_branch = in[26]; p.w_out = in[27]; p.peer_w_q = in[28]; p.peer_keys = in[29]; p.peer_u = in[30]; p.peer_v = in[31]; p.g_final = in[32];
    p.out = (float*)d_out;
    char* ws = (char*)d_ws; size_t off = 0;
    const size_t TB2 = (size_t)NTOK * 2;
    p.bar = (unsigned*)(ws + carve(off, 16384));
    p.mod = (float*)(ws + carve(off, (size_t)NLAYER * 8 * 6144 * 4));
    p.win_t = (bf16_t*)(ws + carve(off, (size_t)NLAYER * 3840 * 1024 * 2));
    p.wg_t = (bf16_t*)(ws + carve(off, (size_t)NLAYER * 3072 * 1024 * 2));
    p.wb_t = (bf16_t*)(ws + carve(off, (size_t)NLAYER * 3 * 1024 * 512 * 2));
    p.wo_t = (bf16_t*)(ws + carve(off, (size_t)NLAYER * 1024 * 1024 * 2));
    p.wq_t = (bf16_t*)(ws + carve(off, (size_t)NLAYER * 1024 * 1024 * 2));
    p.wuq_t = (bf16_t*)(ws + carve(off, (size_t)NLAYER * 1024 * 256 * 2));
    p.wiq_t = (bf16_t*)(ws + carve(off, (size_t)NLAYER * 256 * 256 * 2));
    p.wuv_t = (bf16_t*)(ws + carve(off, (size_t)NLAYER * 8 * 64 * 128 * 2));
    p.pkeys = (bf16_t*)(ws + carve(off, (size_t)NLAYER * 8 * 2 * 128 * 64 * 2));
    p.ww2_t = (bf16_t*)(ws + carve(off, (size_t)NLAYER * 512 * 64 * 2));
    p.wa2_t = (bf16_t*)(ws + carve(off, (size_t)NLAYER * 512 * 64 * 2));
    p.wg2_t = (bf16_t*)(ws + carve(off, (size_t)NLAYER * 512 * 128 * 2));
    p.hbuf = (bf16_t*)(ws + carve(off, TB2 * 1024));
    char* R1 = ws + carve(off, TB2 * 1536);
    p.GQ = (bf16_t*)R1; p.GK = (bf16_t*)(R1 + TB2 * 256); p.GR = (bf16_t*)(R1 + TB2 * 512); p.GS = (bf16_t*)(R1 + TB2 * 1024);
    p.GV = (bf16_t*)(ws + carve(off, TB2 * 512));
    p.PB = (bf16_t*)(ws + carve(off, TB2 * 512));
    p.PC = (bf16_t*)(ws + carve(off, TB2 * 1792));
    p.yb = (bf16_t*)(ws + carve(off, TB2 * 512));
    p.yc = (bf16_t*)(ws + carve(off, TB2 * 512));
    p.kvn = (bf16_t*)(ws + carve(off, TB2 * 128));
    p.gdec = (float*)(ws + carve(off, (size_t)NB * NCHUNK * 4 * 64 * 4));
    p.qd = (bf16_t*)R1; p.qi = (bf16_t*)(R1 + TB2 * 1024); p.qn = (bf16_t*)(R1 + TB2 * 1280);
    p.ya = p.GV; p.Gtmp = (bf16_t*)R1; p.merged = p.PC;
    p.qp = (bf16_t*)R1; p.tu = (bf16_t*)(R1 + TB2 * 1024); p.tv = (bf16_t*)(R1 + TB2 * 1280);
    p.pe_idx = (unsigned short*)p.PC; p.pe_gate = (float*)((char*)p.PC + (size_t)NTOK * 128 * 2);
    if (off > ws_size) { fprintf(stderr, "kernel_launch: workspace too small: need %zu, have %zu\n", off, ws_size); return; }
    static int grid = 0;
    if (!grid) { int dev = 0, cus = 0; hipGetDevice(&dev); hipDeviceGetAttribute(&cus, hipDeviceAttributeMultiprocessorCount, dev); grid = cus > 0 ? cus : 256; if (grid > 256) grid = 256; }
#if MK_ONE_LAUNCH
    static bool attr = false;
    if (!attr) { if (hipFuncSetAttribute((const void*)mega_fwd, hipFuncAttributeMaxDynamicSharedMemorySize, LDS_BYTES) != hipSuccess) fprintf(stderr, "kernel_launch: hipFuncSetAttribute failed\n"); attr = true; }
    hipMemsetAsync(p.bar, 0, 16384, stream);
    hipLaunchKernelGGL(mega_fwd, dim3(grid), dim3(NTHR), LDS_BYTES, stream, p);
#else
#if DBG_MODE == 1
    hipLaunchKernelGGL(k_dbg_copy, dim3(grid), dim3(NTHR), 0, stream, p.x, p.out);
    launch_phase<PH_FIN>(p, 0, grid, stream);
    return;
#endif
#if DBG_MODE == 2
    {   launch_phase<PH_W>(p, 0, grid, stream);
        const bf16_t* db = nullptr; size_t dn = 0; const int l = 0;
        launch_phase<PH_A1>(p, l, grid, stream); db = p.hbuf; dn = (size_t)NTOK * 1024;
        if (DBG_STOP >= PH_A2) { launch_phase<PH_A2>(p, l, grid, stream); db = DBG_A2BUF; dn = (size_t)NTOK * DBG_A2N; }
        if (DBG_STOP >= PH_G1) { launch_phase<PH_G1>(p, l, grid, stream); db = DBG_G1BUF; dn = DBG_G1N; }
        if (DBG_STOP >= PH_G2) { launch_phase<PH_G2>(p, l, grid, stream); db = p.GS; dn = (size_t)NTOK * 512; }
        if (DBG_STOP >= PH_G3) { launch_phase<PH_G3>(p, l, grid, stream); db = p.ya; dn = (size_t)NTOK * 512; }
        if (DBG_STOP >= PH_D1) { launch_phase<PH_D1>(p, l, grid, stream); db = p.qn; dn = (size_t)NTOK * 256; }
        if (DBG_STOP >= PH_D2) { launch_phase<PH_D2>(p, l, grid, stream); db = p.qd; dn = (size_t)NTOK * 1280; }
        if (DBG_STOP >= PH_D34) { launch_phase<PH_D34>(p, l, grid, stream); db = p.yb; dn = (size_t)NTOK * 512; }
        if (DBG_STOP >= PH_R2) { launch_phase<PH_R2>(p, l, grid, stream); db = p.yc; dn = (size_t)NTOK * 512; }
        if (DBG_STOP >= PH_R3) { launch_phase<PH_R3>(p, l, grid, stream); db = p.yc; dn = (size_t)NTOK * 512; }
        if (DBG_STOP >= PH_M) { launch_phase<PH_M>(p, l, grid, stream); db = p.merged; dn = (size_t)NTOK * 1024; }
        if (DBG_STOP >= PH_O) { launch_phase<PH_O>(p, l, grid, stream); db = nullptr; }
        if (DBG_STOP >= PH_A1F) { launch_phase<PH_A1F>(p, l, grid, stream); }
        if (DBG_STOP >= PH_E1) { launch_phase<PH_E1>(p, l, grid, stream); db = p.qp; dn = (size_t)NTOK * 1024; }
        if (DBG_STOP >= PH_E2) { launch_phase<PH_E2>(p, l, grid, stream); db = (const bf16_t*)p.pe_gate; dn = (size_t)NTOK * 256; }
        if (DBG_STOP >= PH_E3) { launch_phase<PH_E3>(p, l, grid, stream); db = nullptr; }
        if (db) hipLaunchKernelGGL(k_dbg_dump, dim3(grid), dim3(NTHR), 0, stream, db, dn, p.out);
        return; }
#endif
    launch_phase<PH_W>(p, 0, grid, stream);
    for (int l = 0; l < DBG_LAYERS; ++l) {
        launch_phase<PH_A1>(p, l, grid, stream); launch_phase<PH_A2>(p, l, grid, stream);
        launch_phase<PH_G1>(p, l, grid, stream); launch_phase<PH_G2>(p, l, grid, stream); launch_phase<PH_G3>(p, l, grid, stream);
        launch_phase<PH_D1>(p, l, grid, stream); launch_phase<PH_D2>(p, l, grid, stream); launch_phase<PH_D34>(p, l, grid, stream);
        launch_phase<PH_R2>(p, l, grid, stream); launch_phase<PH_R3>(p, l, grid, stream);
        launch_phase<PH_M>(p, l, grid, stream); launch_phase<PH_O>(p, l, grid, stream);
        launch_phase<PH_A1F>(p, l, grid, stream); launch_phase<PH_E1>(p, l, grid, stream); launch_phase<PH_E2>(p, l, grid, stream); launch_phase<PH_E3>(p, l, grid, stream);
    }
    launch_phase<PH_FIN>(p, 0, grid, stream);
#endif
}
```

```cpp
#include <hip/hip_runtime.h>
#include <stdint.h>
#include <stdio.h>
#include <string.h>

#ifndef MK_ONE_LAUNCH
#define MK_ONE_LAUNCH 1
#endif

typedef unsigned short bf16_t;
typedef short bf16x8 __attribute__((ext_vector_type(8)));
typedef float f32x4 __attribute__((ext_vector_type(4)));
typedef float f32x2 __attribute__((ext_vector_type(2)));
typedef unsigned u32x4 __attribute__((ext_vector_type(4)));
typedef unsigned u32x2 __attribute__((ext_vector_type(2)));

#define XB_TMO      128
#define XB_XCNT(j)  (256  + 64 * (j))
#define XB_XSUB(j)  (1280 + 64 * (j))
#define XB_XGEN(j)  (2304 + 64 * (j))
#define XB_TOP      3328
#define XB_TOPGEN   3392
#define XCD_BAR_WORDS 3456
#define XB_SPIN_CAP (1u << 24)
#define LAS __attribute__((address_space(3)))

__device__ __forceinline__ unsigned xb_ld(unsigned* p)              { return __hip_atomic_load(p, __ATOMIC_RELAXED, __HIP_MEMORY_SCOPE_AGENT); }
__device__ __forceinline__ unsigned xb_add(unsigned* p, unsigned v) { return __hip_atomic_fetch_add(p, v, __ATOMIC_RELAXED, __HIP_MEMORY_SCOPE_AGENT); }
__device__ __forceinline__ unsigned xb_xcc_id() { return (unsigned)__builtin_amdgcn_s_getreg((3 << 11) | 20) & 0xFu; }
#define XB_SPIN(cond, bar) do { unsigned _sp = 0; while (cond) { __builtin_amdgcn_s_sleep(1); \
    if ((++_sp & 255u) == 0u) { if (xb_ld(&(bar)[XB_TMO])) break; if (_sp > XB_SPIN_CAP) { atomicAdd(&(bar)[XB_TMO], 1u); break; } } } } while (0)

struct XcdBarrier {
    unsigned* bar; unsigned x;
    volatile LAS unsigned* st;
};

__device__ __forceinline__ XcdBarrier xcd_barrier_post(unsigned* bar, volatile LAS unsigned* st) {
    XcdBarrier b; b.bar = bar; b.x = xb_xcc_id(); b.st = st;
    if (threadIdx.x == 0) (void)xb_add(&bar[XB_XCNT(b.x)], 1u);
    return b;
}
__device__ __forceinline__ void xcd_barrier_complete(unsigned* bar, unsigned x, unsigned& nloc, unsigned& nx) {
    const unsigned G = gridDim.x * gridDim.y * gridDim.z;
    unsigned sum, cnt, mine, sp = 0u;
    for (;;) {
        sum = 0u; cnt = 0u; mine = 0u;
#pragma unroll
        for (unsigned j = 0; j < 16; ++j) { const unsigned c = xb_ld(&bar[XB_XCNT(j)]); sum += c; cnt += (c > 0u) ? 1u : 0u; mine = (j == x) ? c : mine; }
        if (sum == G) break;
        __builtin_amdgcn_s_sleep(1);
        if ((++sp & 255u) == 0u) { if (xb_ld(&bar[XB_TMO])) break; if (sp > XB_SPIN_CAP) { atomicAdd(&bar[XB_TMO], 1u); break; } }
    }
    nloc = mine > 0u ? mine : 1u; nx = cnt > 0u ? cnt : 1u;
}

__device__ __forceinline__ void xcd_barrier(const XcdBarrier& b) {
    asm volatile("s_waitcnt vmcnt(0)" ::: "memory");
    __syncthreads();
    if (threadIdx.x == 0) {
        unsigned* bar = b.bar;
        __builtin_amdgcn_s_waitcnt(0);
        unsigned nloc = b.st[0], nx = b.st[1];
        if (nloc == 0u) { xcd_barrier_complete(bar, b.x, nloc, nx); b.st[0] = nloc; b.st[1] = nx; }
        const unsigned old = xb_add(&bar[XB_XSUB(b.x)], 1u);
        const unsigned gen = old / nloc;
        if (old + 1u == (gen + 1u) * nloc) {
            __builtin_amdgcn_fence(__ATOMIC_RELEASE, "agent");
            asm volatile("s_waitcnt vmcnt(0)" ::: "memory");
            const unsigned og = xb_add(&bar[XB_TOP], 1u);
            const unsigned tg = og / nx;
            if (og + 1u == (tg + 1u) * nx) xb_add(&bar[XB_TOPGEN], 1u);
            else XB_SPIN(xb_ld(&bar[XB_TOPGEN]) == tg, bar);
            __builtin_amdgcn_fence(__ATOMIC_ACQUIRE, "agent");
            xb_add(&bar[XB_XGEN(b.x)], 1u);
            asm volatile("s_waitcnt vmcnt(0)" ::: "memory");
        } else {
            XB_SPIN(xb_ld(&bar[XB_XGEN(b.x)]) == gen, bar);
            __builtin_amdgcn_fence(__ATOMIC_ACQUIRE, "agent");
            asm volatile("s_waitcnt vmcnt(0)" ::: "memory");
        }
    }
    __syncthreads();
}
namespace pg8 {
#define PG8_LAS __attribute__((address_space(3)))
typedef unsigned short bf16_t;
typedef short bf16x8 __attribute__((ext_vector_type(8)));
typedef float f32x4 __attribute__((ext_vector_type(4)));
typedef unsigned u32x4 __attribute__((ext_vector_type(4)));
constexpr int BM = 256, BK = 64, HALF = 128, HTB = HALF * BK * 2  , STAGE_BYTES = 8 * HTB, NXCD = 8, WGM = 8;

__host__ __device__ __forceinline__ int lds_byte(int r, int c) { const int st = (r >> 4) * 2 + (c >> 5), rr = r & 15, cc = c & 31, ob = rr * 64 + cc * 2; return st * 1024 + (ob ^ (((ob >> 9) & 1) << 5)); }
__host__ __device__ __forceinline__ void stage_rc(int b, int& R, int& C) { const int st = b / 1024, sb = b % 1024, swz = sb ^ (((sb >> 9) & 1) << 5); R = (st >> 1) * 16 + swz / 64; C = (st & 1) * 32 + (swz % 64) / 2; }
__host__ __device__ __forceinline__ int perm32(int rho) { const int n = rho >> 4, i = rho & 15; return 8 * (i >> 2) + 4 * n + (i & 3); }

struct Unit { int pm, pn; };
struct Gemm { const bf16_t* A; const bf16_t* Bt; int M, N, K; };

struct StaticOrder {
    int nM, nN, nwg, G, c;
    __host__ __device__ void init(int M, int N, int G_, int c_) { nM = M / BM; nN = N / BM; nwg = nM * nN; G = G_; c = c_; }
    __host__ __device__ bool next(int i, Unit& u) const {
        const long L = (long)i * G + c; if (L >= nwg) return false;
        int wgid = (int)L; { const int q = nwg / NXCD, r = nwg % NXCD, xcd = wgid % NXCD, off = wgid / NXCD; wgid = (xcd < r ? xcd * (q + 1) : r * (q + 1) + (xcd - r) * q) + off; }
        const int nig = WGM * nN, gid = wgid / nig, fm = gid * WGM, gsz = (nM - fm) < WGM ? (nM - fm) : WGM;
        u.pm = fm + ((wgid % nig) % gsz); u.pn = (wgid % nig) / gsz; return true;
    }
    __device__ __forceinline__ void a_ready(const Unit&) const {}
    __device__ __forceinline__ void done(const Unit&) const {}
};
struct CountedOrder : StaticOrder {
    const unsigned* ready; unsigned need; unsigned* tmo;
    __device__ __forceinline__ void a_ready(const Unit& u) const {
        if (threadIdx.x < 64) {
            const unsigned long long t0 = __builtin_amdgcn_s_memrealtime(); unsigned polls = 0;
            while ((unsigned)__builtin_amdgcn_readfirstlane(__hip_atomic_load(ready + 64 * u.pm, __ATOMIC_RELAXED, __HIP_MEMORY_SCOPE_AGENT)) < need) {
                if ((++polls & 255u) == 0u && __builtin_amdgcn_readfirstlane(__hip_atomic_load(tmo, __ATOMIC_RELAXED, __HIP_MEMORY_SCOPE_AGENT)) != 0u) break;
                if (__builtin_amdgcn_s_memrealtime() - t0 > 2000000ull) {
                    if (threadIdx.x == 0) { unsigned expect = 0u; __hip_atomic_compare_exchange_strong(tmo + 1, &expect, 0x600u | (unsigned)(u.pm & 0xff), __ATOMIC_RELAXED, __ATOMIC_RELAXED, __HIP_MEMORY_SCOPE_AGENT); __hip_atomic_store(tmo, 1u, __ATOMIC_RELAXED, __HIP_MEMORY_SCOPE_AGENT); }
                    break; }
                __builtin_amdgcn_s_sleep(2); }
            __builtin_amdgcn_fence(__ATOMIC_ACQUIRE, "agent");
            asm volatile("s_waitcnt vmcnt(0)" ::: "memory");
        }
#if !defined(BROKEN_HOOK_NO_BARRIER)
        asm volatile("" ::: "memory"); __builtin_amdgcn_s_barrier(); asm volatile("" ::: "memory");
#endif
    }
};

typedef __bf16 bf16x2_t __attribute__((ext_vector_type(2)));
__device__ __forceinline__ unsigned cvt_pk_bf16(float lo, float hi) { typedef float f2_t __attribute__((ext_vector_type(2))); const f2_t v = {lo, hi}; const bf16x2_t b = __builtin_convertvector(v, bf16x2_t); return __builtin_bit_cast(unsigned, b); }
typedef float f32x2 __attribute__((ext_vector_type(2)));
__device__ __forceinline__ f32x2 gelu_pk(f32x2 v) {
    const f32x2 av = __builtin_elementwise_abs(v), d = av * 0.2316418882f + 1.0f;
    f32x2 t; t.x = __builtin_amdgcn_rcpf(d.x); t.y = __builtin_amdgcn_rcpf(d.y);
    f32x2 q = t * 0.5307027145f + (-0.7265760135f); q = q * t + 0.7107068705f; q = q * t + (-0.142248368f); q = q * t + 0.127414796f; q = q * t;
    const f32x2 s = (v * v) * (-0.72134752044f);
    f32x2 e; e.x = __builtin_amdgcn_exp2f(s.x); e.y = __builtin_amdgcn_exp2f(s.y);
    const f32x2 m = v * (q * e), r = v - m;
    f32x2 o; o.x = v.x < 0.f ? m.x : r.x; o.y = v.y < 0.f ? m.y : r.y; return o;
}

struct EpiF32 {
    static constexpr bool PERM = false, AFTER_DRAIN = false;
    float* C; int ldc; const float* bias;
    __device__ __forceinline__ void operator()(const f32x4 (&acc)[2][2][4][2], const Unit& u, int wr, int wc, int fr, int fq) const {
        const int row0 = u.pm * BM + wr * 64 + fr, col0 = u.pn * BM + wc * 32 + 4 * fq;
        f32x4 bv[2][2];
#pragma unroll
        for (int bj = 0; bj < 2; ++bj)
#pragma unroll
            for (int n = 0; n < 2; ++n) bv[bj][n] = bias ? *(const f32x4*)(bias + col0 + bj * HALF + n * 16) : (f32x4){0.f, 0.f, 0.f, 0.f};
#pragma unroll
        for (int ai = 0; ai < 2; ++ai)
#pragma unroll
            for (int m = 0; m < 4; ++m) { float* rowp = C + (size_t)(row0 + ai * HALF + m * 16) * ldc + col0;
#pragma unroll
                for (int bj = 0; bj < 2; ++bj)
#pragma unroll
                    for (int n = 0; n < 2; ++n) *(f32x4*)(rowp + bj * HALF + n * 16) = acc[ai][bj][m][n] + bv[bj][n]; }
    }
};
template <int ACT  > struct EpiBf16 {
    static constexpr bool PERM = true, AFTER_DRAIN = false;
    bf16_t* O; int ldc; const float* bias; int split_cols; size_t split_stride;
    __device__ __forceinline__ void operator()(const f32x4 (&acc)[2][2][4][2], const Unit& u, int wr, int wc, int fr, int fq) const {
        const int row0 = u.pm * BM + wr * 64 + fr; int colt = u.pn * BM; bf16_t* base = O;
        if (split_cols) { const int t = colt / split_cols; base += (size_t)t * split_stride; colt -= t * split_cols; }
        const int col0 = colt + wc * 32 + 8 * fq, bcol0 = u.pn * BM + wc * 32 + 8 * fq;
        f32x4 bv[2][2];
#pragma unroll
        for (int bj = 0; bj < 2; ++bj)
#pragma unroll
            for (int n = 0; n < 2; ++n) bv[bj][n] = bias ? *(const f32x4*)(bias + bcol0 + bj * HALF + 4 * n) : (f32x4){0.f, 0.f, 0.f, 0.f};
#pragma unroll
        for (int ai = 0; ai < 2; ++ai)
#pragma unroll
            for (int m = 0; m < 4; ++m) { bf16_t* rowp = base + (size_t)(row0 + ai * HALF + m * 16) * ldc + col0;
#pragma unroll
                for (int bj = 0; bj < 2; ++bj) { f32x4 v0 = acc[ai][bj][m][0] + bv[bj][0], v1 = acc[ai][bj][m][1] + bv[bj][1];
                    if (ACT == 1) { f32x2 a = gelu_pk((f32x2){v0[0], v0[1]}), b = gelu_pk((f32x2){v0[2], v0[3]}), c = gelu_pk((f32x2){v1[0], v1[1]}), d = gelu_pk((f32x2){v1[2], v1[3]});
                        v0 = (f32x4){a.x, a.y, b.x, b.y}; v1 = (f32x4){c.x, c.y, d.x, d.y}; }
                    if (ACT == 2) {
#pragma unroll
                        for (int j = 0; j < 4; ++j) { v0[j] = 0.5f * v0[j] * (1.0f + erff(v0[j] * 0.70710678f)); v1[j] = 0.5f * v1[j] * (1.0f + erff(v1[j] * 0.70710678f)); } }
                    u32x4 w; w.x = cvt_pk_bf16(v0[0], v0[1]); w.y = cvt_pk_bf16(v0[2], v0[3]); w.z = cvt_pk_bf16(v1[0], v1[1]); w.w = cvt_pk_bf16(v1[2], v1[3]);
                    *(u32x4*)(rowp + bj * HALF) = w; } }
    }
};
template <class Epi, class Sched, bool STAMP = false>
__device__ __forceinline__ void gemm_phase(PG8_LAS unsigned char* lds, const Gemm g, const Sched& S, const Epi& E, unsigned long long* stamps) {
    const int tid = threadIdx.x, wid = __builtin_amdgcn_readfirstlane(tid >> 6), lane = tid & 63, wr = wid >> 2, wc = wid & 3, fr = lane & 15, fq = lane >> 4;
    const int K = g.K, nt = K / BK;
    int ts_lo = 0, ts_hi = 0, nts = 0; const unsigned long long rt_entry = STAMP ? (unsigned long long)wall_clock64() : 0ull;
#define PG8_STAMP() do { if (STAMP && wid == 0 && nts < 64) { const unsigned long long _c = (unsigned long long)clock64(); \
        ts_lo = (lane == nts) ? (int)(unsigned)_c : ts_lo; ts_hi = (lane == nts) ? (int)(unsigned)(_c >> 32) : ts_hi; ++nts; } } while (0)
    PG8_STAMP();
    unsigned voffA[2], voffB[2];
#pragma unroll
    for (int i = 0; i < 2; ++i) { int R, C; stage_rc(tid * 16 + i * 8192, R, C); const int Rb = Epi::PERM ? ((R & ~31) + perm32(R & 31)) : R;
        voffA[i] = (unsigned)(R * K + C) * 2u; voffB[i] = (unsigned)(Rb * K + C) * 2u; }
    const size_t kstep = (size_t)(BK * 2);
    const size_t hstep = (size_t)HALF * K * 2;
    const size_t tstep = 2 * hstep;
    const unsigned ldsw = (unsigned)wid * 1024u;
    const int aoff = lds_byte(wr * 64 + fr, fq * 8), boff = lds_byte(wc * 32 + fr, fq * 8);
#define PG8_SA(b, h) (((b) * 2 + (h)) * HTB)
#define PG8_SB(b, h) ((4 + (b) * 2 + (h)) * HTB)
#define PG8_STAGE(bufoff, gbase, voff) do { _Pragma("unroll") for (int _i = 0; _i < 2; ++_i) \
        __builtin_amdgcn_global_load_lds((const unsigned*)((const char*)(gbase) + (voff)[_i]), (PG8_LAS unsigned*)(lds + (bufoff) + ldsw + _i * 8192), 16, 0, 0); } while (0)
#define PG8_LDA(dst, b, h) do { _Pragma("unroll") for (int m = 0; m < 4; ++m) _Pragma("unroll") for (int k = 0; k < 2; ++k) dst[m][k] = *(const PG8_LAS bf16x8*)(lds + PG8_SA(b, h) + aoff + m * 2048 + k * 1024); } while (0)
#define PG8_LDB(dst, b, h) do { _Pragma("unroll") for (int n = 0; n < 2; ++n) _Pragma("unroll") for (int k = 0; k < 2; ++k) dst[n][k] = *(const PG8_LAS bf16x8*)(lds + PG8_SB(b, h) + boff + n * 2048 + k * 1024); } while (0)
#define PG8_MMA(ai, bj, At, Bt) do { __builtin_amdgcn_s_setprio(1); _Pragma("unroll") for (int m = 0; m < 4; ++m) _Pragma("unroll") for (int n = 0; n < 2; ++n) _Pragma("unroll") for (int k = 0; k < 2; ++k) \
        acc[ai][bj][m][n] = __builtin_amdgcn_mfma_f32_16x16x32_bf16(Bt[n][k], At[m][k], acc[ai][bj][m][n], 0, 0, 0); __builtin_amdgcn_s_setprio(0); } while (0)
#define PG8_WAIT_V(n) asm volatile("s_waitcnt vmcnt(" #n ")" ::: "memory")
#define PG8_WAIT_L(n) asm volatile("s_waitcnt lgkmcnt(" #n ")" ::: "memory")
#define PG8_BAR __builtin_amdgcn_s_barrier()
#define PG8_SCHED __builtin_amdgcn_sched_barrier(0)
    Unit cur, nxt; int ui = 0;
    if (!S.next(0, cur)) return;
    f32x4 acc[2][2][4][2];
#pragma unroll
    for (int a = 0; a < 2; ++a)
#pragma unroll
        for (int b = 0; b < 2; ++b)
#pragma unroll
            for (int m = 0; m < 4; ++m)
#pragma unroll
                for (int n = 0; n < 2; ++n) acc[a][b][m][n] = (f32x4){0.f, 0.f, 0.f, 0.f};
    bf16x8 At[4][2], B0[2][2], B1[2][2];
    const char* cA = (const char*)g.A + (size_t)cur.pm * tstep; const char* cB = (const char*)g.Bt + (size_t)cur.pn * tstep;
    S.a_ready(cur);
    PG8_STAGE(PG8_SB(0, 0), cB, voffB); PG8_STAGE(PG8_SA(0, 0), cA, voffA); PG8_STAGE(PG8_SB(0, 1), cB + hstep, voffB); PG8_STAGE(PG8_SA(0, 1), cA + hstep, voffA);
    if (wr == 1) PG8_BAR;
    PG8_WAIT_V(4); PG8_BAR;
    PG8_STAGE(PG8_SB(1, 0), cB + kstep, voffB); PG8_STAGE(PG8_SA(1, 0), cA + kstep, voffA); PG8_STAGE(PG8_SB(1, 1), cB + hstep + kstep, voffB);
    PG8_WAIT_V(6); PG8_BAR;
    PG8_STAMP();
    for (;;) {
        const bool has_next = S.next(ui + 1, nxt);
        const char* nA = has_next ? (const char*)g.A + (size_t)nxt.pm * tstep : cA; const char* nB = has_next ? (const char*)g.Bt + (size_t)nxt.pn * tstep : cB;
        for (int t = 0; t < nt; t += 2) {
            const bool last = (t == nt - 2);
            const char* a1 = cA + (size_t)(t + 1) * kstep;
            const char* a2 = last ? nA : cA + (size_t)(t + 2) * kstep; const char* b2 = last ? nB : cB + (size_t)(t + 2) * kstep;
            const char* a3 = a2 + kstep; const char* b3 = b2 + kstep;
            if (last && has_next) S.a_ready(nxt);
            PG8_LDB(B0, 0, 0); PG8_SCHED; PG8_LDA(At, 0, 0); PG8_STAGE(PG8_SA(1, 1), a1 + hstep, voffA);
            PG8_WAIT_L(8); PG8_BAR; PG8_WAIT_L(0); PG8_MMA(0, 0, At, B0); PG8_BAR; PG8_SCHED;
            PG8_LDB(B1, 0, 1); PG8_STAGE(PG8_SB(0, 0), b2, voffB);
            PG8_BAR; PG8_WAIT_L(0); PG8_MMA(0, 1, At, B1); PG8_BAR;
            PG8_LDA(At, 0, 1); PG8_STAGE(PG8_SA(0, 0), a2, voffA);
            PG8_BAR; PG8_WAIT_L(0); PG8_MMA(1, 0, At, B0); PG8_BAR; PG8_SCHED;
            PG8_STAGE(PG8_SB(0, 1), b2 + hstep, voffB);
            PG8_WAIT_V(6); PG8_BAR; PG8_MMA(1, 1, At, B1); PG8_BAR;
            PG8_LDB(B0, 1, 0); PG8_SCHED; PG8_LDA(At, 1, 0); PG8_STAGE(PG8_SA(0, 1), a2 + hstep, voffA);
            PG8_WAIT_L(8); PG8_BAR; PG8_WAIT_L(0); PG8_MMA(0, 0, At, B0); PG8_BAR; PG8_SCHED;
            PG8_LDB(B1, 1, 1); PG8_STAGE(PG8_SB(1, 0), b3, voffB);
            PG8_BAR; PG8_WAIT_L(0); PG8_MMA(0, 1, At, B1); PG8_BAR;
            PG8_LDA(At, 1, 1); PG8_STAGE(PG8_SA(1, 0), a3, voffA);
            PG8_BAR; PG8_WAIT_L(0); PG8_MMA(1, 0, At, B0); PG8_BAR; PG8_SCHED;
            PG8_STAGE(PG8_SB(1, 1), b3 + hstep, voffB);
            PG8_WAIT_V(6); PG8_BAR; PG8_MMA(1, 1, At, B1); PG8_BAR;
        }
        PG8_STAMP();
        if constexpr (!Epi::AFTER_DRAIN) { E(acc, cur, wr, wc, fr, fq); S.done(cur); }
        PG8_STAMP();
        if (!has_next) break;
#pragma unroll
        for (int a = 0; a < 2; ++a)
#pragma unroll
            for (int b = 0; b < 2; ++b)
#pragma unroll
                for (int m = 0; m < 4; ++m)
#pragma unroll
                    for (int n = 0; n < 2; ++n) acc[a][b][m][n] = (f32x4){0.f, 0.f, 0.f, 0.f};
        cur = nxt; cA = nA; cB = nB; ++ui;
    }
    PG8_WAIT_V(0);
    if (wr == 0) PG8_BAR;
    PG8_BAR;
    if constexpr (Epi::AFTER_DRAIN) { E.fused(acc, cur, wr, wc, fr, fq, lds, wid, lane); S.done(cur); }
    PG8_STAMP();
    if (STAMP && wid == 0) { stamps[lane] = lane < nts ? (((unsigned long long)(unsigned)ts_hi << 32) | (unsigned)ts_lo) : 0ull;
        if (lane == 62) stamps[62] = rt_entry; if (lane == 63) stamps[63] = (unsigned long long)wall_clock64(); }
#undef PG8_STAMP
#undef PG8_SA
#undef PG8_SB
#undef PG8_STAGE
#undef PG8_LDA
#undef PG8_LDB
#undef PG8_MMA
#undef PG8_WAIT_V
#undef PG8_WAIT_L
#undef PG8_BAR
#undef PG8_SCHED
}
}

constexpr int NB = 8, SEQ = 8192, DM = 1024, NTOK = NB * SEQ, NLAYER = 4, NCHUNK = 128;
constexpr int IN_W = 6868;
constexpr int NTHR = 512;
constexpr int LDS_BYTES = 160 * 1024;
constexpr int LDS_BAR_OFF = LDS_BYTES - 16;
#define LASP __attribute__((address_space(3)))

constexpr int PB_QC = 0, PB_KVC = 256, PB_IK = 384, PB_GALR = 448, PB_IW = 464, PB_LD = 512;
constexpr int PC_R = 0, PC_K = 512, PC_V = 1024, PC_WLR = 1536, PC_ALR = 1600, PC_GLR = 1664, PC_LD = 1792;

struct Params {
    const float *x, *c, *w_ada, *b_ada, *g_mix, *g_ffn, *w_in, *gla_w_a2, *gla_b_a, *gla_g_o, *dsa_g_qc, *dsa_w_uq, *dsa_w_iq, *dsa_g_kv, *dsa_w_uv;
    const float *rw_mu, *rw_w0, *rw_w_w2, *rw_a0, *rw_w_a2, *rw_w_g2, *rw_k_k, *rw_k_a, *rw_r_k, *rw_ln_g, *rw_ln_b, *w_branch, *w_out, *peer_w_q, *peer_keys, *peer_u, *peer_v, *g_final;
    float* out;
    unsigned* bar;
    float* mod;
    bf16_t *win_t, *wg_t, *wb_t, *wo_t, *wq_t, *wuq_t, *wiq_t, *wuv_t, *pkeys, *ww2_t, *wa2_t, *wg2_t;
    bf16_t *hbuf, *GQ, *GK, *GR, *GS, *GV, *PB, *PC, *yb, *yc, *kvn;
    float* gdec;
    bf16_t *qd, *qi, *qn, *ya, *Gtmp, *merged, *qp, *tu, *tv;
    unsigned short* pe_idx; float* pe_gate;
};

typedef __bf16 bf16x2_t __attribute__((ext_vector_type(2)));
__device__ __forceinline__ unsigned pk_bf16(float lo, float hi) { const f32x2 v = {lo, hi}; const bf16x2_t b = __builtin_convertvector(v, bf16x2_t); return __builtin_bit_cast(unsigned, b); }
__device__ __forceinline__ bf16_t f2bf(float f) { return (bf16_t)(pk_bf16(f, 0.f) & 0xffffu); }
__device__ __forceinline__ float bf2f(bf16_t v) { return __uint_as_float(((unsigned)v) << 16); }
__device__ __forceinline__ float bflo(unsigned u) { return __uint_as_float(u << 16); }
__device__ __forceinline__ float bfhi(unsigned u) { return __uint_as_float(u & 0xffff0000u); }
__device__ __forceinline__ float sigmoidf_(float x) { return __builtin_amdgcn_rcpf(1.0f + __expf(-x)); }
__device__ __forceinline__ float siluf_(float x) { return x * __builtin_amdgcn_rcpf(1.0f + __expf(-x)); }
__device__ __forceinline__ float softplusf_(float x) { return fmaxf(x, 0.f) + log1pf(__expf(-fabsf(x))); }
__device__ __forceinline__ float wave_sum(float v) {
#pragma unroll
    for (int o = 32; o >= 1; o >>= 1) v += __shfl_xor(v, o);
    return v;
}
template <int CTRL> __device__ __forceinline__ float dppf(float v) { return __int_as_float(__builtin_amdgcn_update_dpp(0, __float_as_int(v), CTRL, 0xF, 0xF, true)); }
template <int CTRL> __device__ __forceinline__ unsigned dppu(unsigned v) { return (unsigned)__builtin_amdgcn_update_dpp(0, (int)v, CTRL, 0xF, 0xF, true); }
__device__ __forceinline__ float row16_sum(float v) { v += dppf<0xB1>(v); v += dppf<0x4E>(v); v += dppf<0x141>(v); v += dppf<0x140>(v); return v; }
__device__ __forceinline__ float row16_max(float v) { v = fmaxf(v, dppf<0xB1>(v)); v = fmaxf(v, dppf<0x4E>(v)); v = fmaxf(v, dppf<0x141>(v)); v = fmaxf(v, dppf<0x140>(v)); return v; }
#define R16_STEP4(op, ctrl) \
    op " %0, %0, %0 " ctrl " row_mask:0xf bank_mask:0xf bound_ctrl:1\n\t" op " %1, %1, %1 " ctrl " row_mask:0xf bank_mask:0xf bound_ctrl:1\n\t" \
    op " %2, %2, %2 " ctrl " row_mask:0xf bank_mask:0xf bound_ctrl:1\n\t" op " %3, %3, %3 " ctrl " row_mask:0xf bank_mask:0xf bound_ctrl:1\n\t"
#define R16_ALL4(op) "s_nop 1\n\t" R16_STEP4(op, "quad_perm:[1,0,3,2]") R16_STEP4(op, "quad_perm:[2,3,0,1]") R16_STEP4(op, "row_half_mirror") R16_STEP4(op, "row_mirror") "s_nop 1"
__device__ __forceinline__ void row16_max_x4(float& a, float& b, float& c, float& d) { asm(R16_ALL4("v_max_f32_dpp") : "+v"(a), "+v"(b), "+v"(c), "+v"(d)); }
#define R16_STEP4_IN(op, ctrl) \
    op " %0, %4, %4 " ctrl " row_mask:0xf bank_mask:0xf bound_ctrl:1\n\t" op " %1, %5, %5 " ctrl " row_mask:0xf bank_mask:0xf bound_ctrl:1\n\t" \
    op " %2, %6, %6 " ctrl " row_mask:0xf bank_mask:0xf bound_ctrl:1\n\t" op " %3, %7, %7 " ctrl " row_mask:0xf bank_mask:0xf bound_ctrl:1\n\t"
__device__ __forceinline__ void row16_maxu_x4(unsigned (&o)[4], unsigned a, unsigned b, unsigned c, unsigned d) {
    asm("s_nop 1\n\t" R16_STEP4_IN("v_max_u32_dpp", "quad_perm:[1,0,3,2]") R16_STEP4("v_max_u32_dpp", "quad_perm:[2,3,0,1]") R16_STEP4("v_max_u32_dpp", "row_half_mirror") R16_STEP4("v_max_u32_dpp", "row_mirror") "s_nop 1"
        : "=&v"(o[0]), "=&v"(o[1]), "=&v"(o[2]), "=&v"(o[3]) : "v"(a), "v"(b), "v"(c), "v"(d)); }
__device__ __forceinline__ void row16_sum_x4(float& a, float& b, float& c, float& d) { asm(R16_ALL4("v_add_f32_dpp") : "+v"(a), "+v"(b), "+v"(c), "+v"(d)); }
__device__ __forceinline__ unsigned row16_maxu(unsigned v) { unsigned t; t = dppu<0xB1>(v); v = v > t ? v : t; t = dppu<0x4E>(v); v = v > t ? v : t; t = dppu<0x141>(v); v = v > t ? v : t; t = dppu<0x140>(v); v = v > t ? v : t; return v; }
__device__ __forceinline__ unsigned wave_scan_incl(unsigned v) {
    v += (unsigned)__builtin_amdgcn_update_dpp(0, (int)v, 0x111, 0xF, 0xF, false);
    v += (unsigned)__builtin_amdgcn_update_dpp(0, (int)v, 0x112, 0xF, 0xF, false);
    v += (unsigned)__builtin_amdgcn_update_dpp(0, (int)v, 0x114, 0xF, 0xF, false);
    v += (unsigned)__builtin_amdgcn_update_dpp(0, (int)v, 0x118, 0xF, 0xF, false);
    v += (unsigned)__builtin_amdgcn_update_dpp(0, (int)v, 0x142, 0xA, 0xF, false);
    v += (unsigned)__builtin_amdgcn_update_dpp(0, (int)v, 0x143, 0xC, 0xF, false);
    return v;
}
__device__ __forceinline__ unsigned fkey(float f) { unsigned u = __float_as_uint(f); if (f == 0.f) u = 0u; return (u & 0x80000000u) ? ~u : (u | 0x80000000u); }
__device__ __forceinline__ float fkey_inv(unsigned k) { const unsigned u = (k & 0x80000000u) ? (k & 0x7fffffffu) : ~k; return __uint_as_float(u); }

__device__ __forceinline__ bf16x8 ld_frag_g(const bf16_t* p) { return *(const bf16x8*)p; }
#define MFMA16(a, b, c) __builtin_amdgcn_mfma_f32_16x16x32_bf16((a), (b), (c), 0, 0, 0)

namespace pg8 {
struct EpiP {
    static constexpr bool PERM = true, AFTER_DRAIN = false;
    bf16_t *GQ, *GK, *GV, *GR, *PB, *PC;
    __device__ __forceinline__ void operator()(const f32x4 (&acc)[2][2][4][2], const Unit& u, int wr, int wc, int fr, int fq) const {
        const int pn = u.pn; bf16_t* base; int ldc, cb;
        if (pn == 0) { base = GQ; ldc = 256; cb = 0; } else if (pn == 1) { base = GK; ldc = 256; cb = 0; }
        else if (pn < 4) { base = GV; ldc = 512; cb = (pn - 2) * 256; } else if (pn < 6) { base = GR; ldc = 512; cb = (pn - 4) * 256; }
        else if (pn < 8) { base = PB; ldc = 512; cb = (pn - 6) * 256; } else { base = PC; ldc = 1792; cb = (pn - 8) * 256; }
        const int row0 = u.pm * BM + wr * 64 + fr, col0 = cb + wc * 32 + 8 * fq;
#pragma unroll
        for (int ai = 0; ai < 2; ++ai)
#pragma unroll
            for (int m = 0; m < 4; ++m) { bf16_t* rowp = base + (size_t)(row0 + ai * HALF + m * 16) * ldc + col0;
#pragma unroll
                for (int bj = 0; bj < 2; ++bj) { const f32x4 v0 = acc[ai][bj][m][0], v1 = acc[ai][bj][m][1];
                    u32x4 w; w.x = cvt_pk_bf16(v0[0], v0[1]); w.y = cvt_pk_bf16(v0[2], v0[3]); w.z = cvt_pk_bf16(v1[0], v1[1]); w.w = cvt_pk_bf16(v1[2], v1[3]);
                    *(u32x4*)(rowp + bj * HALF) = w; } }
    }
};
template <int SIG> struct EpiStore {
    static constexpr bool PERM = true, AFTER_DRAIN = false;
    bf16_t* O; int ldc;
    __device__ __forceinline__ void operator()(const f32x4 (&acc)[2][2][4][2], const Unit& u, int wr, int wc, int fr, int fq) const {
        const int row0 = u.pm * BM + wr * 64 + fr, col0 = u.pn * BM + wc * 32 + 8 * fq;
#pragma unroll
        for (int ai = 0; ai < 2; ++ai)
#pragma unroll
            for (int m = 0; m < 4; ++m) { bf16_t* rowp = O + (size_t)(row0 + ai * HALF + m * 16) * ldc + col0;
#pragma unroll
                for (int bj = 0; bj < 2; ++bj) { f32x4 v0 = acc[ai][bj][m][0], v1 = acc[ai][bj][m][1];
                    if (SIG) {
#pragma unroll
                        for (int j = 0; j < 4; ++j) { v0[j] = __builtin_amdgcn_rcpf(1.0f + __expf(-v0[j])); v1[j] = __builtin_amdgcn_rcpf(1.0f + __expf(-v1[j])); } }
                    u32x4 w; w.x = cvt_pk_bf16(v0[0], v0[1]); w.y = cvt_pk_bf16(v0[2], v0[3]); w.z = cvt_pk_bf16(v1[0], v1[1]); w.w = cvt_pk_bf16(v1[2], v1[3]);
                    *(u32x4*)(rowp + bj * HALF) = w; } }
    }
};
template <int FIRST> struct EpiMerge {
    static constexpr bool PERM = true, AFTER_DRAIN = false;
    const bf16_t* G; bf16_t* O; int ldc;
    __device__ __forceinline__ void operator()(const f32x4 (&acc)[2][2][4][2], const Unit& u, int wr, int wc, int fr, int fq) const {
        const int row0 = u.pm * BM + wr * 64 + fr, col0 = u.pn * BM + wc * 32 + 8 * fq;
#pragma unroll
        for (int ai = 0; ai < 2; ++ai)
#pragma unroll
            for (int m = 0; m < 4; ++m) { const size_t off = (size_t)(row0 + ai * HALF + m * 16) * ldc + col0;
#pragma unroll
                for (int bj = 0; bj < 2; ++bj) { const f32x4 v0 = acc[ai][bj][m][0], v1 = acc[ai][bj][m][1];
                    const u32x4 g = *(const u32x4*)(G + off + bj * HALF);
                    float o[8];
                    o[0] = __uint_as_float(g.x << 16) * v0[0]; o[1] = __uint_as_float(g.x & 0xffff0000u) * v0[1]; o[2] = __uint_as_float(g.y << 16) * v0[2]; o[3] = __uint_as_float(g.y & 0xffff0000u) * v0[3];
                    o[4] = __uint_as_float(g.z << 16) * v1[0]; o[5] = __uint_as_float(g.z & 0xffff0000u) * v1[1]; o[6] = __uint_as_float(g.w << 16) * v1[2]; o[7] = __uint_as_float(g.w & 0xffff0000u) * v1[3];
                    if (!FIRST) { const u32x4 p = *(const u32x4*)(O + off + bj * HALF);
                        o[0] += __uint_as_float(p.x << 16); o[1] += __uint_as_float(p.x & 0xffff0000u); o[2] += __uint_as_float(p.y << 16); o[3] += __uint_as_float(p.y & 0xffff0000u);
                        o[4] += __uint_as_float(p.z << 16); o[5] += __uint_as_float(p.z & 0xffff0000u); o[6] += __uint_as_float(p.w << 16); o[7] += __uint_as_float(p.w & 0xffff0000u); }
                    u32x4 w; w.x = cvt_pk_bf16(o[0], o[1]); w.y = cvt_pk_bf16(o[2], o[3]); w.z = cvt_pk_bf16(o[4], o[5]); w.w = cvt_pk_bf16(o[6], o[7]);
                    *(u32x4*)(O + off + bj * HALF) = w; } }
    }
};
struct EpiResid {
    static constexpr bool PERM = false, AFTER_DRAIN = false;
    const float* xin; float* xout; const float* gate;
    __device__ __forceinline__ void operator()(const f32x4 (&acc)[2][2][4][2], const Unit& u, int wr, int wc, int fr, int fq) const {
        const int row0 = u.pm * BM + wr * 64 + fr, col0 = u.pn * BM + wc * 32 + 4 * fq;
        const float* gp = gate + (size_t)((u.pm * BM) >> 13) * 6144;
        f32x4 gv[2][2];
#pragma unroll
        for (int bj = 0; bj < 2; ++bj)
#pragma unroll
            for (int n = 0; n < 2; ++n) gv[bj][n] = *(const f32x4*)(gp + col0 + bj * HALF + n * 16);
#pragma unroll
        for (int ai = 0; ai < 2; ++ai)
#pragma unroll
            for (int m = 0; m < 4; ++m) { const size_t off = (size_t)(row0 + ai * HALF + m * 16) * 1024 + col0;
#pragma unroll
                for (int bj = 0; bj < 2; ++bj)
#pragma unroll
                    for (int n = 0; n < 2; ++n) { const f32x4 xi = *(const f32x4*)(xin + off + bj * HALF + n * 16);
                        *(f32x4*)(xout + off + bj * HALF + n * 16) = xi + gv[bj][n] * acc[ai][bj][m][n]; } }
    }
};

#ifndef EPI_DEPTH
#define EPI_DEPTH 2
#endif
struct EpiGen {
    static constexpr bool PERM = true, AFTER_DRAIN = false;
    int kind; int ldc;
    bf16_t* O; const bf16_t* G;
    bf16_t *GQ, *GK, *GV, *GR, *PB, *PC;
    const float* xin; float* xout; const float* gate;
    __device__ __forceinline__ void operator()(const f32x4 (&acc)[2][2][4][2], const Unit& u, int wr, int wc, int fr, int fq) const {
        const int row0 = u.pm * BM + wr * 64 + fr;
#ifdef DBG_DOUBLE
        if (kind == 6) return;
        const float pmul = kind == 7 ? 0.f : 1.f;
#define EPI_PMUL(x) ((x) * pmul)
#define EPI_K4(k) ((k) <= 4 || (k) == 7)
#else
#define EPI_PMUL(x) (x)
#define EPI_K4(k) ((k) <= 4)
#endif
        if (kind <= 2) {
            bf16_t* base = O; int ld = ldc, cb = u.pn * BM;
            if (kind == 0) { const int pn = u.pn;
                if (pn == 0) { base = GQ; ld = 256; cb = 0; } else if (pn == 1) { base = GK; ld = 256; cb = 0; }
                else if (pn < 4) { base = GV; ld = 512; cb = (pn - 2) * 256; } else if (pn < 6) { base = GR; ld = 512; cb = (pn - 4) * 256; }
                else if (pn < 8) { base = PB; ld = 512; cb = (pn - 6) * 256; } else { base = PC; ld = 1792; cb = (pn - 8) * 256; } }
            const int col0 = cb + wc * 32 + 8 * fq; const bool sig = kind == 2;
#pragma unroll
            for (int ai = 0; ai < 2; ++ai)
#pragma unroll
                for (int m = 0; m < 4; ++m) { bf16_t* rowp = base + (size_t)(row0 + ai * HALF + m * 16) * ld + col0;
#pragma unroll
                    for (int bj = 0; bj < 2; ++bj) { f32x4 v0 = acc[ai][bj][m][0], v1 = acc[ai][bj][m][1];
                        if (sig) {
#pragma unroll
                            for (int j = 0; j < 4; ++j) { v0[j] = __builtin_amdgcn_rcpf(1.0f + __expf(-v0[j])); v1[j] = __builtin_amdgcn_rcpf(1.0f + __expf(-v1[j])); } }
                        u32x4 w; w.x = cvt_pk_bf16(v0[0], v0[1]); w.y = cvt_pk_bf16(v0[2], v0[3]); w.z = cvt_pk_bf16(v1[0], v1[1]); w.w = cvt_pk_bf16(v1[2], v1[3]);
                        *(u32x4*)(rowp + bj * HALF) = w; } }
        } else if (EPI_K4(kind)) {
            const int col0 = u.pn * BM + wc * 32 + 8 * fq; const bool first = kind == 3;
            const u32x4 z4 = {0u, 0u, 0u, 0u};
            u32x4 gq[EPI_DEPTH][2], pq[EPI_DEPTH][2];
#define EPI_LD34(am_, slot_) do { const int ai2 = (am_) >> 2, m2 = (am_) & 3; const size_t off2 = (size_t)(row0 + ai2 * HALF + m2 * 16) * 1024 + col0; \
                _Pragma("unroll") for (int bj = 0; bj < 2; ++bj) { gq[slot_][bj] = *(const u32x4*)(G + off2 + bj * HALF); pq[slot_][bj] = first ? z4 : *(const u32x4*)(O + off2 + bj * HALF); } } while (0)
#pragma unroll
            for (int d = 0; d < EPI_DEPTH; ++d) EPI_LD34(d, d);
#pragma unroll
            for (int am = 0; am < 8; ++am) { const int ai = am >> 2, m = am & 3; const size_t off = (size_t)(row0 + ai * HALF + m * 16) * 1024 + col0;
                u32x4 gc[2], pc[2];
#pragma unroll
                for (int bj = 0; bj < 2; ++bj) { gc[bj] = gq[am % EPI_DEPTH][bj]; pc[bj] = pq[am % EPI_DEPTH][bj]; }
                if (am + EPI_DEPTH < 8) EPI_LD34(am + EPI_DEPTH, am % EPI_DEPTH);
#pragma unroll
                for (int bj = 0; bj < 2; ++bj) { const f32x4 v0 = acc[ai][bj][m][0], v1 = acc[ai][bj][m][1]; const u32x4 g = gc[bj], p = pc[bj];
                    float o[8];
                    o[0] = __uint_as_float(g.x << 16) * EPI_PMUL(v0[0]) + __uint_as_float(p.x << 16); o[1] = __uint_as_float(g.x & 0xffff0000u) * EPI_PMUL(v0[1]) + __uint_as_float(p.x & 0xffff0000u);
                    o[2] = __uint_as_float(g.y << 16) * EPI_PMUL(v0[2]) + __uint_as_float(p.y << 16); o[3] = __uint_as_float(g.y & 0xffff0000u) * EPI_PMUL(v0[3]) + __uint_as_float(p.y & 0xffff0000u);
                    o[4] = __uint_as_float(g.z << 16) * EPI_PMUL(v1[0]) + __uint_as_float(p.z << 16); o[5] = __uint_as_float(g.z & 0xffff0000u) * EPI_PMUL(v1[1]) + __uint_as_float(p.z & 0xffff0000u);
                    o[6] = __uint_as_float(g.w << 16) * EPI_PMUL(v1[2]) + __uint_as_float(p.w << 16); o[7] = __uint_as_float(g.w & 0xffff0000u) * EPI_PMUL(v1[3]) + __uint_as_float(p.w & 0xffff0000u);
                    u32x4 w; w.x = cvt_pk_bf16(o[0], o[1]); w.y = cvt_pk_bf16(o[2], o[3]); w.z = cvt_pk_bf16(o[4], o[5]); w.w = cvt_pk_bf16(o[6], o[7]);
                    *(u32x4*)(O + off + bj * HALF) = w; } }
        } else {
            const int col0 = u.pn * BM + wc * 32 + 8 * fq;
            const float* gp = gate + (size_t)((u.pm * BM) >> 13) * 6144;
            f32x4 gv[2][2];
#pragma unroll
            for (int bj = 0; bj < 2; ++bj)
#pragma unroll
                for (int n = 0; n < 2; ++n) gv[bj][n] = *(const f32x4*)(gp + col0 + bj * HALF + n * 4);
            f32x4 xq[EPI_DEPTH][2][2];
#define EPI_LD5(am_, slot_) do { const int ai2 = (am_) >> 2, m2 = (am_) & 3; const size_t off2 = (size_t)(row0 + ai2 * HALF + m2 * 16) * 1024 + col0; \
                _Pragma("unroll") for (int bj = 0; bj < 2; ++bj) _Pragma("unroll") for (int n = 0; n < 2; ++n) xq[slot_][bj][n] = *(const f32x4*)(xin + off2 + bj * HALF + n * 4); } while (0)
#pragma unroll
            for (int d = 0; d < EPI_DEPTH; ++d) EPI_LD5(d, d);
#pragma unroll
            for (int am = 0; am < 8; ++am) { const int ai = am >> 2, m = am & 3; const size_t off = (size_t)(row0 + ai * HALF + m * 16) * 1024 + col0;
                f32x4 xc[2][2];
#pragma unroll
                for (int bj = 0; bj < 2; ++bj)
#pragma unroll
                    for (int n = 0; n < 2; ++n) xc[bj][n] = xq[am % EPI_DEPTH][bj][n];
                if (am + EPI_DEPTH < 8) EPI_LD5(am + EPI_DEPTH, am % EPI_DEPTH);
#pragma unroll
                for (int bj = 0; bj < 2; ++bj)
#pragma unroll
                    for (int n = 0; n < 2; ++n) *(f32x4*)(xout + off + bj * HALF + n * 4) = xc[bj][n] + gv[bj][n] * acc[ai][bj][m][n]; }
        }
    }
};
}

template <class Epi> __device__ __forceinline__ void run_gemm(LASP unsigned char* lds, const bf16_t* A, const bf16_t* Bt, int M, int N, int K, const Epi& E, int wg, int nwg) {
    pg8::Gemm g; g.A = A; g.Bt = Bt; g.M = M; g.N = N; g.K = K;
    pg8::StaticOrder S; S.init(M, N, nwg, wg);
    pg8::gemm_phase<Epi, pg8::StaticOrder, false>(lds, g, S, E, nullptr);
    __syncthreads();
}

__device__ __forceinline__ int pmap(int n) {
    if (n < 1024) return n;
    if (n < 1536) return 1040 + (n - 1024);
    if (n < 1792) return 1552 + (n - 1536);
    if (n < 1920) return 1808 + (n - 1792);
    if (n < 1984) return 1936 + (n - 1920);
    if (n < 2000) return 1024 + (n - 1984);
    if (n < 2004) return 2000 + (n - 2000);
    if (n < 2048) return -1;
    return 2004 + (n - 2048);
}
__device__ __forceinline__ void tcvt_tile(const float* src, int ldsrc, bf16_t* dst, int K, int n0, int k0, int mode, LASP float* tile) {
    const int tid = threadIdx.x, j = tid & 63, i = tid >> 6;
    const int n = n0 + j; const int c = mode == 0 ? n : (mode == 1 ? pmap(n) : n + 3796);
#pragma unroll
    for (int ii = 0; ii < 8; ++ii) { const int kk = ii * 8 + i; tile[kk * 65 + j] = c >= 0 ? src[(size_t)(k0 + kk) * ldsrc + c] : 0.f; }
    __syncthreads();
#pragma unroll
    for (int it = 0; it < 8; ++it) { const int jj = it * 8 + (tid >> 6), kk = tid & 63; dst[(size_t)(n0 + jj) * K + k0 + kk] = f2bf(tile[kk * 65 + jj]); }
    __syncthreads();
}
constexpr int W_TILES_L = 960 + 768 + 384 + 256 + 256 + 64 + 16 + 16 + 8 + 8 + 16;
constexpr int W_TILES = W_TILES_L * NLAYER, W_MOD_UNITS = 384, W_PK_UNITS = 128;
template <int PART> __device__ __forceinline__ void phase_weights(const Params& p, LASP unsigned char* lds, int wg, int nwg) {
    LASP float* tile = (LASP float*)lds;
    const int tid = threadIdx.x;
    if constexpr (PART == 0) {
        for (int id = wg; id < NLAYER * 1728; id += nwg) { const int l = id / 1728; int t = id % 1728;
            if (t < 960) tcvt_tile(p.w_in + (size_t)l * 1024 * IN_W, IN_W, p.win_t + (size_t)l * 3840 * 1024, 1024, (t % 60) * 64, (t / 60) * 64, 1, tile);
            else { t -= 960; tcvt_tile(p.w_in + (size_t)l * 1024 * IN_W, IN_W, p.wg_t + (size_t)l * 3072 * 1024, 1024, (t % 48) * 64, (t / 48) * 64, 2, tile); } }
    } else if constexpr (PART == 1) {
        for (int id = wg; id < NLAYER * 896; id += nwg) { const int l = id / 896; int t = id % 896;
            if (t < 384) { const int j = t / 128, r = t % 128; tcvt_tile(p.w_branch + (size_t)(l * 3 + j) * 512 * 1024, 1024, p.wb_t + (size_t)(l * 3 + j) * 1024 * 512, 512, (r % 16) * 64, (r / 16) * 64, 0, tile); }
            else if (t < 640) { t -= 384; tcvt_tile(p.w_out + (size_t)l * 1024 * 1024, 1024, p.wo_t + (size_t)l * 1024 * 1024, 1024, (t % 16) * 64, (t / 16) * 64, 0, tile); }
            else { t -= 640; tcvt_tile(p.peer_w_q + (size_t)l * 1024 * 1024, 1024, p.wq_t + (size_t)l * 1024 * 1024, 1024, (t % 16) * 64, (t / 16) * 64, 0, tile); } }
    } else if constexpr (PART == 2) {
        for (int id = wg; id < NLAYER * 96; id += nwg) { const int l = id / 96; int t = id % 96;
            if (t < 64) tcvt_tile(p.dsa_w_uq + (size_t)l * 256 * 1024, 1024, p.wuq_t + (size_t)l * 1024 * 256, 256, (t % 16) * 64, (t / 16) * 64, 0, tile);
            else if (t < 80) { t -= 64; tcvt_tile(p.dsa_w_iq + (size_t)l * 256 * 256, 256, p.wiq_t + (size_t)l * 256 * 256, 256, (t % 4) * 64, (t / 4) * 64, 0, tile); }
            else { t -= 80; const int h = t / 2, kt = t % 2; tcvt_tile(p.dsa_w_uv + (size_t)(l * 8 + h) * 128 * 64, 64, p.wuv_t + (size_t)(l * 8 + h) * 64 * 128, 128, 0, kt * 64, 0, tile); } }
    } else if constexpr (PART == 3) {
        for (int id = wg; id < NLAYER * 32; id += nwg) { const int l = id / 32; int t = id % 32;
            if (t < 8) tcvt_tile(p.rw_w_w2 + (size_t)l * 64 * 512, 512, p.ww2_t + (size_t)l * 512 * 64, 64, t * 64, 0, 0, tile);
            else if (t < 16) { t -= 8; tcvt_tile(p.rw_w_a2 + (size_t)l * 64 * 512, 512, p.wa2_t + (size_t)l * 512 * 64, 64, t * 64, 0, 0, tile); }
            else { t -= 16; tcvt_tile(p.rw_w_g2 + (size_t)l * 128 * 512, 512, p.wg2_t + (size_t)l * 512 * 128, 128, (t % 8) * 64, (t / 8) * 64, 0, tile); } }
    } else {
        for (int u = wg; u < W_PK_UNITS; u += nwg) {
            const size_t e = (size_t)u * 4096 + (size_t)tid * 8;
            const f32x4 a = *(const f32x4*)(p.peer_keys + e), b = *(const f32x4*)(p.peer_keys + e + 4);
            u32x4 w; w.x = pk_bf16(a[0], a[1]); w.y = pk_bf16(a[2], a[3]); w.z = pk_bf16(b[0], b[1]); w.w = pk_bf16(b[2], b[3]);
            *(u32x4*)(p.pkeys + e) = w;
        }
        bool have = false;
        for (int u = wg; u < W_MOD_UNITS; u += nwg) {
            LASP float* cond = (LASP float*)lds;
            LASP float* red = (LASP float*)(lds + 32768);
            if (!have) { for (int i = tid; i < 8 * 1024; i += NTHR) cond[i] = siluf_(p.c[i]); have = true; }
            __syncthreads();
            const int l = u / 96, cb = u % 96, col = cb * 64 + (tid & 63), ks = tid >> 6;
            float acc[8];
#pragma unroll
            for (int b = 0; b < 8; ++b) acc[b] = 0.f;
            const float* wp = p.w_ada + (size_t)l * 1024 * 6144 + col;
            for (int k = ks * 128; k < ks * 128 + 128; ++k) { const float w = wp[(size_t)k * 6144];
#pragma unroll
                for (int b = 0; b < 8; ++b) acc[b] = fmaf(w, cond[b * 1024 + k], acc[b]); }
#pragma unroll
            for (int b = 0; b < 8; ++b) red[(ks * 8 + b) * 64 + (tid & 63)] = acc[b];
            __syncthreads();
            { const int b = tid >> 6, cc = tid & 63; float s = 0.f;
#pragma unroll
              for (int k2 = 0; k2 < 8; ++k2) s += red[(k2 * 8 + b) * 64 + cc];
              p.mod[((size_t)l * 8 + b) * 6144 + cb * 64 + cc] = s + p.b_ada[(size_t)l * 6144 + cb * 64 + cc]; }
            __syncthreads();
        }
    }
}

__device__ void phase_adaln(const float* x, const float* g, const float* modl  , int sh_off, int sc_off, bf16_t* h, int wg, int nwg) {
    const int lane = threadIdx.x & 63, wave = threadIdx.x >> 6;
    int tok = wg * 8 + wave;
    f32x4 vn[4];
    if (tok < NTOK) { const f32x4* xr = (const f32x4*)(x + (size_t)tok * 1024);
#pragma unroll
        for (int i = 0; i < 4; ++i) vn[i] = xr[lane + 64 * i]; }
    for (; tok < NTOK; tok += nwg * 8) {
        f32x4 v[4]; float ss = 0.f;
#pragma unroll
        for (int i = 0; i < 4; ++i) { v[i] = vn[i]; ss += v[i][0] * v[i][0] + v[i][1] * v[i][1] + v[i][2] * v[i][2] + v[i][3] * v[i][3]; }
        if (tok + nwg * 8 < NTOK) { const f32x4* xr = (const f32x4*)(x + (size_t)(tok + nwg * 8) * 1024);
#pragma unroll
            for (int i = 0; i < 4; ++i) vn[i] = xr[lane + 64 * i]; }
        ss = wave_sum(ss);
        const float rstd = rsqrtf(ss * (1.0f / 1024.0f) + 1e-6f);
        const float* mb = modl + (size_t)(tok >> 13) * 6144;
#pragma unroll
        for (int i = 0; i < 4; ++i) { const int col = 4 * (lane + 64 * i);
            const f32x4 gg = *(const f32x4*)(g + col), sc = *(const f32x4*)(mb + sc_off + col), sh = *(const f32x4*)(mb + sh_off + col);
            f32x4 o = (v[i] * rstd) * gg; o = o * (sc + 1.0f) + sh;
            u32x2 w; w.x = pk_bf16(o[0], o[1]); w.y = pk_bf16(o[2], o[3]);
            *(u32x2*)(h + (size_t)tok * 1024 + col) = w; }
    }
}
__device__ void phase_final(float* x, const float* g, int wg, int nwg) {
    const int lane = threadIdx.x & 63, wave = threadIdx.x >> 6;
    for (int tok = wg * 8 + wave; tok < NTOK; tok += nwg * 8) {
        f32x4* xr = (f32x4*)(x + (size_t)tok * 1024);
        f32x4 v[4]; float ss = 0.f;
#pragma unroll
        for (int i = 0; i < 4; ++i) { v[i] = xr[lane + 64 * i]; ss += v[i][0] * v[i][0] + v[i][1] * v[i][1] + v[i][2] * v[i][2] + v[i][3] * v[i][3]; }
        ss = wave_sum(ss);
        const float rstd = rsqrtf(ss * (1.0f / 1024.0f) + 1e-6f);
#pragma unroll
        for (int i = 0; i < 4; ++i) { const f32x4 gg = *(const f32x4*)(g + 4 * (lane + 64 * i)); xr[lane + 64 * i] = (v[i] * rstd) * gg; }
    }
}

__device__ void phase_gla1(const Params& p, int l, LASP unsigned char* lds, int wg, int nwg) {
    LASP float* alr = (LASP float*)lds;
    LASP float* part = (LASP float*)(lds + 4096);
    LASP bf16_t* kdT = (LASP bf16_t*)(lds + 8192);
    LASP bf16_t* vT = (LASP bf16_t*)(lds + 8192 + 9216);
    const int tid = threadIdx.x, lane = tid & 63, wave = tid >> 6;
    const int k = tid & 63, tq = tid >> 6;
    constexpr int NU = NB * NCHUNK * 4;
    bf16_t alr_n[2], gk_n[8]; u32x4 va_n, vb_n;
    auto ldu = [&](int u) { const int h = u & 3, c = (u >> 2) & 127, b = u >> 9; const size_t t0 = (size_t)b * SEQ + (size_t)c * 64;
#pragma unroll
        for (int j = 0; j < 2; ++j) { const int i = tid + j * NTHR; alr_n[j] = p.PB[(t0 + (i >> 4)) * PB_LD + PB_GALR + (i & 15)]; }
        { const int t = tid >> 3, vq = tid & 7; const bf16_t* vp = p.GV + (t0 + t) * 512 + h * 128 + vq * 16; va_n = *(const u32x4*)vp; vb_n = *(const u32x4*)(vp + 8); }
#pragma unroll
        for (int i = 0; i < 8; ++i) gk_n[i] = p.GK[(t0 + tq * 8 + i) * 256 + h * 64 + k]; };
    float wa[16]; float ba = 0.f; int hcur = -1;
#pragma unroll
    for (int r = 0; r < 16; ++r) wa[r] = 0.f;
    if (wg < NU) ldu(wg);
    for (int u = wg; u < NU; u += nwg) {
        const int h = u & 3;
        bf16_t alr_c[2], gk_c[8];
#pragma unroll
        for (int j = 0; j < 2; ++j) alr_c[j] = alr_n[j];
#pragma unroll
        for (int i = 0; i < 8; ++i) gk_c[i] = gk_n[i];
        const u32x4 a = va_n, bq = vb_n;
        if (h != hcur) { hcur = h;
#pragma unroll
            for (int r = 0; r < 16; ++r) wa[r] = p.gla_w_a2[((size_t)l * 16 + r) * 256 + h * 64 + k];
            ba = p.gla_b_a[(size_t)l * 256 + h * 64 + k]; }
        ldu(u + nwg < NU ? u + nwg : u);
#pragma unroll
        for (int j = 0; j < 2; ++j) alr[tid + j * NTHR] = bf2f(alr_c[j]);
        { const int t = tid >> 3, vq = tid & 7;
          const unsigned w[8] = {a.x, a.y, a.z, a.w, bq.x, bq.y, bq.z, bq.w};
#pragma unroll
          for (int j = 0; j < 8; ++j) { vT[(vq * 16 + 2 * j) * 72 + t] = (bf16_t)(w[j] & 0xffffu); vT[(vq * 16 + 2 * j + 1) * 72 + t] = (bf16_t)(w[j] >> 16); } }
        __syncthreads();
        float cum[8]; float run = 0.f;
#pragma unroll
        for (int i = 0; i < 8; ++i) { const int t = tq * 8 + i; float g = ba;
#pragma unroll
            for (int r = 0; r < 16; ++r) g = fmaf(alr[t * 16 + r], wa[r], g);
            const float ls = fminf(g, 0.f) - log1pf(__expf(-fabsf(g)));
            run += ls * (1.0f / 16.0f); cum[i] = run; }
        part[tq * 64 + k] = run;
        __syncthreads();
        float off = 0.f, tot = 0.f;
#pragma unroll
        for (int q = 0; q < 8; ++q) { const float v = part[q * 64 + k]; tot += v; if (q < tq) off += v; }
#pragma unroll
        for (int i = 0; i < 8; ++i) { const int t = tq * 8 + i; const float kv = bf2f(gk_c[i]);
            kdT[k * 72 + t] = f2bf(kv * __expf(tot - (off + cum[i]))); }
        if (tq == 0) p.gdec[(size_t)u * 64 + k] = __expf(tot);
        __syncthreads();
        { const int fr = lane & 15, fq = lane >> 4;
          bf16x8 bfr[2];
#pragma unroll
          for (int ks = 0; ks < 2; ++ks) bfr[ks] = *(const LASP bf16x8*)(vT + (wave * 16 + fr) * 72 + ks * 32 + fq * 8);
          bf16_t* gs = p.GS + (size_t)u * 8192 + (size_t)(wave * 16 + fr) * 64;
#pragma unroll
          for (int mt = 0; mt < 4; ++mt) { f32x4 acc = {0.f, 0.f, 0.f, 0.f};
#pragma unroll
              for (int ks = 0; ks < 2; ++ks) { const bf16x8 afr = *(const LASP bf16x8*)(kdT + (mt * 16 + fr) * 72 + ks * 32 + fq * 8); acc = MFMA16(afr, bfr[ks], acc); }
              u32x2 w; w.x = pk_bf16(acc[0], acc[1]); w.y = pk_bf16(acc[2], acc[3]);
              *(u32x2*)(gs + mt * 16 + fq * 4) = w; } }
        __syncthreads();
    }
}
__device__ void phase_gla2(const Params& p, int wg, int nwg) {
    for (int e = wg * NTHR + threadIdx.x; e < NB * 4 * 128 * 32; e += nwg * NTHR) {
        const int kp = e & 31, v = (e >> 5) & 127, h = (e >> 12) & 3, b = e >> 14;
        float s0 = 0.f, s1 = 0.f;
        for (int c0 = 0; c0 < NCHUNK; c0 += 4) {
            unsigned uv[4]; f32x2 dv[4];
#pragma unroll
            for (int j = 0; j < 4; ++j) { const size_t u = ((size_t)b * NCHUNK + c0 + j) * 4 + h; uv[j] = *(const unsigned*)(p.GS + u * 8192 + v * 64 + 2 * kp); dv[j] = *(const f32x2*)(p.gdec + u * 64 + 2 * kp); }
#pragma unroll
            for (int j = 0; j < 4; ++j) { const size_t u = ((size_t)b * NCHUNK + c0 + j) * 4 + h;
                s0 = fmaf(dv[j][0], s0, bflo(uv[j])); s1 = fmaf(dv[j][1], s1, bfhi(uv[j]));
                *(unsigned*)(p.GS + u * 8192 + v * 64 + 2 * kp) = pk_bf16(s0, s1); }
        }
    }
}
__device__ void phase_gla3(const Params& p, int l, LASP unsigned char* lds, int wg, int nwg) {
    LASP float* ssq = (LASP float*)lds;
    const int tid = threadIdx.x, lane = tid & 63, wave = tid >> 6, fr = lane & 15, fq = lane >> 4;
    const int nt = wave & 3, vh = wave >> 2;
    for (int u = wg; u < NB * NCHUNK * 4; u += nwg) {
        const int h = u & 3, c = (u >> 2) & 127, b = u >> 9; const size_t t0 = (size_t)b * SEQ + (size_t)c * 64;
        bf16x8 bq[2];
#pragma unroll
        for (int ks = 0; ks < 2; ++ks) bq[ks] = ld_frag_g(p.GQ + (t0 + nt * 16 + fr) * 256 + h * 64 + ks * 32 + fq * 8);
        f32x4 acc[4];
#pragma unroll
        for (int mi = 0; mi < 4; ++mi) { acc[mi] = (f32x4){0.f, 0.f, 0.f, 0.f};
#pragma unroll
            for (int ks = 0; ks < 2; ++ks) { const bf16x8 a = ld_frag_g(p.GS + (size_t)u * 8192 + (size_t)((vh * 4 + mi) * 16 + fr) * 64 + ks * 32 + fq * 8); acc[mi] = MFMA16(a, bq[ks], acc[mi]); } }
        float ss = 0.f;
#pragma unroll
        for (int mi = 0; mi < 4; ++mi) ss += acc[mi][0] * acc[mi][0] + acc[mi][1] * acc[mi][1] + acc[mi][2] * acc[mi][2] + acc[mi][3] * acc[mi][3];
        ss += __shfl_xor(ss, 16); ss += __shfl_xor(ss, 32);
        if (fq == 0) ssq[vh * 64 + nt * 16 + fr] = ss;
        __syncthreads();
        const float tot = ssq[nt * 16 + fr] + ssq[64 + nt * 16 + fr];
        const float sc = 0.125f * rsqrtf(tot * (1.0f / 8192.0f) + 1e-6f);
        const size_t trow = t0 + nt * 16 + fr;
#pragma unroll
        for (int mi = 0; mi < 4; ++mi) { const int v0 = (vh * 4 + mi) * 16 + fq * 4;
            const u32x2 rr = *(const u32x2*)(p.GR + trow * 512 + h * 128 + v0);
            const f32x4 go = *(const f32x4*)(p.gla_g_o + (size_t)l * 128 + v0);
            const float o0 = acc[mi][0] * sc * go[0] * siluf_(bflo(rr.x)), o1 = acc[mi][1] * sc * go[1] * siluf_(bfhi(rr.x));
            const float o2 = acc[mi][2] * sc * go[2] * siluf_(bflo(rr.y)), o3 = acc[mi][3] * sc * go[3] * siluf_(bfhi(rr.y));
            u32x2 w; w.x = pk_bf16(o0, o1); w.y = pk_bf16(o2, o3);
            *(u32x2*)(p.ya + trow * 512 + h * 128 + v0) = w; }
        __syncthreads();
    }
}

#ifndef DSA_FORCE_SLOW
#define DSA_FORCE_SLOW 0
#endif
#ifndef DBG_DOUBLE
#define DBG_DOUBLE 0
#endif
#ifndef DBG_DSA_SCALE
#define DBG_DSA_SCALE 1.0f
#endif
__device__ void phase_dsa1(const Params& p, int l, int wg, int nwg) {
    const int lane = threadIdx.x & 63, wave = threadIdx.x >> 6;
    for (int tok = wg * 8 + wave; tok < NTOK; tok += nwg * 8) {
        const bf16_t* row = p.PB + (size_t)tok * PB_LD;
        const u32x2 q = *(const u32x2*)(row + PB_QC + 4 * lane);
        const unsigned kv = *(const unsigned*)(row + PB_KVC + 2 * lane);
        const float q0 = bflo(q.x), q1 = bfhi(q.x), q2 = bflo(q.y), q3 = bfhi(q.y), k0 = bflo(kv), k1 = bfhi(kv);
        const float sq = wave_sum(q0 * q0 + q1 * q1 + q2 * q2 + q3 * q3), sk = wave_sum(k0 * k0 + k1 * k1);
        const float rq = rsqrtf(sq * (1.0f / 256.0f) + 1e-6f), rk = rsqrtf(sk * (1.0f / 128.0f) + 1e-6f);
        const f32x4 gq = *(const f32x4*)(p.dsa_g_qc + (size_t)l * 256 + 4 * lane); const f32x2 gk = *(const f32x2*)(p.dsa_g_kv + (size_t)l * 128 + 2 * lane);
        u32x2 w; w.x = pk_bf16(q0 * rq * gq[0], q1 * rq * gq[1]); w.y = pk_bf16(q2 * rq * gq[2], q3 * rq * gq[3]);
        *(u32x2*)(p.qn + (size_t)tok * 256 + 4 * lane) = w;
        *(unsigned*)(p.kvn + (size_t)tok * 128 + 2 * lane) = pk_bf16(k0 * rk * gk[0], k1 * rk * gk[1]);
    }
}

constexpr int D_HIST = 0, D_CIDX = 65536, D_WH = 98304, D_MSK = 131072, D_SEL = 147456, D_CTL = 155648, D_OT = 106496, D_OT_LD = 1032, DSA_CAP = 1024;
__device__ __forceinline__ unsigned lds_add(LASP unsigned* p, unsigned v) { return __hip_atomic_fetch_add(p, v, __ATOMIC_RELAXED, __HIP_MEMORY_SCOPE_WORKGROUP); }
__device__ __forceinline__ void lds_or(LASP unsigned* p, unsigned v) { (void)__hip_atomic_fetch_or(p, v, __ATOMIC_RELAXED, __HIP_MEMORY_SCOPE_WORKGROUP); }
struct DsaQ { bf16x8 qa[4][2]; f32x2 w01[4], w23[4]; };

__device__ __forceinline__ void dsa_score(const DsaQ& Q, const bf16x8& kb0, const bf16x8& kb1, float (&sc)[4]) {
    f32x2 s01 = {0.f, 0.f}, s23 = {0.f, 0.f};
#pragma unroll
    for (int hh = 0; hh < 4; ++hh) { f32x4 d = {0.f, 0.f, 0.f, 0.f}; d = MFMA16(Q.qa[hh][0], kb0, d); d = MFMA16(Q.qa[hh][1], kb1, d);
#pragma unroll
        for (int r = 0; r < 4; ++r) d[r] = __int_as_float(max(__float_as_int(d[r]), 0));
        const f32x2 d01 = {d[0], d[1]}, d23 = {d[2], d[3]};
        s01 = __builtin_elementwise_fma(Q.w01[hh], d01, s01); s23 = __builtin_elementwise_fma(Q.w23[hh], d23, s23); }
    sc[0] = s01[0]; sc[1] = s01[1]; sc[2] = s23[0]; sc[3] = s23[1];
}
__device__ __forceinline__ unsigned dkey(float f) { const unsigned u = __float_as_uint(f); return u ^ ((unsigned)((int)u >> 31) | 0x80000000u); }
__device__ __forceinline__ unsigned dbin(float f) { const unsigned u = __float_as_uint(f); const unsigned m = (unsigned)((int)u >> 31); return (u >> 21) ^ ((m & 0x3ffu) | 0x400u); }
template <class F> __device__ __forceinline__ void dsa_tiles(const bf16_t* ik0, int ntile, int wave, int fr, int fq, F&& f) {
    const bf16_t* base = ik0 + (size_t)fr * PB_LD + fq * 8;
    bf16x8 a0 = {0, 0, 0, 0, 0, 0, 0, 0}, a1 = a0, b0 = a0, b1 = a0;
    int kt = wave;
    if (kt < ntile) { const bf16_t* kp = base + (size_t)kt * 16 * PB_LD; a0 = ld_frag_g(kp); a1 = ld_frag_g(kp + 32); }
    if (kt + 8 < ntile) { const bf16_t* kp = base + (size_t)(kt + 8) * 16 * PB_LD; b0 = ld_frag_g(kp); b1 = ld_frag_g(kp + 32); }
    for (; kt < ntile; kt += 16) {
        { const bf16x8 c0 = a0, c1 = a1;
          if (kt + 16 < ntile) { const bf16_t* kp = base + (size_t)(kt + 16) * 16 * PB_LD; a0 = ld_frag_g(kp); a1 = ld_frag_g(kp + 32); }
          f(kt, c0, c1); }
        if (kt + 8 < ntile) { const bf16x8 c0 = b0, c1 = b1;
          if (kt + 24 < ntile) { const bf16_t* kp = base + (size_t)(kt + 24) * 16 * PB_LD; b0 = ld_frag_g(kp); b1 = ld_frag_g(kp + 32); }
          f(kt + 8, c0, c1); }
    }
}
__device__ __forceinline__ void wave_find_bin(const LASP unsigned* hist, unsigned need, int lane, unsigned& bin_out, unsigned& above_out, unsigned& inbin_out) {
    unsigned loc = 0;
#pragma unroll
    for (int j = 0; j < 4; ++j) { const u32x4 w4 = *(const LASP u32x4*)(hist + 1008 - 16 * lane + 4 * j);
        loc += (w4.x & 0xffffu) + (w4.x >> 16) + (w4.y & 0xffffu) + (w4.y >> 16) + (w4.z & 0xffffu) + (w4.z >> 16) + (w4.w & 0xffffu) + (w4.w >> 16); }
    const unsigned incl = wave_scan_incl(loc);
    const unsigned excl = incl - loc;
    const bool mine = (excl < need) && (incl >= need);
    const unsigned long long m = __ballot(mine);
    const int L = m ? (int)__builtin_ctzll(m) : 63;
    const unsigned base = (unsigned)__builtin_amdgcn_readlane((int)excl, L);
    unsigned c2 = 0; const unsigned bin = 2047u - 32u * (unsigned)L - (unsigned)(lane & 31);
    { const unsigned w = hist[bin >> 1]; c2 = (bin & 1u) ? (w >> 16) : (w & 0xffffu); if (lane >= 32) c2 = 0; }
    const unsigned inc2 = wave_scan_incl(c2);
    const unsigned ex2 = inc2 - c2;
    const bool mine2 = (lane < 32) && (base + ex2 < need) && (base + inc2 >= need);
    const unsigned long long m2 = __ballot(mine2);
    const int L2 = m2 ? (int)__builtin_ctzll(m2) : 31;
    bin_out = 2047u - 32u * (unsigned)L - (unsigned)L2;
    above_out = base + (unsigned)__builtin_amdgcn_readlane((int)ex2, L2);
    inbin_out = (unsigned)__builtin_amdgcn_readlane((int)c2, L2);
}

#define DSA_UNIT_SETUP \
    LASP unsigned* hist = (LASP unsigned*)(lds + D_HIST); \
    LASP unsigned short* sel = (LASP unsigned short*)(lds + D_SEL); \
    LASP bf16_t* Ot = (LASP bf16_t*)(lds + D_OT); \
    LASP unsigned* ctl = (LASP unsigned*)(lds + D_CTL); \
    const int tid = threadIdx.x, lane = tid & 63, wave = tid >> 6, fr = lane & 15, fq = lane >> 4; \
    const int uw = pos & 255, uk = pos >> 8, ur = uw >> 3; const int uix = (uk & 1) ? 32 * uk + 31 - ur : 32 * uk + ur; \
    const int sub = uix & 3, b = uw & 7, c = 127 - (uix >> 2); \
    const int n = 64 * (c + 1); const size_t krow0 = (size_t)b * SEQ; const size_t t0 = krow0 + (size_t)c * 64 + sub * 16; \
    (void)0;
__device__ __forceinline__ void dsa_select_unit(const Params& p, int l, LASP unsigned char* lds, int pos) {
    DSA_UNIT_SETUP
    (void)Ot; (void)l;
    if (tid < 128) ctl[tid] = 0u;
    if (n <= 256) {
        for (int i = tid; i < 16 * 256; i += NTHR) sel[i] = (unsigned short)(i & 255);
        __syncthreads();
        if (tid < 16) ctl[tid] = (unsigned)n;
        __syncthreads();
        return;
    }
    LASP unsigned* ckey = (LASP unsigned*)(lds + D_HIST);
    LASP unsigned short* cidx = (LASP unsigned short*)(lds + D_CIDX);
    LASP unsigned short* msk = (LASP unsigned short*)(lds + D_MSK);
    DsaQ Q;
#pragma unroll
    for (int hh = 0; hh < 4; ++hh)
#pragma unroll
        for (int ks = 0; ks < 2; ++ks) Q.qa[hh][ks] = ld_frag_g(p.qi + (t0 + fr) * 256 + hh * 64 + ks * 32 + fq * 8);
    { u32x2 w[4];
#pragma unroll
      for (int r = 0; r < 4; ++r) w[r] = *(const u32x2*)(p.PB + (t0 + fq * 4 + r) * PB_LD + PB_IW);
      Q.w01[0] = (f32x2){bflo(w[0].x), bflo(w[1].x)}; Q.w01[1] = (f32x2){bfhi(w[0].x), bfhi(w[1].x)}; Q.w01[2] = (f32x2){bflo(w[0].y), bflo(w[1].y)}; Q.w01[3] = (f32x2){bfhi(w[0].y), bfhi(w[1].y)};
      Q.w23[0] = (f32x2){bflo(w[2].x), bflo(w[3].x)}; Q.w23[1] = (f32x2){bfhi(w[2].x), bfhi(w[3].x)}; Q.w23[2] = (f32x2){bflo(w[2].y), bflo(w[3].y)}; Q.w23[3] = (f32x2){bfhi(w[2].y), bfhi(w[3].y)}; }
    const bf16_t* ik0 = p.PB + krow0 * PB_LD + PB_IK;
    const int ntile = n >> 4;
    { const u32x4 z4 = {0u, 0u, 0u, 0u};
      for (int i = tid; i < 16 * 1024 / 4; i += NTHR) ((LASP u32x4*)hist)[i] = z4;
      for (int i = tid; i < 16 * 512 * 2 / 16; i += NTHR) ((LASP u32x4*)msk)[i] = z4; }
    __syncthreads();
    dsa_tiles(ik0, ntile, wave, fr, fq, [&](int, const bf16x8& kb0, const bf16x8& kb1) {
        float sc[4]; dsa_score(Q, kb0, kb1, sc);
#pragma unroll
        for (int r = 0; r < 4; ++r) { const unsigned key = dkey(sc[r]); lds_add(&hist[(fq * 4 + r) * 1024 + ((key >> 22) & 0x3ffu)], 1u + ((key >> 21) & 1u) * 65535u); } });
#if DBG_DOUBLE & 512
    { LASP unsigned* h2 = (LASP unsigned*)(lds + D_WH);
      dsa_tiles(ik0, ntile, wave, fr, fq, [&](int, const bf16x8& kb0, const bf16x8& kb1) {
        float sc[4]; dsa_score(Q, kb0, kb1, sc);
#pragma unroll
        for (int r = 0; r < 4; ++r) { const unsigned bin = dbin(sc[r]); lds_add(&h2[((fq * 4 + r) & 7) * 1024 + (bin >> 1)], (bin & 1u) ? 65536u : 1u); } }); }
#endif
#if DBG_DOUBLE & 1024
    { float accs = 0.f;
      dsa_tiles(ik0, ntile, wave, fr, fq, [&](int, const bf16x8& kb0, const bf16x8& kb1) {
        float sc[4]; dsa_score(Q, kb0, kb1, sc); accs += sc[0] + sc[1] + sc[2] + sc[3]; });
      if (accs == 123.456f) ctl[120] = 1u; }
#endif
    __syncthreads();
#pragma unroll
    for (int qi2 = 0; qi2 < 2; ++qi2) { const int q = wave * 2 + qi2;
        unsigned bin, above, inbin; wave_find_bin(hist + q * 1024, 256u, lane, bin, above, inbin);
        if (lane == 0) { ctl[16 + q] = bin; ctl[32 + q] = 256u - above; if (inbin > (unsigned)DSA_CAP || DSA_FORCE_SLOW) ctl[97] = 1u; } }
    __syncthreads();
    if (!ctl[97]) {
        float elo[4], ehi[4];
#pragma unroll
        for (int r = 0; r < 4; ++r) { const unsigned tb = ctl[16 + fq * 4 + r]; elo[r] = fkey_inv(tb << 21); ehi[r] = tb >= 2047u ? INFINITY : fkey_inv((tb + 1u) << 21); }
        dsa_tiles(ik0, ntile, wave, fr, fq, [&](int kt, const bf16x8& kb0, const bf16x8& kb1) {
            float sc[4]; dsa_score(Q, kb0, kb1, sc);
            unsigned pc[4]; bool cand[4]; unsigned long long tm[4];
#pragma unroll
            for (int r = 0; r < 4; ++r) { const bool above = sc[r] >= ehi[r];
                tm[r] = __ballot(above);
                cand[r] = (sc[r] >= elo[r]) && !above; }
            if ((tm[0] | tm[1] | tm[2] | tm[3]) != 0ull) {
#pragma unroll
                for (int r = 0; r < 4; ++r) if (fr == 0) msk[(fq * 4 + r) * 512 + kt] = (unsigned short)((tm[r] >> (16 * fq)) & 0xffffull); }
            if (__ballot(cand[0] || cand[1] || cand[2] || cand[3]) != 0ull) {
#pragma unroll
                for (int r = 0; r < 4; ++r) pc[r] = cand[r] ? lds_add(&ctl[112 + fq * 4 + r], 1u) : 0xffffffffu;
#pragma unroll
                for (int r = 0; r < 4; ++r) if (cand[r] && pc[r] < (unsigned)DSA_CAP) { const int q = fq * 4 + r; ckey[q * DSA_CAP + pc[r]] = dkey(sc[r]); cidx[q * DSA_CAP + pc[r]] = (unsigned short)(kt * 16 + fr); } } });
        __syncthreads();
        LASP unsigned* wh = (LASP unsigned*)(lds + D_WH) + wave * 1024;
#if DBG_DOUBLE & 65536
        for (int rep_ = 0; rep_ < 2; ++rep_)
#endif
#pragma unroll 1
        for (int qi2 = 0; qi2 < 2; ++qi2) { const int q = wave * 2 + qi2;
            unsigned m = ctl[112 + q]; m = m > (unsigned)DSA_CAP ? (unsigned)DSA_CAP : m; unsigned need = ctl[32 + q];
            const LASP unsigned* ck = ckey + q * DSA_CAP; const LASP unsigned short* ci = cidx + q * DSA_CAP;
            unsigned pmask = 0u, pval = 0u, inb = 0u;
#pragma unroll 1
            for (int lvl = 0; lvl < 2; ++lvl) { const unsigned shift = lvl == 0 ? 10u : 0u, nbm = lvl == 0 ? 0x7ffu : 0x3ffu;
#pragma unroll
                for (int k = 0; k < 4; ++k) ((LASP u32x4*)wh)[lane + 64 * k] = (u32x4){0u, 0u, 0u, 0u};
                for (unsigned i = lane; i < m; i += 64) { const unsigned key = ck[i]; if ((key & pmask) == pval) { const unsigned bin = (key >> shift) & nbm; lds_add(&wh[bin >> 1], (bin & 1u) ? 65536u : 1u); } }
                unsigned bin, above; wave_find_bin(wh, need, lane, bin, above, inb);
                pval |= bin << shift; pmask |= nbm << shift; need -= above; }
            unsigned sthr = 0xffffu;
            if (need < inb) {
#pragma unroll
                for (int k = 0; k < 4; ++k) ((LASP u32x4*)wh)[lane + 64 * k] = (u32x4){0u, 0u, 0u, 0u};
                for (unsigned i = lane; i < m; i += 64) { if ((ck[i] & 0x1fffffu) == pval) { const unsigned bin = 2047u - ((unsigned)ci[i] >> 2); lds_add(&wh[bin >> 1], (bin & 1u) ? 65536u : 1u); } }
                unsigned binC, aboveC, inC; wave_find_bin(wh, need, lane, binC, aboveC, inC);
                const unsigned needC = need - aboveC;
#pragma unroll
                for (int k = 0; k < 4; ++k) ((LASP u32x4*)wh)[lane + 64 * k] = (u32x4){0u, 0u, 0u, 0u};
                for (unsigned i = lane; i < m; i += 64) { const unsigned s = ci[i]; if ((ck[i] & 0x1fffffu) == pval && (2047u - (s >> 2)) == binC) { const unsigned bin = 2047u - (s & 3u); lds_add(&wh[bin >> 1], (bin & 1u) ? 65536u : 1u); } }
                unsigned binD, aboveD, inD; wave_find_bin(wh, needC, lane, binD, aboveD, inD);
                sthr = ((2047u - binC) << 2) | (2047u - binD);
            }
            for (unsigned i = lane; i < m; i += 64) { const unsigned k21 = ck[i] & 0x1fffffu, si = ci[i];
                if (k21 > pval || (k21 == pval && si <= sthr)) { const unsigned widx = (unsigned)q * 512u + (si >> 4); lds_or((LASP unsigned*)msk + (widx >> 1), 1u << (16u * (widx & 1u) + (si & 15u))); } } }
        __syncthreads();
    } else {
        for (int pass = 1; pass < 3; ++pass) {
            for (int i = tid; i < 16 * 1024; i += NTHR) hist[i] = 0u;
            __syncthreads();
            dsa_tiles(ik0, ntile, wave, fr, fq, [&](int, const bf16x8& kb0, const bf16x8& kb1) {
                float sc[4]; dsa_score(Q, kb0, kb1, sc);
#pragma unroll
                for (int r = 0; r < 4; ++r) { const int q = fq * 4 + r; const unsigned key = dkey(sc[r]); unsigned bin; bool on;
                    if (pass == 1) { bin = (key >> 10) & 0x7ffu; on = (key >> 21) == ctl[16 + q]; }
                    else { bin = key & 0x3ffu; on = (key >> 10) == ctl[16 + q]; }
                    if (on) lds_add(&hist[q * 1024 + (bin >> 1)], (bin & 1u) ? 65536u : 1u); } });
            __syncthreads();
#pragma unroll
            for (int qi2 = 0; qi2 < 2; ++qi2) { const int q = wave * 2 + qi2;
                const unsigned need = ctl[32 + q];
                unsigned bin, above, inbin; wave_find_bin(hist + q * 1024, need, lane, bin, above, inbin);
                if (lane == 0) { const unsigned pre = ctl[16 + q];
                    ctl[16 + q] = pass == 1 ? ((pre << 11) | bin) : ((pre << 10) | bin);
                    ctl[32 + q] = need - above;
                    if (pass == 2) { const unsigned fl = (need - above < inbin) ? 1u : 0u; ctl[48 + q] = fl; if (fl) ctl[96] = 1u; } } }
            __syncthreads();
        }
        if (ctl[96]) {
            for (int i = tid; i < 16 * 1024; i += NTHR) hist[i] = 0u;
            __syncthreads();
            dsa_tiles(ik0, ntile, wave, fr, fq, [&](int kt, const bf16x8& kb0, const bf16x8& kb1) {
                float sc[4]; dsa_score(Q, kb0, kb1, sc);
#pragma unroll
                for (int r = 0; r < 4; ++r) { const int q = fq * 4 + r; const unsigned key = dkey(sc[r]);
                    if (ctl[48 + q] && key == ctl[16 + q]) { const unsigned s = (unsigned)(kt * 16 + fr); const unsigned bin = 2047u - (s >> 2); lds_add(&hist[q * 1024 + (bin >> 1)], (bin & 1u) ? 65536u : 1u); } } });
            __syncthreads();
#pragma unroll
            for (int qi2 = 0; qi2 < 2; ++qi2) { const int q = wave * 2 + qi2;
                if (ctl[48 + q]) { unsigned bin, above, inbin; wave_find_bin(hist + q * 1024, ctl[32 + q], lane, bin, above, inbin);
                    if (lane == 0) { ctl[64 + q] = bin; ctl[80 + q] = ctl[32 + q] - above; } } }
            __syncthreads();
        }
        dsa_tiles(ik0, ntile, wave, fr, fq, [&](int kt, const bf16x8& kb0, const bf16x8& kb1) {
            float sc[4]; dsa_score(Q, kb0, kb1, sc);
#pragma unroll
            for (int r = 0; r < 4; ++r) { const int q = fq * 4 + r; const unsigned key = dkey(sc[r]); const unsigned thr = ctl[16 + q];
                const unsigned s = (unsigned)(kt * 16 + fr);
                bool take = key > thr; const bool eq = key == thr; const bool fl = ctl[48 + q] != 0u;
                if (!fl) take = take || eq;
                const unsigned ibin = 2047u - (s >> 2), tb = ctl[64 + q];
                const bool eqb = eq && fl && (ibin == tb);
                const unsigned long long em = __ballot(eqb);
                if (eq && fl) {
                    if (ibin > tb) take = true;
                    else if (ibin == tb) { const unsigned long long low = em & (((1ull << lane) - 1ull) & ~((1ull << (lane & ~3)) - 1ull)); take = (unsigned)__popcll(low) < ctl[80 + q]; } }
                const unsigned long long tm = __ballot(take);
                if (fr == 0) msk[q * 512 + kt] = (unsigned short)((tm >> (16 * fq)) & 0xffffull); } });
        __syncthreads();
    }
#if DBG_DOUBLE & 131072
    for (int rep_ = 0; rep_ < 2; ++rep_)
#endif
#pragma unroll 1
    for (int qi2 = 0; qi2 < 2; ++qi2) { const int q = wave * 2 + qi2;
        LASP unsigned* pre = (LASP unsigned*)(lds + D_WH) + wave * 1024;
        const LASP unsigned* mskw = (const LASP unsigned*)msk + q * 256;
        const u32x4 mw = *(const LASP u32x4*)(mskw + lane * 4);
        const unsigned c0 = (unsigned)__popc(mw.x), c1 = (unsigned)__popc(mw.y), c2 = (unsigned)__popc(mw.z), c3 = (unsigned)__popc(mw.w), c8 = c0 + c1 + c2 + c3;
        const unsigned incl = wave_scan_incl(c8), base = incl - c8;
        { u32x4 pv; pv.x = base + c0; pv.y = pv.x + c1; pv.z = pv.y + c2; pv.w = incl; *(LASP u32x4*)(pre + lane * 4) = pv; }
        asm volatile("s_waitcnt lgkmcnt(0)" ::: "memory");
        const unsigned total = (unsigned)__builtin_amdgcn_readlane((int)incl, 63);
#pragma unroll
        for (int i = 0; i < 4; ++i) { const unsigned j = (unsigned)lane + 64u * i;
            unsigned w = 0;
#pragma unroll
            for (unsigned step = 128; step >= 1; step >>= 1) { const unsigned pvw = pre[w + step - 1]; w += pvw <= j ? step : 0u; }
            if (j < total) {
                unsigned r = j - (w ? pre[w - 1] : 0u), x = mskw[w], pos = 0;
                { const unsigned t = (unsigned)__popc(x & 0xffffu); const bool up = r >= t; pos += up ? 16u : 0u; r -= up ? t : 0u; x = up ? x >> 16 : x; }
                { const unsigned t = (unsigned)__popc(x & 0xffu); const bool up = r >= t; pos += up ? 8u : 0u; r -= up ? t : 0u; x = up ? x >> 8 : x; }
                { const unsigned t = (unsigned)__popc(x & 0xfu); const bool up = r >= t; pos += up ? 4u : 0u; r -= up ? t : 0u; x = up ? x >> 4 : x; }
                { const unsigned t = (unsigned)__popc(x & 0x3u); const bool up = r >= t; pos += up ? 2u : 0u; r -= up ? t : 0u; x = up ? x >> 2 : x; }
                pos += (r >= (x & 1u)) ? 1u : 0u;
                sel[q * 256 + j] = (unsigned short)(w * 32u + pos); } }
        if (lane == 63) ctl[q] = incl > 256u ? 256u : incl; }
    __syncthreads();
}
constexpr int DA_WAVE = 13312, DA_PB = 8192, DA_PLD = 40, DA_QA = 8832;
typedef short v4s_t __attribute__((ext_vector_type(4)));
__device__ __forceinline__ unsigned da_off(unsigned row, unsigned ch) { return 256u * row + 16u * (ch ^ (((row & 3u) << 2) | ((row >> 2) & 3u))); }
__device__ __forceinline__ void dsa_attend_query(const Params& p, int l, LASP unsigned char* lds, int pos) {
    DSA_UNIT_SETUP
    (void)hist; (void)n; (void)c; (void)sub;
    LASP unsigned char* img = lds + wave * DA_WAVE;
    LASP bf16_t* Pb = (LASP bf16_t*)(img + DA_PB);
    const unsigned ufr = (unsigned)fr, ufq = (unsigned)fq;
    const unsigned wbase = 2048u * ufq + 16u * (ufr ^ ((ufq & 1u) << 1));
    const unsigned lbase = 256u * ufr + 16u * (ufq ^ (((ufr & 3u) << 2) | ((ufr >> 2) & 3u)));
    const unsigned pbase = 256u * (8u * ufq + (ufr >> 2)) + 16u * (((ufr & 3u) >> 1) ^ (((ufr >> 2) << 2) | ((ufq & 1u) << 1))) + 8u * (ufr & 1u);
    u32x4 rw[8];
    const char* kvb = (const char*)(p.kvn + krow0 * 128);
    auto gather = [&](int qq, int ch) {
        const u32x4 iw = *(const LASP u32x4*)(sel + qq * 256 + ch * 32 + fq * 8);
        const unsigned iv[4] = {iw.x, iw.y, iw.z, iw.w};
#pragma unroll
        for (int i = 0; i < 8; ++i) { const unsigned idx = ((i & 1) ? (iv[i >> 1] >> 16) : iv[i >> 1]) & 0x1fffu;
            rw[i] = *(const u32x4*)(kvb + ((idx << 8) | (ufr << 4))); } };
    bf16x8 qf[4];
    auto ldq = [&](int qq) {
#pragma unroll
        for (int ks = 0; ks < 4; ++ks) qf[ks] = ld_frag_g(p.qd + (t0 + qq) * 1024 + (fr & 7) * 128 + ks * 32 + fq * 8); };
    ldq(wave * 2); gather(wave * 2, 0);
#pragma unroll 1
    for (int qi2 = 0; qi2 < 2; ++qi2) {
        const int q = wave * 2 + qi2;
        unsigned cnt = (unsigned)__builtin_amdgcn_readfirstlane((int)ctl[q]); cnt = cnt > 256u ? 256u : cnt;
        const int nch = (int)(cnt >> 5);
#pragma unroll
        for (int ks = 0; ks < 4; ++ks) *(LASP bf16x8*)(img + DA_QA + ks * 1024 + lane * 16) = qf[ks];
        float mrun[4] = {-INFINITY, -INFINITY, -INFINITY, -INFINITY}, lrun[4] = {0.f, 0.f, 0.f, 0.f};
        f32x4 oacc[8];
#pragma unroll
        for (int cc = 0; cc < 8; ++cc) oacc[cc] = (f32x4){0.f, 0.f, 0.f, 0.f};
#pragma unroll 1
        for (int ch = 0; ch < nch; ++ch) {
            unsigned wb = wbase, lb = lbase, pb = pbase; asm volatile("" : "+v"(wb), "+v"(lb), "+v"(pb));
#pragma unroll
            for (int i = 0; i < 8; ++i) { const unsigned ci = (unsigned)(((i & 3) << 2) | (i >> 2)); *(LASP u32x4*)(img + ((wb ^ (16u * ci)) + 256u * i)) = rw[i]; }
            { const bool more = ch + 1 < nch; const int qn = more ? q : (wave * 2 + 1), chn = more ? ch + 1 : (qi2 == 0 ? 0 : ch);
              gather(qn, chn);
              if (!more) ldq(wave * 2 + 1); }
            float lg[2][4];
#pragma unroll
            for (int tl = 0; tl < 2; ++tl) { f32x4 dd = {0.f, 0.f, 0.f, 0.f};
#pragma unroll
                for (int ks = 0; ks < 4; ++ks) dd = MFMA16(*(const LASP bf16x8*)(img + DA_QA + ks * 1024 + lane * 16), *(const LASP bf16x8*)(img + ((lb ^ (64u * ks)) + 4096u * tl)), dd);
#pragma unroll
                for (int r = 0; r < 4; ++r) lg[tl][r] = dd[r]; }

            float scv[4], tmx[4], p0[4], p1[4], ps[4];
#pragma unroll
            for (int r = 0; r < 4; ++r) tmx[r] = fmaxf(fmaxf(lg[0][r], lg[1][r]), mrun[r]);
            row16_max_x4(tmx[0], tmx[1], tmx[2], tmx[3]);
            constexpr float ES = 0.08838834764831845f * 1.4426950408889634f;
#pragma unroll
            for (int r = 0; r < 4; ++r) { const float mnew = tmx[r], nm = -mnew * ES;
                scv[r] = __builtin_amdgcn_exp2f(fmaf(mrun[r], ES, nm));
                p0[r] = __builtin_amdgcn_exp2f(fmaf(lg[0][r], ES, nm)); p1[r] = __builtin_amdgcn_exp2f(fmaf(lg[1][r], ES, nm)); ps[r] = p0[r] + p1[r]; mrun[r] = mnew; }
            row16_sum_x4(ps[0], ps[1], ps[2], ps[3]);
            unsigned short pb0[4], pb1[4];
#pragma unroll
            for (int r = 0; r < 4; ++r) { lrun[r] = lrun[r] * scv[r] + ps[r]; pb0[r] = f2bf(p0[r]); pb1[r] = f2bf(p1[r]); }
            if (fq < 2) {
#pragma unroll
                for (int r = 0; r < 4; ++r) { Pb[(fq * 4 + r) * DA_PLD + fr] = pb0[r]; Pb[(fq * 4 + r) * DA_PLD + 16 + fr] = pb1[r]; } }
            const bf16x8 pa = *(const LASP bf16x8*)(Pb + (fr & 7) * DA_PLD + fq * 8);
#pragma unroll
            for (int cc = 0; cc < 8; ++cc) {
                const v4s_t lo = __builtin_amdgcn_ds_read_tr16_b64_v4i16((LASP v4s_t*)(img + (pb ^ (32u * cc))));
                const v4s_t hi = __builtin_amdgcn_ds_read_tr16_b64_v4i16((LASP v4s_t*)(img + (((pb ^ 16u) ^ (32u * cc)) + 1024u)));
                const bf16x8 bv = {lo[0], lo[1], lo[2], lo[3], hi[0], hi[1], hi[2], hi[3]};
                f32x4 a = oacc[cc];
#pragma unroll
                for (int r = 0; r < 4; ++r) a[r] *= scv[r];
                oacc[cc] = MFMA16(pa, bv, a);
            }
        }
        if (fq < 2) {
#pragma unroll
            for (int r = 0; r < 4; ++r) { const float inv = __builtin_amdgcn_rcpf(lrun[r]);
#pragma unroll
                for (int cc = 0; cc < 8; ++cc) Ot[q * D_OT_LD + (fq * 4 + r) * 128 + cc * 16 + fr] = f2bf(oacc[cc][r] * inv); } }
    }
}
__device__ __forceinline__ void dsa_upproj_unit(const Params& p, int l, LASP unsigned char* lds, int pos) {
    DSA_UNIT_SETUP
    (void)hist; (void)n; (void)c; (void)sub; (void)sel; (void)ctl; (void)krow0;
    const bf16_t* wu = p.wuv_t + ((size_t)l * 8 + wave) * 64 * 128;
    bf16x8 wf[4][4];
#pragma unroll
    for (int nt = 0; nt < 4; ++nt)
#pragma unroll
        for (int ks = 0; ks < 4; ++ks) wf[nt][ks] = ld_frag_g(wu + (size_t)(nt * 16 + fr) * 128 + ks * 32 + fq * 8);
    __syncthreads();
    bf16x8 oa[4];
#pragma unroll
    for (int ks = 0; ks < 4; ++ks) oa[ks] = *(const LASP bf16x8*)(Ot + fr * D_OT_LD + wave * 128 + ks * 32 + fq * 8);
#pragma unroll
    for (int nt = 0; nt < 4; ++nt) { f32x4 d = {0.f, 0.f, 0.f, 0.f};
#pragma unroll
        for (int ks = 0; ks < 4; ++ks) d = MFMA16(wf[nt][ks], oa[ks], d);
        u32x2 w; w.x = pk_bf16(DBG_DSA_SCALE * d[0], DBG_DSA_SCALE * d[1]); w.y = pk_bf16(DBG_DSA_SCALE * d[2], DBG_DSA_SCALE * d[3]);
        *(u32x2*)(p.yb + (t0 + fr) * 512 + wave * 64 + nt * 16 + fq * 4) = w; }
    __syncthreads();
}
__device__ void phase_dsa34(const Params& p, int l, LASP unsigned char* lds, int wg, int nwg) {
    for (int pos = wg; pos < 4096; pos += nwg) { dsa_select_unit(p, l, lds, pos); dsa_attend_query(p, l, lds, pos); dsa_upproj_unit(p, l, lds, pos); }
}

#ifndef DBG_DOUBLE
#define DBG_DOUBLE 0
#endif
constexpr int R_W = 0, R_A = 8192, R_B = 16384, R_K2 = 24576, R_R = 32768, R_V = 40960, R_Y = 43008, R_BUF = 45056;
#ifndef SCAN_PRIO
#define SCAN_PRIO 0
#endif
#ifndef PREP_PRIO
#define PREP_PRIO 0
#endif
constexpr int R_WM = 90112, R_AM = 99328, R_CONST = 108544, R_STG = 110848, R_STG_SZ = 4352;
__device__ __forceinline__ f32x4 lerp4(u32x2 cur, u32x2 prv, f32x4 mu) {
    f32x4 c = {bflo(cur.x), bfhi(cur.x), bflo(cur.y), bfhi(cur.y)}, q = {bflo(prv.x), bfhi(prv.x), bflo(prv.y), bfhi(prv.y)};
    return c + (q - c) * mu;
}
__device__ __forceinline__ void lerp8(const u32x4 cur, const u32x4 prv, const f32x4 m0, const f32x4 m1, f32x4& o0, f32x4& o1) {
    const f32x4 c0 = {bflo(cur.x), bfhi(cur.x), bflo(cur.y), bfhi(cur.y)}, c1 = {bflo(cur.z), bfhi(cur.z), bflo(cur.w), bfhi(cur.w)};
    const f32x4 q0 = {bflo(prv.x), bfhi(prv.x), bflo(prv.y), bfhi(prv.y)}, q1 = {bflo(prv.z), bfhi(prv.z), bflo(prv.w), bfhi(prv.w)};
    o0 = c0 + (q0 - c0) * m0; o1 = c1 + (q1 - c1) * m1;
}
__device__ __forceinline__ float fast_tanh(float x) { return fmaf(-2.0f, __builtin_amdgcn_rcpf(1.0f + __builtin_amdgcn_exp2f(2.8853900817779268f * x)), 1.0f); }
struct RwRaw { u32x4 cr, pr, ck, pk, cw, pw, ca, pa, cv, pv; };
__device__ __forceinline__ void rwkv_scan_setup(const Params& p, int l, LASP unsigned char* lds, int u) {
    const int tid = threadIdx.x, lane = tid & 63, wave = tid >> 6, fr = lane & 15, fq = lane >> 4;
    LASP bf16_t* sWm = (LASP bf16_t*)(lds + R_WM); LASP bf16_t* sAm = (LASP bf16_t*)(lds + R_AM); LASP float* sC = (LASP float*)(lds + R_CONST);
    const int rg = u & 3, h = (u >> 2) & 7, b = u >> 5;
    const size_t row0 = (size_t)b * SEQ;
    (void)tid; (void)lane; (void)wave; (void)fr; (void)fq; (void)sWm; (void)sAm; (void)sC; (void)rg; (void)h; (void)row0; (void)l;
        __syncthreads();
        for (int i = tid; i < 64 * 8; i += NTHR) { const int j = i >> 3, c8 = i & 7;
            *(LASP u32x4*)(sWm + j * 72 + c8 * 8) = *(const u32x4*)(p.ww2_t + ((size_t)l * 512 + h * 64 + j) * 64 + c8 * 8);
            *(LASP u32x4*)(sAm + j * 72 + c8 * 8) = *(const u32x4*)(p.wa2_t + ((size_t)l * 512 + h * 64 + j) * 64 + c8 * 8); }
        { const float* mu = p.rw_mu + (size_t)l * 1792;
          if (tid < 64) { sC[tid] = mu[PC_R + h * 64 + tid]; sC[64 + tid] = mu[PC_K + h * 64 + tid]; sC[128 + tid] = mu[PC_WLR + tid]; sC[192 + tid] = mu[PC_ALR + tid]; }
          if (tid < 16) sC[256 + tid] = mu[PC_V + h * 64 + 16 * rg + tid];
          if (tid < 64) { const size_t o = (size_t)l * 512 + h * 64 + tid; sC[272 + tid] = p.rw_k_k[o]; sC[336 + tid] = p.rw_k_a[o]; sC[400 + tid] = p.rw_w0[o]; sC[464 + tid] = p.rw_a0[o]; } }
        __syncthreads();
}
__device__ __forceinline__ void rwkv_scan_waves(const Params& p, int l, LASP unsigned char* lds, int u) {
    const int tid = threadIdx.x, lane = tid & 63, wave = tid >> 6, fr = lane & 15, fq = lane >> 4;
    LASP bf16_t* sWm = (LASP bf16_t*)(lds + R_WM); LASP bf16_t* sAm = (LASP bf16_t*)(lds + R_AM); LASP float* sC = (LASP float*)(lds + R_CONST);
    const int rg = u & 3, h = (u >> 2) & 7, b = u >> 5;
    const size_t row0 = (size_t)b * SEQ;
    (void)tid; (void)lane; (void)wave; (void)fr; (void)fq; (void)sWm; (void)sAm; (void)sC; (void)rg; (void)h; (void)row0; (void)l;
            __builtin_amdgcn_s_setprio(SCAN_PRIO);
            f32x4 S4 = {0.f, 0.f, 0.f, 0.f}; float yacc = 0.f;
            const int rl = wave * 4 + fq;
            __syncthreads();
            for (int blk = 0; blk < SEQ / 32; ++blk) {
                LASP unsigned char* bf = lds + (blk & 1) * R_BUF;
                LASP float* sW = (LASP float*)(bf + R_W); LASP float* sA = (LASP float*)(bf + R_A); LASP float* sB = (LASP float*)(bf + R_B);
                LASP float* sK2 = (LASP float*)(bf + R_K2); LASP float* sR = (LASP float*)(bf + R_R); LASP float* sV = (LASP float*)(bf + R_V); LASP float* sY = (LASP float*)(bf + R_Y);
                f32x4 w4 = *(const LASP f32x4*)(sW + 4 * fr), a4 = *(const LASP f32x4*)(sA + 4 * fr), b4 = *(const LASP f32x4*)(sB + 4 * fr);
                f32x4 k4 = *(const LASP f32x4*)(sK2 + 4 * fr), r4 = *(const LASP f32x4*)(sR + 4 * fr); float v = sV[rl];
                float sa = S4[0] * a4[0] + S4[1] * a4[1] + S4[2] * a4[2] + S4[3] * a4[3];
                sa = row16_sum(sa);
                f32x4 tv = S4 * w4 + k4 * v;
#pragma unroll 4
                for (int tt = 0; tt < 32; ++tt) {
                    const int tn = tt < 31 ? tt + 1 : 31;
                    const f32x4 w4n = *(const LASP f32x4*)(sW + tn * 64 + 4 * fr), a4n = *(const LASP f32x4*)(sA + tn * 64 + 4 * fr), b4n = *(const LASP f32x4*)(sB + tn * 64 + 4 * fr);
                    const f32x4 k4n = *(const LASP f32x4*)(sK2 + tn * 64 + 4 * fr), r4n = *(const LASP f32x4*)(sR + tn * 64 + 4 * fr); const float vn = sV[tn * 16 + rl];
                    S4 = tv + b4 * sa;
                    const f32x4 py = S4 * r4, ps = S4 * a4n;
                    float y = (py[0] + py[2]) + (py[1] + py[3]), sp = (ps[0] + ps[2]) + (ps[1] + ps[3]);
                    tv = S4 * w4n + k4n * vn;
                    sp += dppf<0xB1>(sp); y += dppf<0xB1>(y); sp += dppf<0x4E>(sp); y += dppf<0x4E>(y);
                    sp += dppf<0x141>(sp); y += dppf<0x141>(y); sp += dppf<0x140>(sp); y += dppf<0x140>(y);
                    sa = sp;
                    yacc = (fr == (tt & 15)) ? y : yacc;
                    if ((tt & 15) == 15) { sY[(tt - 15 + fr) * 16 + rl] = yacc; }
                    b4 = b4n; r4 = r4n;
                }
                __syncthreads();
            }
            __builtin_amdgcn_s_setprio(0);
            __syncthreads();
}
__device__ __forceinline__ void rwkv_prep_waves(const Params& p, int l, LASP unsigned char* lds, int u) {
    const int tid = threadIdx.x, lane = tid & 63, wave = tid >> 6, fr = lane & 15, fq = lane >> 4;
    LASP bf16_t* sWm = (LASP bf16_t*)(lds + R_WM); LASP bf16_t* sAm = (LASP bf16_t*)(lds + R_AM); LASP float* sC = (LASP float*)(lds + R_CONST);
    const int rg = u & 3, h = (u >> 2) & 7, b = u >> 5;
    const size_t row0 = (size_t)b * SEQ;
    (void)tid; (void)lane; (void)wave; (void)fr; (void)fq; (void)sWm; (void)sAm; (void)sC; (void)rg; (void)h; (void)row0; (void)l;
            __builtin_amdgcn_s_setprio(PREP_PRIO);
            const int pw = wave - 4, s8 = lane >> 3, c8 = lane & 7;
            LASP unsigned char* stg = lds + R_STG + pw * R_STG_SZ;
            LASP bf16_t* sPw = (LASP bf16_t*)stg; LASP bf16_t* sPa = (LASP bf16_t*)(stg + 1152); LASP float* sKt = (LASP float*)(stg + 2304);
            const u32x4 z4 = {0u, 0u, 0u, 0u};
            auto load_raw = [&](int blk, RwRaw& R) {
                const int t = blk * 32 + pw * 8 + s8; const bf16_t* cur = p.PC + (row0 + t) * PC_LD; const bf16_t* prv = cur - PC_LD; const bool hasp = t > 0;
                R.cr = *(const u32x4*)(cur + PC_R + h * 64 + 8 * c8); R.ck = *(const u32x4*)(cur + PC_K + h * 64 + 8 * c8);
                R.cw = *(const u32x4*)(cur + PC_WLR + 8 * c8); R.ca = *(const u32x4*)(cur + PC_ALR + 8 * c8);
                R.pr = hasp ? *(const u32x4*)(prv + PC_R + h * 64 + 8 * c8) : z4; R.pk = hasp ? *(const u32x4*)(prv + PC_K + h * 64 + 8 * c8) : z4;
                R.pw = hasp ? *(const u32x4*)(prv + PC_WLR + 8 * c8) : z4; R.pa = hasp ? *(const u32x4*)(prv + PC_ALR + 8 * c8) : z4;
                R.cv = z4; R.pv = z4;
                if (c8 < 2) { R.cv = *(const u32x4*)(cur + PC_V + h * 64 + 16 * rg + 8 * c8); if (hasp) R.pv = *(const u32x4*)(prv + PC_V + h * 64 + 16 * rg + 8 * c8); } };
            auto stageA = [&](int blk, const RwRaw& R) {
                LASP unsigned char* bf = lds + (blk & 1) * R_BUF;
                LASP float* sW = (LASP float*)(bf + R_W); LASP float* sA = (LASP float*)(bf + R_A); LASP float* sB = (LASP float*)(bf + R_B);
                LASP float* sK2 = (LASP float*)(bf + R_K2); LASP float* sR = (LASP float*)(bf + R_R); LASP float* sV = (LASP float*)(bf + R_V);
                const int t = pw * 8 + s8;
                { f32x4 o0, o1;
                  lerp8(R.cr, R.pr, *(const LASP f32x4*)(sC + 8 * c8), *(const LASP f32x4*)(sC + 8 * c8 + 4), o0, o1); *(LASP f32x4*)(sR + t * 64 + 8 * c8) = o0; *(LASP f32x4*)(sR + t * 64 + 8 * c8 + 4) = o1;
                  lerp8(R.ck, R.pk, *(const LASP f32x4*)(sC + 64 + 8 * c8), *(const LASP f32x4*)(sC + 64 + 8 * c8 + 4), o0, o1); *(LASP f32x4*)(sKt + s8 * 64 + 8 * c8) = o0; *(LASP f32x4*)(sKt + s8 * 64 + 8 * c8 + 4) = o1;
                  lerp8(R.cw, R.pw, *(const LASP f32x4*)(sC + 128 + 8 * c8), *(const LASP f32x4*)(sC + 128 + 8 * c8 + 4), o0, o1);
                  { u32x4 tw; tw.x = pk_bf16(fast_tanh(o0[0]), fast_tanh(o0[1])); tw.y = pk_bf16(fast_tanh(o0[2]), fast_tanh(o0[3])); tw.z = pk_bf16(fast_tanh(o1[0]), fast_tanh(o1[1])); tw.w = pk_bf16(fast_tanh(o1[2]), fast_tanh(o1[3]));
                    *(LASP u32x4*)(sPw + s8 * 72 + 8 * c8) = tw; }
                  lerp8(R.ca, R.pa, *(const LASP f32x4*)(sC + 192 + 8 * c8), *(const LASP f32x4*)(sC + 192 + 8 * c8 + 4), o0, o1);
                  { u32x4 ta; ta.x = pk_bf16(o0[0], o0[1]); ta.y = pk_bf16(o0[2], o0[3]); ta.z = pk_bf16(o1[0], o1[1]); ta.w = pk_bf16(o1[2], o1[3]); *(LASP u32x4*)(sPa + s8 * 72 + 8 * c8) = ta; }
                  if (c8 < 2) { lerp8(R.cv, R.pv, *(const LASP f32x4*)(sC + 256 + 8 * c8), *(const LASP f32x4*)(sC + 256 + 8 * c8 + 4), o0, o1); *(LASP f32x4*)(sV + t * 16 + 8 * c8) = o0; *(LASP f32x4*)(sV + t * 16 + 8 * c8 + 4) = o1; } }
                asm volatile("s_waitcnt lgkmcnt(0)" ::: "memory"); };
            auto stageBC = [&](int blk) {
                LASP unsigned char* bf = lds + (blk & 1) * R_BUF;
                LASP float* sW = (LASP float*)(bf + R_W); LASP float* sA = (LASP float*)(bf + R_A); LASP float* sB = (LASP float*)(bf + R_B); LASP float* sK2 = (LASP float*)(bf + R_K2);
                bf16x8 aw[2], aa[2];
#pragma unroll
                for (int ks = 0; ks < 2; ++ks) { aw[ks] = *(const LASP bf16x8*)(sPw + (fr & 7) * 72 + ks * 32 + fq * 8); aa[ks] = *(const LASP bf16x8*)(sPa + (fr & 7) * 72 + ks * 32 + fq * 8); }
                float ss[4] = {0.f, 0.f, 0.f, 0.f};
                const bool hi = fq >= 2;
                const int jb = (hi ? 32 : 0) + fr, tb8 = (fq & 1) * 4;
                LASP unsigned char* ebase = bf + ((pw * 8 + tb8) * 64 + jb) * 4; const LASP float* ktbase = sKt + tb8 * 64 + jb; const LASP float* cbase = sC + jb;
                float kkv[2][4], rtv[2][4];
#pragma unroll
                for (int nn = 0; nn < 2; ++nn) {
                    f32x4 dz0 = {0.f, 0.f, 0.f, 0.f}, da0 = dz0, dz1 = dz0, da1 = dz0;
#pragma unroll
                    for (int ks = 0; ks < 2; ++ks) {
                        dz0 = MFMA16(aw[ks], *(const LASP bf16x8*)(sWm + (nn * 16 + fr) * 72 + ks * 32 + fq * 8), dz0); da0 = MFMA16(aa[ks], *(const LASP bf16x8*)(sAm + (nn * 16 + fr) * 72 + ks * 32 + fq * 8), da0);
                        dz1 = MFMA16(aw[ks], *(const LASP bf16x8*)(sWm + ((nn + 2) * 16 + fr) * 72 + ks * 32 + fq * 8), dz1); da1 = MFMA16(aa[ks], *(const LASP bf16x8*)(sAm + ((nn + 2) * 16 + fr) * 72 + ks * 32 + fq * 8), da1); }
                    LASP unsigned char* eb = ebase + nn * 64; const LASP float* kt = ktbase + nn * 16; const LASP float* cb = cbase + nn * 16;
                    const float kkc = cb[272], w0c = cb[400], a0c = cb[464];
#pragma unroll
                    for (int r = 0; r < 4; ++r) {
                        const float dzr = hi ? dz1[r] : dz0[r], dar = hi ? da1[r] : da0[r];
                        const float dec = __builtin_amdgcn_exp2f(-0.8750387749145276f * sigmoidf_(w0c + dzr));
                        const float kk = kt[r * 64] * kkc; ss[r] += kk * kk;
                        *(LASP float*)(eb + r * 256 + R_W) = dec; rtv[nn][r] = sigmoidf_(a0c + dar); kkv[nn][r] = kk; } }
#pragma unroll
                for (int r = 0; r < 4; ++r) { float t = row16_sum(ss[r]); t += __shfl_xor(t, 32); ss[r] = rsqrtf(t + 1e-12f); }
                asm volatile("s_waitcnt lgkmcnt(0)" ::: "memory");
#pragma unroll
                for (int nn = 0; nn < 2; ++nn) { LASP unsigned char* eb = ebase + nn * 64; const LASP float* kt = ktbase + nn * 16; const float kac = cbase[nn * 16 + 336];
#pragma unroll
                    for (int r = 0; r < 4; ++r) { const float kn = kkv[nn][r] * ss[r], ar = rtv[nn][r];
                        *(LASP float*)(eb + r * 256 + R_A) = -kn; *(LASP float*)(eb + r * 256 + R_B) = kn * ar; *(LASP float*)(eb + r * 256 + R_K2) = kt[r * 64] * ((ar - 1.0f) * kac + 1.0f); } }
            };
            auto yout = [&](int blk) {
                const LASP float* sY = (const LASP float*)(lds + (blk & 1) * R_BUF + R_Y); const int id = pw * 64 + lane;
#pragma unroll
                for (int k = 0; k < 2; ++k) { const int t = (id >> 4) + 16 * k, i = id & 15; p.yc[(row0 + blk * 32 + t) * 512 + h * 64 + 16 * rg + i] = f2bf(sY[t * 16 + i]); } };
            RwRaw R;
            load_raw(0, R);
            stageA(0, R); load_raw(1, R); stageBC(0);
            __syncthreads();
#pragma unroll 1
            for (int blk = 0; blk < SEQ / 32; ++blk) {
                if (blk >= 1) yout(blk - 1);
#if DBG_DOUBLE & 8192
                if (blk + 1 < SEQ / 32) { stageA(blk + 1, R); stageBC(blk + 1); stageBC(blk + 1); if (blk + 2 < SEQ / 32) load_raw(blk + 2, R); }
#elif DBG_DOUBLE & 16384
                if (blk + 1 < SEQ / 32) { stageA(blk + 1, R); stageA(blk + 1, R); stageBC(blk + 1); if (blk + 2 < SEQ / 32) load_raw(blk + 2, R); }
#else
                if (blk + 1 < SEQ / 32) { stageA(blk + 1, R); if (blk + 2 < SEQ / 32) load_raw(blk + 2, R); stageBC(blk + 1); }
#endif
                __syncthreads();
            }
            yout(SEQ / 32 - 1);
            __builtin_amdgcn_s_setprio(0);
            __syncthreads();
}
__device__ void phase_rwkv_scan(const Params& p, int l, LASP unsigned char* lds, int wg, int nwg) {
    for (int u = wg; u < NB * 8 * 4; u += nwg) { rwkv_scan_setup(p, l, lds, u); if ((threadIdx.x >> 6) < 4) rwkv_scan_waves(p, l, lds, u); else rwkv_prep_waves(p, l, lds, u); }
}

constexpr int R3_A = 0, R3_G = 65536, R3_PA = 131072, R3_PG = 135680;
__device__ __forceinline__ void rwkv_post_ab(const Params& p, int l, LASP unsigned char* lds, int u) {
    LASP float* sAr = (LASP float*)(lds + R3_A); LASP float* sG = (LASP float*)(lds + R3_G);
    LASP bf16_t* sPa = (LASP bf16_t*)(lds + R3_PA); LASP bf16_t* sPg = (LASP bf16_t*)(lds + R3_PG);
    const int tid = threadIdx.x, lane = tid & 63, wave = tid >> 6, fr = lane & 15, fq = lane >> 4;
    const float* mu = p.rw_mu + (size_t)l * 1792;
        const size_t tr0 = (size_t)u * 32;
        const int pt = tid >> 4, cq = tid & 15;
        const size_t tr = tr0 + pt; const bool hasp = (tr & (SEQ - 1)) != 0;
        const bf16_t* cur = p.PC + tr * PC_LD; const bf16_t* prv = cur - PC_LD; const u32x2 z2 = {0u, 0u};
        (void)sAr; (void)sG; (void)wave; (void)lane;
        { const u32x2 ca = *(const u32x2*)(cur + PC_ALR + 4 * cq), pa = hasp ? *(const u32x2*)(prv + PC_ALR + 4 * cq) : z2;
          const f32x4 a4 = lerp4(ca, pa, *(const f32x4*)(mu + PC_ALR + 4 * cq));
          u32x2 ta; ta.x = pk_bf16(a4[0], a4[1]); ta.y = pk_bf16(a4[2], a4[3]); *(LASP u32x2*)(sPa + pt * 72 + 4 * cq) = ta;
#pragma unroll
          for (int g2 = 0; g2 < 2; ++g2) { const int col = 8 * cq + 4 * g2;
              const u32x2 cg = *(const u32x2*)(cur + PC_GLR + col), pg = hasp ? *(const u32x2*)(prv + PC_GLR + col) : z2;
              const f32x4 g4 = lerp4(cg, pg, *(const f32x4*)(mu + PC_GLR + col));
              u32x2 tg; tg.x = pk_bf16(sigmoidf_(g4[0]), sigmoidf_(g4[1])); tg.y = pk_bf16(sigmoidf_(g4[2]), sigmoidf_(g4[3])); *(LASP u32x2*)(sPg + pt * 136 + col) = tg; } }
        __syncthreads();
        { bf16x8 aa[2][2], ag[2][4];
#pragma unroll
          for (int m2 = 0; m2 < 2; ++m2) {
#pragma unroll
              for (int ks = 0; ks < 2; ++ks) aa[m2][ks] = *(const LASP bf16x8*)(sPa + (m2 * 16 + fr) * 72 + ks * 32 + fq * 8);
#pragma unroll
              for (int ks = 0; ks < 4; ++ks) ag[m2][ks] = *(const LASP bf16x8*)(sPg + (m2 * 16 + fr) * 136 + ks * 32 + fq * 8); }
#pragma unroll 1
          for (int ni = 0; ni < 4; ++ni) { const int n = (wave + 8 * ni) * 16 + fr;
              bf16x8 bwa[2], bwg[4];
#pragma unroll
              for (int ks = 0; ks < 2; ++ks) bwa[ks] = ld_frag_g(p.wa2_t + ((size_t)l * 512 + n) * 64 + ks * 32 + fq * 8);
#pragma unroll
              for (int ks = 0; ks < 4; ++ks) bwg[ks] = ld_frag_g(p.wg2_t + ((size_t)l * 512 + n) * 128 + ks * 32 + fq * 8);
              const float a0n = p.rw_a0[(size_t)l * 512 + n];
#pragma unroll
              for (int m2 = 0; m2 < 2; ++m2) { f32x4 da = {0.f, 0.f, 0.f, 0.f}, dg = {0.f, 0.f, 0.f, 0.f};
#pragma unroll
                  for (int ks = 0; ks < 2; ++ks) da = MFMA16(aa[m2][ks], bwa[ks], da);
#pragma unroll
                  for (int ks = 0; ks < 4; ++ks) dg = MFMA16(ag[m2][ks], bwg[ks], dg);
#pragma unroll
                  for (int r = 0; r < 4; ++r) { const int t = m2 * 16 + fq * 4 + r; sAr[t * 512 + n] = sigmoidf_(a0n + da[r]); sG[t * 512 + n] = dg[r]; } } } }
        __syncthreads();
}
__device__ __forceinline__ void rwkv_post_c(const Params& p, int l, LASP unsigned char* lds, int u) {
    LASP float* sAr = (LASP float*)(lds + R3_A); LASP float* sG = (LASP float*)(lds + R3_G);
    LASP bf16_t* sPa = (LASP bf16_t*)(lds + R3_PA); LASP bf16_t* sPg = (LASP bf16_t*)(lds + R3_PG);
    const int tid = threadIdx.x, lane = tid & 63, wave = tid >> 6, fr = lane & 15, fq = lane >> 4;
    const float* mu = p.rw_mu + (size_t)l * 1792;
        const size_t tr0 = (size_t)u * 32;
        const int pt = tid >> 4, cq = tid & 15;
        const size_t tr = tr0 + pt; const bool hasp = (tr & (SEQ - 1)) != 0;
        const bf16_t* cur = p.PC + tr * PC_LD; const bf16_t* prv = cur - PC_LD; const u32x2 z2 = {0u, 0u};
        (void)sPa; (void)sPg; (void)wave; (void)lane; (void)fr; (void)fq;
        struct HeadRaw { u32x2 cr, ck, cv, pr, pk, pv, yw; };
        auto load_head = [&](int h, HeadRaw& R) { const int col = h * 64 + 4 * cq;
            R.cr = *(const u32x2*)(cur + PC_R + col); R.ck = *(const u32x2*)(cur + PC_K + col); R.cv = *(const u32x2*)(cur + PC_V + col);
            R.pr = hasp ? *(const u32x2*)(prv + PC_R + col) : z2; R.pk = hasp ? *(const u32x2*)(prv + PC_K + col) : z2; R.pv = hasp ? *(const u32x2*)(prv + PC_V + col) : z2;
            R.yw = *(const u32x2*)(p.yc + tr * 512 + col); };
        HeadRaw Rn; load_head(0, Rn);
#pragma unroll 1
        for (int h = 0; h < 8; ++h) { const int col = h * 64 + 4 * cq;
            const HeadRaw R = Rn;
            if (h < 7) load_head(h + 1, Rn);
            const f32x4 r4 = lerp4(R.cr, R.pr, *(const f32x4*)(mu + PC_R + col)), k4 = lerp4(R.ck, R.pk, *(const f32x4*)(mu + PC_K + col)), v4 = lerp4(R.cv, R.pv, *(const f32x4*)(mu + PC_V + col));
            const f32x4 ar = *(const LASP f32x4*)(sAr + pt * 512 + col), g4 = *(const LASP f32x4*)(sG + pt * 512 + col);
            const f32x4 ka4 = *(const f32x4*)(p.rw_k_a + (size_t)l * 512 + col), rk4 = *(const f32x4*)(p.rw_r_k + (size_t)l * 512 + col);
            const f32x4 k2 = k4 * ((ar - 1.0f) * ka4 + 1.0f);
            const f32x4 bt = r4 * k2 * rk4; float bonus = row16_sum(bt[0] + bt[1] + bt[2] + bt[3]);
            const u32x2 yw = R.yw;
            const f32x4 y4 = {bflo(yw.x), bfhi(yw.x), bflo(yw.y), bfhi(yw.y)};
            const float mean = row16_sum(y4[0] + y4[1] + y4[2] + y4[3]) * (1.0f / 64.0f);
            const f32x4 dy = y4 - mean; const float var = row16_sum(dy[0] * dy[0] + dy[1] * dy[1] + dy[2] * dy[2] + dy[3] * dy[3]) * (1.0f / 64.0f);
            const float rstd = rsqrtf(var + 64e-5f);
            const f32x4 lg4 = *(const f32x4*)(p.rw_ln_g + (size_t)l * 512 + col), lb4 = *(const f32x4*)(p.rw_ln_b + (size_t)l * 512 + col);
            const f32x4 o = ((dy * rstd) * lg4 + lb4 + v4 * bonus) * g4;
            u32x2 w; w.x = pk_bf16(o[0], o[1]); w.y = pk_bf16(o[2], o[3]);
            *(u32x2*)(p.yc + tr * 512 + col) = w; }
        __syncthreads();
}
__device__ void phase_rwkv_post(const Params& p, int l, LASP unsigned char* lds, int wg, int nwg) {
    for (int u = wg; u < NTOK / 32; u += nwg) { rwkv_post_ab(p, l, lds, u); rwkv_post_c(p, l, lds, u); }
}

__device__ void phase_peer_tables(const Params& p, int l, int wg, int nwg) {
    const int lane = threadIdx.x & 63, wave = threadIdx.x >> 6;
    unsigned char* t8 = (unsigned char*)p.tu; float* tsc = (float*)((unsigned char*)p.tu + (size_t)2 * 16384 * 1024);
    for (int r = wg * 8 + wave; r < 2 * 16384; r += nwg * 8) {
        const int tb = r >> 14, row = r & 16383;
        const float* src = (tb ? p.peer_v : p.peer_u) + ((size_t)l * 16384 + row) * 1024 + 16 * lane;
        f32x4 v[4]; float am = 0.f;
#pragma unroll
        for (int i = 0; i < 4; ++i) { v[i] = *(const f32x4*)(src + 4 * i); am = fmaxf(am, fmaxf(fmaxf(fabsf(v[i][0]), fabsf(v[i][1])), fmaxf(fabsf(v[i][2]), fabsf(v[i][3])))); }
#pragma unroll
        for (int o = 32; o >= 1; o >>= 1) am = fmaxf(am, __shfl_xor(am, o));
        int ex = 0; if (am > 0.f) (void)frexpf(am, &ex);
        const float sc = ldexpf(1.0f, 8 - ex), inv = ldexpf(1.0f, ex - 8);
        u32x4 w;
#pragma unroll
        for (int i = 0; i < 4; ++i) { int q = 0; q = __builtin_amdgcn_cvt_pk_fp8_f32(v[i][0] * sc, v[i][1] * sc, q, false); q = __builtin_amdgcn_cvt_pk_fp8_f32(v[i][2] * sc, v[i][3] * sc, q, true); w[i] = (unsigned)q; }
        *(u32x4*)(t8 + (size_t)tb * 16384 * 1024 + (size_t)(lane >> 3) * 16384 * 128 + (size_t)row * 128 + 16 * (lane & 7)) = w;
        if (lane == 0) tsc[r] = inv;
    }
}
__device__ __forceinline__ float pk_val(unsigned key) { return fkey_inv(key & 0xffffff80u); }
__device__ void phase_peer_select(const Params& p, int l, LASP unsigned char* lds, int wg, int nwg) {
    LASP unsigned* top = (LASP unsigned*)lds;
    const int tid = threadIdx.x, lane = tid & 63, wave = tid >> 6, fr = lane & 15, fq = lane >> 4;
    int ca, cb; bool cvalid = lane < 50;
    { const int c = lane;
      if (c < 16) { ca = 0; cb = c; } else if (c < 24) { ca = 1; cb = c - 16; } else if (c < 29) { ca = 2; cb = c - 24; } else if (c < 33) { ca = 3; cb = c - 29; }
      else if (c < 36) { ca = 4; cb = c - 33; } else if (c < 38) { ca = 5; cb = c - 36; } else if (c < 40) { ca = 6; cb = c - 38; } else if (c < 42) { ca = 7; cb = c - 40; }
      else if (c < 50) { ca = c - 42 + 8; cb = 0; } else { ca = 0; cb = 0; } }
    for (int u = wg; u < NTOK / 64; u += nwg) {
        const size_t t0 = (size_t)u * 64;
#pragma unroll 1
        for (int pi = 0; pi < 2; ++pi) { const int hp = wave * 2 + pi;
            const bf16_t* kb = p.pkeys + ((size_t)l * 16 + hp) * 128 * 64;
            bf16x8 bk[8][2];
#pragma unroll
            for (int nt = 0; nt < 8; ++nt)
#pragma unroll
                for (int ks = 0; ks < 2; ++ks) bk[nt][ks] = ld_frag_g(kb + (size_t)(nt * 16 + fr) * 64 + ks * 32 + fq * 8);
#pragma unroll 1
            for (int mt = 0; mt < 4; ++mt) {
                bf16x8 qa[2];
#pragma unroll
                for (int ks = 0; ks < 2; ++ks) qa[ks] = ld_frag_g(p.qp + (t0 + mt * 16 + fr) * 1024 + hp * 64 + ks * 32 + fq * 8);
                unsigned key[8][4];
#pragma unroll
                for (int nt = 0; nt < 8; ++nt) { f32x4 d = {0.f, 0.f, 0.f, 0.f}; d = MFMA16(qa[0], bk[nt][0], d); d = MFMA16(qa[1], bk[nt][1], d);
#pragma unroll
                    for (int r = 0; r < 4; ++r) key[nt][r] = (fkey(d[r]) & 0xffffff80u) | (unsigned)(127 - (nt * 16 + fr)); }
#define PE_CE(a, b) { const unsigned hi_ = key[a][r] > key[b][r] ? key[a][r] : key[b][r], lo_ = key[a][r] > key[b][r] ? key[b][r] : key[a][r]; key[a][r] = hi_; key[b][r] = lo_; }
#pragma unroll
                for (int r = 0; r < 4; ++r) {
                    PE_CE(0, 1) PE_CE(2, 3) PE_CE(4, 5) PE_CE(6, 7)
                    PE_CE(0, 2) PE_CE(1, 3) PE_CE(4, 6) PE_CE(5, 7)
                    PE_CE(1, 2) PE_CE(5, 6)
                    PE_CE(0, 4) PE_CE(1, 5) PE_CE(2, 6) PE_CE(3, 7)
                    PE_CE(2, 4) PE_CE(3, 5)
                    PE_CE(1, 2) PE_CE(3, 4) PE_CE(5, 6) }
#undef PE_CE
                unsigned mine[4] = {0u, 0u, 0u, 0u};
#pragma unroll 1
                for (int it = 0; it < 16; ++it) {
                    unsigned mx[4];
                    row16_maxu_x4(mx, key[0][0], key[0][1], key[0][2], key[0][3]);
#pragma unroll
                    for (int r = 0; r < 4; ++r) { const unsigned m = mx[r];
                        if (fr == it) mine[r] = m;
                        const bool win = key[0][r] == m;
#pragma unroll
                        for (int nt = 0; nt < 7; ++nt) key[nt][r] = win ? key[nt + 1][r] : key[nt][r];
                        key[7][r] = win ? 0u : key[7][r]; }
                }
#pragma unroll
                for (int r = 0; r < 4; ++r) top[((mt * 16 + fq * 4 + r) * 16 + hp) * 16 + fr] = mine[r];
            }
        }
        __syncthreads();
        { const int t = tid >> 3, h = tid & 7;
          const LASP unsigned* l1 = top + (t * 16 + h * 2) * 16; const LASP unsigned* l2 = l1 + 16;
          float v1[16];
#pragma unroll
          for (int a = 0; a < 16; ++a) v1[a] = pk_val(l1[a]);
          unsigned long long ptrs = 0ull;
          float wsum[16]; unsigned wab[16];
#pragma unroll
          for (int rd = 0; rd < 16; ++rd) {
              float best = -INFINITY; unsigned bab = 0u;
#pragma unroll
              for (int a = 0; a < 16; ++a) {
                  if (a <= rd) {
                      const unsigned b = (unsigned)(ptrs >> (4 * a)) & 15u; const unsigned lim = 16u / (unsigned)(a + 1);
                      const float c = b < lim ? v1[a] + pk_val(l2[b]) : -INFINITY;
                      if (c > best) { best = c; bab = ((unsigned)a << 4) | b; } } }
              wsum[rd] = best; wab[rd] = bab;
              ptrs += 1ull << (4 * (bab >> 4));
          }
          float den = 0.f; float ex[16];
#pragma unroll
          for (int k = 0; k < 16; ++k) { ex[k] = __expf(wsum[k] - wsum[0]); den += ex[k]; }
          const float rd_ = __builtin_amdgcn_rcpf(den);
          const size_t o = (t0 + t) * 128 + h * 16;
          unsigned ew[8];
#pragma unroll
          for (int k = 0; k < 16; ++k) { const unsigned a = wab[k] >> 4, b = wab[k] & 15u; const unsigned e = ((127u - (l1[a] & 127u)) << 7) | (127u - (l2[b] & 127u));
              if (k & 1) ew[k >> 1] |= e << 16; else ew[k >> 1] = e; }
          *(u32x4*)(p.pe_idx + o) = (u32x4){ew[0], ew[1], ew[2], ew[3]}; *(u32x4*)(p.pe_idx + o + 8) = (u32x4){ew[4], ew[5], ew[6], ew[7]};
#pragma unroll
          for (int k4 = 0; k4 < 4; ++k4) *(f32x4*)(p.pe_gate + o + 4 * k4) = (f32x4){ex[4 * k4] * rd_, ex[4 * k4 + 1] * rd_, ex[4 * k4 + 2] * rd_, ex[4 * k4 + 3] * rd_};
        }
        __syncthreads();
    }
}
__device__ __forceinline__ void fp8x16_to_f32(const u32x4& w, float (&f)[16]) {
#pragma unroll
    for (int i = 0; i < 4; ++i) { const f32x2 a = __builtin_amdgcn_cvt_pk_f32_fp8((int)w[i], false), b = __builtin_amdgcn_cvt_pk_f32_fp8((int)w[i], true); f[4 * i] = a[0]; f[4 * i + 1] = a[1]; f[4 * i + 2] = b[0]; f[4 * i + 3] = b[1]; }
}
template <bool DRY> __device__ void phase_peer_gather(const Params& p, int l, int wg, int nwg) {
    const int lane = threadIdx.x & 63, wave = threadIdx.x >> 6;
    const float* gate = p.mod + (size_t)l * 8 * 6144 + 5120;
    const unsigned char* tu8 = (const unsigned char*)p.tu; const unsigned char* tv8 = tu8 + (size_t)16384 * 1024; const float* tsc = (const float*)(tu8 + (size_t)2 * 16384 * 1024);
    for (int tok = wg * 8 + wave; tok < NTOK; tok += nwg * 8) {
        float xv[16];
        { const u32x4 a = *(const u32x4*)(p.hbuf + (size_t)tok * 1024 + 16 * lane), b = *(const u32x4*)(p.hbuf + (size_t)tok * 1024 + 16 * lane + 8);
          xv[0] = bflo(a.x); xv[1] = bfhi(a.x); xv[2] = bflo(a.y); xv[3] = bfhi(a.y); xv[4] = bflo(a.z); xv[5] = bfhi(a.z); xv[6] = bflo(a.w); xv[7] = bfhi(a.w);
          xv[8] = bflo(b.x); xv[9] = bfhi(b.x); xv[10] = bflo(b.y); xv[11] = bfhi(b.y); xv[12] = bflo(b.z); xv[13] = bfhi(b.z); xv[14] = bflo(b.w); xv[15] = bfhi(b.w); }
        const unsigned e_lo = p.pe_idx[(size_t)tok * 128 + lane], e_hi = p.pe_idx[(size_t)tok * 128 + 64 + lane];
        const float g_lo = p.pe_gate[(size_t)tok * 128 + lane] , g_hi = p.pe_gate[(size_t)tok * 128 + 64 + lane];
        const float su_lo = tsc[e_lo], su_hi = tsc[e_hi], sv_lo = tsc[16384 + e_lo], sv_hi = tsc[16384 + e_hi];
        float d_lo = 0.f, d_hi = 0.f;
#pragma unroll 1
        for (int i0 = 0; i0 < 128; i0 += 8) {
            u32x4 ua[8];
#pragma unroll
            for (int j = 0; j < 8; ++j) { const int i = i0 + j; const unsigned e = (unsigned)__builtin_amdgcn_readlane((int)(i0 < 64 ? e_lo : e_hi), i & 63); ua[j] = *(const u32x4*)(tu8 + (size_t)e * 1024 + 16 * lane); }
#pragma unroll
            for (int j = 0; j < 8; ++j) { const int i = i0 + j; float uf[16]; fp8x16_to_f32(ua[j], uf);
                float s = uf[0] * xv[0];
#pragma unroll
                for (int k = 1; k < 16; ++k) s = fmaf(uf[k], xv[k], s);
                s = row16_sum(s); s += __shfl_xor(s, 16); s += __shfl_xor(s, 32);
                if (i0 < 64) { if (lane == (i & 63)) d_lo = s; } else { if (lane == (i & 63)) d_hi = s; } }
        }
        d_lo *= su_lo; d_hi *= su_hi;
        const float w_lo = sv_lo * g_lo * 0.5f * d_lo * (1.0f + erff(d_lo * 0.70710678118654752f)), w_hi = sv_hi * g_hi * 0.5f * d_hi * (1.0f + erff(d_hi * 0.70710678118654752f));
        float ov[16];
#pragma unroll
        for (int j = 0; j < 16; ++j) ov[j] = 0.f;
#pragma unroll 1
        for (int i0 = 0; i0 < 128; i0 += 8) {
            u32x4 va[8]; float ww[8];
#pragma unroll
            for (int j = 0; j < 8; ++j) { const int i = i0 + j; const unsigned e = (unsigned)__builtin_amdgcn_readlane((int)(i0 < 64 ? e_lo : e_hi), i & 63);
                ww[j] = __int_as_float(__builtin_amdgcn_readlane(__float_as_int(i0 < 64 ? w_lo : w_hi), i & 63));
                va[j] = *(const u32x4*)(tv8 + (size_t)e * 1024 + 16 * lane); }
#pragma unroll
            for (int j = 0; j < 8; ++j) { float vf[16]; fp8x16_to_f32(va[j], vf);
#pragma unroll
                for (int k = 0; k < 16; ++k) ov[k] = fmaf(ww[j], vf[k], ov[k]); }
        }
        const float* gp = gate + (size_t)(tok >> 13) * 6144; float* xr = DRY ? (float*)p.qp + (size_t)(tok & 32767) * 1024 : p.out + (size_t)tok * 1024;
#pragma unroll
        for (int q4 = 0; q4 < 4; ++q4) { const int col = 16 * lane + 4 * q4;
            const f32x4 gg = *(const f32x4*)(gp + col); f32x4 xx = *(const f32x4*)(xr + col);
            xx[0] = fmaf(gg[0], ov[q4 * 4 + 0], xx[0]); xx[1] = fmaf(gg[1], ov[q4 * 4 + 1], xx[1]); xx[2] = fmaf(gg[2], ov[q4 * 4 + 2], xx[2]); xx[3] = fmaf(gg[3], ov[q4 * 4 + 3], xx[3]);
            *(f32x4*)(xr + col) = xx; }
    }
}

typedef __bf16 bf2_t __attribute__((ext_vector_type(2)));
__device__ __forceinline__ float fp8_dot16(const u32x4& w, const u32x4& xa, const u32x4& xb) {
    const unsigned xs[8] = {xa.x, xa.y, xa.z, xa.w, xb.x, xb.y, xb.z, xb.w};
    unsigned u[8];
#pragma unroll
    for (int i = 0; i < 4; ++i) { u[2 * i] = __builtin_bit_cast(unsigned, __builtin_amdgcn_cvt_scalef32_pk_bf16_fp8((int)w[i], 1.0f, false)); u[2 * i + 1] = __builtin_bit_cast(unsigned, __builtin_amdgcn_cvt_scalef32_pk_bf16_fp8((int)w[i], 1.0f, true)); }
    float acc = 0.f;
    asm("v_dot2c_f32_bf16 %0, %1, %9\n\tv_dot2c_f32_bf16 %0, %2, %10\n\tv_dot2c_f32_bf16 %0, %3, %11\n\tv_dot2c_f32_bf16 %0, %4, %12\n\t"
        "v_dot2c_f32_bf16 %0, %5, %13\n\tv_dot2c_f32_bf16 %0, %6, %14\n\tv_dot2c_f32_bf16 %0, %7, %15\n\tv_dot2c_f32_bf16 %0, %8, %16\n\ts_nop 1"
        : "+v"(acc) : "v"(u[0]), "v"(u[1]), "v"(u[2]), "v"(u[3]), "v"(u[4]), "v"(u[5]), "v"(u[6]), "v"(u[7]), "v"(xs[0]), "v"(xs[1]), "v"(xs[2]), "v"(xs[3]), "v"(xs[4]), "v"(xs[5]), "v"(xs[6]), "v"(xs[7]));
    return acc;
}
constexpr int PS_IDS = 131072;
#ifndef PSA
#define PSA 8
#endif
#ifndef PSB
#define PSB 4
#endif
#define PS_COMMON \
    LASP float* acc = (LASP float*)lds; \
    const int tid = threadIdx.x, lane = tid & 63, wave = tid >> 6, g = lane >> 3, c = lane & 7; \
    LASP unsigned short* idl = (LASP unsigned short*)(lds + PS_IDS) + wave * 1024 + g * 128; \
    const unsigned char* tu8 = (const unsigned char*)p.tu; const unsigned char* tv8 = tu8 + (size_t)16384 * 1024; const float* tsc = (const float*)(tu8 + (size_t)2 * 16384 * 1024); \
    (void)tid; (void)tu8; (void)tv8; (void)tsc; (void)acc; (void)l;
template <int NB_> __device__ __forceinline__ void ps_load4(const unsigned char* tab, const LASP unsigned short* idl, int jb, int off, u32x4 (&r)[NB_]) {
    unsigned idw[NB_ / 2];
#pragma unroll
    for (int j = 0; j < NB_ / 2; ++j) idw[j] = *(const LASP unsigned*)(idl + jb * NB_ + 2 * j);
#pragma unroll
    for (int j = 0; j < NB_; ++j) { const unsigned e = (j & 1) ? (idw[j >> 1] >> 16) : (idw[j >> 1] & 0xffffu); r[j] = *(const u32x4*)(tab + (size_t)e * 128 + off); }
}
__device__ __forceinline__ void peer_slab_a(const Params& p, int l, LASP unsigned char* lds, int u) {
    PS_COMMON
#pragma unroll 1
    for (int s = 0; s < 8; ++s) {
#pragma unroll 1
        for (int it = 0; it < 4; ++it) { const int tt = wave * 32 + it * 8 + g; const size_t t = (size_t)u * 256 + tt; const int off = s * 128 + c * 16;
            { const u32x4 i0 = *(const u32x4*)(p.pe_idx + t * 128 + c * 16), i1 = *(const u32x4*)(p.pe_idx + t * 128 + c * 16 + 8);
              *(LASP u32x4*)(idl + c * 16) = i0; *(LASP u32x4*)(idl + c * 16 + 8) = i1; }
            const u32x4 xa = *(const u32x4*)(p.hbuf + t * 1024 + off), xb = *(const u32x4*)(p.hbuf + t * 1024 + off + 8);
            asm volatile("s_waitcnt lgkmcnt(0)" ::: "memory");
            auto use4 = [&](int jb, const u32x4 (&ua)[PSA]) {
                float mine0 = 0.f;
#pragma unroll
                for (int j = 0; j < PSA; ++j) {
                    float d = fp8_dot16(ua[j], xa, xb);
                    d += dppf<0xB1>(d); d += dppf<0x4E>(d); d += dppf<0x141>(d);
                    if ((c & (PSA - 1)) == j) mine0 = d; }
                if (c < PSA) { LASP float* ap = acc + tt * 128 + jb * PSA + c; if (s == 0) ap[0] = mine0; else ap[0] += mine0; } };
            u32x4 ra[PSA], rb[PSA];
            const int toff = s * (16384 * 128) + c * 16;
            ps_load4(tu8, idl, 0, toff, ra);
#pragma unroll 1
            for (int jb = 0; jb < 128 / PSA - 2; jb += 2) {
                ps_load4(tu8, idl, jb + 1, toff, rb);
                use4(jb, ra);
                ps_load4(tu8, idl, jb + 2, toff, ra);
                use4(jb + 1, rb);
            }
            ps_load4(tu8, idl, 128 / PSA - 1, toff, rb);
            use4(128 / PSA - 2, ra);
            use4(128 / PSA - 1, rb);
        }
    }
    __syncthreads();
    for (int i = tid; i < 256 * 128; i += NTHR) { const size_t t = (size_t)u * 256 + (i >> 7); const int k = i & 127;
        const unsigned e = p.pe_idx[t * 128 + k]; const float d = acc[i] * tsc[e];
        acc[i] = tsc[16384 + e] * p.pe_gate[t * 128 + k] * 0.5f * d * (1.0f + erff(d * 0.70710678118654752f)); }
    __syncthreads();
}
__device__ __forceinline__ void peer_slab_b(const Params& p, int l, LASP unsigned char* lds, int u) {
    PS_COMMON
    const float* gate = p.mod + (size_t)l * 8 * 6144 + 5120;
#pragma unroll 1
    for (int s = 0; s < 8; ++s) {
#pragma unroll 1
        for (int it = 0; it < 4; ++it) { const int tt = wave * 32 + it * 8 + g; const size_t t = (size_t)u * 256 + tt; const int off = s * 128 + c * 16;
            { const u32x4 i0 = *(const u32x4*)(p.pe_idx + t * 128 + c * 16), i1 = *(const u32x4*)(p.pe_idx + t * 128 + c * 16 + 8);
              *(LASP u32x4*)(idl + c * 16) = i0; *(LASP u32x4*)(idl + c * 16 + 8) = i1; }
            float ov[16];
#pragma unroll
            for (int k = 0; k < 16; ++k) ov[k] = 0.f;
            asm volatile("s_waitcnt lgkmcnt(0)" ::: "memory");
            auto use4 = [&](int jb, const u32x4 (&va)[PSB]) {
                float wq[PSB];
#pragma unroll
                for (int j = 0; j < PSB; ++j) wq[j] = acc[tt * 128 + jb * PSB + j];
#pragma unroll
                for (int j = 0; j < PSB; ++j) { float vf[16]; fp8x16_to_f32(va[j], vf); const float w = wq[j];
#pragma unroll
                    for (int k = 0; k < 16; ++k) ov[k] = fmaf(w, vf[k], ov[k]); } };
            u32x4 ra[PSB], rb[PSB];
            const int toff = s * (16384 * 128) + c * 16;
            ps_load4(tv8, idl, 0, toff, ra);
#pragma unroll 1
            for (int jb = 0; jb < 128 / PSB - 2; jb += 2) {
                ps_load4(tv8, idl, jb + 1, toff, rb);
                use4(jb, ra);
                ps_load4(tv8, idl, jb + 2, toff, ra);
                use4(jb + 1, rb);
            }
            ps_load4(tv8, idl, 128 / PSB - 1, toff, rb);
            use4(128 / PSB - 2, ra);
            use4(128 / PSB - 1, rb);
            const float* gp = gate + (size_t)(t >> 13) * 6144 + off; float* xr = p.out + t * 1024 + off;
#pragma unroll
            for (int q4 = 0; q4 < 4; ++q4) { const f32x4 gg = *(const f32x4*)(gp + 4 * q4); f32x4 xx = *(const f32x4*)(xr + 4 * q4);
                xx[0] = fmaf(gg[0], ov[q4 * 4 + 0], xx[0]); xx[1] = fmaf(gg[1], ov[q4 * 4 + 1], xx[1]); xx[2] = fmaf(gg[2], ov[q4 * 4 + 2], xx[2]); xx[3] = fmaf(gg[3], ov[q4 * 4 + 3], xx[3]);
                *(f32x4*)(xr + 4 * q4) = xx; }
        }
    }
    __syncthreads();
}
__device__ void phase_peer_gather_slab(const Params& p, int l, LASP unsigned char* lds, int wg, int nwg) {
    for (int u = wg; u < NTOK / 256; u += nwg) { peer_slab_a(p, l, lds, u); peer_slab_b(p, l, lds, u); }
}

#if MK_ONE_LAUNCH
#define PHASE_INLINE __attribute__((noinline))
#else
#define PHASE_INLINE __forceinline__
#endif
#ifndef E3_SLAB
#define E3_SLAB 1
#endif
enum { PH_W = 0, PH_A1, PH_A2, PH_G1, PH_G2, PH_G3, PH_D1, PH_D2, PH_D34, PH_R2, PH_R3, PH_M, PH_O, PH_A1F, PH_E1, PH_E2, PH_E3, PH_FIN, PH_W1, PH_W2, PH_W3, PH_W4, PH_E3DRY, PH_COUNT };
enum { UN_DSEL = 0, UN_DATT, UN_R3AB, UN_R3C, UN_R2SETUP, UN_R2SCAN, UN_R2PREP, UN_E3A, UN_E3B, UN_DUP };

template <int PH> __device__ __forceinline__ void run_phase(const Params& p, int l, LASP unsigned char* lds, int wg, int nwg) {
    const float* modl = p.mod + (size_t)l * 8 * 6144;
    const float* xin = l == 0 ? p.x : p.out;
    if constexpr (PH == PH_W) phase_weights<0>(p, lds, wg, nwg);
    else if constexpr (PH == PH_W1) phase_weights<1>(p, lds, wg, nwg);
    else if constexpr (PH == PH_W2) phase_weights<2>(p, lds, wg, nwg);
    else if constexpr (PH == PH_W3) phase_weights<3>(p, lds, wg, nwg);
    else if constexpr (PH == PH_W4) phase_weights<4>(p, lds, wg, nwg);
    else if constexpr (PH == PH_A1) phase_adaln(xin, p.g_mix + (size_t)l * 1024, modl, 0, 1024, p.hbuf, wg, nwg);
    else if constexpr (PH == PH_A2) { pg8::EpiP E; E.GQ = p.GQ; E.GK = p.GK; E.GV = p.GV; E.GR = p.GR; E.PB = p.PB; E.PC = p.PC;
        run_gemm(lds, p.hbuf, p.win_t + (size_t)l * 3840 * 1024, NTOK, 3840, 1024, E, wg, nwg); }
    else if constexpr (PH == PH_G1) phase_gla1(p, l, lds, wg, nwg);
    else if constexpr (PH == PH_G2) phase_gla2(p, wg, nwg);
    else if constexpr (PH == PH_G3) phase_gla3(p, l, lds, wg, nwg);
    else if constexpr (PH == PH_D1) phase_dsa1(p, l, wg, nwg);
    else if constexpr (PH == PH_D2) { pg8::EpiStore<0> E; E.O = p.qd; E.ldc = 1024; run_gemm(lds, p.qn, p.wuq_t + (size_t)l * 1024 * 256, NTOK, 1024, 256, E, wg, nwg);
        pg8::EpiStore<0> E2; E2.O = p.qi; E2.ldc = 256; run_gemm(lds, p.qn, p.wiq_t + (size_t)l * 256 * 256, NTOK, 256, 256, E2, wg, nwg); }
    else if constexpr (PH == PH_D34) phase_dsa34(p, l, lds, wg, nwg);
    else if constexpr (PH == PH_R2) phase_rwkv_scan(p, l, lds, wg, nwg);
    else if constexpr (PH == PH_R3) phase_rwkv_post(p, l, lds, wg, nwg);
    else if constexpr (PH == PH_M) {
        pg8::EpiStore<1> EG; EG.O = p.Gtmp; EG.ldc = 1024;
        const bf16_t* wg_l = p.wg_t + (size_t)l * 3072 * 1024; const bf16_t* wb_l = p.wb_t + (size_t)l * 3 * 1024 * 512;
        run_gemm(lds, p.hbuf, wg_l, NTOK, 1024, 1024, EG, wg, nwg);
        { pg8::EpiMerge<1> EM; EM.G = p.Gtmp; EM.O = p.merged; EM.ldc = 1024; run_gemm(lds, p.ya, wb_l, NTOK, 1024, 512, EM, wg, nwg); }
        run_gemm(lds, p.hbuf, wg_l + (size_t)1024 * 1024, NTOK, 1024, 1024, EG, wg, nwg);
        { pg8::EpiMerge<0> EM; EM.G = p.Gtmp; EM.O = p.merged; EM.ldc = 1024; run_gemm(lds, p.yb, wb_l + (size_t)1024 * 512, NTOK, 1024, 512, EM, wg, nwg); }
        run_gemm(lds, p.hbuf, wg_l + (size_t)2 * 1024 * 1024, NTOK, 1024, 1024, EG, wg, nwg);
        { pg8::EpiMerge<0> EM; EM.G = p.Gtmp; EM.O = p.merged; EM.ldc = 1024; run_gemm(lds, p.yc, wb_l + (size_t)2 * 1024 * 512, NTOK, 1024, 512, EM, wg, nwg); } }
    else if constexpr (PH == PH_O) { pg8::EpiResid E; E.xin = xin; E.xout = p.out; E.gate = modl + 2048; run_gemm(lds, p.merged, p.wo_t + (size_t)l * 1024 * 1024, NTOK, 1024, 1024, E, wg, nwg); }
    else if constexpr (PH == PH_A1F) { phase_adaln(p.out, p.g_ffn + (size_t)l * 1024, modl, 3072, 4096, p.hbuf, wg, nwg); phase_peer_tables(p, l, wg, nwg); }
    else if constexpr (PH == PH_E1) { pg8::EpiStore<0> E; E.O = p.qp; E.ldc = 1024; run_gemm(lds, p.hbuf, p.wq_t + (size_t)l * 1024 * 1024, NTOK, 1024, 1024, E, wg, nwg); }
    else if constexpr (PH == PH_E2) phase_peer_select(p, l, lds, wg, nwg);
    else if constexpr (PH == PH_E3) { if (E3_SLAB) phase_peer_gather_slab(p, l, lds, wg, nwg); else phase_peer_gather<false>(p, l, wg, nwg); }
    else if constexpr (PH == PH_E3DRY) phase_peer_gather<true>(p, l, wg, nwg);
    else if constexpr (PH == PH_FIN) phase_final(p.out, p.g_final, wg, nwg);
}

extern __shared__ __attribute__((aligned(16))) unsigned char smem_dyn[];
#ifndef DBG_MODE
#define DBG_MODE 0
#endif
#ifndef DBG_DOUBLE
#define DBG_DOUBLE 0
#endif
#ifndef DBG_LAYERS
#define DBG_LAYERS NLAYER
#endif
__global__ void __launch_bounds__(NTHR, 2) k_dbg_copy(const float* x, float* out) {
    for (size_t i = (size_t)blockIdx.x * NTHR + threadIdx.x; i < (size_t)NTOK * 1024 / 4; i += (size_t)gridDim.x * NTHR) ((f32x4*)out)[i] = ((const f32x4*)x)[i];
}

__global__ void __launch_bounds__(NTHR, 2) k_dbg_dump(const bf16_t* buf, size_t n, float* out) {
    const size_t NOUT = (size_t)NTOK * 1024;
    for (size_t i = (size_t)blockIdx.x * NTHR + threadIdx.x; i < NOUT; i += (size_t)gridDim.x * NTHR) {
        float s = 0.f; if (n >= NOUT) { for (size_t j = i; j < n; j += NOUT) s += bf2f(buf[j]); } else s = bf2f(buf[i % n]);
        out[i] = s; }
}
#ifndef DBG_A2BUF
#define DBG_A2BUF p.PC
#define DBG_A2N 1792
#endif
#ifndef DBG_G1BUF
#define DBG_G1BUF p.GS
#define DBG_G1N ((size_t)NTOK * 512)
#endif
#ifndef DBG_STOP
#define DBG_STOP PH_O
#endif
#if MK_ONE_LAUNCH
typedef const __attribute__((address_space(4))) Params* KParams;
__device__ __forceinline__ KParams kparams_from(unsigned lo_, unsigned hi_) {
    const unsigned lo = (unsigned)__builtin_amdgcn_readfirstlane((int)lo_), hi = (unsigned)__builtin_amdgcn_readfirstlane((int)hi_);
    return (KParams)(((unsigned long long)hi << 32) | lo);
}
struct ParamsPtrs { void* w[sizeof(Params) / 8]; };
static_assert(sizeof(ParamsPtrs) == sizeof(Params), "Params must be a whole number of pointers");
__device__ __forceinline__ Params load_kparams(KParams pp) {
    typedef const __attribute__((address_space(4))) unsigned long long* KQ; const KQ q = (KQ)pp; ParamsPtrs r;
#pragma unroll
    for (int i = 0; i < (int)(sizeof(Params) / 8); ++i) r.w[i] = (void*)(__attribute__((address_space(1))) void*)q[i];
    return __builtin_bit_cast(Params, r);
}
template <int PH> __device__ __attribute__((noinline)) void phase_call(int l_, LASP unsigned char* lds_, unsigned plo, unsigned phi) {
    const int l = __builtin_amdgcn_readfirstlane(l_);
    LASP unsigned char* lds = (LASP unsigned char*)(unsigned)__builtin_amdgcn_readfirstlane((int)(unsigned)(size_t)lds_);
    const KParams pp = kparams_from(plo, phi);
    const Params p = load_kparams(pp);
    run_phase<PH>(p, l, lds, (int)blockIdx.x, (int)gridDim.x);
}
template <int UN> __device__ __attribute__((noinline)) void unit_call(int l_, LASP unsigned char* lds_, int u_, unsigned plo, unsigned phi) {
    const int l = __builtin_amdgcn_readfirstlane(l_), u = __builtin_amdgcn_readfirstlane(u_);
    LASP unsigned char* lds = (LASP unsigned char*)(unsigned)__builtin_amdgcn_readfirstlane((int)(unsigned)(size_t)lds_);
    const KParams pp = kparams_from(plo, phi);
    const Params p = load_kparams(pp);
    if constexpr (UN == UN_DSEL) dsa_select_unit(p, l, lds, u);
    else if constexpr (UN == UN_DATT) dsa_attend_query(p, l, lds, u);
    else if constexpr (UN == UN_DUP) dsa_upproj_unit(p, l, lds, u);
    else if constexpr (UN == UN_R3AB) rwkv_post_ab(p, l, lds, u);
    else if constexpr (UN == UN_R3C) rwkv_post_c(p, l, lds, u);
    else if constexpr (UN == UN_R2SETUP) rwkv_scan_setup(p, l, lds, u);
    else if constexpr (UN == UN_R2SCAN) rwkv_scan_waves(p, l, lds, u);
    else if constexpr (UN == UN_R2PREP) rwkv_prep_waves(p, l, lds, u);
    else if constexpr (UN == UN_E3A) peer_slab_a(p, l, lds, u);
    else peer_slab_b(p, l, lds, u);
}
constexpr int NSTEP = 22;
struct GemmStep { const bf16_t* A; const bf16_t* Bt; int N, K; pg8::EpiGen E; };
__device__ __forceinline__ bool make_gemm_step(const Params& p, int l, int s, GemmStep& g) {
    const float* modl = p.mod + (size_t)l * 8 * 6144;
    pg8::EpiGen& E = g.E;
    E.kind = 1; E.ldc = 1024; E.O = nullptr; E.G = p.Gtmp; E.GQ = p.GQ; E.GK = p.GK; E.GV = p.GV; E.GR = p.GR; E.PB = p.PB; E.PC = p.PC; E.xin = l == 0 ? p.x : p.out; E.xout = p.out; E.gate = modl + 2048;
    const bf16_t* wg_l = p.wg_t + (size_t)l * 3072 * 1024; const bf16_t* wb_l = p.wb_t + (size_t)l * 3 * 1024 * 512;
    g.N = 1024; g.K = 1024; g.A = p.hbuf; g.Bt = nullptr;
    switch (s) {
    case 1: g.Bt = p.win_t + (size_t)l * 3840 * 1024; g.N = 3840; E.kind = 0; return true;
    case 6: g.A = p.qn; g.Bt = p.wuq_t + (size_t)l * 1024 * 256; g.K = 256; E.O = p.qd; return true;
    case 7: g.A = p.qn; g.Bt = p.wiq_t + (size_t)l * 256 * 256; g.N = 256; g.K = 256; E.O = p.qi; E.ldc = 256; return true;
    case 11: g.Bt = wg_l; E.kind = 2; E.O = p.Gtmp; return true;
    case 12: g.A = p.ya; g.Bt = wb_l; g.K = 512; E.kind = 3; E.O = p.merged; return true;
    case 13: g.Bt = wg_l + (size_t)1024 * 1024; E.kind = 2; E.O = p.Gtmp; return true;
    case 14: g.A = p.yb; g.Bt = wb_l + (size_t)1024 * 512; g.K = 512; E.kind = 4; E.O = p.merged; return true;
    case 15: g.Bt = wg_l + (size_t)2 * 1024 * 1024; E.kind = 2; E.O = p.Gtmp; return true;
    case 16: g.A = p.yc; g.Bt = wb_l + (size_t)2 * 1024 * 512; g.K = 512; E.kind = 4; E.O = p.merged; return true;
    case 17: g.A = p.merged; g.Bt = p.wo_t + (size_t)l * 1024 * 1024; E.kind = 5; return true;
    case 19: g.Bt = p.wq_t + (size_t)l * 1024 * 1024; E.O = p.qp; return true;
    default: return false; }
}
__global__ void __launch_bounds__(NTHR, 2) mega_fwd(Params p) {
    LASP unsigned char* lds = (LASP unsigned char*)smem_dyn;
    if (threadIdx.x < 4) ((LASP unsigned*)(lds + LDS_BAR_OFF))[threadIdx.x] = 0u;
    __syncthreads();
    const XcdBarrier bar = xcd_barrier_post(p.bar, (volatile LAS unsigned*)(lds + LDS_BAR_OFF));
    const int wg = blockIdx.x, nwg = gridDim.x;
    const unsigned long long kpa = (unsigned long long)__builtin_amdgcn_kernarg_segment_ptr(); const unsigned kplo = (unsigned)kpa, kphi = (unsigned)(kpa >> 32);
#if DBG_DOUBLE & 2048
    phase_call<PH_W>(0, lds, kplo, kphi); phase_call<PH_W1>(0, lds, kplo, kphi); phase_call<PH_W2>(0, lds, kplo, kphi); phase_call<PH_W3>(0, lds, kplo, kphi); phase_call<PH_W4>(0, lds, kplo, kphi);
#endif
    phase_call<PH_W>(0, lds, kplo, kphi); phase_call<PH_W1>(0, lds, kplo, kphi); phase_call<PH_W2>(0, lds, kplo, kphi); phase_call<PH_W3>(0, lds, kplo, kphi); phase_call<PH_W4>(0, lds, kplo, kphi); xcd_barrier(bar);
#pragma unroll 1
    for (int ls = 0; ls < NLAYER * NSTEP; ++ls) {
        const int l = ls / NSTEP, s = ls % NSTEP;
        GemmStep g;
        if (make_gemm_step(p, l, s, g)) {
#if DBG_DOUBLE & 1
            if (s != 17 && s != 14 && s != 16) { pg8::Gemm gg; gg.A = g.A; gg.Bt = g.Bt; gg.M = NTOK; gg.N = g.N; gg.K = g.K; pg8::StaticOrder S; S.init(NTOK, g.N, nwg, wg);
                pg8::gemm_phase<pg8::EpiGen, pg8::StaticOrder, false>(lds, gg, S, g.E, nullptr); __syncthreads(); }
#endif
            pg8::Gemm gg; gg.A = g.A; gg.Bt = g.Bt; gg.M = NTOK; gg.N = g.N; gg.K = g.K;
            pg8::StaticOrder S; S.init(NTOK, g.N, nwg, wg);
#if DBG_DOUBLE & 0x3C0000
            int reps = 1; const int k0 = g.E.kind;
            if ((DBG_DOUBLE & 0x40000) && (s == 11 || s == 13 || s == 15)) { reps = 2; g.E.kind = 6; }
            if ((DBG_DOUBLE & 0x80000) && (s == 11 || s == 13 || s == 15)) { reps = 2; }
            if ((DBG_DOUBLE & 0x100000) && (s == 12 || s == 14 || s == 16)) { reps = 2; g.E.kind = 6; }
            if ((DBG_DOUBLE & 0x200000) && (s == 12 || s == 14 || s == 16)) { reps = 2; g.E.kind = 7; }
            for (int rep = 0; rep < reps; ++rep) { if (rep == reps - 1) g.E.kind = k0;
                pg8::gemm_phase<pg8::EpiGen, pg8::StaticOrder, false>(lds, gg, S, g.E, nullptr); __syncthreads(); }
#else
            pg8::gemm_phase<pg8::EpiGen, pg8::StaticOrder, false>(lds, gg, S, g.E, nullptr);
            __syncthreads();
#endif
        } else {
#if DBG_DOUBLE & 2
            if (s == 8) for (int pos = wg; pos < 4096; pos += nwg) { unit_call<UN_DSEL>(l, lds, pos, kplo, kphi); unit_call<UN_DATT>(l, lds, pos, kplo, kphi); unit_call<UN_DUP>(l, lds, pos, kplo, kphi); }
#endif
#if DBG_DOUBLE & 4
            if (s == 9) for (int u = wg; u < NB * 8 * 4; u += nwg) { unit_call<UN_R2SETUP>(l, lds, u, kplo, kphi);
                if ((threadIdx.x >> 6) < 4) unit_call<UN_R2SCAN>(l, lds, u, kplo, kphi); else unit_call<UN_R2PREP>(l, lds, u, kplo, kphi); }
#endif
#if DBG_DOUBLE & 8
            if (s == 20) phase_call<PH_E2>(l, lds, kplo, kphi);
#endif
#if DBG_DOUBLE & 16
            if (s == 21) phase_call<PH_E3DRY>(l, lds, kplo, kphi);
#endif
#if DBG_DOUBLE & 32
            if (s == 0) phase_call<PH_A1>(l, lds, kplo, kphi);
            if (s == 2) phase_call<PH_G1>(l, lds, kplo, kphi);
            if (s == 4) phase_call<PH_G3>(l, lds, kplo, kphi);
            if (s == 5) phase_call<PH_D1>(l, lds, kplo, kphi);
            if (s == 18) phase_call<PH_A1F>(l, lds, kplo, kphi);
#endif
            switch (s) {
            case 0: phase_call<PH_A1>(l, lds, kplo, kphi); break;
            case 2: phase_call<PH_G1>(l, lds, kplo, kphi); break;
            case 3: phase_call<PH_G2>(l, lds, kplo, kphi); break;
            case 4: phase_call<PH_G3>(l, lds, kplo, kphi); break;
            case 5: phase_call<PH_D1>(l, lds, kplo, kphi); break;
            case 8: for (int pos = wg; pos < 4096; pos += nwg) {
#if DBG_DOUBLE & 64
                unit_call<UN_DSEL>(l, lds, pos, kplo, kphi);
#endif
                unit_call<UN_DSEL>(l, lds, pos, kplo, kphi);
#if DBG_DOUBLE & 128
                unit_call<UN_DATT>(l, lds, pos, kplo, kphi);
#endif
                unit_call<UN_DATT>(l, lds, pos, kplo, kphi); unit_call<UN_DUP>(l, lds, pos, kplo, kphi); } break;
            case 9: for (int u = wg; u < NB * 8 * 4; u += nwg) { unit_call<UN_R2SETUP>(l, lds, u, kplo, kphi);
                if ((threadIdx.x >> 6) < 4) unit_call<UN_R2SCAN>(l, lds, u, kplo, kphi); else unit_call<UN_R2PREP>(l, lds, u, kplo, kphi); } break;
            case 10: for (int u = wg; u < NTOK / 32; u += nwg) {
#if DBG_DOUBLE & 4096
                unit_call<UN_R3AB>(l, lds, u, kplo, kphi);
#endif
                unit_call<UN_R3AB>(l, lds, u, kplo, kphi); unit_call<UN_R3C>(l, lds, u, kplo, kphi); } break;
            case 18: phase_call<PH_A1F>(l, lds, kplo, kphi); break;
            case 20: phase_call<PH_E2>(l, lds, kplo, kphi); break;
            default: if (E3_SLAB) { for (int u = wg; u < NTOK / 256; u += nwg) {
#if DBG_DOUBLE & 0x400000
                         unit_call<UN_E3A>(l, lds, u, kplo, kphi);
#endif
                         unit_call<UN_E3A>(l, lds, u, kplo, kphi); unit_call<UN_E3B>(l, lds, u, kplo, kphi); } }
                     else phase_call<PH_E3>(l, lds, kplo, kphi);
                     break; }
        }
        const bool nobar = (s == 6) || (s >= 11 && s <= 15);
        if (!nobar) xcd_barrier(bar);
#if DBG_DOUBLE & 32768
        if (!nobar) xcd_barrier(bar);
#endif
    }
    phase_call<PH_FIN>(0, lds, kplo, kphi);
}
#else
template <int PH> __global__ void __launch_bounds__(NTHR, 2) k_phase(Params p, int l) {
    LASP unsigned char* lds = (LASP unsigned char*)smem_dyn;
    run_phase<PH>(p, l, lds, blockIdx.x, gridDim.x);
}
template <int PH> static void launch_phase(const Params& p, int l, int grid, hipStream_t stream) {
    static bool attr = false;
    if (!attr) { hipFuncSetAttribute((const void*)k_phase<PH>, hipFuncAttributeMaxDynamicSharedMemorySize, LDS_BYTES); attr = true; }
    hipLaunchKernelGGL(k_phase<PH>, dim3(grid), dim3(NTHR), LDS_BYTES, stream, p, l);
}
#endif

static size_t carve(size_t& off, size_t bytes) { const size_t o = off; off += (bytes + 255) & ~(size_t)255; return o; }

extern "C" void kernel_launch(void* const* d_in, const int* in_sizes, int n_in, void* d_out, int out_size, void* d_ws, size_t ws_size, hipStream_t stream) {
    (void)in_sizes; (void)out_size;
    if (n_in != 33) { fprintf(stderr, "kernel_launch: expected 33 inputs, got %d\n", n_in); return; }
    Params p; memset(&p, 0, sizeof(p));
    const float* const* in = (const float* const*)d_in;
    p.x = in[0]; p.c = in[1]; p.w_ada = in[2]; p.b_ada = in[3]; p.g_mix = in[4]; p.g_ffn = in[5]; p.w_in = in[6]; p.gla_w_a2 = in[7]; p.gla_b_a = in[8]; p.gla_g_o = in[9];
    p.dsa_g_qc = in[10]; p.dsa_w_uq = in[11]; p.dsa_w_iq = in[12]; p.dsa_g_kv = in[13]; p.dsa_w_uv = in[14];
    p.rw_mu = in[15]; p.rw_w0 = in[16]; p.rw_w_w2 = in[17]; p.rw_a0 = in[18]; p.rw_w_a2 = in[19]; p.rw_w_g2 = in[20]; p.rw_k_k = in[21]; p.rw_k_a = in[22]; p.rw_r_k = in[23];
    p.rw_ln_g = in[24]; p.rw_ln_b = in[25]; p.w_branch = in[26]; p.w_out = in[27]; p.peer_w_q = in[28]; p.peer_keys = in[29]; p.peer_u = in[30]; p.peer_v = in[31]; p.g_final = in[32];
    p.out = (float*)d_out;
    char* ws = (char*)d_ws; size_t off = 0;
    const size_t TB2 = (size_t)NTOK * 2;
    p.bar = (unsigned*)(ws + carve(off, 16384));
    p.mod = (float*)(ws + carve(off, (size_t)NLAYER * 8 * 6144 * 4));
    p.win_t = (bf16_t*)(ws + carve(off, (size_t)NLAYER * 3840 * 1024 * 2));
    p.wg_t = (bf16_t*)(ws + carve(off, (size_t)NLAYER * 3072 * 1024 * 2));
    p.wb_t = (bf16_t*)(ws + carve(off, (size_t)NLAYER * 3 * 1024 * 512 * 2));
    p.wo_t = (bf16_t*)(ws + carve(off, (size_t)NLAYER * 1024 * 1024 * 2));
    p.wq_t = (bf16_t*)(ws + carve(off, (size_t)NLAYER * 1024 * 1024 * 2));
    p.wuq_t = (bf16_t*)(ws + carve(off, (size_t)NLAYER * 1024 * 256 * 2));
    p.wiq_t = (bf16_t*)(ws + carve(off, (size_t)NLAYER * 256 * 256 * 2));
    p.wuv_t = (bf16_t*)(ws + carve(off, (size_t)NLAYER * 8 * 64 * 128 * 2));
    p.pkeys = (bf16_t*)(ws + carve(off, (size_t)NLAYER * 8 * 2 * 128 * 64 * 2));
    p.ww2_t = (bf16_t*)(ws + carve(off, (size_t)NLAYER * 512 * 64 * 2));
    p.wa2_t = (bf16_t*)(ws + carve(off, (size_t)NLAYER * 512 * 64 * 2));
    p.wg2_t = (bf16_t*)(ws + carve(off, (size_t)NLAYER * 512 * 128 * 2));
    p.hbuf = (bf16_t*)(ws + carve(off, TB2 * 1024));
    char* R1 = ws + carve(off, TB2 * 1536);
    p.GQ = (bf16_t*)R1; p.GK = (bf16_t*)(R1 + TB2 * 256); p.GR = (bf16_t*)(R1 + TB2 * 512); p.GS = (bf16_t*)(R1 + TB2 * 1024);
    p.GV = (bf16_t*)(ws + carve(off, TB2 * 512));
    p.PB = (bf16_t*)(ws + carve(off, TB2 * 512));
    p.PC = (bf16_t*)(ws + carve(off, TB2 * 1792));
    p.yb = (bf16_t*)(ws + carve(off, TB2 * 512));
    p.yc = (bf16_t*)(ws + carve(off, TB2 * 512));
    p.kvn = (bf16_t*)(ws + carve(off, TB2 * 128));
    p.gdec = (float*)(ws + carve(off, (size_t)NB * NCHUNK * 4 * 64 * 4));
    p.qd = (bf16_t*)R1; p.qi = (bf16_t*)(R1 + TB2 * 1024); p.qn = (bf16_t*)(R1 + TB2 * 1280);
    p.ya = p.GV; p.Gtmp = (bf16_t*)R1; p.merged = p.PC;
    p.qp = (bf16_t*)R1; p.tu = (bf16_t*)(R1 + TB2 * 1024); p.tv = (bf16_t*)(R1 + TB2 * 1280);
    p.pe_idx = (unsigned short*)p.PC; p.pe_gate = (float*)((char*)p.PC + (size_t)NTOK * 128 * 2);
    if (off > ws_size) { fprintf(stderr, "kernel_launch: workspace too small: need %zu, have %zu\n", off, ws_size); return; }
    static int grid = 0;
    if (!grid) { int dev = 0, cus = 0; hipGetDevice(&dev); hipDeviceGetAttribute(&cus, hipDeviceAttributeMultiprocessorCount, dev); grid = cus > 0 ? cus : 256; if (grid > 256) grid = 256; }
#if MK_ONE_LAUNCH
    static bool attr = false;
    if (!attr) { if (hipFuncSetAttribute((const void*)mega_fwd, hipFuncAttributeMaxDynamicSharedMemorySize, LDS_BYTES) != hipSuccess) fprintf(stderr, "kernel_launch: hipFuncSetAttribute failed\n"); attr = true; }
    hipMemsetAsync(p.bar, 0, 16384, stream);
    hipLaunchKernelGGL(mega_fwd, dim3(grid), dim3(NTHR), LDS_BYTES, stream, p);
#else
#if DBG_MODE == 1
    hipLaunchKernelGGL(k_dbg_copy, dim3(grid), dim3(NTHR), 0, stream, p.x, p.out);
    launch_phase<PH_FIN>(p, 0, grid, stream);
    return;
#endif
#if DBG_MODE == 2
    {   launch_phase<PH_W>(p, 0, grid, stream); launch_phase<PH_W1>(p, 0, grid, stream); launch_phase<PH_W2>(p, 0, grid, stream); launch_phase<PH_W3>(p, 0, grid, stream); launch_phase<PH_W4>(p, 0, grid, stream);
        const bf16_t* db = nullptr; size_t dn = 0; const int l = 0;
        launch_phase<PH_A1>(p, l, grid, stream); db = p.hbuf; dn = (size_t)NTOK * 1024;
        if (DBG_STOP >= PH_A2) { launch_phase<PH_A2>(p, l, grid, stream); db = DBG_A2BUF; dn = (size_t)NTOK * DBG_A2N; }
        if (DBG_STOP >= PH_G1) { launch_phase<PH_G1>(p, l, grid, stream); db = DBG_G1BUF; dn = DBG_G1N; }
        if (DBG_STOP >= PH_G2) { launch_phase<PH_G2>(p, l, grid, stream); db = p.GS; dn = (size_t)NTOK * 512; }
        if (DBG_STOP >= PH_G3) { launch_phase<PH_G3>(p, l, grid, stream); db = p.ya; dn = (size_t)NTOK * 512; }
        if (DBG_STOP >= PH_D1) { launch_phase<PH_D1>(p, l, grid, stream); db = p.qn; dn = (size_t)NTOK * 256; }
        if (DBG_STOP >= PH_D2) { launch_phase<PH_D2>(p, l, grid, stream); db = p.qd; dn = (size_t)NTOK * 1280; }
        if (DBG_STOP >= PH_D34) { launch_phase<PH_D34>(p, l, grid, stream); db = p.yb; dn = (size_t)NTOK * 512; }
        if (DBG_STOP >= PH_R2) { launch_phase<PH_R2>(p, l, grid, stream); db = p.yc; dn = (size_t)NTOK * 512; }
        if (DBG_STOP >= PH_R3) { launch_phase<PH_R3>(p, l, grid, stream); db = p.yc; dn = (size_t)NTOK * 512; }
        if (DBG_STOP >= PH_M) { launch_phase<PH_M>(p, l, grid, stream); db = p.merged; dn = (size_t)NTOK * 1024; }
        if (DBG_STOP >= PH_O) { launch_phase<PH_O>(p, l, grid, stream); db = nullptr; }
        if (DBG_STOP >= PH_A1F) { launch_phase<PH_A1F>(p, l, grid, stream); }
        if (DBG_STOP >= PH_E1) { launch_phase<PH_E1>(p, l, grid, stream); db = p.qp; dn = (size_t)NTOK * 1024; }
        if (DBG_STOP >= PH_E2) { launch_phase<PH_E2>(p, l, grid, stream); db = (const bf16_t*)p.pe_gate; dn = (size_t)NTOK * 256; }
        if (DBG_STOP >= PH_E3) { launch_phase<PH_E3>(p, l, grid, stream); db = nullptr; }
        if (db) hipLaunchKernelGGL(k_dbg_dump, dim3(grid), dim3(NTHR), 0, stream, db, dn, p.out);
        return; }
#endif
    launch_phase<PH_W>(p, 0, grid, stream); launch_phase<PH_W1>(p, 0, grid, stream); launch_phase<PH_W2>(p, 0, grid, stream); launch_phase<PH_W3>(p, 0, grid, stream); launch_phase<PH_W4>(p, 0, grid, stream);
    for (int l = 0; l < DBG_LAYERS; ++l) {
        launch_phase<PH_A1>(p, l, grid, stream); launch_phase<PH_A2>(p, l, grid, stream);
        launch_phase<PH_G1>(p, l, grid, stream); launch_phase<PH_G2>(p, l, grid, stream); launch_phase<PH_G3>(p, l, grid, stream);
        launch_phase<PH_D1>(p, l, grid, stream); launch_phase<PH_D2>(p, l, grid, stream); launch_phase<PH_D34>(p, l, grid, stream);
        launch_phase<PH_R2>(p, l, grid, stream); launch_phase<PH_R3>(p, l, grid, stream);
        launch_phase<PH_M>(p, l, grid, stream); launch_phase<PH_O>(p, l, grid, stream);
        launch_phase<PH_A1F>(p, l, grid, stream); launch_phase<PH_E1>(p, l, grid, stream); launch_phase<PH_E2>(p, l, grid, stream); launch_phase<PH_E3>(p, l, grid, stream);
    }
    launch_phase<PH_FIN>(p, 0, grid, stream);
#endif
}
```

```cpp
#include <hip/hip_runtime.h>
#include <stdint.h>
#include <stdio.h>
#include <string.h>

#ifndef MK_ONE_LAUNCH
#define MK_ONE_LAUNCH 1
#endif

typedef unsigned short bf16_t;
typedef short bf16x8 __attribute__((ext_vector_type(8)));
typedef float f32x4 __attribute__((ext_vector_type(4)));
typedef float f32x2 __attribute__((ext_vector_type(2)));
typedef unsigned u32x4 __attribute__((ext_vector_type(4)));
typedef unsigned u32x2 __attribute__((ext_vector_type(2)));

#define XB_TMO      128
#define XB_XCNT(j)  (256  + 64 * (j))
#define XB_XSUB(j)  (1280 + 64 * (j))
#define XB_XGEN(j)  (2304 + 64 * (j))
#define XB_TOP      3328
#define XB_TOPGEN   3392
#define XCD_BAR_WORDS 3456
#define XB_SPIN_CAP (1u << 24)
#define LAS __attribute__((address_space(3)))

__device__ __forceinline__ unsigned xb_ld(unsigned* p)              { return __hip_atomic_load(p, __ATOMIC_RELAXED, __HIP_MEMORY_SCOPE_AGENT); }
__device__ __forceinline__ unsigned xb_add(unsigned* p, unsigned v) { return __hip_atomic_fetch_add(p, v, __ATOMIC_RELAXED, __HIP_MEMORY_SCOPE_AGENT); }
__device__ __forceinline__ unsigned xb_xcc_id() { return (unsigned)__builtin_amdgcn_s_getreg((3 << 11) | 20) & 0xFu; }
#define XB_SPIN(cond, bar) do { unsigned _sp = 0; while (cond) { __builtin_amdgcn_s_sleep(1); \
    if ((++_sp & 255u) == 0u) { if (xb_ld(&(bar)[XB_TMO])) break; if (_sp > XB_SPIN_CAP) { atomicAdd(&(bar)[XB_TMO], 1u); break; } } } } while (0)

struct XcdBarrier {
    unsigned* bar; unsigned x;
    volatile LAS unsigned* st;
};

__device__ __forceinline__ XcdBarrier xcd_barrier_post(unsigned* bar, volatile LAS unsigned* st) {
    XcdBarrier b; b.bar = bar; b.x = xb_xcc_id(); b.st = st;
    if (threadIdx.x == 0) (void)xb_add(&bar[XB_XCNT(b.x)], 1u);
    return b;
}
__device__ __forceinline__ void xcd_barrier_complete(unsigned* bar, unsigned x, unsigned& nloc, unsigned& nx) {
    const unsigned G = gridDim.x * gridDim.y * gridDim.z;
    unsigned sum, cnt, mine, sp = 0u;
    for (;;) {
        sum = 0u; cnt = 0u; mine = 0u;
#pragma unroll
        for (unsigned j = 0; j < 16; ++j) { const unsigned c = xb_ld(&bar[XB_XCNT(j)]); sum += c; cnt += (c > 0u) ? 1u : 0u; mine = (j == x) ? c : mine; }
        if (sum == G) break;
        __builtin_amdgcn_s_sleep(1);
        if ((++sp & 255u) == 0u) { if (xb_ld(&bar[XB_TMO])) break; if (sp > XB_SPIN_CAP) { atomicAdd(&bar[XB_TMO], 1u); break; } }
    }
    nloc = mine > 0u ? mine : 1u; nx = cnt > 0u ? cnt : 1u;
}

__device__ __forceinline__ void xcd_barrier(const XcdBarrier& b) {
    asm volatile("s_waitcnt vmcnt(0)" ::: "memory");
    __syncthreads();
    if (threadIdx.x == 0) {
        unsigned* bar = b.bar;
        __builtin_amdgcn_s_waitcnt(0);
        unsigned nloc = b.st[0], nx = b.st[1];
        if (nloc == 0u) { xcd_barrier_complete(bar, b.x, nloc, nx); b.st[0] = nloc; b.st[1] = nx; }
        const unsigned old = xb_add(&bar[XB_XSUB(b.x)], 1u);
        const unsigned gen = old / nloc;
        if (old + 1u == (gen + 1u) * nloc) {
            __builtin_amdgcn_fence(__ATOMIC_RELEASE, "agent");
            asm volatile("s_waitcnt vmcnt(0)" ::: "memory");
            const unsigned og = xb_add(&bar[XB_TOP], 1u);
            const unsigned tg = og / nx;
            if (og + 1u == (tg + 1u) * nx) xb_add(&bar[XB_TOPGEN], 1u);
            else XB_SPIN(xb_ld(&bar[XB_TOPGEN]) == tg, bar);
            __builtin_amdgcn_fence(__ATOMIC_ACQUIRE, "agent");
            xb_add(&bar[XB_XGEN(b.x)], 1u);
            asm volatile("s_waitcnt vmcnt(0)" ::: "memory");
        } else {
            XB_SPIN(xb_ld(&bar[XB_XGEN(b.x)]) == gen, bar);
            __builtin_amdgcn_fence(__ATOMIC_ACQUIRE, "agent");
            asm volatile("s_waitcnt vmcnt(0)" ::: "memory");
        }
    }
    __syncthreads();
}
namespace pg8 {
#define PG8_LAS __attribute__((address_space(3)))
typedef unsigned short bf16_t;
typedef short bf16x8 __attribute__((ext_vector_type(8)));
typedef float f32x4 __attribute__((ext_vector_type(4)));
typedef unsigned u32x4 __attribute__((ext_vector_type(4)));
constexpr int BM = 256, BK = 64, HALF = 128, HTB = HALF * BK * 2  , STAGE_BYTES = 8 * HTB, NXCD = 8, WGM = 8;

__host__ __device__ __forceinline__ int lds_byte(int r, int c) { const int st = (r >> 4) * 2 + (c >> 5), rr = r & 15, cc = c & 31, ob = rr * 64 + cc * 2; return st * 1024 + (ob ^ (((ob >> 9) & 1) << 5)); }
__host__ __device__ __forceinline__ void stage_rc(int b, int& R, int& C) { const int st = b / 1024, sb = b % 1024, swz = sb ^ (((sb >> 9) & 1) << 5); R = (st >> 1) * 16 + swz / 64; C = (st & 1) * 32 + (swz % 64) / 2; }
__host__ __device__ __forceinline__ int perm32(int rho) { const int n = rho >> 4, i = rho & 15; return 8 * (i >> 2) + 4 * n + (i & 3); }

struct Unit { int pm, pn; };
struct Gemm { const bf16_t* A; const bf16_t* Bt; int M, N, K; };

struct StaticOrder {
    int nM, nN, nwg, G, c;
    __host__ __device__ void init(int M, int N, int G_, int c_) { nM = M / BM; nN = N / BM; nwg = nM * nN; G = G_; c = c_; }
    __host__ __device__ bool next(int i, Unit& u) const {
        const long L = (long)i * G + c; if (L >= nwg) return false;
        int wgid = (int)L; { const int q = nwg / NXCD, r = nwg % NXCD, xcd = wgid % NXCD, off = wgid / NXCD; wgid = (xcd < r ? xcd * (q + 1) : r * (q + 1) + (xcd - r) * q) + off; }
        const int nig = WGM * nN, gid = wgid / nig, fm = gid * WGM, gsz = (nM - fm) < WGM ? (nM - fm) : WGM;
        u.pm = fm + ((wgid % nig) % gsz); u.pn = (wgid % nig) / gsz; return true;
    }
    __device__ __forceinline__ void a_ready(const Unit&) const {}
    __device__ __forceinline__ void done(const Unit&) const {}
};
struct CountedOrder : StaticOrder {
    const unsigned* ready; unsigned need; unsigned* tmo;
    __device__ __forceinline__ void a_ready(const Unit& u) const {
        if (threadIdx.x < 64) {
            const unsigned long long t0 = __builtin_amdgcn_s_memrealtime(); unsigned polls = 0;
            while ((unsigned)__builtin_amdgcn_readfirstlane(__hip_atomic_load(ready + 64 * u.pm, __ATOMIC_RELAXED, __HIP_MEMORY_SCOPE_AGENT)) < need) {
                if ((++polls & 255u) == 0u && __builtin_amdgcn_readfirstlane(__hip_atomic_load(tmo, __ATOMIC_RELAXED, __HIP_MEMORY_SCOPE_AGENT)) != 0u) break;
                if (__builtin_amdgcn_s_memrealtime() - t0 > 2000000ull) {
                    if (threadIdx.x == 0) { unsigned expect = 0u; __hip_atomic_compare_exchange_strong(tmo + 1, &expect, 0x600u | (unsigned)(u.pm & 0xff), __ATOMIC_RELAXED, __ATOMIC_RELAXED, __HIP_MEMORY_SCOPE_AGENT); __hip_atomic_store(tmo, 1u, __ATOMIC_RELAXED, __HIP_MEMORY_SCOPE_AGENT); }
                    break; }
                __builtin_amdgcn_s_sleep(2); }
            __builtin_amdgcn_fence(__ATOMIC_ACQUIRE, "agent");
            asm volatile("s_waitcnt vmcnt(0)" ::: "memory");
        }
#if !defined(BROKEN_HOOK_NO_BARRIER)
        asm volatile("" ::: "memory"); __builtin_amdgcn_s_barrier(); asm volatile("" ::: "memory");
#endif
    }
};

typedef __bf16 bf16x2_t __attribute__((ext_vector_type(2)));
__device__ __forceinline__ unsigned cvt_pk_bf16(float lo, float hi) { typedef float f2_t __attribute__((ext_vector_type(2))); const f2_t v = {lo, hi}; const bf16x2_t b = __builtin_convertvector(v, bf16x2_t); return __builtin_bit_cast(unsigned, b); }
typedef float f32x2 __attribute__((ext_vector_type(2)));
__device__ __forceinline__ f32x2 gelu_pk(f32x2 v) {
    const f32x2 av = __builtin_elementwise_abs(v), d = av * 0.2316418882f + 1.0f;
    f32x2 t; t.x = __builtin_amdgcn_rcpf(d.x); t.y = __builtin_amdgcn_rcpf(d.y);
    f32x2 q = t * 0.5307027145f + (-0.7265760135f); q = q * t + 0.7107068705f; q = q * t + (-0.142248368f); q = q * t + 0.127414796f; q = q * t;
    const f32x2 s = (v * v) * (-0.72134752044f);
    f32x2 e; e.x = __builtin_amdgcn_exp2f(s.x); e.y = __builtin_amdgcn_exp2f(s.y);
    const f32x2 m = v * (q * e), r = v - m;
    f32x2 o; o.x = v.x < 0.f ? m.x : r.x; o.y = v.y < 0.f ? m.y : r.y; return o;
}

struct EpiF32 {
    static constexpr bool PERM = false, AFTER_DRAIN = false;
    float* C; int ldc; const float* bias;
    __device__ __forceinline__ void operator()(const f32x4 (&acc)[2][2][4][2], const Unit& u, int wr, int wc, int fr, int fq) const {
        const int row0 = u.pm * BM + wr * 64 + fr, col0 = u.pn * BM + wc * 32 + 4 * fq;
        f32x4 bv[2][2];
#pragma unroll
        for (int bj = 0; bj < 2; ++bj)
#pragma unroll
            for (int n = 0; n < 2; ++n) bv[bj][n] = bias ? *(const f32x4*)(bias + col0 + bj * HALF + n * 16) : (f32x4){0.f, 0.f, 0.f, 0.f};
#pragma unroll
        for (int ai = 0; ai < 2; ++ai)
#pragma unroll
            for (int m = 0; m < 4; ++m) { float* rowp = C + (size_t)(row0 + ai * HALF + m * 16) * ldc + col0;
#pragma unroll
                for (int bj = 0; bj < 2; ++bj)
#pragma unroll
                    for (int n = 0; n < 2; ++n) *(f32x4*)(rowp + bj * HALF + n * 16) = acc[ai][bj][m][n] + bv[bj][n]; }
    }
};
template <int ACT  > struct EpiBf16 {
    static constexpr bool PERM = true, AFTER_DRAIN = false;
    bf16_t* O; int ldc; const float* bias; int split_cols; size_t split_stride;
    __device__ __forceinline__ void operator()(const f32x4 (&acc)[2][2][4][2], const Unit& u, int wr, int wc, int fr, int fq) const {
        const int row0 = u.pm * BM + wr * 64 + fr; int colt = u.pn * BM; bf16_t* base = O;
        if (split_cols) { const int t = colt / split_cols; base += (size_t)t * split_stride; colt -= t * split_cols; }
        const int col0 = colt + wc * 32 + 8 * fq, bcol0 = u.pn * BM + wc * 32 + 8 * fq;
        f32x4 bv[2][2];
#pragma unroll
        for (int bj = 0; bj < 2; ++bj)
#pragma unroll
            for (int n = 0; n < 2; ++n) bv[bj][n] = bias ? *(const f32x4*)(bias + bcol0 + bj * HALF + 4 * n) : (f32x4){0.f, 0.f, 0.f, 0.f};
#pragma unroll
        for (int ai = 0; ai < 2; ++ai)
#pragma unroll
            for (int m = 0; m < 4; ++m) { bf16_t* rowp = base + (size_t)(row0 + ai * HALF + m * 16) * ldc + col0;
#pragma unroll
                for (int bj = 0; bj < 2; ++bj) { f32x4 v0 = acc[ai][bj][m][0] + bv[bj][0], v1 = acc[ai][bj][m][1] + bv[bj][1];
                    if (ACT == 1) { f32x2 a = gelu_pk((f32x2){v0[0], v0[1]}), b = gelu_pk((f32x2){v0[2], v0[3]}), c = gelu_pk((f32x2){v1[0], v1[1]}), d = gelu_pk((f32x2){v1[2], v1[3]});
                        v0 = (f32x4){a.x, a.y, b.x, b.y}; v1 = (f32x4){c.x, c.y, d.x, d.y}; }
                    if (ACT == 2) {
#pragma unroll
                        for (int j = 0; j < 4; ++j) { v0[j] = 0.5f * v0[j] * (1.0f + erff(v0[j] * 0.70710678f)); v1[j] = 0.5f * v1[j] * (1.0f + erff(v1[j] * 0.70710678f)); } }
                    u32x4 w; w.x = cvt_pk_bf16(v0[0], v0[1]); w.y = cvt_pk_bf16(v0[2], v0[3]); w.z = cvt_pk_bf16(v1[0], v1[1]); w.w = cvt_pk_bf16(v1[2], v1[3]);
                    *(u32x4*)(rowp + bj * HALF) = w; } }
    }
};
template <class Epi, class Sched, bool STAMP = false>
__device__ __forceinline__ void gemm_phase(PG8_LAS unsigned char* lds, const Gemm g, const Sched& S, const Epi& E, unsigned long long* stamps) {
    const int tid = threadIdx.x, wid = __builtin_amdgcn_readfirstlane(tid >> 6), lane = tid & 63, wr = wid >> 2, wc = wid & 3, fr = lane & 15, fq = lane >> 4;
    const int K = g.K, nt = K / BK;
    int ts_lo = 0, ts_hi = 0, nts = 0; const unsigned long long rt_entry = STAMP ? (unsigned long long)wall_clock64() : 0ull;
#define PG8_STAMP() do { if (STAMP && wid == 0 && nts < 64) { const unsigned long long _c = (unsigned long long)clock64(); \
        ts_lo = (lane == nts) ? (int)(unsigned)_c : ts_lo; ts_hi = (lane == nts) ? (int)(unsigned)(_c >> 32) : ts_hi; ++nts; } } while (0)
    PG8_STAMP();
    unsigned voffA[2], voffB[2];
#pragma unroll
    for (int i = 0; i < 2; ++i) { int R, C; stage_rc(tid * 16 + i * 8192, R, C); const int Rb = Epi::PERM ? ((R & ~31) + perm32(R & 31)) : R;
        voffA[i] = (unsigned)(R * K + C) * 2u; voffB[i] = (unsigned)(Rb * K + C) * 2u; }
    const size_t kstep = (size_t)(BK * 2);
    const size_t hstep = (size_t)HALF * K * 2;
    const size_t tstep = 2 * hstep;
    const unsigned ldsw = (unsigned)wid * 1024u;
    const int aoff = lds_byte(wr * 64 + fr, fq * 8), boff = lds_byte(wc * 32 + fr, fq * 8);
#define PG8_SA(b, h) (((b) * 2 + (h)) * HTB)
#define PG8_SB(b, h) ((4 + (b) * 2 + (h)) * HTB)
#define PG8_STAGE(bufoff, gbase, voff) do { _Pragma("unroll") for (int _i = 0; _i < 2; ++_i) \
        __builtin_amdgcn_global_load_lds((const unsigned*)((const char*)(gbase) + (voff)[_i]), (PG8_LAS unsigned*)(lds + (bufoff) + ldsw + _i * 8192), 16, 0, 0); } while (0)
#define PG8_LDA(dst, b, h) do { _Pragma("unroll") for (int m = 0; m < 4; ++m) _Pragma("unroll") for (int k = 0; k < 2; ++k) dst[m][k] = *(const PG8_LAS bf16x8*)(lds + PG8_SA(b, h) + aoff + m * 2048 + k * 1024); } while (0)
#define PG8_LDB(dst, b, h) do { _Pragma("unroll") for (int n = 0; n < 2; ++n) _Pragma("unroll") for (int k = 0; k < 2; ++k) dst[n][k] = *(const PG8_LAS bf16x8*)(lds + PG8_SB(b, h) + boff + n * 2048 + k * 1024); } while (0)
#define PG8_MMA(ai, bj, At, Bt) do { __builtin_amdgcn_s_setprio(1); _Pragma("unroll") for (int m = 0; m < 4; ++m) _Pragma("unroll") for (int n = 0; n < 2; ++n) _Pragma("unroll") for (int k = 0; k < 2; ++k) \
        acc[ai][bj][m][n] = __builtin_amdgcn_mfma_f32_16x16x32_bf16(Bt[n][k], At[m][k], acc[ai][bj][m][n], 0, 0, 0); __builtin_amdgcn_s_setprio(0); } while (0)
#define PG8_WAIT_V(n) asm volatile("s_waitcnt vmcnt(" #n ")" ::: "memory")
#define PG8_WAIT_L(n) asm volatile("s_waitcnt lgkmcnt(" #n ")" ::: "memory")
#define PG8_BAR __builtin_amdgcn_s_barrier()
#define PG8_SCHED __builtin_amdgcn_sched_barrier(0)
    Unit cur, nxt; int ui = 0;
    if (!S.next(0, cur)) return;
    f32x4 acc[2][2][4][2];
#pragma unroll
    for (int a = 0; a < 2; ++a)
#pragma unroll
        for (int b = 0; b < 2; ++b)
#pragma unroll
            for (int m = 0; m < 4; ++m)
#pragma unroll
                for (int n = 0; n < 2; ++n) acc[a][b][m][n] = (f32x4){0.f, 0.f, 0.f, 0.f};
    bf16x8 At[4][2], B0[2][2], B1[2][2];
    const char* cA = (const char*)g.A + (size_t)cur.pm * tstep; const char* cB = (const char*)g.Bt + (size_t)cur.pn * tstep;
    S.a_ready(cur);
    PG8_STAGE(PG8_SB(0, 0), cB, voffB); PG8_STAGE(PG8_SA(0, 0), cA, voffA); PG8_STAGE(PG8_SB(0, 1), cB + hstep, voffB); PG8_STAGE(PG8_SA(0, 1), cA + hstep, voffA);
    if (wr == 1) PG8_BAR;
    PG8_WAIT_V(4); PG8_BAR;
    PG8_STAGE(PG8_SB(1, 0), cB + kstep, voffB); PG8_STAGE(PG8_SA(1, 0), cA + kstep, voffA); PG8_STAGE(PG8_SB(1, 1), cB + hstep + kstep, voffB);
    PG8_WAIT_V(6); PG8_BAR;
    PG8_STAMP();
    for (;;) {
        const bool has_next = S.next(ui + 1, nxt);
        const char* nA = has_next ? (const char*)g.A + (size_t)nxt.pm * tstep : cA; const char* nB = has_next ? (const char*)g.Bt + (size_t)nxt.pn * tstep : cB;
        for (int t = 0; t < nt; t += 2) {
            const bool last = (t == nt - 2);
            const char* a1 = cA + (size_t)(t + 1) * kstep;
            const char* a2 = last ? nA : cA + (size_t)(t + 2) * kstep; const char* b2 = last ? nB : cB + (size_t)(t + 2) * kstep;
            const char* a3 = a2 + kstep; const char* b3 = b2 + kstep;
            if (last && has_next) S.a_ready(nxt);
            PG8_LDB(B0, 0, 0); PG8_SCHED; PG8_LDA(At, 0, 0); PG8_STAGE(PG8_SA(1, 1), a1 + hstep, voffA);
            PG8_WAIT_L(8); PG8_BAR; PG8_WAIT_L(0); PG8_MMA(0, 0, At, B0); PG8_BAR; PG8_SCHED;
            PG8_LDB(B1, 0, 1); PG8_STAGE(PG8_SB(0, 0), b2, voffB);
            PG8_BAR; PG8_WAIT_L(0); PG8_MMA(0, 1, At, B1); PG8_BAR;
            PG8_LDA(At, 0, 1); PG8_STAGE(PG8_SA(0, 0), a2, voffA);
            PG8_BAR; PG8_WAIT_L(0); PG8_MMA(1, 0, At, B0); PG8_BAR; PG8_SCHED;
            PG8_STAGE(PG8_SB(0, 1), b2 + hstep, voffB);
            PG8_WAIT_V(6); PG8_BAR; PG8_MMA(1, 1, At, B1); PG8_BAR;
            PG8_LDB(B0, 1, 0); PG8_SCHED; PG8_LDA(At, 1, 0); PG8_STAGE(PG8_SA(0, 1), a2 + hstep, voffA);
            PG8_WAIT_L(8); PG8_BAR; PG8_WAIT_L(0); PG8_MMA(0, 0, At, B0); PG8_BAR; PG8_SCHED;
            PG8_LDB(B1, 1, 1); PG8_STAGE(PG8_SB(1, 0), b3, voffB);
            PG8_BAR; PG8_WAIT_L(0); PG8_MMA(0, 1, At, B1); PG8_BAR;
            PG8_LDA(At, 1, 1); PG8_STAGE(PG8_SA(1, 0), a3, voffA);
            PG8_BAR; PG8_WAIT_L(0); PG8_MMA(1, 0, At, B0); PG8_BAR; PG8_SCHED;
            PG8_STAGE(PG8_SB(1, 1), b3 + hstep, voffB);
            PG8_WAIT_V(6); PG8_BAR; PG8_MMA(1, 1, At, B1); PG8_BAR;
        }
        PG8_STAMP();
        if constexpr (!Epi::AFTER_DRAIN) { E(acc, cur, wr, wc, fr, fq); S.done(cur); }
        PG8_STAMP();
        if (!has_next) break;
#pragma unroll
        for (int a = 0; a < 2; ++a)
#pragma unroll
            for (int b = 0; b < 2; ++b)
#pragma unroll
                for (int m = 0; m < 4; ++m)
#pragma unroll
                    for (int n = 0; n < 2; ++n) acc[a][b][m][n] = (f32x4){0.f, 0.f, 0.f, 0.f};
        cur = nxt; cA = nA; cB = nB; ++ui;
    }
    PG8_WAIT_V(0);
    if (wr == 0) PG8_BAR;
    PG8_BAR;
    if constexpr (Epi::AFTER_DRAIN) { E.fused(acc, cur, wr, wc, fr, fq, lds, wid, lane); S.done(cur); }
    PG8_STAMP();
    if (STAMP && wid == 0) { stamps[lane] = lane < nts ? (((unsigned long long)(unsigned)ts_hi << 32) | (unsigned)ts_lo) : 0ull;
        if (lane == 62) stamps[62] = rt_entry; if (lane == 63) stamps[63] = (unsigned long long)wall_clock64(); }
#undef PG8_STAMP
#undef PG8_SA
#undef PG8_SB
#undef PG8_STAGE
#undef PG8_LDA
#undef PG8_LDB
#undef PG8_MMA
#undef PG8_WAIT_V
#undef PG8_WAIT_L
#undef PG8_BAR
#undef PG8_SCHED
}
}

constexpr int NB = 8, SEQ = 8192, DM = 1024, NTOK = NB * SEQ, NLAYER = 4, NCHUNK = 128;
constexpr int IN_W = 6868;
constexpr int NTHR = 512;
constexpr int LDS_BYTES = 160 * 1024;
constexpr int LDS_BAR_OFF = LDS_BYTES - 16;
#define LASP __attribute__((address_space(3)))

constexpr int PB_QC = 0, PB_KVC = 256, PB_IK = 384, PB_GALR = 448, PB_IW = 464, PB_LD = 512;
constexpr int PC_R = 0, PC_K = 512, PC_V = 1024, PC_WLR = 1536, PC_ALR = 1600, PC_GLR = 1664, PC_LD = 1792;

struct Params {
    const float *x, *c, *w_ada, *b_ada, *g_mix, *g_ffn, *w_in, *gla_w_a2, *gla_b_a, *gla_g_o, *dsa_g_qc, *dsa_w_uq, *dsa_w_iq, *dsa_g_kv, *dsa_w_uv;
    const float *rw_mu, *rw_w0, *rw_w_w2, *rw_a0, *rw_w_a2, *rw_w_g2, *rw_k_k, *rw_k_a, *rw_r_k, *rw_ln_g, *rw_ln_b, *w_branch, *w_out, *peer_w_q, *peer_keys, *peer_u, *peer_v, *g_final;
    float* out;
    unsigned* bar;
    float* mod;
    bf16_t *win_t, *wg_t, *wb_t, *wo_t, *wq_t, *wuq_t, *wiq_t, *wuv_t, *pkeys, *ww2_t, *wa2_t, *wg2_t;
    bf16_t *hbuf, *GQ, *GK, *GR, *GS, *GV, *PB, *PC, *yb, *yc, *kvn;
    float* gdec;
    bf16_t *qd, *qi, *qn, *ya, *Gtmp, *merged, *qp, *tu, *tv;
    unsigned short* pe_idx; float* pe_gate;
};

typedef __bf16 bf16x2_t __attribute__((ext_vector_type(2)));
__device__ __forceinline__ unsigned pk_bf16(float lo, float hi) { const f32x2 v = {lo, hi}; const bf16x2_t b = __builtin_convertvector(v, bf16x2_t); return __builtin_bit_cast(unsigned, b); }
__device__ __forceinline__ bf16_t f2bf(float f) { return (bf16_t)(pk_bf16(f, 0.f) & 0xffffu); }
__device__ __forceinline__ float bf2f(bf16_t v) { return __uint_as_float(((unsigned)v) << 16); }
__device__ __forceinline__ float bflo(unsigned u) { return __uint_as_float(u << 16); }
__device__ __forceinline__ float bfhi(unsigned u) { return __uint_as_float(u & 0xffff0000u); }
__device__ __forceinline__ float sigmoidf_(float x) { return __builtin_amdgcn_rcpf(1.0f + __expf(-x)); }
__device__ __forceinline__ float siluf_(float x) { return x * __builtin_amdgcn_rcpf(1.0f + __expf(-x)); }
__device__ __forceinline__ float softplusf_(float x) { return fmaxf(x, 0.f) + log1pf(__expf(-fabsf(x))); }
__device__ __forceinline__ float wave_sum(float v) {
#pragma unroll
    for (int o = 32; o >= 1; o >>= 1) v += __shfl_xor(v, o);
    return v;
}
template <int CTRL> __device__ __forceinline__ float dppf(float v) { return __int_as_float(__builtin_amdgcn_update_dpp(0, __float_as_int(v), CTRL, 0xF, 0xF, true)); }
template <int CTRL> __device__ __forceinline__ unsigned dppu(unsigned v) { return (unsigned)__builtin_amdgcn_update_dpp(0, (int)v, CTRL, 0xF, 0xF, true); }
__device__ __forceinline__ float row16_sum(float v) { v += dppf<0xB1>(v); v += dppf<0x4E>(v); v += dppf<0x141>(v); v += dppf<0x140>(v); return v; }
__device__ __forceinline__ float row16_max(float v) { v = fmaxf(v, dppf<0xB1>(v)); v = fmaxf(v, dppf<0x4E>(v)); v = fmaxf(v, dppf<0x141>(v)); v = fmaxf(v, dppf<0x140>(v)); return v; }
#define R16_STEP4(op, ctrl) \
    op " %0, %0, %0 " ctrl " row_mask:0xf bank_mask:0xf bound_ctrl:1\n\t" op " %1, %1, %1 " ctrl " row_mask:0xf bank_mask:0xf bound_ctrl:1\n\t" \
    op " %2, %2, %2 " ctrl " row_mask:0xf bank_mask:0xf bound_ctrl:1\n\t" op " %3, %3, %3 " ctrl " row_mask:0xf bank_mask:0xf bound_ctrl:1\n\t"
#define R16_ALL4(op) "s_nop 1\n\t" R16_STEP4(op, "quad_perm:[1,0,3,2]") R16_STEP4(op, "quad_perm:[2,3,0,1]") R16_STEP4(op, "row_half_mirror") R16_STEP4(op, "row_mirror") "s_nop 1"
__device__ __forceinline__ void row16_max_x4(float& a, float& b, float& c, float& d) { asm(R16_ALL4("v_max_f32_dpp") : "+v"(a), "+v"(b), "+v"(c), "+v"(d)); }
#define R16_STEP4_IN(op, ctrl) \
    op " %0, %4, %4 " ctrl " row_mask:0xf bank_mask:0xf bound_ctrl:1\n\t" op " %1, %5, %5 " ctrl " row_mask:0xf bank_mask:0xf bound_ctrl:1\n\t" \
    op " %2, %6, %6 " ctrl " row_mask:0xf bank_mask:0xf bound_ctrl:1\n\t" op " %3, %7, %7 " ctrl " row_mask:0xf bank_mask:0xf bound_ctrl:1\n\t"
__device__ __forceinline__ void row16_maxu_x4(unsigned (&o)[4], unsigned a, unsigned b, unsigned c, unsigned d) {
    asm("s_nop 1\n\t" R16_STEP4_IN("v_max_u32_dpp", "quad_perm:[1,0,3,2]") R16_STEP4("v_max_u32_dpp", "quad_perm:[2,3,0,1]") R16_STEP4("v_max_u32_dpp", "row_half_mirror") R16_STEP4("v_max_u32_dpp", "row_mirror") "s_nop 1"
        : "=&v"(o[0]), "=&v"(o[1]), "=&v"(o[2]), "=&v"(o[3]) : "v"(a), "v"(b), "v"(c), "v"(d)); }
__device__ __forceinline__ void row16_sum_x4(float& a, float& b, float& c, float& d) { asm(R16_ALL4("v_add_f32_dpp") : "+v"(a), "+v"(b), "+v"(c), "+v"(d)); }
__device__ __forceinline__ unsigned row16_maxu(unsigned v) { unsigned t; t = dppu<0xB1>(v); v = v > t ? v : t; t = dppu<0x4E>(v); v = v > t ? v : t; t = dppu<0x141>(v); v = v > t ? v : t; t = dppu<0x140>(v); v = v > t ? v : t; return v; }
__device__ __forceinline__ unsigned wave_scan_incl(unsigned v) {
    v += (unsigned)__builtin_amdgcn_update_dpp(0, (int)v, 0x111, 0xF, 0xF, false);
    v += (unsigned)__builtin_amdgcn_update_dpp(0, (int)v, 0x112, 0xF, 0xF, false);
    v += (unsigned)__builtin_amdgcn_update_dpp(0, (int)v, 0x114, 0xF, 0xF, false);
    v += (unsigned)__builtin_amdgcn_update_dpp(0, (int)v, 0x118, 0xF, 0xF, false);
    v += (unsigned)__builtin_amdgcn_update_dpp(0, (int)v, 0x142, 0xA, 0xF, false);
    v += (unsigned)__builtin_amdgcn_update_dpp(0, (int)v, 0x143, 0xC, 0xF, false);
    return v;
}
__device__ __forceinline__ unsigned fkey(float f) { unsigned u = __float_as_uint(f); if (f == 0.f) u = 0u; return (u & 0x80000000u) ? ~u : (u | 0x80000000u); }
__device__ __forceinline__ float fkey_inv(unsigned k) { const unsigned u = (k & 0x80000000u) ? (k & 0x7fffffffu) : ~k; return __uint_as_float(u); }

__device__ __forceinline__ bf16x8 ld_frag_g(const bf16_t* p) { return *(const bf16x8*)p; }
#define MFMA16(a, b, c) __builtin_amdgcn_mfma_f32_16x16x32_bf16((a), (b), (c), 0, 0, 0)

namespace pg8 {
struct EpiP {
    static constexpr bool PERM = true, AFTER_DRAIN = false;
    bf16_t *GQ, *GK, *GV, *GR, *PB, *PC;
    __device__ __forceinline__ void operator()(const f32x4 (&acc)[2][2][4][2], const Unit& u, int wr, int wc, int fr, int fq) const {
        const int pn = u.pn; bf16_t* base; int ldc, cb;
        if (pn == 0) { base = GQ; ldc = 256; cb = 0; } else if (pn == 1) { base = GK; ldc = 256; cb = 0; }
        else if (pn < 4) { base = GV; ldc = 512; cb = (pn - 2) * 256; } else if (pn < 6) { base = GR; ldc = 512; cb = (pn - 4) * 256; }
        else if (pn < 8) { base = PB; ldc = 512; cb = (pn - 6) * 256; } else { base = PC; ldc = 1792; cb = (pn - 8) * 256; }
        const int row0 = u.pm * BM + wr * 64 + fr, col0 = cb + wc * 32 + 8 * fq;
#pragma unroll
        for (int ai = 0; ai < 2; ++ai)
#pragma unroll
            for (int m = 0; m < 4; ++m) { bf16_t* rowp = base + (size_t)(row0 + ai * HALF + m * 16) * ldc + col0;
#pragma unroll
                for (int bj = 0; bj < 2; ++bj) { const f32x4 v0 = acc[ai][bj][m][0], v1 = acc[ai][bj][m][1];
                    u32x4 w; w.x = cvt_pk_bf16(v0[0], v0[1]); w.y = cvt_pk_bf16(v0[2], v0[3]); w.z = cvt_pk_bf16(v1[0], v1[1]); w.w = cvt_pk_bf16(v1[2], v1[3]);
                    *(u32x4*)(rowp + bj * HALF) = w; } }
    }
};
template <int SIG> struct EpiStore {
    static constexpr bool PERM = true, AFTER_DRAIN = false;
    bf16_t* O; int ldc;
    __device__ __forceinline__ void operator()(const f32x4 (&acc)[2][2][4][2], const Unit& u, int wr, int wc, int fr, int fq) const {
        const int row0 = u.pm * BM + wr * 64 + fr, col0 = u.pn * BM + wc * 32 + 8 * fq;
#pragma unroll
        for (int ai = 0; ai < 2; ++ai)
#pragma unroll
            for (int m = 0; m < 4; ++m) { bf16_t* rowp = O + (size_t)(row0 + ai * HALF + m * 16) * ldc + col0;
#pragma unroll
                for (int bj = 0; bj < 2; ++bj) { f32x4 v0 = acc[ai][bj][m][0], v1 = acc[ai][bj][m][1];
                    if (SIG) {
#pragma unroll
                        for (int j = 0; j < 4; ++j) { v0[j] = __builtin_amdgcn_rcpf(1.0f + __expf(-v0[j])); v1[j] = __builtin_amdgcn_rcpf(1.0f + __expf(-v1[j])); } }
                    u32x4 w; w.x = cvt_pk_bf16(v0[0], v0[1]); w.y = cvt_pk_bf16(v0[2], v0[3]); w.z = cvt_pk_bf16(v1[0], v1[1]); w.w = cvt_pk_bf16(v1[2], v1[3]);
                    *(u32x4*)(rowp + bj * HALF) = w; } }
    }
};
template <int FIRST> struct EpiMerge {
    static constexpr bool PERM = true, AFTER_DRAIN = false;
    const bf16_t* G; bf16_t* O; int ldc;
    __device__ __forceinline__ void operator()(const f32x4 (&acc)[2][2][4][2], const Unit& u, int wr, int wc, int fr, int fq) const {
        const int row0 = u.pm * BM + wr * 64 + fr, col0 = u.pn * BM + wc * 32 + 8 * fq;
#pragma unroll
        for (int ai = 0; ai < 2; ++ai)
#pragma unroll
            for (int m = 0; m < 4; ++m) { const size_t off = (size_t)(row0 + ai * HALF + m * 16) * ldc + col0;
#pragma unroll
                for (int bj = 0; bj < 2; ++bj) { const f32x4 v0 = acc[ai][bj][m][0], v1 = acc[ai][bj][m][1];
                    const u32x4 g = *(const u32x4*)(G + off + bj * HALF);
                    float o[8];
                    o[0] = __uint_as_float(g.x << 16) * v0[0]; o[1] = __uint_as_float(g.x & 0xffff0000u) * v0[1]; o[2] = __uint_as_float(g.y << 16) * v0[2]; o[3] = __uint_as_float(g.y & 0xffff0000u) * v0[3];
                    o[4] = __uint_as_float(g.z << 16) * v1[0]; o[5] = __uint_as_float(g.z & 0xffff0000u) * v1[1]; o[6] = __uint_as_float(g.w << 16) * v1[2]; o[7] = __uint_as_float(g.w & 0xffff0000u) * v1[3];
                    if (!FIRST) { const u32x4 p = *(const u32x4*)(O + off + bj * HALF);
                        o[0] += __uint_as_float(p.x << 16); o[1] += __uint_as_float(p.x & 0xffff0000u); o[2] += __uint_as_float(p.y << 16); o[3] += __uint_as_float(p.y & 0xffff0000u);
                        o[4] += __uint_as_float(p.z << 16); o[5] += __uint_as_float(p.z & 0xffff0000u); o[6] += __uint_as_float(p.w << 16); o[7] += __uint_as_float(p.w & 0xffff0000u); }
                    u32x4 w; w.x = cvt_pk_bf16(o[0], o[1]); w.y = cvt_pk_bf16(o[2], o[3]); w.z = cvt_pk_bf16(o[4], o[5]); w.w = cvt_pk_bf16(o[6], o[7]);
                    *(u32x4*)(O + off + bj * HALF) = w; } }
    }
};
struct EpiResid {
    static constexpr bool PERM = false, AFTER_DRAIN = false;
    const float* xin; float* xout; const float* gate;
    __device__ __forceinline__ void operator()(const f32x4 (&acc)[2][2][4][2], const Unit& u, int wr, int wc, int fr, int fq) const {
        const int row0 = u.pm * BM + wr * 64 + fr, col0 = u.pn * BM + wc * 32 + 4 * fq;
        const float* gp = gate + (size_t)((u.pm * BM) >> 13) * 6144;
        f32x4 gv[2][2];
#pragma unroll
        for (int bj = 0; bj < 2; ++bj)
#pragma unroll
            for (int n = 0; n < 2; ++n) gv[bj][n] = *(const f32x4*)(gp + col0 + bj * HALF + n * 16);
#pragma unroll
        for (int ai = 0; ai < 2; ++ai)
#pragma unroll
            for (int m = 0; m < 4; ++m) { const size_t off = (size_t)(row0 + ai * HALF + m * 16) * 1024 + col0;
#pragma unroll
                for (int bj = 0; bj < 2; ++bj)
#pragma unroll
                    for (int n = 0; n < 2; ++n) { const f32x4 xi = *(const f32x4*)(xin + off + bj * HALF + n * 16);
                        *(f32x4*)(xout + off + bj * HALF + n * 16) = xi + gv[bj][n] * acc[ai][bj][m][n]; } }
    }
};

#ifndef EPI_DEPTH
#define EPI_DEPTH 2
#endif
#ifndef EPI_DEPTH34
#define EPI_DEPTH34 3
#endif
#ifndef EPI_DEPTH5
#define EPI_DEPTH5 EPI_DEPTH
#endif
struct EpiGen {
    static constexpr bool PERM = true, AFTER_DRAIN = false;
    int kind; int ldc;
    bf16_t* O; const bf16_t* G;
    bf16_t *GQ, *GK, *GV, *GR, *PB, *PC;
    const float* xin; float* xout; const float* gate;
    __device__ __forceinline__ void operator()(const f32x4 (&acc)[2][2][4][2], const Unit& u, int wr, int wc, int fr, int fq) const {
        const int row0 = u.pm * BM + wr * 64 + fr;
#ifdef DBG_DOUBLE
        if (kind == 6) return;
        const float pmul = kind == 7 ? 0.f : 1.f;
#define EPI_PMUL(x) ((x) * pmul)
#define EPI_K4(k) ((k) <= 4 || (k) == 7)
#else
#define EPI_PMUL(x) (x)
#define EPI_K4(k) ((k) <= 4)
#endif
        if (kind <= 2) {
            bf16_t* base = O; int ld = ldc, cb = u.pn * BM;
            if (kind == 0) { const int pn = u.pn;
                if (pn == 0) { base = GQ; ld = 256; cb = 0; } else if (pn == 1) { base = GK; ld = 256; cb = 0; }
                else if (pn < 4) { base = GV; ld = 512; cb = (pn - 2) * 256; } else if (pn < 6) { base = GR; ld = 512; cb = (pn - 4) * 256; }
                else if (pn < 8) { base = PB; ld = 512; cb = (pn - 6) * 256; } else { base = PC; ld = 1792; cb = (pn - 8) * 256; } }
            const int col0 = cb + wc * 32 + 8 * fq; const bool sig = kind == 2;
#pragma unroll
            for (int ai = 0; ai < 2; ++ai)
#pragma unroll
                for (int m = 0; m < 4; ++m) { bf16_t* rowp = base + (size_t)(row0 + ai * HALF + m * 16) * ld + col0;
#pragma unroll
                    for (int bj = 0; bj < 2; ++bj) { f32x4 v0 = acc[ai][bj][m][0], v1 = acc[ai][bj][m][1];
                        if (sig) {
#pragma unroll
                            for (int j = 0; j < 4; ++j) { v0[j] = __builtin_amdgcn_rcpf(1.0f + __expf(-v0[j])); v1[j] = __builtin_amdgcn_rcpf(1.0f + __expf(-v1[j])); } }
                        u32x4 w; w.x = cvt_pk_bf16(v0[0], v0[1]); w.y = cvt_pk_bf16(v0[2], v0[3]); w.z = cvt_pk_bf16(v1[0], v1[1]); w.w = cvt_pk_bf16(v1[2], v1[3]);
                        *(u32x4*)(rowp + bj * HALF) = w; } }
        } else if (EPI_K4(kind)) {
            const int col0 = u.pn * BM + wc * 32 + 8 * fq; const bool first = kind == 3;
            const u32x4 z4 = {0u, 0u, 0u, 0u};
            u32x4 gq[EPI_DEPTH34][2], pq[EPI_DEPTH34][2];
#define EPI_LD34(am_, slot_) do { const int ai2 = (am_) >> 2, m2 = (am_) & 3; const size_t off2 = (size_t)(row0 + ai2 * HALF + m2 * 16) * 1024 + col0; \
                _Pragma("unroll") for (int bj = 0; bj < 2; ++bj) { gq[slot_][bj] = *(const u32x4*)(G + off2 + bj * HALF); pq[slot_][bj] = first ? z4 : *(const u32x4*)(O + off2 + bj * HALF); } } while (0)
#pragma unroll
            for (int d = 0; d < EPI_DEPTH34; ++d) EPI_LD34(d, d);
#pragma unroll
            for (int am = 0; am < 8; ++am) { const int ai = am >> 2, m = am & 3; const size_t off = (size_t)(row0 + ai * HALF + m * 16) * 1024 + col0;
                u32x4 gc[2], pc[2];
#pragma unroll
                for (int bj = 0; bj < 2; ++bj) { gc[bj] = gq[am % EPI_DEPTH34][bj]; pc[bj] = pq[am % EPI_DEPTH34][bj]; }
                if (am + EPI_DEPTH34 < 8) EPI_LD34(am + EPI_DEPTH34, am % EPI_DEPTH34);
#pragma unroll
                for (int bj = 0; bj < 2; ++bj) { const f32x4 v0 = acc[ai][bj][m][0], v1 = acc[ai][bj][m][1]; const u32x4 g = gc[bj], p = pc[bj];
                    float o[8];
                    o[0] = __uint_as_float(g.x << 16) * EPI_PMUL(v0[0]) + __uint_as_float(p.x << 16); o[1] = __uint_as_float(g.x & 0xffff0000u) * EPI_PMUL(v0[1]) + __uint_as_float(p.x & 0xffff0000u);
                    o[2] = __uint_as_float(g.y << 16) * EPI_PMUL(v0[2]) + __uint_as_float(p.y << 16); o[3] = __uint_as_float(g.y & 0xffff0000u) * EPI_PMUL(v0[3]) + __uint_as_float(p.y & 0xffff0000u);
                    o[4] = __uint_as_float(g.z << 16) * EPI_PMUL(v1[0]) + __uint_as_float(p.z << 16); o[5] = __uint_as_float(g.z & 0xffff0000u) * EPI_PMUL(v1[1]) + __uint_as_float(p.z & 0xffff0000u);
                    o[6] = __uint_as_float(g.w << 16) * EPI_PMUL(v1[2]) + __uint_as_float(p.w << 16); o[7] = __uint_as_float(g.w & 0xffff0000u) * EPI_PMUL(v1[3]) + __uint_as_float(p.w & 0xffff0000u);
                    u32x4 w; w.x = cvt_pk_bf16(o[0], o[1]); w.y = cvt_pk_bf16(o[2], o[3]); w.z = cvt_pk_bf16(o[4], o[5]); w.w = cvt_pk_bf16(o[6], o[7]);
                    *(u32x4*)(O + off + bj * HALF) = w; } }
        } else {
            const int col0 = u.pn * BM + wc * 32 + 8 * fq;
            const float* gp = gate + (size_t)((u.pm * BM) >> 13) * 6144;
            f32x4 gv[2][2];
#pragma unroll
            for (int bj = 0; bj < 2; ++bj)
#pragma unroll
                for (int n = 0; n < 2; ++n) gv[bj][n] = *(const f32x4*)(gp + col0 + bj * HALF + n * 4);
            f32x4 xq[EPI_DEPTH5][2][2];
#define EPI_LD5(am_, slot_) do { const int ai2 = (am_) >> 2, m2 = (am_) & 3; const size_t off2 = (size_t)(row0 + ai2 * HALF + m2 * 16) * 1024 + col0; \
                _Pragma("unroll") for (int bj = 0; bj < 2; ++bj) _Pragma("unroll") for (int n = 0; n < 2; ++n) xq[slot_][bj][n] = *(const f32x4*)(xin + off2 + bj * HALF + n * 4); } while (0)
#pragma unroll
            for (int d = 0; d < EPI_DEPTH5; ++d) EPI_LD5(d, d);
#pragma unroll
            for (int am = 0; am < 8; ++am) { const int ai = am >> 2, m = am & 3; const size_t off = (size_t)(row0 + ai * HALF + m * 16) * 1024 + col0;
                f32x4 xc[2][2];
#pragma unroll
                for (int bj = 0; bj < 2; ++bj)
#pragma unroll
                    for (int n = 0; n < 2; ++n) xc[bj][n] = xq[am % EPI_DEPTH5][bj][n];
                if (am + EPI_DEPTH5 < 8) EPI_LD5(am + EPI_DEPTH5, am % EPI_DEPTH5);
#pragma unroll
                for (int bj = 0; bj < 2; ++bj)
#pragma unroll
                    for (int n = 0; n < 2; ++n) *(f32x4*)(xout + off + bj * HALF + n * 4) = xc[bj][n] + gv[bj][n] * acc[ai][bj][m][n]; }
        }
    }
};
}

template <class Epi> __device__ __forceinline__ void run_gemm(LASP unsigned char* lds, const bf16_t* A, const bf16_t* Bt, int M, int N, int K, const Epi& E, int wg, int nwg) {
    pg8::Gemm g; g.A = A; g.Bt = Bt; g.M = M; g.N = N; g.K = K;
    pg8::StaticOrder S; S.init(M, N, nwg, wg);
    pg8::gemm_phase<Epi, pg8::StaticOrder, false>(lds, g, S, E, nullptr);
    __syncthreads();
}

__device__ __forceinline__ int pmap(int n) {
    if (n < 1024) return n;
    if (n < 1536) return 1040 + (n - 1024);
    if (n < 1792) return 1552 + (n - 1536);
    if (n < 1920) return 1808 + (n - 1792);
    if (n < 1984) return 1936 + (n - 1920);
    if (n < 2000) return 1024 + (n - 1984);
    if (n < 2004) return 2000 + (n - 2000);
    if (n < 2048) return -1;
    return 2004 + (n - 2048);
}
__device__ __forceinline__ void tcvt_tile(const float* src, int ldsrc, bf16_t* dst, int K, int n0, int k0, int mode, LASP float* tile) {
    const int tid = threadIdx.x, j = tid & 63, i = tid >> 6;
    const int n = n0 + j; const int c = mode == 0 ? n : (mode == 1 ? pmap(n) : n + 3796);
#pragma unroll
    for (int ii = 0; ii < 8; ++ii) { const int kk = ii * 8 + i; tile[kk * 65 + j] = c >= 0 ? src[(size_t)(k0 + kk) * ldsrc + c] : 0.f; }
    __syncthreads();
#pragma unroll
    for (int it = 0; it < 8; ++it) { const int jj = it * 8 + (tid >> 6), kk = tid & 63; dst[(size_t)(n0 + jj) * K + k0 + kk] = f2bf(tile[kk * 65 + jj]); }
    __syncthreads();
}
constexpr int W_TILES_L = 960 + 768 + 384 + 256 + 256 + 64 + 16 + 16 + 8 + 8 + 16;
constexpr int W_TILES = W_TILES_L * NLAYER, W_MOD_UNITS = 384, W_PK_UNITS = 128;
template <int PART> __device__ __forceinline__ void phase_weights(const Params& p, LASP unsigned char* lds, int wg, int nwg) {
    LASP float* tile = (LASP float*)lds;
    const int tid = threadIdx.x;
    if constexpr (PART == 0) {
        for (int id = wg; id < NLAYER * 1728; id += nwg) { const int l = id / 1728; int t = id % 1728;
            if (t < 960) tcvt_tile(p.w_in + (size_t)l * 1024 * IN_W, IN_W, p.win_t + (size_t)l * 3840 * 1024, 1024, (t % 60) * 64, (t / 60) * 64, 1, tile);
            else { t -= 960; tcvt_tile(p.w_in + (size_t)l * 1024 * IN_W, IN_W, p.wg_t + (size_t)l * 3072 * 1024, 1024, (t % 48) * 64, (t / 48) * 64, 2, tile); } }
    } else if constexpr (PART == 1) {
        for (int id = wg; id < NLAYER * 896; id += nwg) { const int l = id / 896; int t = id % 896;
            if (t < 384) { const int j = t / 128, r = t % 128; tcvt_tile(p.w_branch + (size_t)(l * 3 + j) * 512 * 1024, 1024, p.wb_t + (size_t)(l * 3 + j) * 1024 * 512, 512, (r % 16) * 64, (r / 16) * 64, 0, tile); }
            else if (t < 640) { t -= 384; tcvt_tile(p.w_out + (size_t)l * 1024 * 1024, 1024, p.wo_t + (size_t)l * 1024 * 1024, 1024, (t % 16) * 64, (t / 16) * 64, 0, tile); }
            else { t -= 640; tcvt_tile(p.peer_w_q + (size_t)l * 1024 * 1024, 1024, p.wq_t + (size_t)l * 1024 * 1024, 1024, (t % 16) * 64, (t / 16) * 64, 0, tile); } }
    } else if constexpr (PART == 2) {
        for (int id = wg; id < NLAYER * 96; id += nwg) { const int l = id / 96; int t = id % 96;
            if (t < 64) tcvt_tile(p.dsa_w_uq + (size_t)l * 256 * 1024, 1024, p.wuq_t + (size_t)l * 1024 * 256, 256, (t % 16) * 64, (t / 16) * 64, 0, tile);
            else if (t < 80) { t -= 64; tcvt_tile(p.dsa_w_iq + (size_t)l * 256 * 256, 256, p.wiq_t + (size_t)l * 256 * 256, 256, (t % 4) * 64, (t / 4) * 64, 0, tile); }
            else { t -= 80; const int h = t / 2, kt = t % 2; tcvt_tile(p.dsa_w_uv + (size_t)(l * 8 + h) * 128 * 64, 64, p.wuv_t + (size_t)(l * 8 + h) * 64 * 128, 128, 0, kt * 64, 0, tile); } }
    } else if constexpr (PART == 3) {
        for (int id = wg; id < NLAYER * 32; id += nwg) { const int l = id / 32; int t = id % 32;
            if (t < 8) tcvt_tile(p.rw_w_w2 + (size_t)l * 64 * 512, 512, p.ww2_t + (size_t)l * 512 * 64, 64, t * 64, 0, 0, tile);
            else if (t < 16) { t -= 8; tcvt_tile(p.rw_w_a2 + (size_t)l * 64 * 512, 512, p.wa2_t + (size_t)l * 512 * 64, 64, t * 64, 0, 0, tile); }
            else { t -= 16; tcvt_tile(p.rw_w_g2 + (size_t)l * 128 * 512, 512, p.wg2_t + (size_t)l * 512 * 128, 128, (t % 8) * 64, (t / 8) * 64, 0, tile); } }
    } else {
        for (int u = wg; u < W_PK_UNITS; u += nwg) {
            const size_t e = (size_t)u * 4096 + (size_t)tid * 8;
            const f32x4 a = *(const f32x4*)(p.peer_keys + e), b = *(const f32x4*)(p.peer_keys + e + 4);
            u32x4 w; w.x = pk_bf16(a[0], a[1]); w.y = pk_bf16(a[2], a[3]); w.z = pk_bf16(b[0], b[1]); w.w = pk_bf16(b[2], b[3]);
            *(u32x4*)(p.pkeys + e) = w;
        }
        bool have = false;
        for (int u = wg; u < W_MOD_UNITS; u += nwg) {
            LASP float* cond = (LASP float*)lds;
            LASP float* red = (LASP float*)(lds + 32768);
            if (!have) { for (int i = tid; i < 8 * 1024; i += NTHR) cond[i] = siluf_(p.c[i]); have = true; }
            __syncthreads();
            const int l = u / 96, cb = u % 96, col = cb * 64 + (tid & 63), ks = tid >> 6;
            float acc[8];
#pragma unroll
            for (int b = 0; b < 8; ++b) acc[b] = 0.f;
            const float* wp = p.w_ada + (size_t)l * 1024 * 6144 + col;
            for (int k = ks * 128; k < ks * 128 + 128; ++k) { const float w = wp[(size_t)k * 6144];
#pragma unroll
                for (int b = 0; b < 8; ++b) acc[b] = fmaf(w, cond[b * 1024 + k], acc[b]); }
#pragma unroll
            for (int b = 0; b < 8; ++b) red[(ks * 8 + b) * 64 + (tid & 63)] = acc[b];
            __syncthreads();
            { const int b = tid >> 6, cc = tid & 63; float s = 0.f;
#pragma unroll
              for (int k2 = 0; k2 < 8; ++k2) s += red[(k2 * 8 + b) * 64 + cc];
              p.mod[((size_t)l * 8 + b) * 6144 + cb * 64 + cc] = s + p.b_ada[(size_t)l * 6144 + cb * 64 + cc]; }
            __syncthreads();
        }
    }
}

__device__ void phase_adaln(const float* x, const float* g, const float* modl  , int sh_off, int sc_off, bf16_t* h, int wg, int nwg) {
    const int lane = threadIdx.x & 63, wave = threadIdx.x >> 6;
    int tok = wg * 8 + wave;
    f32x4 vn[4];
    if (tok < NTOK) { const f32x4* xr = (const f32x4*)(x + (size_t)tok * 1024);
#pragma unroll
        for (int i = 0; i < 4; ++i) vn[i] = xr[lane + 64 * i]; }
    for (; tok < NTOK; tok += nwg * 8) {
        f32x4 v[4]; float ss = 0.f;
#pragma unroll
        for (int i = 0; i < 4; ++i) { v[i] = vn[i]; ss += v[i][0] * v[i][0] + v[i][1] * v[i][1] + v[i][2] * v[i][2] + v[i][3] * v[i][3]; }
        if (tok + nwg * 8 < NTOK) { const f32x4* xr = (const f32x4*)(x + (size_t)(tok + nwg * 8) * 1024);
#pragma unroll
            for (int i = 0; i < 4; ++i) vn[i] = xr[lane + 64 * i]; }
        ss = wave_sum(ss);
        const float rstd = rsqrtf(ss * (1.0f / 1024.0f) + 1e-6f);
        const float* mb = modl + (size_t)(tok >> 13) * 6144;
#pragma unroll
        for (int i = 0; i < 4; ++i) { const int col = 4 * (lane + 64 * i);
            const f32x4 gg = *(const f32x4*)(g + col), sc = *(const f32x4*)(mb + sc_off + col), sh = *(const f32x4*)(mb + sh_off + col);
            f32x4 o = (v[i] * rstd) * gg; o = o * (sc + 1.0f) + sh;
            u32x2 w; w.x = pk_bf16(o[0], o[1]); w.y = pk_bf16(o[2], o[3]);
            *(u32x2*)(h + (size_t)tok * 1024 + col) = w; }
    }
}
__device__ void phase_final(float* x, const float* g, int wg, int nwg) {
    const int lane = threadIdx.x & 63, wave = threadIdx.x >> 6;
    for (int tok = wg * 8 + wave; tok < NTOK; tok += nwg * 8) {
        f32x4* xr = (f32x4*)(x + (size_t)tok * 1024);
        f32x4 v[4]; float ss = 0.f;
#pragma unroll
        for (int i = 0; i < 4; ++i) { v[i] = xr[lane + 64 * i]; ss += v[i][0] * v[i][0] + v[i][1] * v[i][1] + v[i][2] * v[i][2] + v[i][3] * v[i][3]; }
        ss = wave_sum(ss);
        const float rstd = rsqrtf(ss * (1.0f / 1024.0f) + 1e-6f);
#pragma unroll
        for (int i = 0; i < 4; ++i) { const f32x4 gg = *(const f32x4*)(g + 4 * (lane + 64 * i)); xr[lane + 64 * i] = (v[i] * rstd) * gg; }
    }
}

__device__ void phase_gla1(const Params& p, int l, LASP unsigned char* lds, int wg, int nwg) {
    LASP float* alr = (LASP float*)lds;
    LASP float* part = (LASP float*)(lds + 4096);
    LASP bf16_t* kdT = (LASP bf16_t*)(lds + 8192);
    LASP bf16_t* vT = (LASP bf16_t*)(lds + 8192 + 9216);
    const int tid = threadIdx.x, lane = tid & 63, wave = tid >> 6;
    const int k = tid & 63, tq = tid >> 6;
    constexpr int NU = NB * NCHUNK * 4;
    bf16_t alr_n[2], gk_n[8]; u32x4 va_n, vb_n;
    auto ldu = [&](int u) { const int h = u & 3, c = (u >> 2) & 127, b = u >> 9; const size_t t0 = (size_t)b * SEQ + (size_t)c * 64;
#pragma unroll
        for (int j = 0; j < 2; ++j) { const int i = tid + j * NTHR; alr_n[j] = p.PB[(t0 + (i >> 4)) * PB_LD + PB_GALR + (i & 15)]; }
        { const int t = tid >> 3, vq = tid & 7; const bf16_t* vp = p.GV + (t0 + t) * 512 + h * 128 + vq * 16; va_n = *(const u32x4*)vp; vb_n = *(const u32x4*)(vp + 8); }
#pragma unroll
        for (int i = 0; i < 8; ++i) gk_n[i] = p.GK[(t0 + tq * 8 + i) * 256 + h * 64 + k]; };
    float wa[16]; float ba = 0.f; int hcur = -1;
#pragma unroll
    for (int r = 0; r < 16; ++r) wa[r] = 0.f;
    if (wg < NU) ldu(wg);
    for (int u = wg; u < NU; u += nwg) {
        const int h = u & 3;
        bf16_t alr_c[2], gk_c[8];
#pragma unroll
        for (int j = 0; j < 2; ++j) alr_c[j] = alr_n[j];
#pragma unroll
        for (int i = 0; i < 8; ++i) gk_c[i] = gk_n[i];
        const u32x4 a = va_n, bq = vb_n;
        if (h != hcur) { hcur = h;
#pragma unroll
            for (int r = 0; r < 16; ++r) wa[r] = p.gla_w_a2[((size_t)l * 16 + r) * 256 + h * 64 + k];
            ba = p.gla_b_a[(size_t)l * 256 + h * 64 + k]; }
        ldu(u + nwg < NU ? u + nwg : u);
#pragma unroll
        for (int j = 0; j < 2; ++j) alr[tid + j * NTHR] = bf2f(alr_c[j]);
        { const int t = tid >> 3, vq = tid & 7;
          const unsigned w[8] = {a.x, a.y, a.z, a.w, bq.x, bq.y, bq.z, bq.w};
#pragma unroll
          for (int j = 0; j < 8; ++j) { vT[(vq * 16 + 2 * j) * 72 + t] = (bf16_t)(w[j] & 0xffffu); vT[(vq * 16 + 2 * j + 1) * 72 + t] = (bf16_t)(w[j] >> 16); } }
        __syncthreads();
        float cum[8]; float run = 0.f;
#pragma unroll
        for (int i = 0; i < 8; ++i) { const int t = tq * 8 + i; float g = ba;
#pragma unroll
            for (int r = 0; r < 16; ++r) g = fmaf(alr[t * 16 + r], wa[r], g);
            const float ls = fminf(g, 0.f) - log1pf(__expf(-fabsf(g)));
            run += ls * (1.0f / 16.0f); cum[i] = run; }
        part[tq * 64 + k] = run;
        __syncthreads();
        float off = 0.f, tot = 0.f;
#pragma unroll
        for (int q = 0; q < 8; ++q) { const float v = part[q * 64 + k]; tot += v; if (q < tq) off += v; }
#pragma unroll
        for (int i = 0; i < 8; ++i) { const int t = tq * 8 + i; const float kv = bf2f(gk_c[i]);
            kdT[k * 72 + t] = f2bf(kv * __expf(tot - (off + cum[i]))); }
        if (tq == 0) p.gdec[(size_t)u * 64 + k] = __expf(tot);
        __syncthreads();
        { const int fr = lane & 15, fq = lane >> 4;
          bf16x8 bfr[2];
#pragma unroll
          for (int ks = 0; ks < 2; ++ks) bfr[ks] = *(const LASP bf16x8*)(vT + (wave * 16 + fr) * 72 + ks * 32 + fq * 8);
          bf16_t* gs = p.GS + (size_t)u * 8192 + (size_t)(wave * 16 + fr) * 64;
#pragma unroll
          for (int mt = 0; mt < 4; ++mt) { f32x4 acc = {0.f, 0.f, 0.f, 0.f};
#pragma unroll
              for (int ks = 0; ks < 2; ++ks) { const bf16x8 afr = *(const LASP bf16x8*)(kdT + (mt * 16 + fr) * 72 + ks * 32 + fq * 8); acc = MFMA16(afr, bfr[ks], acc); }
              u32x2 w; w.x = pk_bf16(acc[0], acc[1]); w.y = pk_bf16(acc[2], acc[3]);
              *(u32x2*)(gs + mt * 16 + fq * 4) = w; } }
        __syncthreads();
    }
}
__device__ void phase_gla2(const Params& p, int wg, int nwg) {
    for (int e = wg * NTHR + threadIdx.x; e < NB * 4 * 128 * 32; e += nwg * NTHR) {
        const int kp = e & 31, v = (e >> 5) & 127, h = (e >> 12) & 3, b = e >> 14;
        float s0 = 0.f, s1 = 0.f;
        for (int c0 = 0; c0 < NCHUNK; c0 += 4) {
            unsigned uv[4]; f32x2 dv[4];
#pragma unroll
            for (int j = 0; j < 4; ++j) { const size_t u = ((size_t)b * NCHUNK + c0 + j) * 4 + h; uv[j] = *(const unsigned*)(p.GS + u * 8192 + v * 64 + 2 * kp); dv[j] = *(const f32x2*)(p.gdec + u * 64 + 2 * kp); }
#pragma unroll
            for (int j = 0; j < 4; ++j) { const size_t u = ((size_t)b * NCHUNK + c0 + j) * 4 + h;
                s0 = fmaf(dv[j][0], s0, bflo(uv[j])); s1 = fmaf(dv[j][1], s1, bfhi(uv[j]));
                *(unsigned*)(p.GS + u * 8192 + v * 64 + 2 * kp) = pk_bf16(s0, s1); }
        }
    }
}
__device__ void phase_gla3(const Params& p, int l, LASP unsigned char* lds, int wg, int nwg) {
    LASP float* ssq = (LASP float*)lds;
    const int tid = threadIdx.x, lane = tid & 63, wave = tid >> 6, fr = lane & 15, fq = lane >> 4;
    const int nt = wave & 3, vh = wave >> 2;
    for (int u = wg; u < NB * NCHUNK * 4; u += nwg) {
        const int h = u & 3, c = (u >> 2) & 127, b = u >> 9; const size_t t0 = (size_t)b * SEQ + (size_t)c * 64;
        bf16x8 bq[2];
#pragma unroll
        for (int ks = 0; ks < 2; ++ks) bq[ks] = ld_frag_g(p.GQ + (t0 + nt * 16 + fr) * 256 + h * 64 + ks * 32 + fq * 8);
        f32x4 acc[4];
#pragma unroll
        for (int mi = 0; mi < 4; ++mi) { acc[mi] = (f32x4){0.f, 0.f, 0.f, 0.f};
#pragma unroll
            for (int ks = 0; ks < 2; ++ks) { const bf16x8 a = ld_frag_g(p.GS + (size_t)u * 8192 + (size_t)((vh * 4 + mi) * 16 + fr) * 64 + ks * 32 + fq * 8); acc[mi] = MFMA16(a, bq[ks], acc[mi]); } }
        float ss = 0.f;
#pragma unroll
        for (int mi = 0; mi < 4; ++mi) ss += acc[mi][0] * acc[mi][0] + acc[mi][1] * acc[mi][1] + acc[mi][2] * acc[mi][2] + acc[mi][3] * acc[mi][3];
        ss += __shfl_xor(ss, 16); ss += __shfl_xor(ss, 32);
        if (fq == 0) ssq[vh * 64 + nt * 16 + fr] = ss;
        __syncthreads();
        const float tot = ssq[nt * 16 + fr] + ssq[64 + nt * 16 + fr];
        const float sc = 0.125f * rsqrtf(tot * (1.0f / 8192.0f) + 1e-6f);
        const size_t trow = t0 + nt * 16 + fr;
#pragma unroll
        for (int mi = 0; mi < 4; ++mi) { const int v0 = (vh * 4 + mi) * 16 + fq * 4;
            const u32x2 rr = *(const u32x2*)(p.GR + trow * 512 + h * 128 + v0);
            const f32x4 go = *(const f32x4*)(p.gla_g_o + (size_t)l * 128 + v0);
            const float o0 = acc[mi][0] * sc * go[0] * siluf_(bflo(rr.x)), o1 = acc[mi][1] * sc * go[1] * siluf_(bfhi(rr.x));
            const float o2 = acc[mi][2] * sc * go[2] * siluf_(bflo(rr.y)), o3 = acc[mi][3] * sc * go[3] * siluf_(bfhi(rr.y));
            u32x2 w; w.x = pk_bf16(o0, o1); w.y = pk_bf16(o2, o3);
            *(u32x2*)(p.ya + trow * 512 + h * 128 + v0) = w; }
        __syncthreads();
    }
}

#ifndef DSA_FORCE_SLOW
#define DSA_FORCE_SLOW 0
#endif
#ifndef DBG_DOUBLE
#define DBG_DOUBLE 0
#endif
#ifndef DBG_DSA_SCALE
#define DBG_DSA_SCALE 1.0f
#endif
__device__ void phase_dsa1(const Params& p, int l, int wg, int nwg) {
    const int lane = threadIdx.x & 63, wave = threadIdx.x >> 6;
    for (int tok = wg * 8 + wave; tok < NTOK; tok += nwg * 8) {
        const bf16_t* row = p.PB + (size_t)tok * PB_LD;
        const u32x2 q = *(const u32x2*)(row + PB_QC + 4 * lane);
        const unsigned kv = *(const unsigned*)(row + PB_KVC + 2 * lane);
        const float q0 = bflo(q.x), q1 = bfhi(q.x), q2 = bflo(q.y), q3 = bfhi(q.y), k0 = bflo(kv), k1 = bfhi(kv);
        const float sq = wave_sum(q0 * q0 + q1 * q1 + q2 * q2 + q3 * q3), sk = wave_sum(k0 * k0 + k1 * k1);
        const float rq = rsqrtf(sq * (1.0f / 256.0f) + 1e-6f), rk = rsqrtf(sk * (1.0f / 128.0f) + 1e-6f);
        const f32x4 gq = *(const f32x4*)(p.dsa_g_qc + (size_t)l * 256 + 4 * lane); const f32x2 gk = *(const f32x2*)(p.dsa_g_kv + (size_t)l * 128 + 2 * lane);
        u32x2 w; w.x = pk_bf16(q0 * rq * gq[0], q1 * rq * gq[1]); w.y = pk_bf16(q2 * rq * gq[2], q3 * rq * gq[3]);
        *(u32x2*)(p.qn + (size_t)tok * 256 + 4 * lane) = w;
        *(unsigned*)(p.kvn + (size_t)tok * 128 + 2 * lane) = pk_bf16(k0 * rk * gk[0], k1 * rk * gk[1]);
    }
}

constexpr int D_HIST = 0, D_CIDX = 65536, D_WH = 98304, D_MSK = 131072, D_SEL = 147456, D_CTL = 155648, D_OT = 106496, D_OT_LD = 1032, DSA_CAP = 1024;
__device__ __forceinline__ unsigned lds_add(LASP unsigned* p, unsigned v) { return __hip_atomic_fetch_add(p, v, __ATOMIC_RELAXED, __HIP_MEMORY_SCOPE_WORKGROUP); }
__device__ __forceinline__ void lds_or(LASP unsigned* p, unsigned v) { (void)__hip_atomic_fetch_or(p, v, __ATOMIC_RELAXED, __HIP_MEMORY_SCOPE_WORKGROUP); }
struct DsaQ { bf16x8 qa[4][2]; f32x2 w01[4], w23[4]; };

__device__ __forceinline__ void dsa_score(const DsaQ& Q, const bf16x8& kb0, const bf16x8& kb1, float (&sc)[4]) {
    f32x2 s01 = {0.f, 0.f}, s23 = {0.f, 0.f};
#pragma unroll
    for (int hh = 0; hh < 4; ++hh) { f32x4 d = {0.f, 0.f, 0.f, 0.f}; d = MFMA16(Q.qa[hh][0], kb0, d); d = MFMA16(Q.qa[hh][1], kb1, d);
#pragma unroll
        for (int r = 0; r < 4; ++r) d[r] = __int_as_float(max(__float_as_int(d[r]), 0));
        const f32x2 d01 = {d[0], d[1]}, d23 = {d[2], d[3]};
        s01 = __builtin_elementwise_fma(Q.w01[hh], d01, s01); s23 = __builtin_elementwise_fma(Q.w23[hh], d23, s23); }
    sc[0] = s01[0]; sc[1] = s01[1]; sc[2] = s23[0]; sc[3] = s23[1];
}
__device__ __forceinline__ unsigned dkey(float f) { const unsigned u = __float_as_uint(f); return u ^ ((unsigned)((int)u >> 31) | 0x80000000u); }
__device__ __forceinline__ unsigned dbin(float f) { const unsigned u = __float_as_uint(f); const unsigned m = (unsigned)((int)u >> 31); return (u >> 21) ^ ((m & 0x3ffu) | 0x400u); }
template <class F> __device__ __forceinline__ void dsa_tiles(const bf16_t* ik0, int ntile, int wave, int fr, int fq, F&& f) {
    const bf16_t* base = ik0 + (size_t)fr * PB_LD + fq * 8;
    bf16x8 a0 = {0, 0, 0, 0, 0, 0, 0, 0}, a1 = a0, b0 = a0, b1 = a0;
    int kt = wave;
    if (kt < ntile) { const bf16_t* kp = base + (size_t)kt * 16 * PB_LD; a0 = ld_frag_g(kp); a1 = ld_frag_g(kp + 32); }
    if (kt + 8 < ntile) { const bf16_t* kp = base + (size_t)(kt + 8) * 16 * PB_LD; b0 = ld_frag_g(kp); b1 = ld_frag_g(kp + 32); }
    for (; kt < ntile; kt += 16) {
        { const bf16x8 c0 = a0, c1 = a1;
          if (kt + 16 < ntile) { const bf16_t* kp = base + (size_t)(kt + 16) * 16 * PB_LD; a0 = ld_frag_g(kp); a1 = ld_frag_g(kp + 32); }
          f(kt, c0, c1); }
        if (kt + 8 < ntile) { const bf16x8 c0 = b0, c1 = b1;
          if (kt + 24 < ntile) { const bf16_t* kp = base + (size_t)(kt + 24) * 16 * PB_LD; b0 = ld_frag_g(kp); b1 = ld_frag_g(kp + 32); }
          f(kt + 8, c0, c1); }
    }
}
__device__ __forceinline__ void wave_find_bin(const LASP unsigned* hist, unsigned need, int lane, unsigned& bin_out, unsigned& above_out, unsigned& inbin_out) {
    unsigned loc = 0;
#pragma unroll
    for (int j = 0; j < 4; ++j) { const u32x4 w4 = *(const LASP u32x4*)(hist + 1008 - 16 * lane + 4 * j);
        loc += (w4.x & 0xffffu) + (w4.x >> 16) + (w4.y & 0xffffu) + (w4.y >> 16) + (w4.z & 0xffffu) + (w4.z >> 16) + (w4.w & 0xffffu) + (w4.w >> 16); }
    const unsigned incl = wave_scan_incl(loc);
    const unsigned excl = incl - loc;
    const bool mine = (excl < need) && (incl >= need);
    const unsigned long long m = __ballot(mine);
    const int L = m ? (int)__builtin_ctzll(m) : 63;
    const unsigned base = (unsigned)__builtin_amdgcn_readlane((int)excl, L);
    unsigned c2 = 0; const unsigned bin = 2047u - 32u * (unsigned)L - (unsigned)(lane & 31);
    { const unsigned w = hist[bin >> 1]; c2 = (bin & 1u) ? (w >> 16) : (w & 0xffffu); if (lane >= 32) c2 = 0; }
    const unsigned inc2 = wave_scan_incl(c2);
    const unsigned ex2 = inc2 - c2;
    const bool mine2 = (lane < 32) && (base + ex2 < need) && (base + inc2 >= need);
    const unsigned long long m2 = __ballot(mine2);
    const int L2 = m2 ? (int)__builtin_ctzll(m2) : 31;
    bin_out = 2047u - 32u * (unsigned)L - (unsigned)L2;
    above_out = base + (unsigned)__builtin_amdgcn_readlane((int)ex2, L2);
    inbin_out = (unsigned)__builtin_amdgcn_readlane((int)c2, L2);
}

#define DSA_UNIT_SETUP \
    LASP unsigned* hist = (LASP unsigned*)(lds + D_HIST); \
    LASP unsigned short* sel = (LASP unsigned short*)(lds + D_SEL); \
    LASP bf16_t* Ot = (LASP bf16_t*)(lds + D_OT); \
    LASP unsigned* ctl = (LASP unsigned*)(lds + D_CTL); \
    const int tid = threadIdx.x, lane = tid & 63, wave = tid >> 6, fr = lane & 15, fq = lane >> 4; \
    const int uw = pos & 255, uk = pos >> 8, ur = uw >> 3; const int uix = (uk & 1) ? 32 * uk + 31 - ur : 32 * uk + ur; \
    const int sub = uix & 3, b = uw & 7, c = 127 - (uix >> 2); \
    const int n = 64 * (c + 1); const size_t krow0 = (size_t)b * SEQ; const size_t t0 = krow0 + (size_t)c * 64 + sub * 16; \
    (void)0;
__device__ __forceinline__ void dsa_select_unit(const Params& p, int l, LASP unsigned char* lds, int pos) {
    DSA_UNIT_SETUP
    (void)Ot; (void)l;
    if (tid < 128) ctl[tid] = 0u;
    if (n <= 256) {
        for (int i = tid; i < 16 * 256; i += NTHR) sel[i] = (unsigned short)(i & 255);
        __syncthreads();
        if (tid < 16) ctl[tid] = (unsigned)n;
        __syncthreads();
        return;
    }
    LASP unsigned* ckey = (LASP unsigned*)(lds + D_HIST);
    LASP unsigned short* cidx = (LASP unsigned short*)(lds + D_CIDX);
    LASP unsigned short* msk = (LASP unsigned short*)(lds + D_MSK);
    DsaQ Q;
#pragma unroll
    for (int hh = 0; hh < 4; ++hh)
#pragma unroll
        for (int ks = 0; ks < 2; ++ks) Q.qa[hh][ks] = ld_frag_g(p.qi + (t0 + fr) * 256 + hh * 64 + ks * 32 + fq * 8);
    { u32x2 w[4];
#pragma unroll
      for (int r = 0; r < 4; ++r) w[r] = *(const u32x2*)(p.PB + (t0 + fq * 4 + r) * PB_LD + PB_IW);
      Q.w01[0] = (f32x2){bflo(w[0].x), bflo(w[1].x)}; Q.w01[1] = (f32x2){bfhi(w[0].x), bfhi(w[1].x)}; Q.w01[2] = (f32x2){bflo(w[0].y), bflo(w[1].y)}; Q.w01[3] = (f32x2){bfhi(w[0].y), bfhi(w[1].y)};
      Q.w23[0] = (f32x2){bflo(w[2].x), bflo(w[3].x)}; Q.w23[1] = (f32x2){bfhi(w[2].x), bfhi(w[3].x)}; Q.w23[2] = (f32x2){bflo(w[2].y), bflo(w[3].y)}; Q.w23[3] = (f32x2){bfhi(w[2].y), bfhi(w[3].y)}; }
    const bf16_t* ik0 = p.PB + krow0 * PB_LD + PB_IK;
    const int ntile = n >> 4;
    { const u32x4 z4 = {0u, 0u, 0u, 0u};
      for (int i = tid; i < 16 * 1024 / 4; i += NTHR) ((LASP u32x4*)hist)[i] = z4;
      for (int i = tid; i < 16 * 512 * 2 / 16; i += NTHR) ((LASP u32x4*)msk)[i] = z4; }
    __syncthreads();
    dsa_tiles(ik0, ntile, wave, fr, fq, [&](int, const bf16x8& kb0, const bf16x8& kb1) {
        float sc[4]; dsa_score(Q, kb0, kb1, sc);
#pragma unroll
        for (int r = 0; r < 4; ++r) { const unsigned key = dkey(sc[r]); lds_add(&hist[(fq * 4 + r) * 1024 + ((key >> 22) & 0x3ffu)], 1u + ((key >> 21) & 1u) * 65535u); } });
#if DBG_DOUBLE & 512
    { LASP unsigned* h2 = (LASP unsigned*)(lds + D_WH);
      dsa_tiles(ik0, ntile, wave, fr, fq, [&](int, const bf16x8& kb0, const bf16x8& kb1) {
        float sc[4]; dsa_score(Q, kb0, kb1, sc);
#pragma unroll
        for (int r = 0; r < 4; ++r) { const unsigned bin = dbin(sc[r]); lds_add(&h2[((fq * 4 + r) & 7) * 1024 + (bin >> 1)], (bin & 1u) ? 65536u : 1u); } }); }
#endif
#if DBG_DOUBLE & 1024
    { float accs = 0.f;
      dsa_tiles(ik0, ntile, wave, fr, fq, [&](int, const bf16x8& kb0, const bf16x8& kb1) {
        float sc[4]; dsa_score(Q, kb0, kb1, sc); accs += sc[0] + sc[1] + sc[2] + sc[3]; });
      if (accs == 123.456f) ctl[120] = 1u; }
#endif
    __syncthreads();
#pragma unroll
    for (int qi2 = 0; qi2 < 2; ++qi2) { const int q = wave * 2 + qi2;
        unsigned bin, above, inbin; wave_find_bin(hist + q * 1024, 256u, lane, bin, above, inbin);
        if (lane == 0) { ctl[16 + q] = bin; ctl[32 + q] = 256u - above; if (inbin > (unsigned)DSA_CAP || DSA_FORCE_SLOW) ctl[97] = 1u; } }
    __syncthreads();
    if (!ctl[97]) {
        float elo[4], ehi[4];
#pragma unroll
        for (int r = 0; r < 4; ++r) { const unsigned tb = ctl[16 + fq * 4 + r]; elo[r] = fkey_inv(tb << 21); ehi[r] = tb >= 2047u ? INFINITY : fkey_inv((tb + 1u) << 21); }
        dsa_tiles(ik0, ntile, wave, fr, fq, [&](int kt, const bf16x8& kb0, const bf16x8& kb1) {
            float sc[4]; dsa_score(Q, kb0, kb1, sc);
            unsigned pc[4]; bool cand[4]; unsigned long long tm[4];
#pragma unroll
            for (int r = 0; r < 4; ++r) { const bool above = sc[r] >= ehi[r];
                tm[r] = __ballot(above);
                cand[r] = (sc[r] >= elo[r]) && !above; }
            if ((tm[0] | tm[1] | tm[2] | tm[3]) != 0ull) {
#pragma unroll
                for (int r = 0; r < 4; ++r) if (fr == 0) msk[(fq * 4 + r) * 512 + kt] = (unsigned short)((tm[r] >> (16 * fq)) & 0xffffull); }
            if (__ballot(cand[0] || cand[1] || cand[2] || cand[3]) != 0ull) {
#pragma unroll
                for (int r = 0; r < 4; ++r) pc[r] = cand[r] ? lds_add(&ctl[112 + fq * 4 + r], 1u) : 0xffffffffu;
#pragma unroll
                for (int r = 0; r < 4; ++r) if (cand[r] && pc[r] < (unsigned)DSA_CAP) { const int q = fq * 4 + r; ckey[q * DSA_CAP + pc[r]] = dkey(sc[r]); cidx[q * DSA_CAP + pc[r]] = (unsigned short)(kt * 16 + fr); } } });
        __syncthreads();
        LASP unsigned* wh = (LASP unsigned*)(lds + D_WH) + wave * 1024;
#if DBG_DOUBLE & 65536
        for (int rep_ = 0; rep_ < 2; ++rep_)
#endif
#pragma unroll 1
        for (int qi2 = 0; qi2 < 2; ++qi2) { const int q = wave * 2 + qi2;
            unsigned m = ctl[112 + q]; m = m > (unsigned)DSA_CAP ? (unsigned)DSA_CAP : m; unsigned need = ctl[32 + q];
            const LASP unsigned* ck = ckey + q * DSA_CAP; const LASP unsigned short* ci = cidx + q * DSA_CAP;
            unsigned pmask = 0u, pval = 0u, inb = 0u;
#pragma unroll 1
            for (int lvl = 0; lvl < 2; ++lvl) { const unsigned shift = lvl == 0 ? 10u : 0u, nbm = lvl == 0 ? 0x7ffu : 0x3ffu;
#pragma unroll
                for (int k = 0; k < 4; ++k) ((LASP u32x4*)wh)[lane + 64 * k] = (u32x4){0u, 0u, 0u, 0u};
                for (unsigned i = lane; i < m; i += 64) { const unsigned key = ck[i]; if ((key & pmask) == pval) { const unsigned bin = (key >> shift) & nbm; lds_add(&wh[bin >> 1], (bin & 1u) ? 65536u : 1u); } }
                unsigned bin, above; wave_find_bin(wh, need, lane, bin, above, inb);
                pval |= bin << shift; pmask |= nbm << shift; need -= above; }
            unsigned sthr = 0xffffu;
            if (need < inb) {
#pragma unroll
                for (int k = 0; k < 4; ++k) ((LASP u32x4*)wh)[lane + 64 * k] = (u32x4){0u, 0u, 0u, 0u};
                for (unsigned i = lane; i < m; i += 64) { if ((ck[i] & 0x1fffffu) == pval) { const unsigned bin = 2047u - ((unsigned)ci[i] >> 2); lds_add(&wh[bin >> 1], (bin & 1u) ? 65536u : 1u); } }
                unsigned binC, aboveC, inC; wave_find_bin(wh, need, lane, binC, aboveC, inC);
                const unsigned needC = need - aboveC;
#pragma unroll
                for (int k = 0; k < 4; ++k) ((LASP u32x4*)wh)[lane + 64 * k] = (u32x4){0u, 0u, 0u, 0u};
                for (unsigned i = lane; i < m; i += 64) { const unsigned s = ci[i]; if ((ck[i] & 0x1fffffu) == pval && (2047u - (s >> 2)) == binC) { const unsigned bin = 2047u - (s & 3u); lds_add(&wh[bin >> 1], (bin & 1u) ? 65536u : 1u); } }
                unsigned binD, aboveD, inD; wave_find_bin(wh, needC, lane, binD, aboveD, inD);
                sthr = ((2047u - binC) << 2) | (2047u - binD);
            }
            for (unsigned i = lane; i < m; i += 64) { const unsigned k21 = ck[i] & 0x1fffffu, si = ci[i];
                if (k21 > pval || (k21 == pval && si <= sthr)) { const unsigned widx = (unsigned)q * 512u + (si >> 4); lds_or((LASP unsigned*)msk + (widx >> 1), 1u << (16u * (widx & 1u) + (si & 15u))); } } }
        __syncthreads();
    } else {
        for (int pass = 1; pass < 3; ++pass) {
            for (int i = tid; i < 16 * 1024; i += NTHR) hist[i] = 0u;
            __syncthreads();
            dsa_tiles(ik0, ntile, wave, fr, fq, [&](int, const bf16x8& kb0, const bf16x8& kb1) {
                float sc[4]; dsa_score(Q, kb0, kb1, sc);
#pragma unroll
                for (int r = 0; r < 4; ++r) { const int q = fq * 4 + r; const unsigned key = dkey(sc[r]); unsigned bin; bool on;
                    if (pass == 1) { bin = (key >> 10) & 0x7ffu; on = (key >> 21) == ctl[16 + q]; }
                    else { bin = key & 0x3ffu; on = (key >> 10) == ctl[16 + q]; }
                    if (on) lds_add(&hist[q * 1024 + (bin >> 1)], (bin & 1u) ? 65536u : 1u); } });
            __syncthreads();
#pragma unroll
            for (int qi2 = 0; qi2 < 2; ++qi2) { const int q = wave * 2 + qi2;
                const unsigned need = ctl[32 + q];
                unsigned bin, above, inbin; wave_find_bin(hist + q * 1024, need, lane, bin, above, inbin);
                if (lane == 0) { const unsigned pre = ctl[16 + q];
                    ctl[16 + q] = pass == 1 ? ((pre << 11) | bin) : ((pre << 10) | bin);
                    ctl[32 + q] = need - above;
                    if (pass == 2) { const unsigned fl = (need - above < inbin) ? 1u : 0u; ctl[48 + q] = fl; if (fl) ctl[96] = 1u; } } }
            __syncthreads();
        }
        if (ctl[96]) {
            for (int i = tid; i < 16 * 1024; i += NTHR) hist[i] = 0u;
            __syncthreads();
            dsa_tiles(ik0, ntile, wave, fr, fq, [&](int kt, const bf16x8& kb0, const bf16x8& kb1) {
                float sc[4]; dsa_score(Q, kb0, kb1, sc);
#pragma unroll
                for (int r = 0; r < 4; ++r) { const int q = fq * 4 + r; const unsigned key = dkey(sc[r]);
                    if (ctl[48 + q] && key == ctl[16 + q]) { const unsigned s = (unsigned)(kt * 16 + fr); const unsigned bin = 2047u - (s >> 2); lds_add(&hist[q * 1024 + (bin >> 1)], (bin & 1u) ? 65536u : 1u); } } });
            __syncthreads();
#pragma unroll
            for (int qi2 = 0; qi2 < 2; ++qi2) { const int q = wave * 2 + qi2;
                if (ctl[48 + q]) { unsigned bin, above, inbin; wave_find_bin(hist + q * 1024, ctl[32 + q], lane, bin, above, inbin);
                    if (lane == 0) { ctl[64 + q] = bin; ctl[80 + q] = ctl[32 + q] - above; } } }
            __syncthreads();
        }
        dsa_tiles(ik0, ntile, wave, fr, fq, [&](int kt, const bf16x8& kb0, const bf16x8& kb1) {
            float sc[4]; dsa_score(Q, kb0, kb1, sc);
#pragma unroll
            for (int r = 0; r < 4; ++r) { const int q = fq * 4 + r; const unsigned key = dkey(sc[r]); const unsigned thr = ctl[16 + q];
                const unsigned s = (unsigned)(kt * 16 + fr);
                bool take = key > thr; const bool eq = key == thr; const bool fl = ctl[48 + q] != 0u;
                if (!fl) take = take || eq;
                const unsigned ibin = 2047u - (s >> 2), tb = ctl[64 + q];
                const bool eqb = eq && fl && (ibin == tb);
                const unsigned long long em = __ballot(eqb);
                if (eq && fl) {
                    if (ibin > tb) take = true;
                    else if (ibin == tb) { const unsigned long long low = em & (((1ull << lane) - 1ull) & ~((1ull << (lane & ~3)) - 1ull)); take = (unsigned)__popcll(low) < ctl[80 + q]; } }
                const unsigned long long tm = __ballot(take);
                if (fr == 0) msk[q * 512 + kt] = (unsigned short)((tm >> (16 * fq)) & 0xffffull); } });
        __syncthreads();
    }
#if DBG_DOUBLE & 131072
    for (int rep_ = 0; rep_ < 2; ++rep_)
#endif
#pragma unroll 1
    for (int qi2 = 0; qi2 < 2; ++qi2) { const int q = wave * 2 + qi2;
        LASP unsigned* pre = (LASP unsigned*)(lds + D_WH) + wave * 1024;
        const LASP unsigned* mskw = (const LASP unsigned*)msk + q * 256;
        const u32x4 mw = *(const LASP u32x4*)(mskw + lane * 4);
        const unsigned c0 = (unsigned)__popc(mw.x), c1 = (unsigned)__popc(mw.y), c2 = (unsigned)__popc(mw.z), c3 = (unsigned)__popc(mw.w), c8 = c0 + c1 + c2 + c3;
        const unsigned incl = wave_scan_incl(c8), base = incl - c8;
        { u32x4 pv; pv.x = base + c0; pv.y = pv.x + c1; pv.z = pv.y + c2; pv.w = incl; *(LASP u32x4*)(pre + lane * 4) = pv; }
        asm volatile("s_waitcnt lgkmcnt(0)" ::: "memory");
        const unsigned total = (unsigned)__builtin_amdgcn_readlane((int)incl, 63);
#pragma unroll
        for (int i = 0; i < 4; ++i) { const unsigned j = (unsigned)lane + 64u * i;
            unsigned w = 0;
#pragma unroll
            for (unsigned step = 128; step >= 1; step >>= 1) { const unsigned pvw = pre[w + step - 1]; w += pvw <= j ? step : 0u; }
            if (j < total) {
                unsigned r = j - (w ? pre[w - 1] : 0u), x = mskw[w], pos = 0;
                { const unsigned t = (unsigned)__popc(x & 0xffffu); const bool up = r >= t; pos += up ? 16u : 0u; r -= up ? t : 0u; x = up ? x >> 16 : x; }
                { const unsigned t = (unsigned)__popc(x & 0xffu); const bool up = r >= t; pos += up ? 8u : 0u; r -= up ? t : 0u; x = up ? x >> 8 : x; }
                { const unsigned t = (unsigned)__popc(x & 0xfu); const bool up = r >= t; pos += up ? 4u : 0u; r -= up ? t : 0u; x = up ? x >> 4 : x; }
                { const unsigned t = (unsigned)__popc(x & 0x3u); const bool up = r >= t; pos += up ? 2u : 0u; r -= up ? t : 0u; x = up ? x >> 2 : x; }
                pos += (r >= (x & 1u)) ? 1u : 0u;
                sel[q * 256 + j] = (unsigned short)(w * 32u + pos); } }
        if (lane == 63) ctl[q] = incl > 256u ? 256u : incl; }
    __syncthreads();
}
constexpr int DA_WAVE = 13312, DA_PB = 8192, DA_PLD = 40, DA_QA = 8832;
typedef short v4s_t __attribute__((ext_vector_type(4)));
__device__ __forceinline__ unsigned da_off(unsigned row, unsigned ch) { return 256u * row + 16u * (ch ^ (((row & 3u) << 2) | ((row >> 2) & 3u))); }
__device__ __forceinline__ void dsa_attend_query(const Params& p, int l, LASP unsigned char* lds, int pos) {
    DSA_UNIT_SETUP
    (void)hist; (void)n; (void)c; (void)sub;
    LASP unsigned char* img = lds + wave * DA_WAVE;
    LASP bf16_t* Pb = (LASP bf16_t*)(img + DA_PB);
    const unsigned ufr = (unsigned)fr, ufq = (unsigned)fq;
    const unsigned wbase = 2048u * ufq + 16u * (ufr ^ ((ufq & 1u) << 1));
    const unsigned lbase = 256u * ufr + 16u * (ufq ^ (((ufr & 3u) << 2) | ((ufr >> 2) & 3u)));
    const unsigned pbase = 256u * (8u * ufq + (ufr >> 2)) + 16u * (((ufr & 3u) >> 1) ^ (((ufr >> 2) << 2) | ((ufq & 1u) << 1))) + 8u * (ufr & 1u);
    u32x4 rw[8];
    const char* kvb = (const char*)(p.kvn + krow0 * 128);
    auto gather = [&](int qq, int ch) {
        const u32x4 iw = *(const LASP u32x4*)(sel + qq * 256 + ch * 32 + fq * 8);
        const unsigned iv[4] = {iw.x, iw.y, iw.z, iw.w};
#pragma unroll
        for (int i = 0; i < 8; ++i) { const unsigned idx = ((i & 1) ? (iv[i >> 1] >> 16) : iv[i >> 1]) & 0x1fffu;
            rw[i] = *(const u32x4*)(kvb + ((idx << 8) | (ufr << 4))); } };
    bf16x8 qf[4];
    auto ldq = [&](int qq) {
#pragma unroll
        for (int ks = 0; ks < 4; ++ks) qf[ks] = ld_frag_g(p.qd + (t0 + qq) * 1024 + (fr & 7) * 128 + ks * 32 + fq * 8); };
    ldq(wave * 2); gather(wave * 2, 0);
#pragma unroll 1
    for (int qi2 = 0; qi2 < 2; ++qi2) {
        const int q = wave * 2 + qi2;
        unsigned cnt = (unsigned)__builtin_amdgcn_readfirstlane((int)ctl[q]); cnt = cnt > 256u ? 256u : cnt;
        const int nch = (int)(cnt >> 5);
#pragma unroll
        for (int ks = 0; ks < 4; ++ks) *(LASP bf16x8*)(img + DA_QA + ks * 1024 + lane * 16) = qf[ks];
        float mrun[4] = {-INFINITY, -INFINITY, -INFINITY, -INFINITY}, lrun[4] = {0.f, 0.f, 0.f, 0.f};
        f32x4 oacc[8];
#pragma unroll
        for (int cc = 0; cc < 8; ++cc) oacc[cc] = (f32x4){0.f, 0.f, 0.f, 0.f};
#pragma unroll 1
        for (int ch = 0; ch < nch; ++ch) {
            unsigned wb = wbase, lb = lbase, pb = pbase; asm volatile("" : "+v"(wb), "+v"(lb), "+v"(pb));
#pragma unroll
            for (int i = 0; i < 8; ++i) { const unsigned ci = (unsigned)(((i & 3) << 2) | (i >> 2)); *(LASP u32x4*)(img + ((wb ^ (16u * ci)) + 256u * i)) = rw[i]; }
            { const bool more = ch + 1 < nch; const int qn = more ? q : (wave * 2 + 1), chn = more ? ch + 1 : (qi2 == 0 ? 0 : ch);
              gather(qn, chn);
              if (!more) ldq(wave * 2 + 1); }
            float lg[2][4];
#pragma unroll
            for (int tl = 0; tl < 2; ++tl) { f32x4 dd = {0.f, 0.f, 0.f, 0.f};
#pragma unroll
                for (int ks = 0; ks < 4; ++ks) dd = MFMA16(*(const LASP bf16x8*)(img + DA_QA + ks * 1024 + lane * 16), *(const LASP bf16x8*)(img + ((lb ^ (64u * ks)) + 4096u * tl)), dd);
#pragma unroll
                for (int r = 0; r < 4; ++r) lg[tl][r] = dd[r]; }

            float scv[4], tmx[4], p0[4], p1[4], ps[4];
#pragma unroll
            for (int r = 0; r < 4; ++r) tmx[r] = fmaxf(fmaxf(lg[0][r], lg[1][r]), mrun[r]);
            row16_max_x4(tmx[0], tmx[1], tmx[2], tmx[3]);
            constexpr float ES = 0.08838834764831845f * 1.4426950408889634f;
#pragma unroll
            for (int r = 0; r < 4; ++r) { const float mnew = tmx[r], nm = -mnew * ES;
                scv[r] = __builtin_amdgcn_exp2f(fmaf(mrun[r], ES, nm));
                p0[r] = __builtin_amdgcn_exp2f(fmaf(lg[0][r], ES, nm)); p1[r] = __builtin_amdgcn_exp2f(fmaf(lg[1][r], ES, nm)); ps[r] = p0[r] + p1[r]; mrun[r] = mnew; }
            row16_sum_x4(ps[0], ps[1], ps[2], ps[3]);
            unsigned short pb0[4], pb1[4];
#pragma unroll
            for (int r = 0; r < 4; ++r) { lrun[r] = lrun[r] * scv[r] + ps[r]; pb0[r] = f2bf(p0[r]); pb1[r] = f2bf(p1[r]); }
            if (fq < 2) {
#pragma unroll
                for (int r = 0; r < 4; ++r) { Pb[(fq * 4 + r) * DA_PLD + fr] = pb0[r]; Pb[(fq * 4 + r) * DA_PLD + 16 + fr] = pb1[r]; } }
            const bf16x8 pa = *(const LASP bf16x8*)(Pb + (fr & 7) * DA_PLD + fq * 8);
#pragma unroll
            for (int cc = 0; cc < 8; ++cc) {
                const v4s_t lo = __builtin_amdgcn_ds_read_tr16_b64_v4i16((LASP v4s_t*)(img + (pb ^ (32u * cc))));
                const v4s_t hi = __builtin_amdgcn_ds_read_tr16_b64_v4i16((LASP v4s_t*)(img + (((pb ^ 16u) ^ (32u * cc)) + 1024u)));
                const bf16x8 bv = {lo[0], lo[1], lo[2], lo[3], hi[0], hi[1], hi[2], hi[3]};
                f32x4 a = oacc[cc];
#pragma unroll
                for (int r = 0; r < 4; ++r) a[r] *= scv[r];
                oacc[cc] = MFMA16(pa, bv, a);
            }
        }
        if (fq < 2) {
#pragma unroll
            for (int r = 0; r < 4; ++r) { const float inv = __builtin_amdgcn_rcpf(lrun[r]);
#pragma unroll
                for (int cc = 0; cc < 8; ++cc) Ot[q * D_OT_LD + (fq * 4 + r) * 128 + cc * 16 + fr] = f2bf(oacc[cc][r] * inv); } }
    }
}
__device__ __forceinline__ void dsa_upproj_unit(const Params& p, int l, LASP unsigned char* lds, int pos) {
    DSA_UNIT_SETUP
    (void)hist; (void)n; (void)c; (void)sub; (void)sel; (void)ctl; (void)krow0;
    const bf16_t* wu = p.wuv_t + ((size_t)l * 8 + wave) * 64 * 128;
    bf16x8 wf[4][4];
#pragma unroll
    for (int nt = 0; nt < 4; ++nt)
#pragma unroll
        for (int ks = 0; ks < 4; ++ks) wf[nt][ks] = ld_frag_g(wu + (size_t)(nt * 16 + fr) * 128 + ks * 32 + fq * 8);
    __syncthreads();
    bf16x8 oa[4];
#pragma unroll
    for (int ks = 0; ks < 4; ++ks) oa[ks] = *(const LASP bf16x8*)(Ot + fr * D_OT_LD + wave * 128 + ks * 32 + fq * 8);
#pragma unroll
    for (int nt = 0; nt < 4; ++nt) { f32x4 d = {0.f, 0.f, 0.f, 0.f};
#pragma unroll
        for (int ks = 0; ks < 4; ++ks) d = MFMA16(wf[nt][ks], oa[ks], d);
        u32x2 w; w.x = pk_bf16(DBG_DSA_SCALE * d[0], DBG_DSA_SCALE * d[1]); w.y = pk_bf16(DBG_DSA_SCALE * d[2], DBG_DSA_SCALE * d[3]);
        *(u32x2*)(p.yb + (t0 + fr) * 512 + wave * 64 + nt * 16 + fq * 4) = w; }
    __syncthreads();
}
__device__ void phase_dsa34(const Params& p, int l, LASP unsigned char* lds, int wg, int nwg) {
    for (int pos = wg; pos < 4096; pos += nwg) { dsa_select_unit(p, l, lds, pos); dsa_attend_query(p, l, lds, pos); dsa_upproj_unit(p, l, lds, pos); }
}

#ifndef DBG_DOUBLE
#define DBG_DOUBLE 0
#endif
constexpr int R_W = 0, R_A = 8192, R_B = 16384, R_K2 = 24576, R_R = 32768, R_V = 40960, R_Y = 43008, R_BUF = 45056;
#ifndef SCAN_PRIO
#define SCAN_PRIO 0
#endif
#ifndef PREP_PRIO
#define PREP_PRIO 0
#endif
constexpr int R_WM = 90112, R_AM = 99328, R_CONST = 108544, R_STG = 110848, R_STG_SZ = 4352;
__device__ __forceinline__ f32x4 lerp4(u32x2 cur, u32x2 prv, f32x4 mu) {
    f32x4 c = {bflo(cur.x), bfhi(cur.x), bflo(cur.y), bfhi(cur.y)}, q = {bflo(prv.x), bfhi(prv.x), bflo(prv.y), bfhi(prv.y)};
    return c + (q - c) * mu;
}
__device__ __forceinline__ void lerp8(const u32x4 cur, const u32x4 prv, const f32x4 m0, const f32x4 m1, f32x4& o0, f32x4& o1) {
    const f32x4 c0 = {bflo(cur.x), bfhi(cur.x), bflo(cur.y), bfhi(cur.y)}, c1 = {bflo(cur.z), bfhi(cur.z), bflo(cur.w), bfhi(cur.w)};
    const f32x4 q0 = {bflo(prv.x), bfhi(prv.x), bflo(prv.y), bfhi(prv.y)}, q1 = {bflo(prv.z), bfhi(prv.z), bflo(prv.w), bfhi(prv.w)};
    o0 = c0 + (q0 - c0) * m0; o1 = c1 + (q1 - c1) * m1;
}
__device__ __forceinline__ float fast_tanh(float x) { return fmaf(-2.0f, __builtin_amdgcn_rcpf(1.0f + __builtin_amdgcn_exp2f(2.8853900817779268f * x)), 1.0f); }
struct RwRaw { u32x4 cr, pr, ck, pk, cw, pw, ca, pa, cv, pv; };
__device__ __forceinline__ void rwkv_scan_setup(const Params& p, int l, LASP unsigned char* lds, int u) {
    const int tid = threadIdx.x, lane = tid & 63, wave = tid >> 6, fr = lane & 15, fq = lane >> 4;
    LASP bf16_t* sWm = (LASP bf16_t*)(lds + R_WM); LASP bf16_t* sAm = (LASP bf16_t*)(lds + R_AM); LASP float* sC = (LASP float*)(lds + R_CONST);
    const int rg = u & 3, h = (u >> 2) & 7, b = u >> 5;
    const size_t row0 = (size_t)b * SEQ;
    (void)tid; (void)lane; (void)wave; (void)fr; (void)fq; (void)sWm; (void)sAm; (void)sC; (void)rg; (void)h; (void)row0; (void)l;
        __syncthreads();
        for (int i = tid; i < 64 * 8; i += NTHR) { const int j = i >> 3, c8 = i & 7;
            *(LASP u32x4*)(sWm + j * 72 + c8 * 8) = *(const u32x4*)(p.ww2_t + ((size_t)l * 512 + h * 64 + j) * 64 + c8 * 8);
            *(LASP u32x4*)(sAm + j * 72 + c8 * 8) = *(const u32x4*)(p.wa2_t + ((size_t)l * 512 + h * 64 + j) * 64 + c8 * 8); }
        { const float* mu = p.rw_mu + (size_t)l * 1792;
          if (tid < 64) { sC[tid] = mu[PC_R + h * 64 + tid]; sC[64 + tid] = mu[PC_K + h * 64 + tid]; sC[128 + tid] = mu[PC_WLR + tid]; sC[192 + tid] = mu[PC_ALR + tid]; }
          if (tid < 16) sC[256 + tid] = mu[PC_V + h * 64 + 16 * rg + tid];
          if (tid < 64) { const size_t o = (size_t)l * 512 + h * 64 + tid; sC[272 + tid] = p.rw_k_k[o]; sC[336 + tid] = p.rw_k_a[o]; sC[400 + tid] = p.rw_w0[o]; sC[464 + tid] = p.rw_a0[o]; } }
        __syncthreads();
}
__device__ __forceinline__ void rwkv_scan_waves(const Params& p, int l, LASP unsigned char* lds, int u) {
    const int tid = threadIdx.x, lane = tid & 63, wave = tid >> 6, fr = lane & 15, fq = lane >> 4;
    LASP bf16_t* sWm = (LASP bf16_t*)(lds + R_WM); LASP bf16_t* sAm = (LASP bf16_t*)(lds + R_AM); LASP float* sC = (LASP float*)(lds + R_CONST);
    const int rg = u & 3, h = (u >> 2) & 7, b = u >> 5;
    const size_t row0 = (size_t)b * SEQ;
    (void)tid; (void)lane; (void)wave; (void)fr; (void)fq; (void)sWm; (void)sAm; (void)sC; (void)rg; (void)h; (void)row0; (void)l;
            __builtin_amdgcn_s_setprio(SCAN_PRIO);
            f32x4 S4 = {0.f, 0.f, 0.f, 0.f}; float yacc = 0.f;
            const int rl = wave * 4 + fq;
            __syncthreads();
            for (int blk = 0; blk < SEQ / 32; ++blk) {
                LASP unsigned char* bf = lds + (blk & 1) * R_BUF;
                LASP float* sW = (LASP float*)(bf + R_W); LASP float* sA = (LASP float*)(bf + R_A); LASP float* sB = (LASP float*)(bf + R_B);
                LASP float* sK2 = (LASP float*)(bf + R_K2); LASP float* sR = (LASP float*)(bf + R_R); LASP float* sV = (LASP float*)(bf + R_V); LASP float* sY = (LASP float*)(bf + R_Y);
                f32x4 w4 = *(const LASP f32x4*)(sW + 4 * fr), a4 = *(const LASP f32x4*)(sA + 4 * fr), b4 = *(const LASP f32x4*)(sB + 4 * fr);
                f32x4 k4 = *(const LASP f32x4*)(sK2 + 4 * fr), r4 = *(const LASP f32x4*)(sR + 4 * fr); float v = sV[rl];
                float sa = S4[0] * a4[0] + S4[1] * a4[1] + S4[2] * a4[2] + S4[3] * a4[3];
                sa = row16_sum(sa);
                f32x4 tv = S4 * w4 + k4 * v;
#pragma unroll 4
                for (int tt = 0; tt < 32; ++tt) {
                    const int tn = tt < 31 ? tt + 1 : 31;
                    const f32x4 w4n = *(const LASP f32x4*)(sW + tn * 64 + 4 * fr), a4n = *(const LASP f32x4*)(sA + tn * 64 + 4 * fr), b4n = *(const LASP f32x4*)(sB + tn * 64 + 4 * fr);
                    const f32x4 k4n = *(const LASP f32x4*)(sK2 + tn * 64 + 4 * fr), r4n = *(const LASP f32x4*)(sR + tn * 64 + 4 * fr); const float vn = sV[tn * 16 + rl];
                    S4 = tv + b4 * sa;
                    const f32x4 py = S4 * r4, ps = S4 * a4n;
                    float y = (py[0] + py[2]) + (py[1] + py[3]), sp = (ps[0] + ps[2]) + (ps[1] + ps[3]);
                    tv = S4 * w4n + k4n * vn;
                    sp += dppf<0xB1>(sp); y += dppf<0xB1>(y); sp += dppf<0x4E>(sp); y += dppf<0x4E>(y);
                    sp += dppf<0x141>(sp); y += dppf<0x141>(y); sp += dppf<0x140>(sp); y += dppf<0x140>(y);
                    sa = sp;
                    yacc = (fr == (tt & 15)) ? y : yacc;
                    if ((tt & 15) == 15) { sY[(tt - 15 + fr) * 16 + rl] = yacc; }
                    b4 = b4n; r4 = r4n;
                }
                __syncthreads();
            }
            __builtin_amdgcn_s_setprio(0);
            __syncthreads();
}
__device__ __forceinline__ void rwkv_prep_waves(const Params& p, int l, LASP unsigned char* lds, int u) {
    const int tid = threadIdx.x, lane = tid & 63, wave = tid >> 6, fr = lane & 15, fq = lane >> 4;
    LASP bf16_t* sWm = (LASP bf16_t*)(lds + R_WM); LASP bf16_t* sAm = (LASP bf16_t*)(lds + R_AM); LASP float* sC = (LASP float*)(lds + R_CONST);
    const int rg = u & 3, h = (u >> 2) & 7, b = u >> 5;
    const size_t row0 = (size_t)b * SEQ;
    (void)tid; (void)lane; (void)wave; (void)fr; (void)fq; (void)sWm; (void)sAm; (void)sC; (void)rg; (void)h; (void)row0; (void)l;
            __builtin_amdgcn_s_setprio(PREP_PRIO);
            const int pw = wave - 4, s8 = lane >> 3, c8 = lane & 7;
            LASP unsigned char* stg = lds + R_STG + pw * R_STG_SZ;
            LASP bf16_t* sPw = (LASP bf16_t*)stg; LASP bf16_t* sPa = (LASP bf16_t*)(stg + 1152); LASP float* sKt = (LASP float*)(stg + 2304);
            const u32x4 z4 = {0u, 0u, 0u, 0u};
            auto load_raw = [&](int blk, RwRaw& R) {
                const int t = blk * 32 + pw * 8 + s8; const bf16_t* cur = p.PC + (row0 + t) * PC_LD; const bf16_t* prv = cur - PC_LD; const bool hasp = t > 0;
                R.cr = *(const u32x4*)(cur + PC_R + h * 64 + 8 * c8); R.ck = *(const u32x4*)(cur + PC_K + h * 64 + 8 * c8);
                R.cw = *(const u32x4*)(cur + PC_WLR + 8 * c8); R.ca = *(const u32x4*)(cur + PC_ALR + 8 * c8);
                R.pr = hasp ? *(const u32x4*)(prv + PC_R + h * 64 + 8 * c8) : z4; R.pk = hasp ? *(const u32x4*)(prv + PC_K + h * 64 + 8 * c8) : z4;
                R.pw = hasp ? *(const u32x4*)(prv + PC_WLR + 8 * c8) : z4; R.pa = hasp ? *(const u32x4*)(prv + PC_ALR + 8 * c8) : z4;
                R.cv = z4; R.pv = z4;
                if (c8 < 2) { R.cv = *(const u32x4*)(cur + PC_V + h * 64 + 16 * rg + 8 * c8); if (hasp) R.pv = *(const u32x4*)(prv + PC_V + h * 64 + 16 * rg + 8 * c8); } };
            auto stageA = [&](int blk, const RwRaw& R) {
                LASP unsigned char* bf = lds + (blk & 1) * R_BUF;
                LASP float* sW = (LASP float*)(bf + R_W); LASP float* sA = (LASP float*)(bf + R_A); LASP float* sB = (LASP float*)(bf + R_B);
                LASP float* sK2 = (LASP float*)(bf + R_K2); LASP float* sR = (LASP float*)(bf + R_R); LASP float* sV = (LASP float*)(bf + R_V);
                const int t = pw * 8 + s8;
                { f32x4 o0, o1;
                  lerp8(R.cr, R.pr, *(const LASP f32x4*)(sC + 8 * c8), *(const LASP f32x4*)(sC + 8 * c8 + 4), o0, o1); *(LASP f32x4*)(sR + t * 64 + 8 * c8) = o0; *(LASP f32x4*)(sR + t * 64 + 8 * c8 + 4) = o1;
                  lerp8(R.ck, R.pk, *(const LASP f32x4*)(sC + 64 + 8 * c8), *(const LASP f32x4*)(sC + 64 + 8 * c8 + 4), o0, o1); *(LASP f32x4*)(sKt + s8 * 64 + 8 * c8) = o0; *(LASP f32x4*)(sKt + s8 * 64 + 8 * c8 + 4) = o1;
                  lerp8(R.cw, R.pw, *(const LASP f32x4*)(sC + 128 + 8 * c8), *(const LASP f32x4*)(sC + 128 + 8 * c8 + 4), o0, o1);
                  { u32x4 tw; tw.x = pk_bf16(fast_tanh(o0[0]), fast_tanh(o0[1])); tw.y = pk_bf16(fast_tanh(o0[2]), fast_tanh(o0[3])); tw.z = pk_bf16(fast_tanh(o1[0]), fast_tanh(o1[1])); tw.w = pk_bf16(fast_tanh(o1[2]), fast_tanh(o1[3]));
                    *(LASP u32x4*)(sPw + s8 * 72 + 8 * c8) = tw; }
                  lerp8(R.ca, R.pa, *(const LASP f32x4*)(sC + 192 + 8 * c8), *(const LASP f32x4*)(sC + 192 + 8 * c8 + 4), o0, o1);
                  { u32x4 ta; ta.x = pk_bf16(o0[0], o0[1]); ta.y = pk_bf16(o0[2], o0[3]); ta.z = pk_bf16(o1[0], o1[1]); ta.w = pk_bf16(o1[2], o1[3]); *(LASP u32x4*)(sPa + s8 * 72 + 8 * c8) = ta; }
                  if (c8 < 2) { lerp8(R.cv, R.pv, *(const LASP f32x4*)(sC + 256 + 8 * c8), *(const LASP f32x4*)(sC + 256 + 8 * c8 + 4), o0, o1); *(LASP f32x4*)(sV + t * 16 + 8 * c8) = o0; *(LASP f32x4*)(sV + t * 16 + 8 * c8 + 4) = o1; } }
                asm volatile("s_waitcnt lgkmcnt(0)" ::: "memory"); };
            auto stageBC = [&](int blk) {
                LASP unsigned char* bf = lds + (blk & 1) * R_BUF;
                LASP float* sW = (LASP float*)(bf + R_W); LASP float* sA = (LASP float*)(bf + R_A); LASP float* sB = (LASP float*)(bf + R_B); LASP float* sK2 = (LASP float*)(bf + R_K2);
                bf16x8 aw[2], aa[2];
#pragma unroll
                for (int ks = 0; ks < 2; ++ks) { aw[ks] = *(const LASP bf16x8*)(sPw + (fr & 7) * 72 + ks * 32 + fq * 8); aa[ks] = *(const LASP bf16x8*)(sPa + (fr & 7) * 72 + ks * 32 + fq * 8); }
                float ss[4] = {0.f, 0.f, 0.f, 0.f};
                const bool hi = fq >= 2;
                const int jb = (hi ? 32 : 0) + fr, tb8 = (fq & 1) * 4;
                LASP unsigned char* ebase = bf + ((pw * 8 + tb8) * 64 + jb) * 4; const LASP float* ktbase = sKt + tb8 * 64 + jb; const LASP float* cbase = sC + jb;
                float kkv[2][4], rtv[2][4];
#pragma unroll
                for (int nn = 0; nn < 2; ++nn) {
                    f32x4 dz0 = {0.f, 0.f, 0.f, 0.f}, da0 = dz0, dz1 = dz0, da1 = dz0;
#pragma unroll
                    for (int ks = 0; ks < 2; ++ks) {
                        dz0 = MFMA16(aw[ks], *(const LASP bf16x8*)(sWm + (nn * 16 + fr) * 72 + ks * 32 + fq * 8), dz0); da0 = MFMA16(aa[ks], *(const LASP bf16x8*)(sAm + (nn * 16 + fr) * 72 + ks * 32 + fq * 8), da0);
                        dz1 = MFMA16(aw[ks], *(const LASP bf16x8*)(sWm + ((nn + 2) * 16 + fr) * 72 + ks * 32 + fq * 8), dz1); da1 = MFMA16(aa[ks], *(const LASP bf16x8*)(sAm + ((nn + 2) * 16 + fr) * 72 + ks * 32 + fq * 8), da1); }
                    LASP unsigned char* eb = ebase + nn * 64; const LASP float* kt = ktbase + nn * 16; const LASP float* cb = cbase + nn * 16;
                    const float kkc = cb[272], w0c = cb[400], a0c = cb[464];
#pragma unroll
                    for (int r = 0; r < 4; ++r) {
                        const float dzr = hi ? dz1[r] : dz0[r], dar = hi ? da1[r] : da0[r];
                        const float dec = __builtin_amdgcn_exp2f(-0.8750387749145276f * sigmoidf_(w0c + dzr));
                        const float kk = kt[r * 64] * kkc; ss[r] += kk * kk;
                        *(LASP float*)(eb + r * 256 + R_W) = dec; rtv[nn][r] = sigmoidf_(a0c + dar); kkv[nn][r] = kk; } }
#pragma unroll
                for (int r = 0; r < 4; ++r) { float t = row16_sum(ss[r]); t += __shfl_xor(t, 32); ss[r] = rsqrtf(t + 1e-12f); }
                asm volatile("s_waitcnt lgkmcnt(0)" ::: "memory");
#pragma unroll
                for (int nn = 0; nn < 2; ++nn) { LASP unsigned char* eb = ebase + nn * 64; const LASP float* kt = ktbase + nn * 16; const float kac = cbase[nn * 16 + 336];
#pragma unroll
                    for (int r = 0; r < 4; ++r) { const float kn = kkv[nn][r] * ss[r], ar = rtv[nn][r];
                        *(LASP float*)(eb + r * 256 + R_A) = -kn; *(LASP float*)(eb + r * 256 + R_B) = kn * ar; *(LASP float*)(eb + r * 256 + R_K2) = kt[r * 64] * ((ar - 1.0f) * kac + 1.0f); } }
            };
            auto yout = [&](int blk) {
                const LASP float* sY = (const LASP float*)(lds + (blk & 1) * R_BUF + R_Y); const int id = pw * 64 + lane;
#pragma unroll
                for (int k = 0; k < 2; ++k) { const int t = (id >> 4) + 16 * k, i = id & 15; p.yc[(row0 + blk * 32 + t) * 512 + h * 64 + 16 * rg + i] = f2bf(sY[t * 16 + i]); } };
            RwRaw R;
            load_raw(0, R);
            stageA(0, R); load_raw(1, R); stageBC(0);
            __syncthreads();
#pragma unroll 1
            for (int blk = 0; blk < SEQ / 32; ++blk) {
                if (blk >= 1) yout(blk - 1);
#if DBG_DOUBLE & 8192
                if (blk + 1 < SEQ / 32) { stageA(blk + 1, R); stageBC(blk + 1); stageBC(blk + 1); if (blk + 2 < SEQ / 32) load_raw(blk + 2, R); }
#elif DBG_DOUBLE & 16384
                if (blk + 1 < SEQ / 32) { stageA(blk + 1, R); stageA(blk + 1, R); stageBC(blk + 1); if (blk + 2 < SEQ / 32) load_raw(blk + 2, R); }
#else
                if (blk + 1 < SEQ / 32) { stageA(blk + 1, R); if (blk + 2 < SEQ / 32) load_raw(blk + 2, R); stageBC(blk + 1); }
#endif
                __syncthreads();
            }
            yout(SEQ / 32 - 1);
            __builtin_amdgcn_s_setprio(0);
            __syncthreads();
}
__device__ void phase_rwkv_scan(const Params& p, int l, LASP unsigned char* lds, int wg, int nwg) {
    for (int u = wg; u < NB * 8 * 4; u += nwg) { rwkv_scan_setup(p, l, lds, u); if ((threadIdx.x >> 6) < 4) rwkv_scan_waves(p, l, lds, u); else rwkv_prep_waves(p, l, lds, u); }
}

constexpr int R3_A = 0, R3_G = 65536, R3_PA = 131072, R3_PG = 135680;
__device__ __forceinline__ void rwkv_post_ab(const Params& p, int l, LASP unsigned char* lds, int u) {
    LASP float* sAr = (LASP float*)(lds + R3_A); LASP float* sG = (LASP float*)(lds + R3_G);
    LASP bf16_t* sPa = (LASP bf16_t*)(lds + R3_PA); LASP bf16_t* sPg = (LASP bf16_t*)(lds + R3_PG);
    const int tid = threadIdx.x, lane = tid & 63, wave = tid >> 6, fr = lane & 15, fq = lane >> 4;
    const float* mu = p.rw_mu + (size_t)l * 1792;
        const size_t tr0 = (size_t)u * 32;
        const int pt = tid >> 4, cq = tid & 15;
        const size_t tr = tr0 + pt; const bool hasp = (tr & (SEQ - 1)) != 0;
        const bf16_t* cur = p.PC + tr * PC_LD; const bf16_t* prv = cur - PC_LD; const u32x2 z2 = {0u, 0u};
        (void)sAr; (void)sG; (void)wave; (void)lane;
        { const u32x2 ca = *(const u32x2*)(cur + PC_ALR + 4 * cq), pa = hasp ? *(const u32x2*)(prv + PC_ALR + 4 * cq) : z2;
          const f32x4 a4 = lerp4(ca, pa, *(const f32x4*)(mu + PC_ALR + 4 * cq));
          u32x2 ta; ta.x = pk_bf16(a4[0], a4[1]); ta.y = pk_bf16(a4[2], a4[3]); *(LASP u32x2*)(sPa + pt * 72 + 4 * cq) = ta;
#pragma unroll
          for (int g2 = 0; g2 < 2; ++g2) { const int col = 8 * cq + 4 * g2;
              const u32x2 cg = *(const u32x2*)(cur + PC_GLR + col), pg = hasp ? *(const u32x2*)(prv + PC_GLR + col) : z2;
              const f32x4 g4 = lerp4(cg, pg, *(const f32x4*)(mu + PC_GLR + col));
              u32x2 tg; tg.x = pk_bf16(sigmoidf_(g4[0]), sigmoidf_(g4[1])); tg.y = pk_bf16(sigmoidf_(g4[2]), sigmoidf_(g4[3])); *(LASP u32x2*)(sPg + pt * 136 + col) = tg; } }
        __syncthreads();
        { bf16x8 aa[2][2], ag[2][4];
#pragma unroll
          for (int m2 = 0; m2 < 2; ++m2) {
#pragma unroll
              for (int ks = 0; ks < 2; ++ks) aa[m2][ks] = *(const LASP bf16x8*)(sPa + (m2 * 16 + fr) * 72 + ks * 32 + fq * 8);
#pragma unroll
              for (int ks = 0; ks < 4; ++ks) ag[m2][ks] = *(const LASP bf16x8*)(sPg + (m2 * 16 + fr) * 136 + ks * 32 + fq * 8); }
#pragma unroll 1
          for (int ni = 0; ni < 4; ++ni) { const int n = (wave + 8 * ni) * 16 + fr;
              bf16x8 bwa[2], bwg[4];
#pragma unroll
              for (int ks = 0; ks < 2; ++ks) bwa[ks] = ld_frag_g(p.wa2_t + ((size_t)l * 512 + n) * 64 + ks * 32 + fq * 8);
#pragma unroll
              for (int ks = 0; ks < 4; ++ks) bwg[ks] = ld_frag_g(p.wg2_t + ((size_t)l * 512 + n) * 128 + ks * 32 + fq * 8);
              const float a0n = p.rw_a0[(size_t)l * 512 + n];
#pragma unroll
              for (int m2 = 0; m2 < 2; ++m2) { f32x4 da = {0.f, 0.f, 0.f, 0.f}, dg = {0.f, 0.f, 0.f, 0.f};
#pragma unroll
                  for (int ks = 0; ks < 2; ++ks) da = MFMA16(aa[m2][ks], bwa[ks], da);
#pragma unroll
                  for (int ks = 0; ks < 4; ++ks) dg = MFMA16(ag[m2][ks], bwg[ks], dg);
#pragma unroll
                  for (int r = 0; r < 4; ++r) { const int t = m2 * 16 + fq * 4 + r; sAr[t * 512 + n] = sigmoidf_(a0n + da[r]); sG[t * 512 + n] = dg[r]; } } } }
        __syncthreads();
}
__device__ __forceinline__ void rwkv_post_c(const Params& p, int l, LASP unsigned char* lds, int u) {
    LASP float* sAr = (LASP float*)(lds + R3_A); LASP float* sG = (LASP float*)(lds + R3_G);
    LASP bf16_t* sPa = (LASP bf16_t*)(lds + R3_PA); LASP bf16_t* sPg = (LASP bf16_t*)(lds + R3_PG);
    const int tid = threadIdx.x, lane = tid & 63, wave = tid >> 6, fr = lane & 15, fq = lane >> 4;
    const float* mu = p.rw_mu + (size_t)l * 1792;
        const size_t tr0 = (size_t)u * 32;
        const int pt = tid >> 4, cq = tid & 15;
        const size_t tr = tr0 + pt; const bool hasp = (tr & (SEQ - 1)) != 0;
        const bf16_t* cur = p.PC + tr * PC_LD; const bf16_t* prv = cur - PC_LD; const u32x2 z2 = {0u, 0u};
        (void)sPa; (void)sPg; (void)wave; (void)lane; (void)fr; (void)fq;
        struct HeadRaw { u32x2 cr, ck, cv, pr, pk, pv, yw; };
        auto load_head = [&](int h, HeadRaw& R) { const int col = h * 64 + 4 * cq;
            R.cr = *(const u32x2*)(cur + PC_R + col); R.ck = *(const u32x2*)(cur + PC_K + col); R.cv = *(const u32x2*)(cur + PC_V + col);
            R.pr = hasp ? *(const u32x2*)(prv + PC_R + col) : z2; R.pk = hasp ? *(const u32x2*)(prv + PC_K + col) : z2; R.pv = hasp ? *(const u32x2*)(prv + PC_V + col) : z2;
            R.yw = *(const u32x2*)(p.yc + tr * 512 + col); };
        HeadRaw Rn; load_head(0, Rn);
#pragma unroll 1
        for (int h = 0; h < 8; ++h) { const int col = h * 64 + 4 * cq;
            const HeadRaw R = Rn;
            if (h < 7) load_head(h + 1, Rn);
            const f32x4 r4 = lerp4(R.cr, R.pr, *(const f32x4*)(mu + PC_R + col)), k4 = lerp4(R.ck, R.pk, *(const f32x4*)(mu + PC_K + col)), v4 = lerp4(R.cv, R.pv, *(const f32x4*)(mu + PC_V + col));
            const f32x4 ar = *(const LASP f32x4*)(sAr + pt * 512 + col), g4 = *(const LASP f32x4*)(sG + pt * 512 + col);
            const f32x4 ka4 = *(const f32x4*)(p.rw_k_a + (size_t)l * 512 + col), rk4 = *(const f32x4*)(p.rw_r_k + (size_t)l * 512 + col);
            const f32x4 k2 = k4 * ((ar - 1.0f) * ka4 + 1.0f);
            const f32x4 bt = r4 * k2 * rk4; float bonus = row16_sum(bt[0] + bt[1] + bt[2] + bt[3]);
            const u32x2 yw = R.yw;
            const f32x4 y4 = {bflo(yw.x), bfhi(yw.x), bflo(yw.y), bfhi(yw.y)};
            const float mean = row16_sum(y4[0] + y4[1] + y4[2] + y4[3]) * (1.0f / 64.0f);
            const f32x4 dy = y4 - mean; const float var = row16_sum(dy[0] * dy[0] + dy[1] * dy[1] + dy[2] * dy[2] + dy[3] * dy[3]) * (1.0f / 64.0f);
            const float rstd = rsqrtf(var + 64e-5f);
            const f32x4 lg4 = *(const f32x4*)(p.rw_ln_g + (size_t)l * 512 + col), lb4 = *(const f32x4*)(p.rw_ln_b + (size_t)l * 512 + col);
            const f32x4 o = ((dy * rstd) * lg4 + lb4 + v4 * bonus) * g4;
            u32x2 w; w.x = pk_bf16(o[0], o[1]); w.y = pk_bf16(o[2], o[3]);
            *(u32x2*)(p.yc + tr * 512 + col) = w; }
        __syncthreads();
}
__device__ void phase_rwkv_post(const Params& p, int l, LASP unsigned char* lds, int wg, int nwg) {
    for (int u = wg; u < NTOK / 32; u += nwg) { rwkv_post_ab(p, l, lds, u); rwkv_post_c(p, l, lds, u); }
}

__device__ void phase_peer_tables(const Params& p, int l, int wg, int nwg) {
    const int lane = threadIdx.x & 63, wave = threadIdx.x >> 6;
    unsigned char* t8 = (unsigned char*)p.tu; float* tsc = (float*)((unsigned char*)p.tu + (size_t)2 * 16384 * 1024);
    for (int r = wg * 8 + wave; r < 2 * 16384; r += nwg * 8) {
        const int tb = r >> 14, row = r & 16383;
        const float* src = (tb ? p.peer_v : p.peer_u) + ((size_t)l * 16384 + row) * 1024 + 16 * lane;
        f32x4 v[4]; float am = 0.f;
#pragma unroll
        for (int i = 0; i < 4; ++i) { v[i] = *(const f32x4*)(src + 4 * i); am = fmaxf(am, fmaxf(fmaxf(fabsf(v[i][0]), fabsf(v[i][1])), fmaxf(fabsf(v[i][2]), fabsf(v[i][3])))); }
#pragma unroll
        for (int o = 32; o >= 1; o >>= 1) am = fmaxf(am, __shfl_xor(am, o));
        int ex = 0; if (am > 0.f) (void)frexpf(am, &ex);
        const float sc = ldexpf(1.0f, 8 - ex), inv = ldexpf(1.0f, ex - 8);
        u32x4 w;
#pragma unroll
        for (int i = 0; i < 4; ++i) { int q = 0; q = __builtin_amdgcn_cvt_pk_fp8_f32(v[i][0] * sc, v[i][1] * sc, q, false); q = __builtin_amdgcn_cvt_pk_fp8_f32(v[i][2] * sc, v[i][3] * sc, q, true); w[i] = (unsigned)q; }
        *(u32x4*)(t8 + (size_t)tb * 16384 * 1024 + (size_t)(lane >> 3) * 16384 * 128 + (size_t)row * 128 + 16 * (lane & 7)) = w;
        if (lane == 0) tsc[r] = inv;
    }
}
__device__ __forceinline__ float pk_val(unsigned key) { return fkey_inv(key & 0xffffff80u); }
__device__ void phase_peer_select(const Params& p, int l, LASP unsigned char* lds, int wg, int nwg) {
    LASP unsigned* top = (LASP unsigned*)lds;
    const int tid = threadIdx.x, lane = tid & 63, wave = tid >> 6, fr = lane & 15, fq = lane >> 4;
    int ca, cb; bool cvalid = lane < 50;
    { const int c = lane;
      if (c < 16) { ca = 0; cb = c; } else if (c < 24) { ca = 1; cb = c - 16; } else if (c < 29) { ca = 2; cb = c - 24; } else if (c < 33) { ca = 3; cb = c - 29; }
      else if (c < 36) { ca = 4; cb = c - 33; } else if (c < 38) { ca = 5; cb = c - 36; } else if (c < 40) { ca = 6; cb = c - 38; } else if (c < 42) { ca = 7; cb = c - 40; }
      else if (c < 50) { ca = c - 42 + 8; cb = 0; } else { ca = 0; cb = 0; } }
    for (int u = wg; u < NTOK / 64; u += nwg) {
        const size_t t0 = (size_t)u * 64;
#pragma unroll 1
        for (int pi = 0; pi < 2; ++pi) { const int hp = wave * 2 + pi;
            const bf16_t* kb = p.pkeys + ((size_t)l * 16 + hp) * 128 * 64;
            bf16x8 bk[8][2];
#pragma unroll
            for (int nt = 0; nt < 8; ++nt)
#pragma unroll
                for (int ks = 0; ks < 2; ++ks) bk[nt][ks] = ld_frag_g(kb + (size_t)(nt * 16 + fr) * 64 + ks * 32 + fq * 8);
#pragma unroll 1
            for (int mt = 0; mt < 4; ++mt) {
                bf16x8 qa[2];
#pragma unroll
                for (int ks = 0; ks < 2; ++ks) qa[ks] = ld_frag_g(p.qp + (t0 + mt * 16 + fr) * 1024 + hp * 64 + ks * 32 + fq * 8);
                unsigned key[8][4];
#pragma unroll
                for (int nt = 0; nt < 8; ++nt) { f32x4 d = {0.f, 0.f, 0.f, 0.f}; d = MFMA16(qa[0], bk[nt][0], d); d = MFMA16(qa[1], bk[nt][1], d);
#pragma unroll
                    for (int r = 0; r < 4; ++r) key[nt][r] = (fkey(d[r]) & 0xffffff80u) | (unsigned)(127 - (nt * 16 + fr)); }
#define PE_CE(a, b) { const unsigned hi_ = key[a][r] > key[b][r] ? key[a][r] : key[b][r], lo_ = key[a][r] > key[b][r] ? key[b][r] : key[a][r]; key[a][r] = hi_; key[b][r] = lo_; }
#pragma unroll
                for (int r = 0; r < 4; ++r) {
                    PE_CE(0, 1) PE_CE(2, 3) PE_CE(4, 5) PE_CE(6, 7)
                    PE_CE(0, 2) PE_CE(1, 3) PE_CE(4, 6) PE_CE(5, 7)
                    PE_CE(1, 2) PE_CE(5, 6)
                    PE_CE(0, 4) PE_CE(1, 5) PE_CE(2, 6) PE_CE(3, 7)
                    PE_CE(2, 4) PE_CE(3, 5)
                    PE_CE(1, 2) PE_CE(3, 4) PE_CE(5, 6) }
#undef PE_CE
                unsigned mine[4] = {0u, 0u, 0u, 0u};
#pragma unroll 1
                for (int it = 0; it < 16; ++it) {
                    unsigned mx[4];
                    row16_maxu_x4(mx, key[0][0], key[0][1], key[0][2], key[0][3]);
#pragma unroll
                    for (int r = 0; r < 4; ++r) { const unsigned m = mx[r];
                        if (fr == it) mine[r] = m;
                        const bool win = key[0][r] == m;
#pragma unroll
                        for (int nt = 0; nt < 7; ++nt) key[nt][r] = win ? key[nt + 1][r] : key[nt][r];
                        key[7][r] = win ? 0u : key[7][r]; }
                }
#pragma unroll
                for (int r = 0; r < 4; ++r) top[((mt * 16 + fq * 4 + r) * 16 + hp) * 16 + fr] = mine[r];
            }
        }
        __syncthreads();
        { const int t = tid >> 3, h = tid & 7;
          const LASP unsigned* l1 = top + (t * 16 + h * 2) * 16; const LASP unsigned* l2 = l1 + 16;
          float v1[16];
#pragma unroll
          for (int a = 0; a < 16; ++a) v1[a] = pk_val(l1[a]);
          unsigned long long ptrs = 0ull;
          float wsum[16]; unsigned wab[16];
#pragma unroll
          for (int rd = 0; rd < 16; ++rd) {
              float best = -INFINITY; unsigned bab = 0u;
#pragma unroll
              for (int a = 0; a < 16; ++a) {
                  if (a <= rd) {
                      const unsigned b = (unsigned)(ptrs >> (4 * a)) & 15u; const unsigned lim = 16u / (unsigned)(a + 1);
                      const float c = b < lim ? v1[a] + pk_val(l2[b]) : -INFINITY;
                      if (c > best) { best = c; bab = ((unsigned)a << 4) | b; } } }
              wsum[rd] = best; wab[rd] = bab;
              ptrs += 1ull << (4 * (bab >> 4));
          }
          float den = 0.f; float ex[16];
#pragma unroll
          for (int k = 0; k < 16; ++k) { ex[k] = __expf(wsum[k] - wsum[0]); den += ex[k]; }
          const float rd_ = __builtin_amdgcn_rcpf(den);
          const size_t o = (t0 + t) * 128 + h * 16;
          unsigned ew[8];
#pragma unroll
          for (int k = 0; k < 16; ++k) { const unsigned a = wab[k] >> 4, b = wab[k] & 15u; const unsigned e = ((127u - (l1[a] & 127u)) << 7) | (127u - (l2[b] & 127u));
              if (k & 1) ew[k >> 1] |= e << 16; else ew[k >> 1] = e; }
          *(u32x4*)(p.pe_idx + o) = (u32x4){ew[0], ew[1], ew[2], ew[3]}; *(u32x4*)(p.pe_idx + o + 8) = (u32x4){ew[4], ew[5], ew[6], ew[7]};
#pragma unroll
          for (int k4 = 0; k4 < 4; ++k4) *(f32x4*)(p.pe_gate + o + 4 * k4) = (f32x4){ex[4 * k4] * rd_, ex[4 * k4 + 1] * rd_, ex[4 * k4 + 2] * rd_, ex[4 * k4 + 3] * rd_};
        }
        __syncthreads();
    }
}
__device__ __forceinline__ void fp8x16_to_f32(const u32x4& w, float (&f)[16]) {
#pragma unroll
    for (int i = 0; i < 4; ++i) { const f32x2 a = __builtin_amdgcn_cvt_pk_f32_fp8((int)w[i], false), b = __builtin_amdgcn_cvt_pk_f32_fp8((int)w[i], true); f[4 * i] = a[0]; f[4 * i + 1] = a[1]; f[4 * i + 2] = b[0]; f[4 * i + 3] = b[1]; }
}
template <bool DRY> __device__ void phase_peer_gather(const Params& p, int l, int wg, int nwg) {
    const int lane = threadIdx.x & 63, wave = threadIdx.x >> 6;
    const float* gate = p.mod + (size_t)l * 8 * 6144 + 5120;
    const unsigned char* tu8 = (const unsigned char*)p.tu; const unsigned char* tv8 = tu8 + (size_t)16384 * 1024; const float* tsc = (const float*)(tu8 + (size_t)2 * 16384 * 1024);
    for (int tok = wg * 8 + wave; tok < NTOK; tok += nwg * 8) {
        float xv[16];
        { const u32x4 a = *(const u32x4*)(p.hbuf + (size_t)tok * 1024 + 16 * lane), b = *(const u32x4*)(p.hbuf + (size_t)tok * 1024 + 16 * lane + 8);
          xv[0] = bflo(a.x); xv[1] = bfhi(a.x); xv[2] = bflo(a.y); xv[3] = bfhi(a.y); xv[4] = bflo(a.z); xv[5] = bfhi(a.z); xv[6] = bflo(a.w); xv[7] = bfhi(a.w);
          xv[8] = bflo(b.x); xv[9] = bfhi(b.x); xv[10] = bflo(b.y); xv[11] = bfhi(b.y); xv[12] = bflo(b.z); xv[13] = bfhi(b.z); xv[14] = bflo(b.w); xv[15] = bfhi(b.w); }
        const unsigned e_lo = p.pe_idx[(size_t)tok * 128 + lane], e_hi = p.pe_idx[(size_t)tok * 128 + 64 + lane];
        const float g_lo = p.pe_gate[(size_t)tok * 128 + lane] , g_hi = p.pe_gate[(size_t)tok * 128 + 64 + lane];
        const float su_lo = tsc[e_lo], su_hi = tsc[e_hi], sv_lo = tsc[16384 + e_lo], sv_hi = tsc[16384 + e_hi];
        float d_lo = 0.f, d_hi = 0.f;
#pragma unroll 1
        for (int i0 = 0; i0 < 128; i0 += 8) {
            u32x4 ua[8];
#pragma unroll
            for (int j = 0; j < 8; ++j) { const int i = i0 + j; const unsigned e = (unsigned)__builtin_amdgcn_readlane((int)(i0 < 64 ? e_lo : e_hi), i & 63); ua[j] = *(const u32x4*)(tu8 + (size_t)e * 1024 + 16 * lane); }
#pragma unroll
            for (int j = 0; j < 8; ++j) { const int i = i0 + j; float uf[16]; fp8x16_to_f32(ua[j], uf);
                float s = uf[0] * xv[0];
#pragma unroll
                for (int k = 1; k < 16; ++k) s = fmaf(uf[k], xv[k], s);
                s = row16_sum(s); s += __shfl_xor(s, 16); s += __shfl_xor(s, 32);
                if (i0 < 64) { if (lane == (i & 63)) d_lo = s; } else { if (lane == (i & 63)) d_hi = s; } }
        }
        d_lo *= su_lo; d_hi *= su_hi;
        const float w_lo = sv_lo * g_lo * 0.5f * d_lo * (1.0f + erff(d_lo * 0.70710678118654752f)), w_hi = sv_hi * g_hi * 0.5f * d_hi * (1.0f + erff(d_hi * 0.70710678118654752f));
        float ov[16];
#pragma unroll
        for (int j = 0; j < 16; ++j) ov[j] = 0.f;
#pragma unroll 1
        for (int i0 = 0; i0 < 128; i0 += 8) {
            u32x4 va[8]; float ww[8];
#pragma unroll
            for (int j = 0; j < 8; ++j) { const int i = i0 + j; const unsigned e = (unsigned)__builtin_amdgcn_readlane((int)(i0 < 64 ? e_lo : e_hi), i & 63);
                ww[j] = __int_as_float(__builtin_amdgcn_readlane(__float_as_int(i0 < 64 ? w_lo : w_hi), i & 63));
                va[j] = *(const u32x4*)(tv8 + (size_t)e * 1024 + 16 * lane); }
#pragma unroll
            for (int j = 0; j < 8; ++j) { float vf[16]; fp8x16_to_f32(va[j], vf);
#pragma unroll
                for (int k = 0; k < 16; ++k) ov[k] = fmaf(ww[j], vf[k], ov[k]); }
        }
        const float* gp = gate + (size_t)(tok >> 13) * 6144; float* xr = DRY ? (float*)p.qp + (size_t)(tok & 32767) * 1024 : p.out + (size_t)tok * 1024;
#pragma unroll
        for (int q4 = 0; q4 < 4; ++q4) { const int col = 16 * lane + 4 * q4;
            const f32x4 gg = *(const f32x4*)(gp + col); f32x4 xx = *(const f32x4*)(xr + col);
            xx[0] = fmaf(gg[0], ov[q4 * 4 + 0], xx[0]); xx[1] = fmaf(gg[1], ov[q4 * 4 + 1], xx[1]); xx[2] = fmaf(gg[2], ov[q4 * 4 + 2], xx[2]); xx[3] = fmaf(gg[3], ov[q4 * 4 + 3], xx[3]);
            *(f32x4*)(xr + col) = xx; }
    }
}

typedef __bf16 bf2_t __attribute__((ext_vector_type(2)));
__device__ __forceinline__ float fp8_dot16(const u32x4& w, const u32x4& xa, const u32x4& xb) {
    const unsigned xs[8] = {xa.x, xa.y, xa.z, xa.w, xb.x, xb.y, xb.z, xb.w};
    unsigned u[8];
#pragma unroll
    for (int i = 0; i < 4; ++i) { u[2 * i] = __builtin_bit_cast(unsigned, __builtin_amdgcn_cvt_scalef32_pk_bf16_fp8((int)w[i], 1.0f, false)); u[2 * i + 1] = __builtin_bit_cast(unsigned, __builtin_amdgcn_cvt_scalef32_pk_bf16_fp8((int)w[i], 1.0f, true)); }
    float acc = 0.f;
    asm("v_dot2c_f32_bf16 %0, %1, %9\n\tv_dot2c_f32_bf16 %0, %2, %10\n\tv_dot2c_f32_bf16 %0, %3, %11\n\tv_dot2c_f32_bf16 %0, %4, %12\n\t"
        "v_dot2c_f32_bf16 %0, %5, %13\n\tv_dot2c_f32_bf16 %0, %6, %14\n\tv_dot2c_f32_bf16 %0, %7, %15\n\tv_dot2c_f32_bf16 %0, %8, %16\n\ts_nop 1"
        : "+v"(acc) : "v"(u[0]), "v"(u[1]), "v"(u[2]), "v"(u[3]), "v"(u[4]), "v"(u[5]), "v"(u[6]), "v"(u[7]), "v"(xs[0]), "v"(xs[1]), "v"(xs[2]), "v"(xs[3]), "v"(xs[4]), "v"(xs[5]), "v"(xs[6]), "v"(xs[7]));
    return acc;
}
constexpr int PS_IDS = 131072;
#ifndef PSA
#define PSA 8
#endif
#ifndef PSB
#define PSB 4
#endif
#define PS_COMMON \
    LASP float* acc = (LASP float*)lds; \
    const int tid = threadIdx.x, lane = tid & 63, wave = tid >> 6, g = lane >> 3, c = lane & 7; \
    LASP unsigned short* idl = (LASP unsigned short*)(lds + PS_IDS) + wave * 1024 + g * 128; \
    const unsigned char* tu8 = (const unsigned char*)p.tu; const unsigned char* tv8 = tu8 + (size_t)16384 * 1024; const float* tsc = (const float*)(tu8 + (size_t)2 * 16384 * 1024); \
    (void)tid; (void)tu8; (void)tv8; (void)tsc; (void)acc; (void)l;
template <int NB_> __device__ __forceinline__ void ps_load4(const unsigned char* tab, const LASP unsigned short* idl, int jb, int off, u32x4 (&r)[NB_]) {
    unsigned idw[NB_ / 2];
#pragma unroll
    for (int j = 0; j < NB_ / 2; ++j) idw[j] = *(const LASP unsigned*)(idl + jb * NB_ + 2 * j);
#pragma unroll
    for (int j = 0; j < NB_; ++j) { const unsigned e = (j & 1) ? (idw[j >> 1] >> 16) : (idw[j >> 1] & 0xffffu); r[j] = *(const u32x4*)(tab + (size_t)e * 128 + off); }
}
__device__ __forceinline__ void peer_slab_a(const Params& p, int l, LASP unsigned char* lds, int u) {
    PS_COMMON
#pragma unroll 1
    for (int s = 0; s < 8; ++s) {
#pragma unroll 1
        for (int it = 0; it < 4; ++it) { const int tt = wave * 32 + it * 8 + g; const size_t t = (size_t)u * 256 + tt; const int off = s * 128 + c * 16;
            { const u32x4 i0 = *(const u32x4*)(p.pe_idx + t * 128 + c * 16), i1 = *(const u32x4*)(p.pe_idx + t * 128 + c * 16 + 8);
              *(LASP u32x4*)(idl + c * 16) = i0; *(LASP u32x4*)(idl + c * 16 + 8) = i1; }
            const u32x4 xa = *(const u32x4*)(p.hbuf + t * 1024 + off), xb = *(const u32x4*)(p.hbuf + t * 1024 + off + 8);
            asm volatile("s_waitcnt lgkmcnt(0)" ::: "memory");
            auto use4 = [&](int jb, const u32x4 (&ua)[PSA]) {
                float mine0 = 0.f;
#pragma unroll
                for (int j = 0; j < PSA; ++j) {
                    float d = fp8_dot16(ua[j], xa, xb);
                    d += dppf<0xB1>(d); d += dppf<0x4E>(d); d += dppf<0x141>(d);
                    if ((c & (PSA - 1)) == j) mine0 = d; }
                if (c < PSA) { LASP float* ap = acc + tt * 128 + jb * PSA + c; if (s == 0) ap[0] = mine0; else ap[0] += mine0; } };
            u32x4 ra[PSA], rb[PSA];
            const int toff = s * (16384 * 128) + c * 16;
            ps_load4(tu8, idl, 0, toff, ra);
#pragma unroll 1
            for (int jb = 0; jb < 128 / PSA - 2; jb += 2) {
                ps_load4(tu8, idl, jb + 1, toff, rb);
                use4(jb, ra);
                ps_load4(tu8, idl, jb + 2, toff, ra);
                use4(jb + 1, rb);
            }
            ps_load4(tu8, idl, 128 / PSA - 1, toff, rb);
            use4(128 / PSA - 2, ra);
            use4(128 / PSA - 1, rb);
        }
    }
    __syncthreads();
    for (int i = tid; i < 256 * 128; i += NTHR) { const size_t t = (size_t)u * 256 + (i >> 7); const int k = i & 127;
        const unsigned e = p.pe_idx[t * 128 + k]; const float d = acc[i] * tsc[e];
        acc[i] = tsc[16384 + e] * p.pe_gate[t * 128 + k] * 0.5f * d * (1.0f + erff(d * 0.70710678118654752f)); }
    __syncthreads();
}
__device__ __forceinline__ void peer_slab_b(const Params& p, int l, LASP unsigned char* lds, int u) {
    PS_COMMON
    const float* gate = p.mod + (size_t)l * 8 * 6144 + 5120;
#pragma unroll 1
    for (int s = 0; s < 8; ++s) {
#pragma unroll 1
        for (int it = 0; it < 4; ++it) { const int tt = wave * 32 + it * 8 + g; const size_t t = (size_t)u * 256 + tt; const int off = s * 128 + c * 16;
            { const u32x4 i0 = *(const u32x4*)(p.pe_idx + t * 128 + c * 16), i1 = *(const u32x4*)(p.pe_idx + t * 128 + c * 16 + 8);
              *(LASP u32x4*)(idl + c * 16) = i0; *(LASP u32x4*)(idl + c * 16 + 8) = i1; }
            float ov[16];
#pragma unroll
            for (int k = 0; k < 16; ++k) ov[k] = 0.f;
            asm volatile("s_waitcnt lgkmcnt(0)" ::: "memory");
            auto use4 = [&](int jb, const u32x4 (&va)[PSB]) {
                float wq[PSB];
#pragma unroll
                for (int j = 0; j < PSB; ++j) wq[j] = acc[tt * 128 + jb * PSB + j];
#pragma unroll
                for (int j = 0; j < PSB; ++j) { float vf[16]; fp8x16_to_f32(va[j], vf); const float w = wq[j];
#pragma unroll
                    for (int k = 0; k < 16; ++k) ov[k] = fmaf(w, vf[k], ov[k]); } };
            u32x4 ra[PSB], rb[PSB];
            const int toff = s * (16384 * 128) + c * 16;
            ps_load4(tv8, idl, 0, toff, ra);
#pragma unroll 1
            for (int jb = 0; jb < 128 / PSB - 2; jb += 2) {
                ps_load4(tv8, idl, jb + 1, toff, rb);
                use4(jb, ra);
                ps_load4(tv8, idl, jb + 2, toff, ra);
                use4(jb + 1, rb);
            }
            ps_load4(tv8, idl, 128 / PSB - 1, toff, rb);
            use4(128 / PSB - 2, ra);
            use4(128 / PSB - 1, rb);
            const float* gp = gate + (size_t)(t >> 13) * 6144 + off; float* xr = p.out + t * 1024 + off;
#pragma unroll
            for (int q4 = 0; q4 < 4; ++q4) { const f32x4 gg = *(const f32x4*)(gp + 4 * q4); f32x4 xx = *(const f32x4*)(xr + 4 * q4);
                xx[0] = fmaf(gg[0], ov[q4 * 4 + 0], xx[0]); xx[1] = fmaf(gg[1], ov[q4 * 4 + 1], xx[1]); xx[2] = fmaf(gg[2], ov[q4 * 4 + 2], xx[2]); xx[3] = fmaf(gg[3], ov[q4 * 4 + 3], xx[3]);
                *(f32x4*)(xr + 4 * q4) = xx; }
        }
    }
    __syncthreads();
}
__device__ void phase_peer_gather_slab(const Params& p, int l, LASP unsigned char* lds, int wg, int nwg) {
    for (int u = wg; u < NTOK / 256; u += nwg) { peer_slab_a(p, l, lds, u); peer_slab_b(p, l, lds, u); }
}

#if MK_ONE_LAUNCH
#define PHASE_INLINE __attribute__((noinline))
#else
#define PHASE_INLINE __forceinline__
#endif
#ifndef E3_SLAB
#define E3_SLAB 1
#endif
enum { PH_W = 0, PH_A1, PH_A2, PH_G1, PH_G2, PH_G3, PH_D1, PH_D2, PH_D34, PH_R2, PH_R3, PH_M, PH_O, PH_A1F, PH_E1, PH_E2, PH_E3, PH_FIN, PH_W1, PH_W2, PH_W3, PH_W4, PH_E3DRY, PH_COUNT };
enum { UN_DSEL = 0, UN_DATT, UN_R3AB, UN_R3C, UN_R2SETUP, UN_R2SCAN, UN_R2PREP, UN_E3A, UN_E3B, UN_DUP };

template <int PH> __device__ __forceinline__ void run_phase(const Params& p, int l, LASP unsigned char* lds, int wg, int nwg) {
    const float* modl = p.mod + (size_t)l * 8 * 6144;
    const float* xin = l == 0 ? p.x : p.out;
    if constexpr (PH == PH_W) phase_weights<0>(p, lds, wg, nwg);
    else if constexpr (PH == PH_W1) phase_weights<1>(p, lds, wg, nwg);
    else if constexpr (PH == PH_W2) phase_weights<2>(p, lds, wg, nwg);
    else if constexpr (PH == PH_W3) phase_weights<3>(p, lds, wg, nwg);
    else if constexpr (PH == PH_W4) phase_weights<4>(p, lds, wg, nwg);
    else if constexpr (PH == PH_A1) phase_adaln(xin, p.g_mix + (size_t)l * 1024, modl, 0, 1024, p.hbuf, wg, nwg);
    else if constexpr (PH == PH_A2) { pg8::EpiP E; E.GQ = p.GQ; E.GK = p.GK; E.GV = p.GV; E.GR = p.GR; E.PB = p.PB; E.PC = p.PC;
        run_gemm(lds, p.hbuf, p.win_t + (size_t)l * 3840 * 1024, NTOK, 3840, 1024, E, wg, nwg); }
    else if constexpr (PH == PH_G1) phase_gla1(p, l, lds, wg, nwg);
    else if constexpr (PH == PH_G2) phase_gla2(p, wg, nwg);
    else if constexpr (PH == PH_G3) phase_gla3(p, l, lds, wg, nwg);
    else if constexpr (PH == PH_D1) phase_dsa1(p, l, wg, nwg);
    else if constexpr (PH == PH_D2) { pg8::EpiStore<0> E; E.O = p.qd; E.ldc = 1024; run_gemm(lds, p.qn, p.wuq_t + (size_t)l * 1024 * 256, NTOK, 1024, 256, E, wg, nwg);
        pg8::EpiStore<0> E2; E2.O = p.qi; E2.ldc = 256; run_gemm(lds, p.qn, p.wiq_t + (size_t)l * 256 * 256, NTOK, 256, 256, E2, wg, nwg); }
    else if constexpr (PH == PH_D34) phase_dsa34(p, l, lds, wg, nwg);
    else if constexpr (PH == PH_R2) phase_rwkv_scan(p, l, lds, wg, nwg);
    else if constexpr (PH == PH_R3) phase_rwkv_post(p, l, lds, wg, nwg);
    else if constexpr (PH == PH_M) {
        pg8::EpiStore<1> EG; EG.O = p.Gtmp; EG.ldc = 1024;
        const bf16_t* wg_l = p.wg_t + (size_t)l * 3072 * 1024; const bf16_t* wb_l = p.wb_t + (size_t)l * 3 * 1024 * 512;
        run_gemm(lds, p.hbuf, wg_l, NTOK, 1024, 1024, EG, wg, nwg);
        { pg8::EpiMerge<1> EM; EM.G = p.Gtmp; EM.O = p.merged; EM.ldc = 1024; run_gemm(lds, p.ya, wb_l, NTOK, 1024, 512, EM, wg, nwg); }
        run_gemm(lds, p.hbuf, wg_l + (size_t)1024 * 1024, NTOK, 1024, 1024, EG, wg, nwg);
        { pg8::EpiMerge<0> EM; EM.G = p.Gtmp; EM.O = p.merged; EM.ldc = 1024; run_gemm(lds, p.yb, wb_l + (size_t)1024 * 512, NTOK, 1024, 512, EM, wg, nwg); }
        run_gemm(lds, p.hbuf, wg_l + (size_t)2 * 1024 * 1024, NTOK, 1024, 1024, EG, wg, nwg);
        { pg8::EpiMerge<0> EM; EM.G = p.Gtmp; EM.O = p.merged; EM.ldc = 1024; run_gemm(lds, p.yc, wb_l + (size_t)2 * 1024 * 512, NTOK, 1024, 512, EM, wg, nwg); } }
    else if constexpr (PH == PH_O) { pg8::EpiResid E; E.xin = xin; E.xout = p.out; E.gate = modl + 2048; run_gemm(lds, p.merged, p.wo_t + (size_t)l * 1024 * 1024, NTOK, 1024, 1024, E, wg, nwg); }
    else if constexpr (PH == PH_A1F) { phase_adaln(p.out, p.g_ffn + (size_t)l * 1024, modl, 3072, 4096, p.hbuf, wg, nwg); phase_peer_tables(p, l, wg, nwg); }
    else if constexpr (PH == PH_E1) { pg8::EpiStore<0> E; E.O = p.qp; E.ldc = 1024; run_gemm(lds, p.hbuf, p.wq_t + (size_t)l * 1024 * 1024, NTOK, 1024, 1024, E, wg, nwg); }
    else if constexpr (PH == PH_E2) phase_peer_select(p, l, lds, wg, nwg);
    else if constexpr (PH == PH_E3) { if (E3_SLAB) phase_peer_gather_slab(p, l, lds, wg, nwg); else phase_peer_gather<false>(p, l, wg, nwg); }
    else if constexpr (PH == PH_E3DRY) phase_peer_gather<true>(p, l, wg, nwg);
    else if constexpr (PH == PH_FIN) phase_final(p.out, p.g_final, wg, nwg);
}

extern __shared__ __attribute__((aligned(16))) unsigned char smem_dyn[];
#ifndef DBG_MODE
#define DBG_MODE 0
#endif
#ifndef DBG_DOUBLE
#define DBG_DOUBLE 0
#endif
#ifndef DBG_LAYERS
#define DBG_LAYERS NLAYER
#endif
__global__ void __launch_bounds__(NTHR, 2) k_dbg_copy(const float* x, float* out) {
    for (size_t i = (size_t)blockIdx.x * NTHR + threadIdx.x; i < (size_t)NTOK * 1024 / 4; i += (size_t)gridDim.x * NTHR) ((f32x4*)out)[i] = ((const f32x4*)x)[i];
}

__global__ void __launch_bounds__(NTHR, 2) k_dbg_dump(const bf16_t* buf, size_t n, float* out) {
    const size_t NOUT = (size_t)NTOK * 1024;
    for (size_t i = (size_t)blockIdx.x * NTHR + threadIdx.x; i < NOUT; i += (size_t)gridDim.x * NTHR) {
        float s = 0.f; if (n >= NOUT) { for (size_t j = i; j < n; j += NOUT) s += bf2f(buf[j]); } else s = bf2f(buf[i % n]);
        out[i] = s; }
}
#ifndef DBG_A2BUF
#define DBG_A2BUF p.PC
#define DBG_A2N 1792
#endif
#ifndef DBG_G1BUF
#define DBG_G1BUF p.GS
#define DBG_G1N ((size_t)NTOK * 512)
#endif
#ifndef DBG_STOP
#define DBG_STOP PH_O
#endif
#if MK_ONE_LAUNCH
typedef const __attribute__((address_space(4))) Params* KParams;
__device__ __forceinline__ KParams kparams_from(unsigned lo_, unsigned hi_) {
    const unsigned lo = (unsigned)__builtin_amdgcn_readfirstlane((int)lo_), hi = (unsigned)__builtin_amdgcn_readfirstlane((int)hi_);
    return (KParams)(((unsigned long long)hi << 32) | lo);
}
struct ParamsPtrs { void* w[sizeof(Params) / 8]; };
static_assert(sizeof(ParamsPtrs) == sizeof(Params), "Params must be a whole number of pointers");
__device__ __forceinline__ Params load_kparams(KParams pp) {
    typedef const __attribute__((address_space(4))) unsigned long long* KQ; const KQ q = (KQ)pp; ParamsPtrs r;
#pragma unroll
    for (int i = 0; i < (int)(sizeof(Params) / 8); ++i) r.w[i] = (void*)(__attribute__((address_space(1))) void*)q[i];
    return __builtin_bit_cast(Params, r);
}
template <int PH> __device__ __attribute__((noinline)) void phase_call(int l_, LASP unsigned char* lds_, unsigned plo, unsigned phi) {
    const int l = __builtin_amdgcn_readfirstlane(l_);
    LASP unsigned char* lds = (LASP unsigned char*)(unsigned)__builtin_amdgcn_readfirstlane((int)(unsigned)(size_t)lds_);
    const KParams pp = kparams_from(plo, phi);
    const Params p = load_kparams(pp);
    run_phase<PH>(p, l, lds, (int)blockIdx.x, (int)gridDim.x);
}
template <int UN> __device__ __attribute__((noinline)) void unit_call(int l_, LASP unsigned char* lds_, int u_, unsigned plo, unsigned phi) {
    const int l = __builtin_amdgcn_readfirstlane(l_), u = __builtin_amdgcn_readfirstlane(u_);
    LASP unsigned char* lds = (LASP unsigned char*)(unsigned)__builtin_amdgcn_readfirstlane((int)(unsigned)(size_t)lds_);
    const KParams pp = kparams_from(plo, phi);
    const Params p = load_kparams(pp);
    if constexpr (UN == UN_DSEL) dsa_select_unit(p, l, lds, u);
    else if constexpr (UN == UN_DATT) dsa_attend_query(p, l, lds, u);
    else if constexpr (UN == UN_DUP) dsa_upproj_unit(p, l, lds, u);
    else if constexpr (UN == UN_R3AB) rwkv_post_ab(p, l, lds, u);
    else if constexpr (UN == UN_R3C) rwkv_post_c(p, l, lds, u);
    else if constexpr (UN == UN_R2SETUP) rwkv_scan_setup(p, l, lds, u);
    else if constexpr (UN == UN_R2SCAN) rwkv_scan_waves(p, l, lds, u);
    else if constexpr (UN == UN_R2PREP) rwkv_prep_waves(p, l, lds, u);
    else if constexpr (UN == UN_E3A) peer_slab_a(p, l, lds, u);
    else peer_slab_b(p, l, lds, u);
}
constexpr int NSTEP = 22;
struct GemmStep { const bf16_t* A; const bf16_t* Bt; int N, K; pg8::EpiGen E; };
__device__ __forceinline__ bool make_gemm_step(const Params& p, int l, int s, GemmStep& g) {
    const float* modl = p.mod + (size_t)l * 8 * 6144;
    pg8::EpiGen& E = g.E;
    E.kind = 1; E.ldc = 1024; E.O = nullptr; E.G = p.Gtmp; E.GQ = p.GQ; E.GK = p.GK; E.GV = p.GV; E.GR = p.GR; E.PB = p.PB; E.PC = p.PC; E.xin = l == 0 ? p.x : p.out; E.xout = p.out; E.gate = modl + 2048;
    const bf16_t* wg_l = p.wg_t + (size_t)l * 3072 * 1024; const bf16_t* wb_l = p.wb_t + (size_t)l * 3 * 1024 * 512;
    g.N = 1024; g.K = 1024; g.A = p.hbuf; g.Bt = nullptr;
    switch (s) {
    case 1: g.Bt = p.win_t + (size_t)l * 3840 * 1024; g.N = 3840; E.kind = 0; return true;
    case 6: g.A = p.qn; g.Bt = p.wuq_t + (size_t)l * 1024 * 256; g.K = 256; E.O = p.qd; return true;
    case 7: g.A = p.qn; g.Bt = p.wiq_t + (size_t)l * 256 * 256; g.N = 256; g.K = 256; E.O = p.qi; E.ldc = 256; return true;
    case 11: g.Bt = wg_l; E.kind = 2; E.O = p.Gtmp; return true;
    case 12: g.A = p.ya; g.Bt = wb_l; g.K = 512; E.kind = 3; E.O = p.merged; return true;
    case 13: g.Bt = wg_l + (size_t)1024 * 1024; E.kind = 2; E.O = p.Gtmp; return true;
    case 14: g.A = p.yb; g.Bt = wb_l + (size_t)1024 * 512; g.K = 512; E.kind = 4; E.O = p.merged; return true;
    case 15: g.Bt = wg_l + (size_t)2 * 1024 * 1024; E.kind = 2; E.O = p.Gtmp; return true;
    case 16: g.A = p.yc; g.Bt = wb_l + (size_t)2 * 1024 * 512; g.K = 512; E.kind = 4; E.O = p.merged; return true;
    case 17: g.A = p.merged; g.Bt = p.wo_t + (size_t)l * 1024 * 1024; E.kind = 5; return true;
    case 19: g.Bt = p.wq_t + (size_t)l * 1024 * 1024; E.O = p.qp; return true;
    default: return false; }
}
__global__ void __launch_bounds__(NTHR, 2) mega_fwd(Params p) {
    LASP unsigned char* lds = (LASP unsigned char*)smem_dyn;
    if (threadIdx.x < 4) ((LASP unsigned*)(lds + LDS_BAR_OFF))[threadIdx.x] = 0u;
    __syncthreads();
    const XcdBarrier bar = xcd_barrier_post(p.bar, (volatile LAS unsigned*)(lds + LDS_BAR_OFF));
    const int wg = blockIdx.x, nwg = gridDim.x;
    const unsigned long long kpa = (unsigned long long)__builtin_amdgcn_kernarg_segment_ptr(); const unsigned kplo = (unsigned)kpa, kphi = (unsigned)(kpa >> 32);
#if DBG_DOUBLE & 2048
    phase_call<PH_W>(0, lds, kplo, kphi); phase_call<PH_W1>(0, lds, kplo, kphi); phase_call<PH_W2>(0, lds, kplo, kphi); phase_call<PH_W3>(0, lds, kplo, kphi); phase_call<PH_W4>(0, lds, kplo, kphi);
#endif
    phase_call<PH_W>(0, lds, kplo, kphi); phase_call<PH_W1>(0, lds, kplo, kphi); phase_call<PH_W2>(0, lds, kplo, kphi); phase_call<PH_W3>(0, lds, kplo, kphi); phase_call<PH_W4>(0, lds, kplo, kphi); xcd_barrier(bar);
#pragma unroll 1
    for (int ls = 0; ls < NLAYER * NSTEP; ++ls) {
        const int l = ls / NSTEP, s = ls % NSTEP;
        GemmStep g;
        if (make_gemm_step(p, l, s, g)) {
#if DBG_DOUBLE & 1
            if (s != 17 && s != 14 && s != 16) { pg8::Gemm gg; gg.A = g.A; gg.Bt = g.Bt; gg.M = NTOK; gg.N = g.N; gg.K = g.K; pg8::StaticOrder S; S.init(NTOK, g.N, nwg, wg);
                pg8::gemm_phase<pg8::EpiGen, pg8::StaticOrder, false>(lds, gg, S, g.E, nullptr); __syncthreads(); }
#endif
            pg8::Gemm gg; gg.A = g.A; gg.Bt = g.Bt; gg.M = NTOK; gg.N = g.N; gg.K = g.K;
            pg8::StaticOrder S; S.init(NTOK, g.N, nwg, wg);
#if DBG_DOUBLE & 0x3C0000
            int reps = 1; const int k0 = g.E.kind;
            if ((DBG_DOUBLE & 0x40000) && (s == 11 || s == 13 || s == 15)) { reps = 2; g.E.kind = 6; }
            if ((DBG_DOUBLE & 0x80000) && (s == 11 || s == 13 || s == 15)) { reps = 2; }
            if ((DBG_DOUBLE & 0x100000) && (s == 12 || s == 14 || s == 16)) { reps = 2; g.E.kind = 6; }
            if ((DBG_DOUBLE & 0x200000) && (s == 12 || s == 14 || s == 16)) { reps = 2; g.E.kind = 7; }
            for (int rep = 0; rep < reps; ++rep) { if (rep == reps - 1) g.E.kind = k0;
                pg8::gemm_phase<pg8::EpiGen, pg8::StaticOrder, false>(lds, gg, S, g.E, nullptr); __syncthreads(); }
#else
            pg8::gemm_phase<pg8::EpiGen, pg8::StaticOrder, false>(lds, gg, S, g.E, nullptr);
            __syncthreads();
#endif
        } else {
#if DBG_DOUBLE & 2
            if (s == 8) for (int pos = wg; pos < 4096; pos += nwg) { unit_call<UN_DSEL>(l, lds, pos, kplo, kphi); unit_call<UN_DATT>(l, lds, pos, kplo, kphi); unit_call<UN_DUP>(l, lds, pos, kplo, kphi); }
#endif
#if DBG_DOUBLE & 4
            if (s == 9) for (int u = wg; u < NB * 8 * 4; u += nwg) { unit_call<UN_R2SETUP>(l, lds, u, kplo, kphi);
                if ((threadIdx.x >> 6) < 4) unit_call<UN_R2SCAN>(l, lds, u, kplo, kphi); else unit_call<UN_R2PREP>(l, lds, u, kplo, kphi); }
#endif
#if DBG_DOUBLE & 8
            if (s == 20) phase_call<PH_E2>(l, lds, kplo, kphi);
#endif
#if DBG_DOUBLE & 16
            if (s == 21) phase_call<PH_E3DRY>(l, lds, kplo, kphi);
#endif
#if DBG_DOUBLE & 32
            if (s == 0) phase_call<PH_A1>(l, lds, kplo, kphi);
            if (s == 2) phase_call<PH_G1>(l, lds, kplo, kphi);
            if (s == 4) phase_call<PH_G3>(l, lds, kplo, kphi);
            if (s == 5) phase_call<PH_D1>(l, lds, kplo, kphi);
            if (s == 18) phase_call<PH_A1F>(l, lds, kplo, kphi);
#endif
            switch (s) {
            case 0: phase_call<PH_A1>(l, lds, kplo, kphi); break;
            case 2: phase_call<PH_G1>(l, lds, kplo, kphi); break;
            case 3: phase_call<PH_G2>(l, lds, kplo, kphi); break;
            case 4: phase_call<PH_G3>(l, lds, kplo, kphi); break;
            case 5: phase_call<PH_D1>(l, lds, kplo, kphi); break;
            case 8: for (int pos = wg; pos < 4096; pos += nwg) {
#if DBG_DOUBLE & 64
                unit_call<UN_DSEL>(l, lds, pos, kplo, kphi);
#endif
                unit_call<UN_DSEL>(l, lds, pos, kplo, kphi);
#if DBG_DOUBLE & 128
                unit_call<UN_DATT>(l, lds, pos, kplo, kphi);
#endif
                unit_call<UN_DATT>(l, lds, pos, kplo, kphi); unit_call<UN_DUP>(l, lds, pos, kplo, kphi); } break;
            case 9: for (int u = wg; u < NB * 8 * 4; u += nwg) { unit_call<UN_R2SETUP>(l, lds, u, kplo, kphi);
                if ((threadIdx.x >> 6) < 4) unit_call<UN_R2SCAN>(l, lds, u, kplo, kphi); else unit_call<UN_R2PREP>(l, lds, u, kplo, kphi); } break;
            case 10: for (int u = wg; u < NTOK / 32; u += nwg) {
#if DBG_DOUBLE & 4096
                unit_call<UN_R3AB>(l, lds, u, kplo, kphi);
#endif
                unit_call<UN_R3AB>(l, lds, u, kplo, kphi); unit_call<UN_R3C>(l, lds, u, kplo, kphi); } break;
            case 18: phase_call<PH_A1F>(l, lds, kplo, kphi); break;
            case 20: phase_call<PH_E2>(l, lds, kplo, kphi); break;
            default: if (E3_SLAB) { for (int u = wg; u < NTOK / 256; u += nwg) {
#if DBG_DOUBLE & 0x400000
                         unit_call<UN_E3A>(l, lds, u, kplo, kphi);
#endif
                         unit_call<UN_E3A>(l, lds, u, kplo, kphi); unit_call<UN_E3B>(l, lds, u, kplo, kphi); } }
                     else phase_call<PH_E3>(l, lds, kplo, kphi);
                     break; }
        }
        const bool nobar = (s == 6) || (s >= 11 && s <= 15);
        if (!nobar) xcd_barrier(bar);
#if DBG_DOUBLE & 32768
        if (!nobar) xcd_barrier(bar);
#endif
    }
    phase_call<PH_FIN>(0, lds, kplo, kphi);
}
#else
template <int PH> __global__ void __launch_bounds__(NTHR, 2) k_phase(Params p, int l) {
    LASP unsigned char* lds = (LASP unsigned char*)smem_dyn;
    run_phase<PH>(p, l, lds, blockIdx.x, gridDim.x);
}
template <int PH> static void launch_phase(const Params& p, int l, int grid, hipStream_t stream) {
    static bool attr = false;
    if (!attr) { hipFuncSetAttribute((const void*)k_phase<PH>, hipFuncAttributeMaxDynamicSharedMemorySize, LDS_BYTES); attr = true; }
    hipLaunchKernelGGL(k_phase<PH>, dim3(grid), dim3(NTHR), LDS_BYTES, stream, p, l);
}
#endif

static size_t carve(size_t& off, size_t bytes) { const size_t o = off; off += (bytes + 255) & ~(size_t)255; return o; }

extern "C" void kernel_launch(void* const* d_in, const int* in_sizes, int n_in, void* d_out, int out_size, void* d_ws, size_t ws_size, hipStream_t stream) {
    (void)in_sizes; (void)out_size;
    if (n_in != 33) { fprintf(stderr, "kernel_launch: expected 33 inputs, got %d\n", n_in); return; }
    Params p; memset(&p, 0, sizeof(p));
    const float* const* in = (const float* const*)d_in;
    p.x = in[0]; p.c = in[1]; p.w_ada = in[2]; p.b_ada = in[3]; p.g_mix = in[4]; p.g_ffn = in[5]; p.w_in = in[6]; p.gla_w_a2 = in[7]; p.gla_b_a = in[8]; p.gla_g_o = in[9];
    p.dsa_g_qc = in[10]; p.dsa_w_uq = in[11]; p.dsa_w_iq = in[12]; p.dsa_g_kv = in[13]; p.dsa_w_uv = in[14];
    p.rw_mu = in[15]; p.rw_w0 = in[16]; p.rw_w_w2 = in[17]; p.rw_a0 = in[18]; p.rw_w_a2 = in[19]; p.rw_w_g2 = in[20]; p.rw_k_k = in[21]; p.rw_k_a = in[22]; p.rw_r_k = in[23];
    p.rw_ln_g = in[24]; p.rw_ln_b = in[25]; p.w_branch = in[26]; p.w_out = in[27]; p.peer_w_q = in[28]; p.peer_keys = in[29]; p.peer_u = in[30]; p.peer_v = in[31]; p.g_final = in[32];
    p.out = (float*)d_out;
    char* ws = (char*)d_ws; size_t off = 0;
    const size_t TB2 = (size_t)NTOK * 2;
    p.bar = (unsigned*)(ws + carve(off, 16384));
    p.mod = (float*)(ws + carve(off, (size_t)NLAYER * 8 * 6144 * 4));
    p.win_t = (bf16_t*)(ws + carve(off, (size_t)NLAYER * 3840 * 1024 * 2));
    p.wg_t = (bf16_t*)(ws + carve(off, (size_t)NLAYER * 3072 * 1024 * 2));
    p.wb_t = (bf16_t*)(ws + carve(off, (size_t)NLAYER * 3 * 1024 * 512 * 2));
    p.wo_t = (bf16_t*)(ws + carve(off, (size_t)NLAYER * 1024 * 1024 * 2));
    p.wq_t = (bf16_t*)(ws + carve(off, (size_t)NLAYER * 1024 * 1024 * 2));
    p.wuq_t = (bf16_t*)(ws + carve(off, (size_t)NLAYER * 1024 * 256 * 2));
    p.wiq_t = (bf16_t*)(ws + carve(off, (size_t)NLAYER * 256 * 256 * 2));
    p.wuv_t = (bf16_t*)(ws + carve(off, (size_t)NLAYER * 8 * 64 * 128 * 2));
    p.pkeys = (bf16_t*)(ws + carve(off, (size_t)NLAYER * 8 * 2 * 128 * 64 * 2));
    p.ww2_t = (bf16_t*)(ws + carve(off, (size_t)NLAYER * 512 * 64 * 2));
    p.wa2_t = (bf16_t*)(ws + carve(off, (size_t)NLAYER * 512 * 64 * 2));
    p.wg2_t = (bf16_t*)(ws + carve(off, (size_t)NLAYER * 512 * 128 * 2));
    p.hbuf = (bf16_t*)(ws + carve(off, TB2 * 1024));
    char* R1 = ws + carve(off, TB2 * 1536);
    p.GQ = (bf16_t*)R1; p.GK = (bf16_t*)(R1 + TB2 * 256); p.GR = (bf16_t*)(R1 + TB2 * 512); p.GS = (bf16_t*)(R1 + TB2 * 1024);
    p.GV = (bf16_t*)(ws + carve(off, TB2 * 512));
    p.PB = (bf16_t*)(ws + carve(off, TB2 * 512));
    p.PC = (bf16_t*)(ws + carve(off, TB2 * 1792));
    p.yb = (bf16_t*)(ws + carve(off, TB2 * 512));
    p.yc = (bf16_t*)(ws + carve(off, TB2 * 512));
    p.kvn = (bf16_t*)(ws + carve(off, TB2 * 128));
    p.gdec = (float*)(ws + carve(off, (size_t)NB * NCHUNK * 4 * 64 * 4));
    p.qd = (bf16_t*)R1; p.qi = (bf16_t*)(R1 + TB2 * 1024); p.qn = (bf16_t*)(R1 + TB2 * 1280);
    p.ya = p.GV; p.Gtmp = (bf16_t*)R1; p.merged = p.PC;
    p.qp = (bf16_t*)R1; p.tu = (bf16_t*)(R1 + TB2 * 1024); p.tv = (bf16_t*)(R1 + TB2 * 1280);
    p.pe_idx = (unsigned short*)p.PC; p.pe_gate = (float*)((char*)p.PC + (size_t)NTOK * 128 * 2);
    if (off > ws_size) { fprintf(stderr, "kernel_launch: workspace too small: need %zu, have %zu\n", off, ws_size); return; }
    static int grid = 0;
    if (!grid) { int dev = 0, cus = 0; hipGetDevice(&dev); hipDeviceGetAttribute(&cus, hipDeviceAttributeMultiprocessorCount, dev); grid = cus > 0 ? cus : 256; if (grid > 256) grid = 256; }
#if MK_ONE_LAUNCH
    static bool attr = false;
    if (!attr) { if (hipFuncSetAttribute((const void*)mega_fwd, hipFuncAttributeMaxDynamicSharedMemorySize, LDS_BYTES) != hipSuccess) fprintf(stderr, "kernel_launch: hipFuncSetAttribute failed\n"); attr = true; }
    hipMemsetAsync(p.bar, 0, 16384, stream);
    hipLaunchKernelGGL(mega_fwd, dim3(grid), dim3(NTHR), LDS_BYTES, stream, p);
#else
#if DBG_MODE == 1
    hipLaunchKernelGGL(k_dbg_copy, dim3(grid), dim3(NTHR), 0, stream, p.x, p.out);
    launch_phase<PH_FIN>(p, 0, grid, stream);
    return;
#endif
#if DBG_MODE == 2
    {   launch_phase<PH_W>(p, 0, grid, stream); launch_phase<PH_W1>(p, 0, grid, stream); launch_phase<PH_W2>(p, 0, grid, stream); launch_phase<PH_W3>(p, 0, grid, stream); launch_phase<PH_W4>(p, 0, grid, stream);
        const bf16_t* db = nullptr; size_t dn = 0; const int l = 0;
        launch_phase<PH_A1>(p, l, grid, stream); db = p.hbuf; dn = (size_t)NTOK * 1024;
        if (DBG_STOP >= PH_A2) { launch_phase<PH_A2>(p, l, grid, stream); db = DBG_A2BUF; dn = (size_t)NTOK * DBG_A2N; }
        if (DBG_STOP >= PH_G1) { launch_phase<PH_G1>(p, l, grid, stream); db = DBG_G1BUF; dn = DBG_G1N; }
        if (DBG_STOP >= PH_G2) { launch_phase<PH_G2>(p, l, grid, stream); db = p.GS; dn = (size_t)NTOK * 512; }
        if (DBG_STOP >= PH_G3) { launch_phase<PH_G3>(p, l, grid, stream); db = p.ya; dn = (size_t)NTOK * 512; }
        if (DBG_STOP >= PH_D1) { launch_phase<PH_D1>(p, l, grid, stream); db = p.qn; dn = (size_t)NTOK * 256; }
        if (DBG_STOP >= PH_D2) { launch_phase<PH_D2>(p, l, grid, stream); db = p.qd; dn = (size_t)NTOK * 1280; }
        if (DBG_STOP >= PH_D34) { launch_phase<PH_D34>(p, l, grid, stream); db = p.yb; dn = (size_t)NTOK * 512; }
        if (DBG_STOP >= PH_R2) { launch_phase<PH_R2>(p, l, grid, stream); db = p.yc; dn = (size_t)NTOK * 512; }
        if (DBG_STOP >= PH_R3) { launch_phase<PH_R3>(p, l, grid, stream); db = p.yc; dn = (size_t)NTOK * 512; }
        if (DBG_STOP >= PH_M) { launch_phase<PH_M>(p, l, grid, stream); db = p.merged; dn = (size_t)NTOK * 1024; }
        if (DBG_STOP >= PH_O) { launch_phase<PH_O>(p, l, grid, stream); db = nullptr; }
        if (DBG_STOP >= PH_A1F) { launch_phase<PH_A1F>(p, l, grid, stream); }
        if (DBG_STOP >= PH_E1) { launch_phase<PH_E1>(p, l, grid, stream); db = p.qp; dn = (size_t)NTOK * 1024; }
        if (DBG_STOP >= PH_E2) { launch_phase<PH_E2>(p, l, grid, stream); db = (const bf16_t*)p.pe_gate; dn = (size_t)NTOK * 256; }
        if (DBG_STOP >= PH_E3) { launch_phase<PH_E3>(p, l, grid, stream); db = nullptr; }
        if (db) hipLaunchKernelGGL(k_dbg_dump, dim3(grid), dim3(NTHR), 0, stream, db, dn, p.out);
        return; }
#endif
    launch_phase<PH_W>(p, 0, grid, stream); launch_phase<PH_W1>(p, 0, grid, stream); launch_phase<PH_W2>(p, 0, grid, stream); launch_phase<PH_W3>(p, 0, grid, stream); launch_phase<PH_W4>(p, 0, grid, stream);
    for (int l = 0; l < DBG_LAYERS; ++l) {
        launch_phase<PH_A1>(p, l, grid, stream); launch_phase<PH_A2>(p, l, grid, stream);
        launch_phase<PH_G1>(p, l, grid, stream); launch_phase<PH_G2>(p, l, grid, stream); launch_phase<PH_G3>(p, l, grid, stream);
        launch_phase<PH_D1>(p, l, grid, stream); launch_phase<PH_D2>(p, l, grid, stream); launch_phase<PH_D34>(p, l, grid, stream);
        launch_phase<PH_R2>(p, l, grid, stream); launch_phase<PH_R3>(p, l, grid, stream);
        launch_phase<PH_M>(p, l, grid, stream); launch_phase<PH_O>(p, l, grid, stream);
        launch_phase<PH_A1F>(p, l, grid, stream); launch_phase<PH_E1>(p, l, grid, stream); launch_phase<PH_E2>(p, l, grid, stream); launch_phase<PH_E3>(p, l, grid, stream);
    }
    launch_phase<PH_FIN>(p, 0, grid, stream);
#endif
}
```

```cpp
#include <hip/hip_runtime.h>
#include <stdint.h>
#include <stdio.h>
#include <string.h>

#ifndef MK_ONE_LAUNCH
#define MK_ONE_LAUNCH 1
#endif

typedef unsigned short bf16_t;
typedef short bf16x8 __attribute__((ext_vector_type(8)));
typedef float f32x4 __attribute__((ext_vector_type(4)));
typedef float f32x2 __attribute__((ext_vector_type(2)));
typedef unsigned u32x4 __attribute__((ext_vector_type(4)));
typedef unsigned u32x2 __attribute__((ext_vector_type(2)));

#define XB_TMO      128
#define XB_XCNT(j)  (256  + 64 * (j))
#define XB_XSUB(j)  (1280 + 64 * (j))
#define XB_XGEN(j)  (2304 + 64 * (j))
#define XB_TOP      3328
#define XB_TOPGEN   3392
#define XCD_BAR_WORDS 3456
#define XB_SPIN_CAP (1u << 24)
#define LAS __attribute__((address_space(3)))

__device__ __forceinline__ unsigned xb_ld(unsigned* p)              { return __hip_atomic_load(p, __ATOMIC_RELAXED, __HIP_MEMORY_SCOPE_AGENT); }
__device__ __forceinline__ unsigned xb_add(unsigned* p, unsigned v) { return __hip_atomic_fetch_add(p, v, __ATOMIC_RELAXED, __HIP_MEMORY_SCOPE_AGENT); }
__device__ __forceinline__ unsigned xb_xcc_id() { return (unsigned)__builtin_amdgcn_s_getreg((3 << 11) | 20) & 0xFu; }
#define XB_SPIN(cond, bar) do { unsigned _sp = 0; while (cond) { __builtin_amdgcn_s_sleep(1); \
    if ((++_sp & 255u) == 0u) { if (xb_ld(&(bar)[XB_TMO])) break; if (_sp > XB_SPIN_CAP) { atomicAdd(&(bar)[XB_TMO], 1u); break; } } } } while (0)

struct XcdBarrier {
    unsigned* bar; unsigned x;
    volatile LAS unsigned* st;
};

__device__ __forceinline__ XcdBarrier xcd_barrier_post(unsigned* bar, volatile LAS unsigned* st) {
    XcdBarrier b; b.bar = bar; b.x = xb_xcc_id(); b.st = st;
    if (threadIdx.x == 0) (void)xb_add(&bar[XB_XCNT(b.x)], 1u);
    return b;
}
__device__ __forceinline__ void xcd_barrier_complete(unsigned* bar, unsigned x, unsigned& nloc, unsigned& nx) {
    const unsigned G = gridDim.x * gridDim.y * gridDim.z;
    unsigned sum, cnt, mine, sp = 0u;
    for (;;) {
        sum = 0u; cnt = 0u; mine = 0u;
#pragma unroll
        for (unsigned j = 0; j < 16; ++j) { const unsigned c = xb_ld(&bar[XB_XCNT(j)]); sum += c; cnt += (c > 0u) ? 1u : 0u; mine = (j == x) ? c : mine; }
        if (sum == G) break;
        __builtin_amdgcn_s_sleep(1);
        if ((++sp & 255u) == 0u) { if (xb_ld(&bar[XB_TMO])) break; if (sp > XB_SPIN_CAP) { atomicAdd(&bar[XB_TMO], 1u); break; } }
    }
    nloc = mine > 0u ? mine : 1u; nx = cnt > 0u ? cnt : 1u;
}

__device__ __forceinline__ void xcd_barrier(const XcdBarrier& b) {
    asm volatile("s_waitcnt vmcnt(0)" ::: "memory");
    __syncthreads();
    if (threadIdx.x == 0) {
        unsigned* bar = b.bar;
        __builtin_amdgcn_s_waitcnt(0);
        unsigned nloc = b.st[0], nx = b.st[1];
        if (nloc == 0u) { xcd_barrier_complete(bar, b.x, nloc, nx); b.st[0] = nloc; b.st[1] = nx; }
        const unsigned old = xb_add(&bar[XB_XSUB(b.x)], 1u);
        const unsigned gen = old / nloc;
        if (old + 1u == (gen + 1u) * nloc) {
            __builtin_amdgcn_fence(__ATOMIC_RELEASE, "agent");
            asm volatile("s_waitcnt vmcnt(0)" ::: "memory");
            const unsigned og = xb_add(&bar[XB_TOP], 1u);
            const unsigned tg = og / nx;
            if (og + 1u == (tg + 1u) * nx) xb_add(&bar[XB_TOPGEN], 1u);
            else XB_SPIN(xb_ld(&bar[XB_TOPGEN]) == tg, bar);
            __builtin_amdgcn_fence(__ATOMIC_ACQUIRE, "agent");
            xb_add(&bar[XB_XGEN(b.x)], 1u);
            asm volatile("s_waitcnt vmcnt(0)" ::: "memory");
        } else {
            XB_SPIN(xb_ld(&bar[XB_XGEN(b.x)]) == gen, bar);
            __builtin_amdgcn_fence(__ATOMIC_ACQUIRE, "agent");
            asm volatile("s_waitcnt vmcnt(0)" ::: "memory");
        }
    }
    __syncthreads();
}
namespace pg8 {
#define PG8_LAS __attribute__((address_space(3)))
typedef unsigned short bf16_t;
typedef short bf16x8 __attribute__((ext_vector_type(8)));
typedef float f32x4 __attribute__((ext_vector_type(4)));
typedef unsigned u32x4 __attribute__((ext_vector_type(4)));
constexpr int BM = 256, BK = 64, HALF = 128, HTB = HALF * BK * 2  , STAGE_BYTES = 8 * HTB, NXCD = 8, WGM = 8;

__host__ __device__ __forceinline__ int lds_byte(int r, int c) { const int st = (r >> 4) * 2 + (c >> 5), rr = r & 15, cc = c & 31, ob = rr * 64 + cc * 2; return st * 1024 + (ob ^ (((ob >> 9) & 1) << 5)); }
__host__ __device__ __forceinline__ void stage_rc(int b, int& R, int& C) { const int st = b / 1024, sb = b % 1024, swz = sb ^ (((sb >> 9) & 1) << 5); R = (st >> 1) * 16 + swz / 64; C = (st & 1) * 32 + (swz % 64) / 2; }
__host__ __device__ __forceinline__ int perm32(int rho) { const int n = rho >> 4, i = rho & 15; return 8 * (i >> 2) + 4 * n + (i & 3); }

struct Unit { int pm, pn; };
struct Gemm { const bf16_t* A; const bf16_t* Bt; int M, N, K; };

struct StaticOrder {
    int nM, nN, nwg, G, c;
    __host__ __device__ void init(int M, int N, int G_, int c_) { nM = M / BM; nN = N / BM; nwg = nM * nN; G = G_; c = c_; }
    __host__ __device__ bool next(int i, Unit& u) const {
        const long L = (long)i * G + c; if (L >= nwg) return false;
        int wgid = (int)L; { const int q = nwg / NXCD, r = nwg % NXCD, xcd = wgid % NXCD, off = wgid / NXCD; wgid = (xcd < r ? xcd * (q + 1) : r * (q + 1) + (xcd - r) * q) + off; }
        const int nig = WGM * nN, gid = wgid / nig, fm = gid * WGM, gsz = (nM - fm) < WGM ? (nM - fm) : WGM;
        u.pm = fm + ((wgid % nig) % gsz); u.pn = (wgid % nig) / gsz; return true;
    }
    __device__ __forceinline__ void a_ready(const Unit&) const {}
    __device__ __forceinline__ void done(const Unit&) const {}
};
struct CountedOrder : StaticOrder {
    const unsigned* ready; unsigned need; unsigned* tmo;
    __device__ __forceinline__ void a_ready(const Unit& u) const {
        if (threadIdx.x < 64) {
            const unsigned long long t0 = __builtin_amdgcn_s_memrealtime(); unsigned polls = 0;
            while ((unsigned)__builtin_amdgcn_readfirstlane(__hip_atomic_load(ready + 64 * u.pm, __ATOMIC_RELAXED, __HIP_MEMORY_SCOPE_AGENT)) < need) {
                if ((++polls & 255u) == 0u && __builtin_amdgcn_readfirstlane(__hip_atomic_load(tmo, __ATOMIC_RELAXED, __HIP_MEMORY_SCOPE_AGENT)) != 0u) break;
                if (__builtin_amdgcn_s_memrealtime() - t0 > 2000000ull) {
                    if (threadIdx.x == 0) { unsigned expect = 0u; __hip_atomic_compare_exchange_strong(tmo + 1, &expect, 0x600u | (unsigned)(u.pm & 0xff), __ATOMIC_RELAXED, __ATOMIC_RELAXED, __HIP_MEMORY_SCOPE_AGENT); __hip_atomic_store(tmo, 1u, __ATOMIC_RELAXED, __HIP_MEMORY_SCOPE_AGENT); }
                    break; }
                __builtin_amdgcn_s_sleep(2); }
            __builtin_amdgcn_fence(__ATOMIC_ACQUIRE, "agent");
            asm volatile("s_waitcnt vmcnt(0)" ::: "memory");
        }
#if !defined(BROKEN_HOOK_NO_BARRIER)
        asm volatile("" ::: "memory"); __builtin_amdgcn_s_barrier(); asm volatile("" ::: "memory");
#endif
    }
};

typedef __bf16 bf16x2_t __attribute__((ext_vector_type(2)));
__device__ __forceinline__ unsigned cvt_pk_bf16(float lo, float hi) { typedef float f2_t __attribute__((ext_vector_type(2))); const f2_t v = {lo, hi}; const bf16x2_t b = __builtin_convertvector(v, bf16x2_t); return __builtin_bit_cast(unsigned, b); }
typedef float f32x2 __attribute__((ext_vector_type(2)));
__device__ __forceinline__ f32x2 gelu_pk(f32x2 v) {
    const f32x2 av = __builtin_elementwise_abs(v), d = av * 0.2316418882f + 1.0f;
    f32x2 t; t.x = __builtin_amdgcn_rcpf(d.x); t.y = __builtin_amdgcn_rcpf(d.y);
    f32x2 q = t * 0.5307027145f + (-0.7265760135f); q = q * t + 0.7107068705f; q = q * t + (-0.142248368f); q = q * t + 0.127414796f; q = q * t;
    const f32x2 s = (v * v) * (-0.72134752044f);
    f32x2 e; e.x = __builtin_amdgcn_exp2f(s.x); e.y = __builtin_amdgcn_exp2f(s.y);
    const f32x2 m = v * (q * e), r = v - m;
    f32x2 o; o.x = v.x < 0.f ? m.x : r.x; o.y = v.y < 0.f ? m.y : r.y; return o;
}

struct EpiF32 {
    static constexpr bool PERM = false, AFTER_DRAIN = false;
    float* C; int ldc; const float* bias;
    __device__ __forceinline__ void operator()(const f32x4 (&acc)[2][2][4][2], const Unit& u, int wr, int wc, int fr, int fq) const {
        const int row0 = u.pm * BM + wr * 64 + fr, col0 = u.pn * BM + wc * 32 + 4 * fq;
        f32x4 bv[2][2];
#pragma unroll
        for (int bj = 0; bj < 2; ++bj)
#pragma unroll
            for (int n = 0; n < 2; ++n) bv[bj][n] = bias ? *(const f32x4*)(bias + col0 + bj * HALF + n * 16) : (f32x4){0.f, 0.f, 0.f, 0.f};
#pragma unroll
        for (int ai = 0; ai < 2; ++ai)
#pragma unroll
            for (int m = 0; m < 4; ++m) { float* rowp = C + (size_t)(row0 + ai * HALF + m * 16) * ldc + col0;
#pragma unroll
                for (int bj = 0; bj < 2; ++bj)
#pragma unroll
                    for (int n = 0; n < 2; ++n) *(f32x4*)(rowp + bj * HALF + n * 16) = acc[ai][bj][m][n] + bv[bj][n]; }
    }
};
template <int ACT  > struct EpiBf16 {
    static constexpr bool PERM = true, AFTER_DRAIN = false;
    bf16_t* O; int ldc; const float* bias; int split_cols; size_t split_stride;
    __device__ __forceinline__ void operator()(const f32x4 (&acc)[2][2][4][2], const Unit& u, int wr, int wc, int fr, int fq) const {
        const int row0 = u.pm * BM + wr * 64 + fr; int colt = u.pn * BM; bf16_t* base = O;
        if (split_cols) { const int t = colt / split_cols; base += (size_t)t * split_stride; colt -= t * split_cols; }
        const int col0 = colt + wc * 32 + 8 * fq, bcol0 = u.pn * BM + wc * 32 + 8 * fq;
        f32x4 bv[2][2];
#pragma unroll
        for (int bj = 0; bj < 2; ++bj)
#pragma unroll
            for (int n = 0; n < 2; ++n) bv[bj][n] = bias ? *(const f32x4*)(bias + bcol0 + bj * HALF + 4 * n) : (f32x4){0.f, 0.f, 0.f, 0.f};
#pragma unroll
        for (int ai = 0; ai < 2; ++ai)
#pragma unroll
            for (int m = 0; m < 4; ++m) { bf16_t* rowp = base + (size_t)(row0 + ai * HALF + m * 16) * ldc + col0;
#pragma unroll
                for (int bj = 0; bj < 2; ++bj) { f32x4 v0 = acc[ai][bj][m][0] + bv[bj][0], v1 = acc[ai][bj][m][1] + bv[bj][1];
                    if (ACT == 1) { f32x2 a = gelu_pk((f32x2){v0[0], v0[1]}), b = gelu_pk((f32x2){v0[2], v0[3]}), c = gelu_pk((f32x2){v1[0], v1[1]}), d = gelu_pk((f32x2){v1[2], v1[3]});
                        v0 = (f32x4){a.x, a.y, b.x, b.y}; v1 = (f32x4){c.x, c.y, d.x, d.y}; }
                    if (ACT == 2) {
#pragma unroll
                        for (int j = 0; j < 4; ++j) { v0[j] = 0.5f * v0[j] * (1.0f + erff(v0[j] * 0.70710678f)); v1[j] = 0.5f * v1[j] * (1.0f + erff(v1[j] * 0.70710678f)); } }
                    u32x4 w; w.x = cvt_pk_bf16(v0[0], v0[1]); w.y = cvt_pk_bf16(v0[2], v0[3]); w.z = cvt_pk_bf16(v1[0], v1[1]); w.w = cvt_pk_bf16(v1[2], v1[3]);
                    *(u32x4*)(rowp + bj * HALF) = w; } }
    }
};
template <class Epi, class Sched, bool STAMP = false>
__device__ __forceinline__ void gemm_phase(PG8_LAS unsigned char* lds, const Gemm g, const Sched& S, const Epi& E, unsigned long long* stamps) {
    const int tid = threadIdx.x, wid = __builtin_amdgcn_readfirstlane(tid >> 6), lane = tid & 63, wr = wid >> 2, wc = wid & 3, fr = lane & 15, fq = lane >> 4;
    const int K = g.K, nt = K / BK;
    int ts_lo = 0, ts_hi = 0, nts = 0; const unsigned long long rt_entry = STAMP ? (unsigned long long)wall_clock64() : 0ull;
#define PG8_STAMP() do { if (STAMP && wid == 0 && nts < 64) { const unsigned long long _c = (unsigned long long)clock64(); \
        ts_lo = (lane == nts) ? (int)(unsigned)_c : ts_lo; ts_hi = (lane == nts) ? (int)(unsigned)(_c >> 32) : ts_hi; ++nts; } } while (0)
    PG8_STAMP();
    unsigned voffA[2], voffB[2];
#pragma unroll
    for (int i = 0; i < 2; ++i) { int R, C; stage_rc(tid * 16 + i * 8192, R, C); const int Rb = Epi::PERM ? ((R & ~31) + perm32(R & 31)) : R;
        voffA[i] = (unsigned)(R * K + C) * 2u; voffB[i] = (unsigned)(Rb * K + C) * 2u; }
    const size_t kstep = (size_t)(BK * 2);
    const size_t hstep = (size_t)HALF * K * 2;
    const size_t tstep = 2 * hstep;
    const unsigned ldsw = (unsigned)wid * 1024u;
    const int aoff = lds_byte(wr * 64 + fr, fq * 8), boff = lds_byte(wc * 32 + fr, fq * 8);
#define PG8_SA(b, h) (((b) * 2 + (h)) * HTB)
#define PG8_SB(b, h) ((4 + (b) * 2 + (h)) * HTB)
#define PG8_STAGE(bufoff, gbase, voff) do { _Pragma("unroll") for (int _i = 0; _i < 2; ++_i) \
        __builtin_amdgcn_global_load_lds((const unsigned*)((const char*)(gbase) + (voff)[_i]), (PG8_LAS unsigned*)(lds + (bufoff) + ldsw + _i * 8192), 16, 0, 0); } while (0)
#define PG8_LDA(dst, b, h) do { _Pragma("unroll") for (int m = 0; m < 4; ++m) _Pragma("unroll") for (int k = 0; k < 2; ++k) dst[m][k] = *(const PG8_LAS bf16x8*)(lds + PG8_SA(b, h) + aoff + m * 2048 + k * 1024); } while (0)
#define PG8_LDB(dst, b, h) do { _Pragma("unroll") for (int n = 0; n < 2; ++n) _Pragma("unroll") for (int k = 0; k < 2; ++k) dst[n][k] = *(const PG8_LAS bf16x8*)(lds + PG8_SB(b, h) + boff + n * 2048 + k * 1024); } while (0)
#define PG8_MMA(ai, bj, At, Bt) do { __builtin_amdgcn_s_setprio(1); _Pragma("unroll") for (int m = 0; m < 4; ++m) _Pragma("unroll") for (int n = 0; n < 2; ++n) _Pragma("unroll") for (int k = 0; k < 2; ++k) \
        acc[ai][bj][m][n] = __builtin_amdgcn_mfma_f32_16x16x32_bf16(Bt[n][k], At[m][k], acc[ai][bj][m][n], 0, 0, 0); __builtin_amdgcn_s_setprio(0); } while (0)
#define PG8_WAIT_V(n) asm volatile("s_waitcnt vmcnt(" #n ")" ::: "memory")
#define PG8_WAIT_L(n) asm volatile("s_waitcnt lgkmcnt(" #n ")" ::: "memory")
#define PG8_BAR __builtin_amdgcn_s_barrier()
#define PG8_SCHED __builtin_amdgcn_sched_barrier(0)
    Unit cur, nxt; int ui = 0;
    if (!S.next(0, cur)) return;
    f32x4 acc[2][2][4][2];
#pragma unroll
    for (int a = 0; a < 2; ++a)
#pragma unroll
        for (int b = 0; b < 2; ++b)
#pragma unroll
            for (int m = 0; m < 4; ++m)
#pragma unroll
                for (int n = 0; n < 2; ++n) acc[a][b][m][n] = (f32x4){0.f, 0.f, 0.f, 0.f};
    bf16x8 At[4][2], B0[2][2], B1[2][2];
    const char* cA = (const char*)g.A + (size_t)cur.pm * tstep; const char* cB = (const char*)g.Bt + (size_t)cur.pn * tstep;
    S.a_ready(cur);
    PG8_STAGE(PG8_SB(0, 0), cB, voffB); PG8_STAGE(PG8_SA(0, 0), cA, voffA); PG8_STAGE(PG8_SB(0, 1), cB + hstep, voffB); PG8_STAGE(PG8_SA(0, 1), cA + hstep, voffA);
    if (wr == 1) PG8_BAR;
    PG8_WAIT_V(4); PG8_BAR;
    PG8_STAGE(PG8_SB(1, 0), cB + kstep, voffB); PG8_STAGE(PG8_SA(1, 0), cA + kstep, voffA); PG8_STAGE(PG8_SB(1, 1), cB + hstep + kstep, voffB);
    PG8_WAIT_V(6); PG8_BAR;
    PG8_STAMP();
    for (;;) {
        const bool has_next = S.next(ui + 1, nxt);
        const char* nA = has_next ? (const char*)g.A + (size_t)nxt.pm * tstep : cA; const char* nB = has_next ? (const char*)g.Bt + (size_t)nxt.pn * tstep : cB;
        for (int t = 0; t < nt; t += 2) {
            const bool last = (t == nt - 2);
            const char* a1 = cA + (size_t)(t + 1) * kstep;
            const char* a2 = last ? nA : cA + (size_t)(t + 2) * kstep; const char* b2 = last ? nB : cB + (size_t)(t + 2) * kstep;
            const char* a3 = a2 + kstep; const char* b3 = b2 + kstep;
            if (last && has_next) S.a_ready(nxt);
            PG8_LDB(B0, 0, 0); PG8_SCHED; PG8_LDA(At, 0, 0); PG8_STAGE(PG8_SA(1, 1), a1 + hstep, voffA);
            PG8_WAIT_L(8); PG8_BAR; PG8_WAIT_L(0); PG8_MMA(0, 0, At, B0); PG8_BAR; PG8_SCHED;
            PG8_LDB(B1, 0, 1); PG8_STAGE(PG8_SB(0, 0), b2, voffB);
            PG8_BAR; PG8_WAIT_L(0); PG8_MMA(0, 1, At, B1); PG8_BAR;
            PG8_LDA(At, 0, 1); PG8_STAGE(PG8_SA(0, 0), a2, voffA);
            PG8_BAR; PG8_WAIT_L(0); PG8_MMA(1, 0, At, B0); PG8_BAR; PG8_SCHED;
            PG8_STAGE(PG8_SB(0, 1), b2 + hstep, voffB);
            PG8_WAIT_V(6); PG8_BAR; PG8_MMA(1, 1, At, B1); PG8_BAR;
            PG8_LDB(B0, 1, 0); PG8_SCHED; PG8_LDA(At, 1, 0); PG8_STAGE(PG8_SA(0, 1), a2 + hstep, voffA);
            PG8_WAIT_L(8); PG8_BAR; PG8_WAIT_L(0); PG8_MMA(0, 0, At, B0); PG8_BAR; PG8_SCHED;
            PG8_LDB(B1, 1, 1); PG8_STAGE(PG8_SB(1, 0), b3, voffB);
            PG8_BAR; PG8_WAIT_L(0); PG8_MMA(0, 1, At, B1); PG8_BAR;
            PG8_LDA(At, 1, 1); PG8_STAGE(PG8_SA(1, 0), a3, voffA);
            PG8_BAR; PG8_WAIT_L(0); PG8_MMA(1, 0, At, B0); PG8_BAR; PG8_SCHED;
            PG8_STAGE(PG8_SB(1, 1), b3 + hstep, voffB);
            PG8_WAIT_V(6); PG8_BAR; PG8_MMA(1, 1, At, B1); PG8_BAR;
        }
        PG8_STAMP();
        if constexpr (!Epi::AFTER_DRAIN) { E(acc, cur, wr, wc, fr, fq); S.done(cur); }
        PG8_STAMP();
        if (!has_next) break;
#pragma unroll
        for (int a = 0; a < 2; ++a)
#pragma unroll
            for (int b = 0; b < 2; ++b)
#pragma unroll
                for (int m = 0; m < 4; ++m)
#pragma unroll
                    for (int n = 0; n < 2; ++n) acc[a][b][m][n] = (f32x4){0.f, 0.f, 0.f, 0.f};
        cur = nxt; cA = nA; cB = nB; ++ui;
    }
    PG8_WAIT_V(0);
    if (wr == 0) PG8_BAR;
    PG8_BAR;
    if constexpr (Epi::AFTER_DRAIN) { E.fused(acc, cur, wr, wc, fr, fq, lds, wid, lane); S.done(cur); }
    PG8_STAMP();
    if (STAMP && wid == 0) { stamps[lane] = lane < nts ? (((unsigned long long)(unsigned)ts_hi << 32) | (unsigned)ts_lo) : 0ull;
        if (lane == 62) stamps[62] = rt_entry; if (lane == 63) stamps[63] = (unsigned long long)wall_clock64(); }
#undef PG8_STAMP
#undef PG8_SA
#undef PG8_SB
#undef PG8_STAGE
#undef PG8_LDA
#undef PG8_LDB
#undef PG8_MMA
#undef PG8_WAIT_V
#undef PG8_WAIT_L
#undef PG8_BAR
#undef PG8_SCHED
}
}

constexpr int NB = 8, SEQ = 8192, DM = 1024, NTOK = NB * SEQ, NLAYER = 4, NCHUNK = 128;
constexpr int IN_W = 6868;
constexpr int NTHR = 512;
constexpr int LDS_BYTES = 160 * 1024;
constexpr int LDS_BAR_OFF = LDS_BYTES - 16;
#define LASP __attribute__((address_space(3)))

constexpr int PB_QC = 0, PB_KVC = 256, PB_IK = 384, PB_GALR = 448, PB_IW = 464, PB_LD = 512;
constexpr int PC_R = 0, PC_K = 512, PC_V = 1024, PC_WLR = 1536, PC_ALR = 1600, PC_GLR = 1664, PC_LD = 1792;

struct Params {
    const float *x, *c, *w_ada, *b_ada, *g_mix, *g_ffn, *w_in, *gla_w_a2, *gla_b_a, *gla_g_o, *dsa_g_qc, *dsa_w_uq, *dsa_w_iq, *dsa_g_kv, *dsa_w_uv;
    const float *rw_mu, *rw_w0, *rw_w_w2, *rw_a0, *rw_w_a2, *rw_w_g2, *rw_k_k, *rw_k_a, *rw_r_k, *rw_ln_g, *rw_ln_b, *w_branch, *w_out, *peer_w_q, *peer_keys, *peer_u, *peer_v, *g_final;
    float* out;
    unsigned* bar;
    float* mod;
    bf16_t *win_t, *wg_t, *wb_t, *wo_t, *wq_t, *wuq_t, *wiq_t, *wuv_t, *pkeys, *ww2_t, *wa2_t, *wg2_t;
    bf16_t *hbuf, *GQ, *GK, *GR, *GS, *GV, *PB, *PC, *yb, *yc, *kvn;
    float* gdec;
    bf16_t *qd, *qi, *qn, *ya, *Gtmp, *merged, *qp, *tu, *tv;
    unsigned short* pe_idx; float* pe_gate;
};

typedef __bf16 bf16x2_t __attribute__((ext_vector_type(2)));
__device__ __forceinline__ unsigned pk_bf16(float lo, float hi) { const f32x2 v = {lo, hi}; const bf16x2_t b = __builtin_convertvector(v, bf16x2_t); return __builtin_bit_cast(unsigned, b); }
__device__ __forceinline__ bf16_t f2bf(float f) { return (bf16_t)(pk_bf16(f, 0.f) & 0xffffu); }
__device__ __forceinline__ float bf2f(bf16_t v) { return __uint_as_float(((unsigned)v) << 16); }
__device__ __forceinline__ float bflo(unsigned u) { return __uint_as_float(u << 16); }
__device__ __forceinline__ float bfhi(unsigned u) { return __uint_as_float(u & 0xffff0000u); }
__device__ __forceinline__ float sigmoidf_(float x) { return __builtin_amdgcn_rcpf(1.0f + __expf(-x)); }
__device__ __forceinline__ float siluf_(float x) { return x * __builtin_amdgcn_rcpf(1.0f + __expf(-x)); }
__device__ __forceinline__ float softplusf_(float x) { return fmaxf(x, 0.f) + log1pf(__expf(-fabsf(x))); }
__device__ __forceinline__ float wave_sum(float v) {
#pragma unroll
    for (int o = 32; o >= 1; o >>= 1) v += __shfl_xor(v, o);
    return v;
}
template <int CTRL> __device__ __forceinline__ float dppf(float v) { return __int_as_float(__builtin_amdgcn_update_dpp(0, __float_as_int(v), CTRL, 0xF, 0xF, true)); }
template <int CTRL> __device__ __forceinline__ unsigned dppu(unsigned v) { return (unsigned)__builtin_amdgcn_update_dpp(0, (int)v, CTRL, 0xF, 0xF, true); }
__device__ __forceinline__ float row16_sum(float v) { v += dppf<0xB1>(v); v += dppf<0x4E>(v); v += dppf<0x141>(v); v += dppf<0x140>(v); return v; }
__device__ __forceinline__ float row16_max(float v) { v = fmaxf(v, dppf<0xB1>(v)); v = fmaxf(v, dppf<0x4E>(v)); v = fmaxf(v, dppf<0x141>(v)); v = fmaxf(v, dppf<0x140>(v)); return v; }
#define R16_STEP4(op, ctrl) \
    op " %0, %0, %0 " ctrl " row_mask:0xf bank_mask:0xf bound_ctrl:1\n\t" op " %1, %1, %1 " ctrl " row_mask:0xf bank_mask:0xf bound_ctrl:1\n\t" \
    op " %2, %2, %2 " ctrl " row_mask:0xf bank_mask:0xf bound_ctrl:1\n\t" op " %3, %3, %3 " ctrl " row_mask:0xf bank_mask:0xf bound_ctrl:1\n\t"
#define R16_ALL4(op) "s_nop 1\n\t" R16_STEP4(op, "quad_perm:[1,0,3,2]") R16_STEP4(op, "quad_perm:[2,3,0,1]") R16_STEP4(op, "row_half_mirror") R16_STEP4(op, "row_mirror") "s_nop 1"
__device__ __forceinline__ void row16_max_x4(float& a, float& b, float& c, float& d) { asm(R16_ALL4("v_max_f32_dpp") : "+v"(a), "+v"(b), "+v"(c), "+v"(d)); }
#define R16_STEP4_IN(op, ctrl) \
    op " %0, %4, %4 " ctrl " row_mask:0xf bank_mask:0xf bound_ctrl:1\n\t" op " %1, %5, %5 " ctrl " row_mask:0xf bank_mask:0xf bound_ctrl:1\n\t" \
    op " %2, %6, %6 " ctrl " row_mask:0xf bank_mask:0xf bound_ctrl:1\n\t" op " %3, %7, %7 " ctrl " row_mask:0xf bank_mask:0xf bound_ctrl:1\n\t"
__device__ __forceinline__ void row16_maxu_x4(unsigned (&o)[4], unsigned a, unsigned b, unsigned c, unsigned d) {
    asm("s_nop 1\n\t" R16_STEP4_IN("v_max_u32_dpp", "quad_perm:[1,0,3,2]") R16_STEP4("v_max_u32_dpp", "quad_perm:[2,3,0,1]") R16_STEP4("v_max_u32_dpp", "row_half_mirror") R16_STEP4("v_max_u32_dpp", "row_mirror") "s_nop 1"
        : "=&v"(o[0]), "=&v"(o[1]), "=&v"(o[2]), "=&v"(o[3]) : "v"(a), "v"(b), "v"(c), "v"(d)); }
__device__ __forceinline__ void row16_sum_x4(float& a, float& b, float& c, float& d) { asm(R16_ALL4("v_add_f32_dpp") : "+v"(a), "+v"(b), "+v"(c), "+v"(d)); }
__device__ __forceinline__ unsigned row16_maxu(unsigned v) { unsigned t; t = dppu<0xB1>(v); v = v > t ? v : t; t = dppu<0x4E>(v); v = v > t ? v : t; t = dppu<0x141>(v); v = v > t ? v : t; t = dppu<0x140>(v); v = v > t ? v : t; return v; }
__device__ __forceinline__ unsigned wave_scan_incl(unsigned v) {
    v += (unsigned)__builtin_amdgcn_update_dpp(0, (int)v, 0x111, 0xF, 0xF, false);
    v += (unsigned)__builtin_amdgcn_update_dpp(0, (int)v, 0x112, 0xF, 0xF, false);
    v += (unsigned)__builtin_amdgcn_update_dpp(0, (int)v, 0x114, 0xF, 0xF, false);
    v += (unsigned)__builtin_amdgcn_update_dpp(0, (int)v, 0x118, 0xF, 0xF, false);
    v += (unsigned)__builtin_amdgcn_update_dpp(0, (int)v, 0x142, 0xA, 0xF, false);
    v += (unsigned)__builtin_amdgcn_update_dpp(0, (int)v, 0x143, 0xC, 0xF, false);
    return v;
}
__device__ __forceinline__ unsigned fkey(float f) { unsigned u = __float_as_uint(f); if (f == 0.f) u = 0u; return (u & 0x80000000u) ? ~u : (u | 0x80000000u); }
__device__ __forceinline__ float fkey_inv(unsigned k) { const unsigned u = (k & 0x80000000u) ? (k & 0x7fffffffu) : ~k; return __uint_as_float(u); }

__device__ __forceinline__ bf16x8 ld_frag_g(const bf16_t* p) { return *(const bf16x8*)p; }
#define MFMA16(a, b, c) __builtin_amdgcn_mfma_f32_16x16x32_bf16((a), (b), (c), 0, 0, 0)

namespace pg8 {
struct EpiP {
    static constexpr bool PERM = true, AFTER_DRAIN = false;
    bf16_t *GQ, *GK, *GV, *GR, *PB, *PC;
    __device__ __forceinline__ void operator()(const f32x4 (&acc)[2][2][4][2], const Unit& u, int wr, int wc, int fr, int fq) const {
        const int pn = u.pn; bf16_t* base; int ldc, cb;
        if (pn == 0) { base = GQ; ldc = 256; cb = 0; } else if (pn == 1) { base = GK; ldc = 256; cb = 0; }
        else if (pn < 4) { base = GV; ldc = 512; cb = (pn - 2) * 256; } else if (pn < 6) { base = GR; ldc = 512; cb = (pn - 4) * 256; }
        else if (pn < 8) { base = PB; ldc = 512; cb = (pn - 6) * 256; } else { base = PC; ldc = 1792; cb = (pn - 8) * 256; }
        const int row0 = u.pm * BM + wr * 64 + fr, col0 = cb + wc * 32 + 8 * fq;
#pragma unroll
        for (int ai = 0; ai < 2; ++ai)
#pragma unroll
            for (int m = 0; m < 4; ++m) { bf16_t* rowp = base + (size_t)(row0 + ai * HALF + m * 16) * ldc + col0;
#pragma unroll
                for (int bj = 0; bj < 2; ++bj) { const f32x4 v0 = acc[ai][bj][m][0], v1 = acc[ai][bj][m][1];
                    u32x4 w; w.x = cvt_pk_bf16(v0[0], v0[1]); w.y = cvt_pk_bf16(v0[2], v0[3]); w.z = cvt_pk_bf16(v1[0], v1[1]); w.w = cvt_pk_bf16(v1[2], v1[3]);
                    *(u32x4*)(rowp + bj * HALF) = w; } }
    }
};
template <int SIG> struct EpiStore {
    static constexpr bool PERM = true, AFTER_DRAIN = false;
    bf16_t* O; int ldc;
    __device__ __forceinline__ void operator()(const f32x4 (&acc)[2][2][4][2], const Unit& u, int wr, int wc, int fr, int fq) const {
        const int row0 = u.pm * BM + wr * 64 + fr, col0 = u.pn * BM + wc * 32 + 8 * fq;
#pragma unroll
        for (int ai = 0; ai < 2; ++ai)
#pragma unroll
            for (int m = 0; m < 4; ++m) { bf16_t* rowp = O + (size_t)(row0 + ai * HALF + m * 16) * ldc + col0;
#pragma unroll
                for (int bj = 0; bj < 2; ++bj) { f32x4 v0 = acc[ai][bj][m][0], v1 = acc[ai][bj][m][1];
                    if (SIG) {
#pragma unroll
                        for (int j = 0; j < 4; ++j) { v0[j] = __builtin_amdgcn_rcpf(1.0f + __expf(-v0[j])); v1[j] = __builtin_amdgcn_rcpf(1.0f + __expf(-v1[j])); } }
                    u32x4 w; w.x = cvt_pk_bf16(v0[0], v0[1]); w.y = cvt_pk_bf16(v0[2], v0[3]); w.z = cvt_pk_bf16(v1[0], v1[1]); w.w = cvt_pk_bf16(v1[2], v1[3]);
                    *(u32x4*)(rowp + bj * HALF) = w; } }
    }
};
template <int FIRST> struct EpiMerge {
    static constexpr bool PERM = true, AFTER_DRAIN = false;
    const bf16_t* G; bf16_t* O; int ldc;
    __device__ __forceinline__ void operator()(const f32x4 (&acc)[2][2][4][2], const Unit& u, int wr, int wc, int fr, int fq) const {
        const int row0 = u.pm * BM + wr * 64 + fr, col0 = u.pn * BM + wc * 32 + 8 * fq;
#pragma unroll
        for (int ai = 0; ai < 2; ++ai)
#pragma unroll
            for (int m = 0; m < 4; ++m) { const size_t off = (size_t)(row0 + ai * HALF + m * 16) * ldc + col0;
#pragma unroll
                for (int bj = 0; bj < 2; ++bj) { const f32x4 v0 = acc[ai][bj][m][0], v1 = acc[ai][bj][m][1];
                    const u32x4 g = *(const u32x4*)(G + off + bj * HALF);
                    float o[8];
                    o[0] = __uint_as_float(g.x << 16) * v0[0]; o[1] = __uint_as_float(g.x & 0xffff0000u) * v0[1]; o[2] = __uint_as_float(g.y << 16) * v0[2]; o[3] = __uint_as_float(g.y & 0xffff0000u) * v0[3];
                    o[4] = __uint_as_float(g.z << 16) * v1[0]; o[5] = __uint_as_float(g.z & 0xffff0000u) * v1[1]; o[6] = __uint_as_float(g.w << 16) * v1[2]; o[7] = __uint_as_float(g.w & 0xffff0000u) * v1[3];
                    if (!FIRST) { const u32x4 p = *(const u32x4*)(O + off + bj * HALF);
                        o[0] += __uint_as_float(p.x << 16); o[1] += __uint_as_float(p.x & 0xffff0000u); o[2] += __uint_as_float(p.y << 16); o[3] += __uint_as_float(p.y & 0xffff0000u);
                        o[4] += __uint_as_float(p.z << 16); o[5] += __uint_as_float(p.z & 0xffff0000u); o[6] += __uint_as_float(p.w << 16); o[7] += __uint_as_float(p.w & 0xffff0000u); }
                    u32x4 w; w.x = cvt_pk_bf16(o[0], o[1]); w.y = cvt_pk_bf16(o[2], o[3]); w.z = cvt_pk_bf16(o[4], o[5]); w.w = cvt_pk_bf16(o[6], o[7]);
                    *(u32x4*)(O + off + bj * HALF) = w; } }
    }
};
struct EpiResid {
    static constexpr bool PERM = false, AFTER_DRAIN = false;
    const float* xin; float* xout; const float* gate;
    __device__ __forceinline__ void operator()(const f32x4 (&acc)[2][2][4][2], const Unit& u, int wr, int wc, int fr, int fq) const {
        const int row0 = u.pm * BM + wr * 64 + fr, col0 = u.pn * BM + wc * 32 + 4 * fq;
        const float* gp = gate + (size_t)((u.pm * BM) >> 13) * 6144;
        f32x4 gv[2][2];
#pragma unroll
        for (int bj = 0; bj < 2; ++bj)
#pragma unroll
            for (int n = 0; n < 2; ++n) gv[bj][n] = *(const f32x4*)(gp + col0 + bj * HALF + n * 16);
#pragma unroll
        for (int ai = 0; ai < 2; ++ai)
#pragma unroll
            for (int m = 0; m < 4; ++m) { const size_t off = (size_t)(row0 + ai * HALF + m * 16) * 1024 + col0;
#pragma unroll
                for (int bj = 0; bj < 2; ++bj)
#pragma unroll
                    for (int n = 0; n < 2; ++n) { const f32x4 xi = *(const f32x4*)(xin + off + bj * HALF + n * 16);
                        *(f32x4*)(xout + off + bj * HALF + n * 16) = xi + gv[bj][n] * acc[ai][bj][m][n]; } }
    }
};

#ifndef EPI_DEPTH
#define EPI_DEPTH 2
#endif
#ifndef EPI_DEPTH34
#define EPI_DEPTH34 3
#endif
#ifndef EPI_DEPTH5
#define EPI_DEPTH5 EPI_DEPTH
#endif
struct EpiGen {
    static constexpr bool PERM = true, AFTER_DRAIN = false;
    int kind; int ldc;
    bf16_t* O; const bf16_t* G;
    bf16_t *GQ, *GK, *GV, *GR, *PB, *PC;
    const float* xin; float* xout; const float* gate;
    __device__ __forceinline__ void operator()(const f32x4 (&acc)[2][2][4][2], const Unit& u, int wr, int wc, int fr, int fq) const {
        const int row0 = u.pm * BM + wr * 64 + fr;
#ifdef DBG_DOUBLE
        if (kind == 6) return;
        const float pmul = kind == 7 ? 0.f : 1.f;
#define EPI_PMUL(x) ((x) * pmul)
#define EPI_K4(k) ((k) <= 4 || (k) == 7)
#else
#define EPI_PMUL(x) (x)
#define EPI_K4(k) ((k) <= 4)
#endif
        if (kind <= 2) {
            bf16_t* base = O; int ld = ldc, cb = u.pn * BM;
            if (kind == 0) { const int pn = u.pn;
                if (pn == 0) { base = GQ; ld = 256; cb = 0; } else if (pn == 1) { base = GK; ld = 256; cb = 0; }
                else if (pn < 4) { base = GV; ld = 512; cb = (pn - 2) * 256; } else if (pn < 6) { base = GR; ld = 512; cb = (pn - 4) * 256; }
                else if (pn < 8) { base = PB; ld = 512; cb = (pn - 6) * 256; } else { base = PC; ld = 1792; cb = (pn - 8) * 256; } }
            const int col0 = cb + wc * 32 + 8 * fq; const bool sig = kind == 2;
#pragma unroll
            for (int ai = 0; ai < 2; ++ai)
#pragma unroll
                for (int m = 0; m < 4; ++m) { bf16_t* rowp = base + (size_t)(row0 + ai * HALF + m * 16) * ld + col0;
#pragma unroll
                    for (int bj = 0; bj < 2; ++bj) { f32x4 v0 = acc[ai][bj][m][0], v1 = acc[ai][bj][m][1];
                        if (sig) {
#pragma unroll
                            for (int j = 0; j < 4; ++j) { v0[j] = __builtin_amdgcn_rcpf(1.0f + __expf(-v0[j])); v1[j] = __builtin_amdgcn_rcpf(1.0f + __expf(-v1[j])); } }
                        u32x4 w; w.x = cvt_pk_bf16(v0[0], v0[1]); w.y = cvt_pk_bf16(v0[2], v0[3]); w.z = cvt_pk_bf16(v1[0], v1[1]); w.w = cvt_pk_bf16(v1[2], v1[3]);
                        *(u32x4*)(rowp + bj * HALF) = w; } }
        } else if (EPI_K4(kind)) {
            const int col0 = u.pn * BM + wc * 32 + 8 * fq; const bool first = kind == 3;
            const u32x4 z4 = {0u, 0u, 0u, 0u};
            u32x4 gq[EPI_DEPTH34][2], pq[EPI_DEPTH34][2];
#define EPI_LD34(am_, slot_) do { const int ai2 = (am_) >> 2, m2 = (am_) & 3; const size_t off2 = (size_t)(row0 + ai2 * HALF + m2 * 16) * 1024 + col0; \
                _Pragma("unroll") for (int bj = 0; bj < 2; ++bj) { gq[slot_][bj] = *(const u32x4*)(G + off2 + bj * HALF); pq[slot_][bj] = first ? z4 : *(const u32x4*)(O + off2 + bj * HALF); } } while (0)
#pragma unroll
            for (int d = 0; d < EPI_DEPTH34; ++d) EPI_LD34(d, d);
#pragma unroll
            for (int am = 0; am < 8; ++am) { const int ai = am >> 2, m = am & 3; const size_t off = (size_t)(row0 + ai * HALF + m * 16) * 1024 + col0;
                u32x4 gc[2], pc[2];
#pragma unroll
                for (int bj = 0; bj < 2; ++bj) { gc[bj] = gq[am % EPI_DEPTH34][bj]; pc[bj] = pq[am % EPI_DEPTH34][bj]; }
                if (am + EPI_DEPTH34 < 8) EPI_LD34(am + EPI_DEPTH34, am % EPI_DEPTH34);
#pragma unroll
                for (int bj = 0; bj < 2; ++bj) { const f32x4 v0 = acc[ai][bj][m][0], v1 = acc[ai][bj][m][1]; const u32x4 g = gc[bj], p = pc[bj];
                    float o[8];
                    o[0] = __uint_as_float(g.x << 16) * EPI_PMUL(v0[0]) + __uint_as_float(p.x << 16); o[1] = __uint_as_float(g.x & 0xffff0000u) * EPI_PMUL(v0[1]) + __uint_as_float(p.x & 0xffff0000u);
                    o[2] = __uint_as_float(g.y << 16) * EPI_PMUL(v0[2]) + __uint_as_float(p.y << 16); o[3] = __uint_as_float(g.y & 0xffff0000u) * EPI_PMUL(v0[3]) + __uint_as_float(p.y & 0xffff0000u);
                    o[4] = __uint_as_float(g.z << 16) * EPI_PMUL(v1[0]) + __uint_as_float(p.z << 16); o[5] = __uint_as_float(g.z & 0xffff0000u) * EPI_PMUL(v1[1]) + __uint_as_float(p.z & 0xffff0000u);
                    o[6] = __uint_as_float(g.w << 16) * EPI_PMUL(v1[2]) + __uint_as_float(p.w << 16); o[7] = __uint_as_float(g.w & 0xffff0000u) * EPI_PMUL(v1[3]) + __uint_as_float(p.w & 0xffff0000u);
                    u32x4 w; w.x = cvt_pk_bf16(o[0], o[1]); w.y = cvt_pk_bf16(o[2], o[3]); w.z = cvt_pk_bf16(o[4], o[5]); w.w = cvt_pk_bf16(o[6], o[7]);
                    *(u32x4*)(O + off + bj * HALF) = w; } }
        } else {
            const int col0 = u.pn * BM + wc * 32 + 8 * fq;
            const float* gp = gate + (size_t)((u.pm * BM) >> 13) * 6144;
            f32x4 gv[2][2];
#pragma unroll
            for (int bj = 0; bj < 2; ++bj)
#pragma unroll
                for (int n = 0; n < 2; ++n) gv[bj][n] = *(const f32x4*)(gp + col0 + bj * HALF + n * 4);
            f32x4 xq[EPI_DEPTH5][2][2];
#define EPI_LD5(am_, slot_) do { const int ai2 = (am_) >> 2, m2 = (am_) & 3; const size_t off2 = (size_t)(row0 + ai2 * HALF + m2 * 16) * 1024 + col0; \
                _Pragma("unroll") for (int bj = 0; bj < 2; ++bj) _Pragma("unroll") for (int n = 0; n < 2; ++n) xq[slot_][bj][n] = *(const f32x4*)(xin + off2 + bj * HALF + n * 4); } while (0)
#pragma unroll
            for (int d = 0; d < EPI_DEPTH5; ++d) EPI_LD5(d, d);
#pragma unroll
            for (int am = 0; am < 8; ++am) { const int ai = am >> 2, m = am & 3; const size_t off = (size_t)(row0 + ai * HALF + m * 16) * 1024 + col0;
                f32x4 xc[2][2];
#pragma unroll
                for (int bj = 0; bj < 2; ++bj)
#pragma unroll
                    for (int n = 0; n < 2; ++n) xc[bj][n] = xq[am % EPI_DEPTH5][bj][n];
                if (am + EPI_DEPTH5 < 8) EPI_LD5(am + EPI_DEPTH5, am % EPI_DEPTH5);
#pragma unroll
                for (int bj = 0; bj < 2; ++bj)
#pragma unroll
                    for (int n = 0; n < 2; ++n) *(f32x4*)(xout + off + bj * HALF + n * 4) = xc[bj][n] + gv[bj][n] * acc[ai][bj][m][n]; }
        }
    }
};
}

template <class Epi> __device__ __forceinline__ void run_gemm(LASP unsigned char* lds, const bf16_t* A, const bf16_t* Bt, int M, int N, int K, const Epi& E, int wg, int nwg) {
    pg8::Gemm g; g.A = A; g.Bt = Bt; g.M = M; g.N = N; g.K = K;
    pg8::StaticOrder S; S.init(M, N, nwg, wg);
    pg8::gemm_phase<Epi, pg8::StaticOrder, false>(lds, g, S, E, nullptr);
    __syncthreads();
}

__device__ __forceinline__ int pmap(int n) {
    if (n < 1024) return n;
    if (n < 1536) return 1040 + (n - 1024);
    if (n < 1792) return 1552 + (n - 1536);
    if (n < 1920) return 1808 + (n - 1792);
    if (n < 1984) return 1936 + (n - 1920);
    if (n < 2000) return 1024 + (n - 1984);
    if (n < 2004) return 2000 + (n - 2000);
    if (n < 2048) return -1;
    return 2004 + (n - 2048);
}
__device__ __forceinline__ void tcvt_tile(const float* src, int ldsrc, bf16_t* dst, int K, int n0, int k0, int mode, LASP float* tile) {
    const int tid = threadIdx.x, j = tid & 63, i = tid >> 6;
    const int n = n0 + j; const int c = mode == 0 ? n : (mode == 1 ? pmap(n) : n + 3796);
#pragma unroll
    for (int ii = 0; ii < 8; ++ii) { const int kk = ii * 8 + i; tile[kk * 65 + j] = c >= 0 ? src[(size_t)(k0 + kk) * ldsrc + c] : 0.f; }
    __syncthreads();
#pragma unroll
    for (int it = 0; it < 8; ++it) { const int jj = it * 8 + (tid >> 6), kk = tid & 63; dst[(size_t)(n0 + jj) * K + k0 + kk] = f2bf(tile[kk * 65 + jj]); }
    __syncthreads();
}
constexpr int W_TILES_L = 960 + 768 + 384 + 256 + 256 + 64 + 16 + 16 + 8 + 8 + 16;
constexpr int W_TILES = W_TILES_L * NLAYER, W_MOD_UNITS = 384, W_PK_UNITS = 128;
template <int PART> __device__ __forceinline__ void phase_weights(const Params& p, LASP unsigned char* lds, int wg, int nwg) {
    LASP float* tile = (LASP float*)lds;
    const int tid = threadIdx.x;
    if constexpr (PART == 0) {
        for (int id = wg; id < NLAYER * 1728; id += nwg) { const int l = id / 1728; int t = id % 1728;
            if (t < 960) tcvt_tile(p.w_in + (size_t)l * 1024 * IN_W, IN_W, p.win_t + (size_t)l * 3840 * 1024, 1024, (t % 60) * 64, (t / 60) * 64, 1, tile);
            else { t -= 960; tcvt_tile(p.w_in + (size_t)l * 1024 * IN_W, IN_W, p.wg_t + (size_t)l * 3072 * 1024, 1024, (t % 48) * 64, (t / 48) * 64, 2, tile); } }
    } else if constexpr (PART == 1) {
        for (int id = wg; id < NLAYER * 896; id += nwg) { const int l = id / 896; int t = id % 896;
            if (t < 384) { const int j = t / 128, r = t % 128; tcvt_tile(p.w_branch + (size_t)(l * 3 + j) * 512 * 1024, 1024, p.wb_t + (size_t)(l * 3 + j) * 1024 * 512, 512, (r % 16) * 64, (r / 16) * 64, 0, tile); }
            else if (t < 640) { t -= 384; tcvt_tile(p.w_out + (size_t)l * 1024 * 1024, 1024, p.wo_t + (size_t)l * 1024 * 1024, 1024, (t % 16) * 64, (t / 16) * 64, 0, tile); }
            else { t -= 640; tcvt_tile(p.peer_w_q + (size_t)l * 1024 * 1024, 1024, p.wq_t + (size_t)l * 1024 * 1024, 1024, (t % 16) * 64, (t / 16) * 64, 0, tile); } }
    } else if constexpr (PART == 2) {
        for (int id = wg; id < NLAYER * 96; id += nwg) { const int l = id / 96; int t = id % 96;
            if (t < 64) tcvt_tile(p.dsa_w_uq + (size_t)l * 256 * 1024, 1024, p.wuq_t + (size_t)l * 1024 * 256, 256, (t % 16) * 64, (t / 16) * 64, 0, tile);
            else if (t < 80) { t -= 64; tcvt_tile(p.dsa_w_iq + (size_t)l * 256 * 256, 256, p.wiq_t + (size_t)l * 256 * 256, 256, (t % 4) * 64, (t / 4) * 64, 0, tile); }
            else { t -= 80; const int h = t / 2, kt = t % 2; tcvt_tile(p.dsa_w_uv + (size_t)(l * 8 + h) * 128 * 64, 64, p.wuv_t + (size_t)(l * 8 + h) * 64 * 128, 128, 0, kt * 64, 0, tile); } }
    } else if constexpr (PART == 3) {
        for (int id = wg; id < NLAYER * 32; id += nwg) { const int l = id / 32; int t = id % 32;
            if (t < 8) tcvt_tile(p.rw_w_w2 + (size_t)l * 64 * 512, 512, p.ww2_t + (size_t)l * 512 * 64, 64, t * 64, 0, 0, tile);
            else if (t < 16) { t -= 8; tcvt_tile(p.rw_w_a2 + (size_t)l * 64 * 512, 512, p.wa2_t + (size_t)l * 512 * 64, 64, t * 64, 0, 0, tile); }
            else { t -= 16; tcvt_tile(p.rw_w_g2 + (size_t)l * 128 * 512, 512, p.wg2_t + (size_t)l * 512 * 128, 128, (t % 8) * 64, (t / 8) * 64, 0, tile); } }
    } else {
        for (int u = wg; u < W_PK_UNITS; u += nwg) {
            const size_t e = (size_t)u * 4096 + (size_t)tid * 8;
            const f32x4 a = *(const f32x4*)(p.peer_keys + e), b = *(const f32x4*)(p.peer_keys + e + 4);
            u32x4 w; w.x = pk_bf16(a[0], a[1]); w.y = pk_bf16(a[2], a[3]); w.z = pk_bf16(b[0], b[1]); w.w = pk_bf16(b[2], b[3]);
            *(u32x4*)(p.pkeys + e) = w;
        }
        bool have = false;
        for (int u = wg; u < W_MOD_UNITS; u += nwg) {
            LASP float* cond = (LASP float*)lds;
            LASP float* red = (LASP float*)(lds + 32768);
            if (!have) { for (int i = tid; i < 8 * 1024; i += NTHR) cond[i] = siluf_(p.c[i]); have = true; }
            __syncthreads();
            const int l = u / 96, cb = u % 96, col = cb * 64 + (tid & 63), ks = tid >> 6;
            float acc[8];
#pragma unroll
            for (int b = 0; b < 8; ++b) acc[b] = 0.f;
            const float* wp = p.w_ada + (size_t)l * 1024 * 6144 + col;
            for (int k = ks * 128; k < ks * 128 + 128; ++k) { const float w = wp[(size_t)k * 6144];
#pragma unroll
                for (int b = 0; b < 8; ++b) acc[b] = fmaf(w, cond[b * 1024 + k], acc[b]); }
#pragma unroll
            for (int b = 0; b < 8; ++b) red[(ks * 8 + b) * 64 + (tid & 63)] = acc[b];
            __syncthreads();
            { const int b = tid >> 6, cc = tid & 63; float s = 0.f;
#pragma unroll
              for (int k2 = 0; k2 < 8; ++k2) s += red[(k2 * 8 + b) * 64 + cc];
              p.mod[((size_t)l * 8 + b) * 6144 + cb * 64 + cc] = s + p.b_ada[(size_t)l * 6144 + cb * 64 + cc]; }
            __syncthreads();
        }
    }
}

__device__ void phase_adaln(const float* x, const float* g, const float* modl  , int sh_off, int sc_off, bf16_t* h, int wg, int nwg) {
    const int lane = threadIdx.x & 63, wave = threadIdx.x >> 6;
    int tok = wg * 8 + wave;
    f32x4 vn[4];
    if (tok < NTOK) { const f32x4* xr = (const f32x4*)(x + (size_t)tok * 1024);
#pragma unroll
        for (int i = 0; i < 4; ++i) vn[i] = xr[lane + 64 * i]; }
    for (; tok < NTOK; tok += nwg * 8) {
        f32x4 v[4]; float ss = 0.f;
#pragma unroll
        for (int i = 0; i < 4; ++i) { v[i] = vn[i]; ss += v[i][0] * v[i][0] + v[i][1] * v[i][1] + v[i][2] * v[i][2] + v[i][3] * v[i][3]; }
        if (tok + nwg * 8 < NTOK) { const f32x4* xr = (const f32x4*)(x + (size_t)(tok + nwg * 8) * 1024);
#pragma unroll
            for (int i = 0; i < 4; ++i) vn[i] = xr[lane + 64 * i]; }
        ss = wave_sum(ss);
        const float rstd = rsqrtf(ss * (1.0f / 1024.0f) + 1e-6f);
        const float* mb = modl + (size_t)(tok >> 13) * 6144;
#pragma unroll
        for (int i = 0; i < 4; ++i) { const int col = 4 * (lane + 64 * i);
            const f32x4 gg = *(const f32x4*)(g + col), sc = *(const f32x4*)(mb + sc_off + col), sh = *(const f32x4*)(mb + sh_off + col);
            f32x4 o = (v[i] * rstd) * gg; o = o * (sc + 1.0f) + sh;
            u32x2 w; w.x = pk_bf16(o[0], o[1]); w.y = pk_bf16(o[2], o[3]);
            *(u32x2*)(h + (size_t)tok * 1024 + col) = w; }
    }
}
__device__ void phase_final(float* x, const float* g, int wg, int nwg) {
    const int lane = threadIdx.x & 63, wave = threadIdx.x >> 6;
    for (int tok = wg * 8 + wave; tok < NTOK; tok += nwg * 8) {
        f32x4* xr = (f32x4*)(x + (size_t)tok * 1024);
        f32x4 v[4]; float ss = 0.f;
#pragma unroll
        for (int i = 0; i < 4; ++i) { v[i] = xr[lane + 64 * i]; ss += v[i][0] * v[i][0] + v[i][1] * v[i][1] + v[i][2] * v[i][2] + v[i][3] * v[i][3]; }
        ss = wave_sum(ss);
        const float rstd = rsqrtf(ss * (1.0f / 1024.0f) + 1e-6f);
#pragma unroll
        for (int i = 0; i < 4; ++i) { const f32x4 gg = *(const f32x4*)(g + 4 * (lane + 64 * i)); xr[lane + 64 * i] = (v[i] * rstd) * gg; }
    }
}

__device__ void phase_gla1(const Params& p, int l, LASP unsigned char* lds, int wg, int nwg) {
    LASP float* alr = (LASP float*)lds;
    LASP float* part = (LASP float*)(lds + 4096);
    LASP bf16_t* kdT = (LASP bf16_t*)(lds + 8192);
    LASP bf16_t* vT = (LASP bf16_t*)(lds + 8192 + 9216);
    const int tid = threadIdx.x, lane = tid & 63, wave = tid >> 6;
    const int k = tid & 63, tq = tid >> 6;
    constexpr int NU = NB * NCHUNK * 4;
    bf16_t alr_n[2], gk_n[8]; u32x4 va_n, vb_n;
    auto ldu = [&](int u) { const int h = u & 3, c = (u >> 2) & 127, b = u >> 9; const size_t t0 = (size_t)b * SEQ + (size_t)c * 64;
#pragma unroll
        for (int j = 0; j < 2; ++j) { const int i = tid + j * NTHR; alr_n[j] = p.PB[(t0 + (i >> 4)) * PB_LD + PB_GALR + (i & 15)]; }
        { const int t = tid >> 3, vq = tid & 7; const bf16_t* vp = p.GV + (t0 + t) * 512 + h * 128 + vq * 16; va_n = *(const u32x4*)vp; vb_n = *(const u32x4*)(vp + 8); }
#pragma unroll
        for (int i = 0; i < 8; ++i) gk_n[i] = p.GK[(t0 + tq * 8 + i) * 256 + h * 64 + k]; };
    float wa[16]; float ba = 0.f; int hcur = -1;
#pragma unroll
    for (int r = 0; r < 16; ++r) wa[r] = 0.f;
    if (wg < NU) ldu(wg);
    for (int u = wg; u < NU; u += nwg) {
        const int h = u & 3;
        bf16_t alr_c[2], gk_c[8];
#pragma unroll
        for (int j = 0; j < 2; ++j) alr_c[j] = alr_n[j];
#pragma unroll
        for (int i = 0; i < 8; ++i) gk_c[i] = gk_n[i];
        const u32x4 a = va_n, bq = vb_n;
        if (h != hcur) { hcur = h;
#pragma unroll
            for (int r = 0; r < 16; ++r) wa[r] = p.gla_w_a2[((size_t)l * 16 + r) * 256 + h * 64 + k];
            ba = p.gla_b_a[(size_t)l * 256 + h * 64 + k]; }
        ldu(u + nwg < NU ? u + nwg : u);
#pragma unroll
        for (int j = 0; j < 2; ++j) alr[tid + j * NTHR] = bf2f(alr_c[j]);
        { const int t = tid >> 3, vq = tid & 7;
          const unsigned w[8] = {a.x, a.y, a.z, a.w, bq.x, bq.y, bq.z, bq.w};
#pragma unroll
          for (int j = 0; j < 8; ++j) { vT[(vq * 16 + 2 * j) * 72 + t] = (bf16_t)(w[j] & 0xffffu); vT[(vq * 16 + 2 * j + 1) * 72 + t] = (bf16_t)(w[j] >> 16); } }
        __syncthreads();
        float cum[8]; float run = 0.f;
#pragma unroll
        for (int i = 0; i < 8; ++i) { const int t = tq * 8 + i; float g = ba;
#pragma unroll
            for (int r = 0; r < 16; ++r) g = fmaf(alr[t * 16 + r], wa[r], g);
            const float ls = fminf(g, 0.f) - log1pf(__expf(-fabsf(g)));
            run += ls * (1.0f / 16.0f); cum[i] = run; }
        part[tq * 64 + k] = run;
        __syncthreads();
        float off = 0.f, tot = 0.f;
#pragma unroll
        for (int q = 0; q < 8; ++q) { const float v = part[q * 64 + k]; tot += v; if (q < tq) off += v; }
#pragma unroll
        for (int i = 0; i < 8; ++i) { const int t = tq * 8 + i; const float kv = bf2f(gk_c[i]);
            kdT[k * 72 + t] = f2bf(kv * __expf(tot - (off + cum[i]))); }
        if (tq == 0) p.gdec[(size_t)u * 64 + k] = __expf(tot);
        __syncthreads();
        { const int fr = lane & 15, fq = lane >> 4;
          bf16x8 bfr[2];
#pragma unroll
          for (int ks = 0; ks < 2; ++ks) bfr[ks] = *(const LASP bf16x8*)(vT + (wave * 16 + fr) * 72 + ks * 32 + fq * 8);
          bf16_t* gs = p.GS + (size_t)u * 8192 + (size_t)(wave * 16 + fr) * 64;
#pragma unroll
          for (int mt = 0; mt < 4; ++mt) { f32x4 acc = {0.f, 0.f, 0.f, 0.f};
#pragma unroll
              for (int ks = 0; ks < 2; ++ks) { const bf16x8 afr = *(const LASP bf16x8*)(kdT + (mt * 16 + fr) * 72 + ks * 32 + fq * 8); acc = MFMA16(afr, bfr[ks], acc); }
              u32x2 w; w.x = pk_bf16(acc[0], acc[1]); w.y = pk_bf16(acc[2], acc[3]);
              *(u32x2*)(gs + mt * 16 + fq * 4) = w; } }
        __syncthreads();
    }
}
__device__ void phase_gla2(const Params& p, int wg, int nwg) {
    for (int e = wg * NTHR + threadIdx.x; e < NB * 4 * 128 * 32; e += nwg * NTHR) {
        const int kp = e & 31, v = (e >> 5) & 127, h = (e >> 12) & 3, b = e >> 14;
        float s0 = 0.f, s1 = 0.f;
        for (int c0 = 0; c0 < NCHUNK; c0 += 4) {
            unsigned uv[4]; f32x2 dv[4];
#pragma unroll
            for (int j = 0; j < 4; ++j) { const size_t u = ((size_t)b * NCHUNK + c0 + j) * 4 + h; uv[j] = *(const unsigned*)(p.GS + u * 8192 + v * 64 + 2 * kp); dv[j] = *(const f32x2*)(p.gdec + u * 64 + 2 * kp); }
#pragma unroll
            for (int j = 0; j < 4; ++j) { const size_t u = ((size_t)b * NCHUNK + c0 + j) * 4 + h;
                s0 = fmaf(dv[j][0], s0, bflo(uv[j])); s1 = fmaf(dv[j][1], s1, bfhi(uv[j]));
                *(unsigned*)(p.GS + u * 8192 + v * 64 + 2 * kp) = pk_bf16(s0, s1); }
        }
    }
}
__device__ void phase_gla3(const Params& p, int l, LASP unsigned char* lds, int wg, int nwg) {
    LASP float* ssq = (LASP float*)lds;
    const int tid = threadIdx.x, lane = tid & 63, wave = tid >> 6, fr = lane & 15, fq = lane >> 4;
    const int nt = wave & 3, vh = wave >> 2;
    for (int u = wg; u < NB * NCHUNK * 4; u += nwg) {
        const int h = u & 3, c = (u >> 2) & 127, b = u >> 9; const size_t t0 = (size_t)b * SEQ + (size_t)c * 64;
        bf16x8 bq[2];
#pragma unroll
        for (int ks = 0; ks < 2; ++ks) bq[ks] = ld_frag_g(p.GQ + (t0 + nt * 16 + fr) * 256 + h * 64 + ks * 32 + fq * 8);
        f32x4 acc[4];
#pragma unroll
        for (int mi = 0; mi < 4; ++mi) { acc[mi] = (f32x4){0.f, 0.f, 0.f, 0.f};
#pragma unroll
            for (int ks = 0; ks < 2; ++ks) { const bf16x8 a = ld_frag_g(p.GS + (size_t)u * 8192 + (size_t)((vh * 4 + mi) * 16 + fr) * 64 + ks * 32 + fq * 8); acc[mi] = MFMA16(a, bq[ks], acc[mi]); } }
        float ss = 0.f;
#pragma unroll
        for (int mi = 0; mi < 4; ++mi) ss += acc[mi][0] * acc[mi][0] + acc[mi][1] * acc[mi][1] + acc[mi][2] * acc[mi][2] + acc[mi][3] * acc[mi][3];
        ss += __shfl_xor(ss, 16); ss += __shfl_xor(ss, 32);
        if (fq == 0) ssq[vh * 64 + nt * 16 + fr] = ss;
        __syncthreads();
        const float tot = ssq[nt * 16 + fr] + ssq[64 + nt * 16 + fr];
        const float sc = 0.125f * rsqrtf(tot * (1.0f / 8192.0f) + 1e-6f);
        const size_t trow = t0 + nt * 16 + fr;
#pragma unroll
        for (int mi = 0; mi < 4; ++mi) { const int v0 = (vh * 4 + mi) * 16 + fq * 4;
            const u32x2 rr = *(const u32x2*)(p.GR + trow * 512 + h * 128 + v0);
            const f32x4 go = *(const f32x4*)(p.gla_g_o + (size_t)l * 128 + v0);
            const float o0 = acc[mi][0] * sc * go[0] * siluf_(bflo(rr.x)), o1 = acc[mi][1] * sc * go[1] * siluf_(bfhi(rr.x));
            const float o2 = acc[mi][2] * sc * go[2] * siluf_(bflo(rr.y)), o3 = acc[mi][3] * sc * go[3] * siluf_(bfhi(rr.y));
            u32x2 w; w.x = pk_bf16(o0, o1); w.y = pk_bf16(o2, o3);
            *(u32x2*)(p.ya + trow * 512 + h * 128 + v0) = w; }
        __syncthreads();
    }
}

#ifndef DSA_FORCE_SLOW
#define DSA_FORCE_SLOW 0
#endif
#ifndef DBG_DOUBLE
#define DBG_DOUBLE 0
#endif
#ifndef DBG_DSA_SCALE
#define DBG_DSA_SCALE 1.0f
#endif
__device__ void phase_dsa1(const Params& p, int l, int wg, int nwg) {
    const int lane = threadIdx.x & 63, wave = threadIdx.x >> 6;
    for (int tok = wg * 8 + wave; tok < NTOK; tok += nwg * 8) {
        const bf16_t* row = p.PB + (size_t)tok * PB_LD;
        const u32x2 q = *(const u32x2*)(row + PB_QC + 4 * lane);
        const unsigned kv = *(const unsigned*)(row + PB_KVC + 2 * lane);
        const float q0 = bflo(q.x), q1 = bfhi(q.x), q2 = bflo(q.y), q3 = bfhi(q.y), k0 = bflo(kv), k1 = bfhi(kv);
        const float sq = wave_sum(q0 * q0 + q1 * q1 + q2 * q2 + q3 * q3), sk = wave_sum(k0 * k0 + k1 * k1);
        const float rq = rsqrtf(sq * (1.0f / 256.0f) + 1e-6f), rk = rsqrtf(sk * (1.0f / 128.0f) + 1e-6f);
        const f32x4 gq = *(const f32x4*)(p.dsa_g_qc + (size_t)l * 256 + 4 * lane); const f32x2 gk = *(const f32x2*)(p.dsa_g_kv + (size_t)l * 128 + 2 * lane);
        u32x2 w; w.x = pk_bf16(q0 * rq * gq[0], q1 * rq * gq[1]); w.y = pk_bf16(q2 * rq * gq[2], q3 * rq * gq[3]);
        *(u32x2*)(p.qn + (size_t)tok * 256 + 4 * lane) = w;
        *(unsigned*)(p.kvn + (size_t)tok * 128 + 2 * lane) = pk_bf16(k0 * rk * gk[0], k1 * rk * gk[1]);
    }
}

constexpr int D_HIST = 0, D_CIDX = 65536, D_WH = 98304, D_MSK = 131072, D_SEL = 147456, D_CTL = 155648, D_OT = 106496, D_OT_LD = 1032, DSA_CAP = 1024;
__device__ __forceinline__ unsigned lds_add(LASP unsigned* p, unsigned v) { return __hip_atomic_fetch_add(p, v, __ATOMIC_RELAXED, __HIP_MEMORY_SCOPE_WORKGROUP); }
__device__ __forceinline__ void lds_or(LASP unsigned* p, unsigned v) { (void)__hip_atomic_fetch_or(p, v, __ATOMIC_RELAXED, __HIP_MEMORY_SCOPE_WORKGROUP); }
struct DsaQ { bf16x8 qa[4][2]; f32x2 w01[4], w23[4]; };

__device__ __forceinline__ void dsa_score(const DsaQ& Q, const bf16x8& kb0, const bf16x8& kb1, float (&sc)[4]) {
    f32x2 s01 = {0.f, 0.f}, s23 = {0.f, 0.f};
#pragma unroll
    for (int hh = 0; hh < 4; ++hh) { f32x4 d = {0.f, 0.f, 0.f, 0.f}; d = MFMA16(Q.qa[hh][0], kb0, d); d = MFMA16(Q.qa[hh][1], kb1, d);
#pragma unroll
        for (int r = 0; r < 4; ++r) d[r] = __int_as_float(max(__float_as_int(d[r]), 0));
        const f32x2 d01 = {d[0], d[1]}, d23 = {d[2], d[3]};
        s01 = __builtin_elementwise_fma(Q.w01[hh], d01, s01); s23 = __builtin_elementwise_fma(Q.w23[hh], d23, s23); }
    sc[0] = s01[0]; sc[1] = s01[1]; sc[2] = s23[0]; sc[3] = s23[1];
}
__device__ __forceinline__ unsigned dkey(float f) { const unsigned u = __float_as_uint(f); return u ^ ((unsigned)((int)u >> 31) | 0x80000000u); }
__device__ __forceinline__ unsigned dbin(float f) { const unsigned u = __float_as_uint(f); const unsigned m = (unsigned)((int)u >> 31); return (u >> 21) ^ ((m & 0x3ffu) | 0x400u); }
template <class F> __device__ __forceinline__ void dsa_tiles(const bf16_t* ik0, int ntile, int wave, int fr, int fq, F&& f) {
    const bf16_t* base = ik0 + (size_t)fr * PB_LD + fq * 8;
    const int last = ntile - 1;
#define DT_LD(x0, x1, k) do { const int k_ = (k); const bf16_t* kp = base + (size_t)(k_ < ntile ? k_ : last) * 16 * PB_LD; x0 = ld_frag_g(kp); x1 = ld_frag_g(kp + 32); } while (0)
    bf16x8 a0, a1, b0, b1, c0, c1;
    int kt = wave;
    DT_LD(a0, a1, kt); DT_LD(b0, b1, kt + 8); DT_LD(c0, c1, kt + 16);
    for (; kt < ntile; kt += 24) {
        f(kt, a0, a1); DT_LD(a0, a1, kt + 24);
        if (kt + 8 < ntile) f(kt + 8, b0, b1);
        DT_LD(b0, b1, kt + 32);
        if (kt + 16 < ntile) f(kt + 16, c0, c1);
        DT_LD(c0, c1, kt + 40);
    }
#undef DT_LD
}
__device__ __forceinline__ void wave_find_bin(const LASP unsigned* hist, unsigned need, int lane, unsigned& bin_out, unsigned& above_out, unsigned& inbin_out) {
    unsigned loc = 0;
#pragma unroll
    for (int j = 0; j < 4; ++j) { const u32x4 w4 = *(const LASP u32x4*)(hist + 1008 - 16 * lane + 4 * j);
        loc += (w4.x & 0xffffu) + (w4.x >> 16) + (w4.y & 0xffffu) + (w4.y >> 16) + (w4.z & 0xffffu) + (w4.z >> 16) + (w4.w & 0xffffu) + (w4.w >> 16); }
    const unsigned incl = wave_scan_incl(loc);
    const unsigned excl = incl - loc;
    const bool mine = (excl < need) && (incl >= need);
    const unsigned long long m = __ballot(mine);
    const int L = m ? (int)__builtin_ctzll(m) : 63;
    const unsigned base = (unsigned)__builtin_amdgcn_readlane((int)excl, L);
    unsigned c2 = 0; const unsigned bin = 2047u - 32u * (unsigned)L - (unsigned)(lane & 31);
    { const unsigned w = hist[bin >> 1]; c2 = (bin & 1u) ? (w >> 16) : (w & 0xffffu); if (lane >= 32) c2 = 0; }
    const unsigned inc2 = wave_scan_incl(c2);
    const unsigned ex2 = inc2 - c2;
    const bool mine2 = (lane < 32) && (base + ex2 < need) && (base + inc2 >= need);
    const unsigned long long m2 = __ballot(mine2);
    const int L2 = m2 ? (int)__builtin_ctzll(m2) : 31;
    bin_out = 2047u - 32u * (unsigned)L - (unsigned)L2;
    above_out = base + (unsigned)__builtin_amdgcn_readlane((int)ex2, L2);
    inbin_out = (unsigned)__builtin_amdgcn_readlane((int)c2, L2);
}

#define DSA_UNIT_SETUP \
    LASP unsigned* hist = (LASP unsigned*)(lds + D_HIST); \
    LASP unsigned short* sel = (LASP unsigned short*)(lds + D_SEL); \
    LASP bf16_t* Ot = (LASP bf16_t*)(lds + D_OT); \
    LASP unsigned* ctl = (LASP unsigned*)(lds + D_CTL); \
    const int tid = threadIdx.x, lane = tid & 63, wave = tid >> 6, fr = lane & 15, fq = lane >> 4; \
    const int uw = pos & 255, uk = pos >> 8, ur = uw >> 3; const int uix = (uk & 1) ? 32 * uk + 31 - ur : 32 * uk + ur; \
    const int sub = uix & 3, b = uw & 7, c = 127 - (uix >> 2); \
    const int n = 64 * (c + 1); const size_t krow0 = (size_t)b * SEQ; const size_t t0 = krow0 + (size_t)c * 64 + sub * 16; \
    (void)0;
__device__ __forceinline__ void dsa_select_unit(const Params& p, int l, LASP unsigned char* lds, int pos) {
    DSA_UNIT_SETUP
    (void)Ot; (void)l;
    if (tid < 128) ctl[tid] = 0u;
    if (n <= 256) {
        for (int i = tid; i < 16 * 256; i += NTHR) sel[i] = (unsigned short)(i & 255);
        __syncthreads();
        if (tid < 16) ctl[tid] = (unsigned)n;
        __syncthreads();
        return;
    }
    LASP unsigned* ckey = (LASP unsigned*)(lds + D_HIST);
    LASP unsigned short* cidx = (LASP unsigned short*)(lds + D_CIDX);
    LASP unsigned short* msk = (LASP unsigned short*)(lds + D_MSK);
    DsaQ Q;
#pragma unroll
    for (int hh = 0; hh < 4; ++hh)
#pragma unroll
        for (int ks = 0; ks < 2; ++ks) Q.qa[hh][ks] = ld_frag_g(p.qi + (t0 + fr) * 256 + hh * 64 + ks * 32 + fq * 8);
    { u32x2 w[4];
#pragma unroll
      for (int r = 0; r < 4; ++r) w[r] = *(const u32x2*)(p.PB + (t0 + fq * 4 + r) * PB_LD + PB_IW);
      Q.w01[0] = (f32x2){bflo(w[0].x), bflo(w[1].x)}; Q.w01[1] = (f32x2){bfhi(w[0].x), bfhi(w[1].x)}; Q.w01[2] = (f32x2){bflo(w[0].y), bflo(w[1].y)}; Q.w01[3] = (f32x2){bfhi(w[0].y), bfhi(w[1].y)};
      Q.w23[0] = (f32x2){bflo(w[2].x), bflo(w[3].x)}; Q.w23[1] = (f32x2){bfhi(w[2].x), bfhi(w[3].x)}; Q.w23[2] = (f32x2){bflo(w[2].y), bflo(w[3].y)}; Q.w23[3] = (f32x2){bfhi(w[2].y), bfhi(w[3].y)}; }
    const bf16_t* ik0 = p.PB + krow0 * PB_LD + PB_IK;
    const int ntile = n >> 4;
    { const u32x4 z4 = {0u, 0u, 0u, 0u};
      for (int i = tid; i < 16 * 1024 / 4; i += NTHR) ((LASP u32x4*)hist)[i] = z4;
      for (int i = tid; i < 16 * 512 * 2 / 16; i += NTHR) ((LASP u32x4*)msk)[i] = z4; }
    __syncthreads();
    dsa_tiles(ik0, ntile, wave, fr, fq, [&](int, const bf16x8& kb0, const bf16x8& kb1) {
        float sc[4]; dsa_score(Q, kb0, kb1, sc);
#pragma unroll
        for (int r = 0; r < 4; ++r) { const unsigned key = dkey(sc[r]); lds_add(&hist[(fq * 4 + r) * 1024 + ((key >> 22) & 0x3ffu)], 1u + ((key >> 21) & 1u) * 65535u); } });
#if DBG_DOUBLE & 512
    { LASP unsigned* h2 = (LASP unsigned*)(lds + D_WH);
      dsa_tiles(ik0, ntile, wave, fr, fq, [&](int, const bf16x8& kb0, const bf16x8& kb1) {
        float sc[4]; dsa_score(Q, kb0, kb1, sc);
#pragma unroll
        for (int r = 0; r < 4; ++r) { const unsigned bin = dbin(sc[r]); lds_add(&h2[((fq * 4 + r) & 7) * 1024 + (bin >> 1)], (bin & 1u) ? 65536u : 1u); } }); }
#endif
#if DBG_DOUBLE & 1024
    { float accs = 0.f;
      dsa_tiles(ik0, ntile, wave, fr, fq, [&](int, const bf16x8& kb0, const bf16x8& kb1) {
        float sc[4]; dsa_score(Q, kb0, kb1, sc); accs += sc[0] + sc[1] + sc[2] + sc[3]; });
      if (accs == 123.456f) ctl[120] = 1u; }
#endif
    __syncthreads();
#pragma unroll
    for (int qi2 = 0; qi2 < 2; ++qi2) { const int q = wave * 2 + qi2;
        unsigned bin, above, inbin; wave_find_bin(hist + q * 1024, 256u, lane, bin, above, inbin);
        if (lane == 0) { ctl[16 + q] = bin; ctl[32 + q] = 256u - above; if (inbin > (unsigned)DSA_CAP || DSA_FORCE_SLOW) ctl[97] = 1u; } }
    __syncthreads();
    if (!ctl[97]) {
        float elo[4], ehi[4];
#pragma unroll
        for (int r = 0; r < 4; ++r) { const unsigned tb = ctl[16 + fq * 4 + r]; elo[r] = fkey_inv(tb << 21); ehi[r] = tb >= 2047u ? INFINITY : fkey_inv((tb + 1u) << 21); }
        dsa_tiles(ik0, ntile, wave, fr, fq, [&](int kt, const bf16x8& kb0, const bf16x8& kb1) {
            float sc[4]; dsa_score(Q, kb0, kb1, sc);
            unsigned pc[4]; bool cand[4]; unsigned long long tm[4];
#pragma unroll
            for (int r = 0; r < 4; ++r) { const bool above = sc[r] >= ehi[r];
                tm[r] = __ballot(above);
                cand[r] = (sc[r] >= elo[r]) && !above; }
            if ((tm[0] | tm[1] | tm[2] | tm[3]) != 0ull) {
#pragma unroll
                for (int r = 0; r < 4; ++r) if (fr == 0) msk[(fq * 4 + r) * 512 + kt] = (unsigned short)((tm[r] >> (16 * fq)) & 0xffffull); }
            if (__ballot(cand[0] || cand[1] || cand[2] || cand[3]) != 0ull) {
#pragma unroll
                for (int r = 0; r < 4; ++r) pc[r] = cand[r] ? lds_add(&ctl[112 + fq * 4 + r], 1u) : 0xffffffffu;
#pragma unroll
                for (int r = 0; r < 4; ++r) if (cand[r] && pc[r] < (unsigned)DSA_CAP) { const int q = fq * 4 + r; ckey[q * DSA_CAP + pc[r]] = dkey(sc[r]); cidx[q * DSA_CAP + pc[r]] = (unsigned short)(kt * 16 + fr); } } });
        __syncthreads();
        LASP unsigned* wh = (LASP unsigned*)(lds + D_WH) + wave * 1024;
#if DBG_DOUBLE & 65536
        for (int rep_ = 0; rep_ < 2; ++rep_)
#endif
#pragma unroll 1
        for (int qi2 = 0; qi2 < 2; ++qi2) { const int q = wave * 2 + qi2;
            unsigned m = ctl[112 + q]; m = m > (unsigned)DSA_CAP ? (unsigned)DSA_CAP : m; unsigned need = ctl[32 + q];
            const LASP unsigned* ck = ckey + q * DSA_CAP; const LASP unsigned short* ci = cidx + q * DSA_CAP;
            unsigned pmask = 0u, pval = 0u, inb = 0u;
#pragma unroll 1
            for (int lvl = 0; lvl < 2; ++lvl) { const unsigned shift = lvl == 0 ? 10u : 0u, nbm = lvl == 0 ? 0x7ffu : 0x3ffu;
#pragma unroll
                for (int k = 0; k < 4; ++k) ((LASP u32x4*)wh)[lane + 64 * k] = (u32x4){0u, 0u, 0u, 0u};
                for (unsigned i = lane; i < m; i += 64) { const unsigned key = ck[i]; if ((key & pmask) == pval) { const unsigned bin = (key >> shift) & nbm; lds_add(&wh[bin >> 1], (bin & 1u) ? 65536u : 1u); } }
                unsigned bin, above; wave_find_bin(wh, need, lane, bin, above, inb);
                pval |= bin << shift; pmask |= nbm << shift; need -= above; }
            unsigned sthr = 0xffffu;
            if (need < inb) {
#pragma unroll
                for (int k = 0; k < 4; ++k) ((LASP u32x4*)wh)[lane + 64 * k] = (u32x4){0u, 0u, 0u, 0u};
                for (unsigned i = lane; i < m; i += 64) { if ((ck[i] & 0x1fffffu) == pval) { const unsigned bin = 2047u - ((unsigned)ci[i] >> 2); lds_add(&wh[bin >> 1], (bin & 1u) ? 65536u : 1u); } }
                unsigned binC, aboveC, inC; wave_find_bin(wh, need, lane, binC, aboveC, inC);
                const unsigned needC = need - aboveC;
#pragma unroll
                for (int k = 0; k < 4; ++k) ((LASP u32x4*)wh)[lane + 64 * k] = (u32x4){0u, 0u, 0u, 0u};
                for (unsigned i = lane; i < m; i += 64) { const unsigned s = ci[i]; if ((ck[i] & 0x1fffffu) == pval && (2047u - (s >> 2)) == binC) { const unsigned bin = 2047u - (s & 3u); lds_add(&wh[bin >> 1], (bin & 1u) ? 65536u : 1u); } }
                unsigned binD, aboveD, inD; wave_find_bin(wh, needC, lane, binD, aboveD, inD);
                sthr = ((2047u - binC) << 2) | (2047u - binD);
            }
            for (unsigned i = lane; i < m; i += 64) { const unsigned k21 = ck[i] & 0x1fffffu, si = ci[i];
                if (k21 > pval || (k21 == pval && si <= sthr)) { const unsigned widx = (unsigned)q * 512u + (si >> 4); lds_or((LASP unsigned*)msk + (widx >> 1), 1u << (16u * (widx & 1u) + (si & 15u))); } } }
        __syncthreads();
    } else {
        for (int pass = 1; pass < 3; ++pass) {
            for (int i = tid; i < 16 * 1024; i += NTHR) hist[i] = 0u;
            __syncthreads();
            dsa_tiles(ik0, ntile, wave, fr, fq, [&](int, const bf16x8& kb0, const bf16x8& kb1) {
                float sc[4]; dsa_score(Q, kb0, kb1, sc);
#pragma unroll
                for (int r = 0; r < 4; ++r) { const int q = fq * 4 + r; const unsigned key = dkey(sc[r]); unsigned bin; bool on;
                    if (pass == 1) { bin = (key >> 10) & 0x7ffu; on = (key >> 21) == ctl[16 + q]; }
                    else { bin = key & 0x3ffu; on = (key >> 10) == ctl[16 + q]; }
                    if (on) lds_add(&hist[q * 1024 + (bin >> 1)], (bin & 1u) ? 65536u : 1u); } });
            __syncthreads();
#pragma unroll
            for (int qi2 = 0; qi2 < 2; ++qi2) { const int q = wave * 2 + qi2;
                const unsigned need = ctl[32 + q];
                unsigned bin, above, inbin; wave_find_bin(hist + q * 1024, need, lane, bin, above, inbin);
                if (lane == 0) { const unsigned pre = ctl[16 + q];
                    ctl[16 + q] = pass == 1 ? ((pre << 11) | bin) : ((pre << 10) | bin);
                    ctl[32 + q] = need - above;
                    if (pass == 2) { const unsigned fl = (need - above < inbin) ? 1u : 0u; ctl[48 + q] = fl; if (fl) ctl[96] = 1u; } } }
            __syncthreads();
        }
        if (ctl[96]) {
            for (int i = tid; i < 16 * 1024; i += NTHR) hist[i] = 0u;
            __syncthreads();
            dsa_tiles(ik0, ntile, wave, fr, fq, [&](int kt, const bf16x8& kb0, const bf16x8& kb1) {
                float sc[4]; dsa_score(Q, kb0, kb1, sc);
#pragma unroll
                for (int r = 0; r < 4; ++r) { const int q = fq * 4 + r; const unsigned key = dkey(sc[r]);
                    if (ctl[48 + q] && key == ctl[16 + q]) { const unsigned s = (unsigned)(kt * 16 + fr); const unsigned bin = 2047u - (s >> 2); lds_add(&hist[q * 1024 + (bin >> 1)], (bin & 1u) ? 65536u : 1u); } } });
            __syncthreads();
#pragma unroll
            for (int qi2 = 0; qi2 < 2; ++qi2) { const int q = wave * 2 + qi2;
                if (ctl[48 + q]) { unsigned bin, above, inbin; wave_find_bin(hist + q * 1024, ctl[32 + q], lane, bin, above, inbin);
                    if (lane == 0) { ctl[64 + q] = bin; ctl[80 + q] = ctl[32 + q] - above; } } }
            __syncthreads();
        }
        dsa_tiles(ik0, ntile, wave, fr, fq, [&](int kt, const bf16x8& kb0, const bf16x8& kb1) {
            float sc[4]; dsa_score(Q, kb0, kb1, sc);
#pragma unroll
            for (int r = 0; r < 4; ++r) { const int q = fq * 4 + r; const unsigned key = dkey(sc[r]); const unsigned thr = ctl[16 + q];
                const unsigned s = (unsigned)(kt * 16 + fr);
                bool take = key > thr; const bool eq = key == thr; const bool fl = ctl[48 + q] != 0u;
                if (!fl) take = take || eq;
                const unsigned ibin = 2047u - (s >> 2), tb = ctl[64 + q];
                const bool eqb = eq && fl && (ibin == tb);
                const unsigned long long em = __ballot(eqb);
                if (eq && fl) {
                    if (ibin > tb) take = true;
                    else if (ibin == tb) { const unsigned long long low = em & (((1ull << lane) - 1ull) & ~((1ull << (lane & ~3)) - 1ull)); take = (unsigned)__popcll(low) < ctl[80 + q]; } }
                const unsigned long long tm = __ballot(take);
                if (fr == 0) msk[q * 512 + kt] = (unsigned short)((tm >> (16 * fq)) & 0xffffull); } });
        __syncthreads();
    }
#if DBG_DOUBLE & 131072
    for (int rep_ = 0; rep_ < 2; ++rep_)
#endif
#pragma unroll 1
    for (int qi2 = 0; qi2 < 2; ++qi2) { const int q = wave * 2 + qi2;
        LASP unsigned* pre = (LASP unsigned*)(lds + D_WH) + wave * 1024;
        const LASP unsigned* mskw = (const LASP unsigned*)msk + q * 256;
        const u32x4 mw = *(const LASP u32x4*)(mskw + lane * 4);
        const unsigned c0 = (unsigned)__popc(mw.x), c1 = (unsigned)__popc(mw.y), c2 = (unsigned)__popc(mw.z), c3 = (unsigned)__popc(mw.w), c8 = c0 + c1 + c2 + c3;
        const unsigned incl = wave_scan_incl(c8), base = incl - c8;
        { u32x4 pv; pv.x = base + c0; pv.y = pv.x + c1; pv.z = pv.y + c2; pv.w = incl; *(LASP u32x4*)(pre + lane * 4) = pv; }
        asm volatile("s_waitcnt lgkmcnt(0)" ::: "memory");
        const unsigned total = (unsigned)__builtin_amdgcn_readlane((int)incl, 63);
#pragma unroll
        for (int i = 0; i < 4; ++i) { const unsigned j = (unsigned)lane + 64u * i;
            unsigned w = 0;
#pragma unroll
            for (unsigned step = 128; step >= 1; step >>= 1) { const unsigned pvw = pre[w + step - 1]; w += pvw <= j ? step : 0u; }
            if (j < total) {
                unsigned r = j - (w ? pre[w - 1] : 0u), x = mskw[w], pos = 0;
                { const unsigned t = (unsigned)__popc(x & 0xffffu); const bool up = r >= t; pos += up ? 16u : 0u; r -= up ? t : 0u; x = up ? x >> 16 : x; }
                { const unsigned t = (unsigned)__popc(x & 0xffu); const bool up = r >= t; pos += up ? 8u : 0u; r -= up ? t : 0u; x = up ? x >> 8 : x; }
                { const unsigned t = (unsigned)__popc(x & 0xfu); const bool up = r >= t; pos += up ? 4u : 0u; r -= up ? t : 0u; x = up ? x >> 4 : x; }
                { const unsigned t = (unsigned)__popc(x & 0x3u); const bool up = r >= t; pos += up ? 2u : 0u; r -= up ? t : 0u; x = up ? x >> 2 : x; }
                pos += (r >= (x & 1u)) ? 1u : 0u;
                sel[q * 256 + j] = (unsigned short)(w * 32u + pos); } }
        if (lane == 63) ctl[q] = incl > 256u ? 256u : incl; }
    __syncthreads();
}
constexpr int DA_WAVE = 13312, DA_PB = 8192, DA_PLD = 40, DA_QA = 8832;
typedef short v4s_t __attribute__((ext_vector_type(4)));
__device__ __forceinline__ unsigned da_off(unsigned row, unsigned ch) { return 256u * row + 16u * (ch ^ (((row & 3u) << 2) | ((row >> 2) & 3u))); }
__device__ __forceinline__ void dsa_attend_query(const Params& p, int l, LASP unsigned char* lds, int pos) {
    DSA_UNIT_SETUP
    (void)hist; (void)n; (void)c; (void)sub;
    LASP unsigned char* img = lds + wave * DA_WAVE;
    LASP bf16_t* Pb = (LASP bf16_t*)(img + DA_PB);
    const unsigned ufr = (unsigned)fr, ufq = (unsigned)fq;
    const unsigned wbase = 2048u * ufq + 16u * (ufr ^ ((ufq & 1u) << 1));
    const unsigned lbase = 256u * ufr + 16u * (ufq ^ (((ufr & 3u) << 2) | ((ufr >> 2) & 3u)));
    const unsigned pbase = 256u * (8u * ufq + (ufr >> 2)) + 16u * (((ufr & 3u) >> 1) ^ (((ufr >> 2) << 2) | ((ufq & 1u) << 1))) + 8u * (ufr & 1u);
    u32x4 rw[8];
    const char* kvb = (const char*)(p.kvn + krow0 * 128);
    auto gather = [&](int qq, int ch) {
        const u32x4 iw = *(const LASP u32x4*)(sel + qq * 256 + ch * 32 + fq * 8);
        const unsigned iv[4] = {iw.x, iw.y, iw.z, iw.w};
#pragma unroll
        for (int i = 0; i < 8; ++i) { const unsigned idx = ((i & 1) ? (iv[i >> 1] >> 16) : iv[i >> 1]) & 0x1fffu;
            rw[i] = *(const u32x4*)(kvb + ((idx << 8) | (ufr << 4))); } };
    bf16x8 qf[4];
    auto ldq = [&](int qq) {
#pragma unroll
        for (int ks = 0; ks < 4; ++ks) qf[ks] = ld_frag_g(p.qd + (t0 + qq) * 1024 + (fr & 7) * 128 + ks * 32 + fq * 8); };
    ldq(wave * 2); gather(wave * 2, 0);
#pragma unroll 1
    for (int qi2 = 0; qi2 < 2; ++qi2) {
        const int q = wave * 2 + qi2;
        unsigned cnt = (unsigned)__builtin_amdgcn_readfirstlane((int)ctl[q]); cnt = cnt > 256u ? 256u : cnt;
        const int nch = (int)(cnt >> 5);
#pragma unroll
        for (int ks = 0; ks < 4; ++ks) *(LASP bf16x8*)(img + DA_QA + ks * 1024 + lane * 16) = qf[ks];
        float mrun[4] = {-INFINITY, -INFINITY, -INFINITY, -INFINITY}, lrun[4] = {0.f, 0.f, 0.f, 0.f};
        f32x4 oacc[8];
#pragma unroll
        for (int cc = 0; cc < 8; ++cc) oacc[cc] = (f32x4){0.f, 0.f, 0.f, 0.f};
#pragma unroll 1
        for (int ch = 0; ch < nch; ++ch) {
            unsigned wb = wbase, lb = lbase, pb = pbase; asm volatile("" : "+v"(wb), "+v"(lb), "+v"(pb));
#pragma unroll
            for (int i = 0; i < 8; ++i) { const unsigned ci = (unsigned)(((i & 3) << 2) | (i >> 2)); *(LASP u32x4*)(img + ((wb ^ (16u * ci)) + 256u * i)) = rw[i]; }
            { const bool more = ch + 1 < nch; const int qn = more ? q : (wave * 2 + 1), chn = more ? ch + 1 : (qi2 == 0 ? 0 : ch);
              gather(qn, chn);
              if (!more) ldq(wave * 2 + 1); }
            float lg[2][4];
#pragma unroll
            for (int tl = 0; tl < 2; ++tl) { f32x4 dd = {0.f, 0.f, 0.f, 0.f};
#pragma unroll
                for (int ks = 0; ks < 4; ++ks) dd = MFMA16(*(const LASP bf16x8*)(img + DA_QA + ks * 1024 + lane * 16), *(const LASP bf16x8*)(img + ((lb ^ (64u * ks)) + 4096u * tl)), dd);
#pragma unroll
                for (int r = 0; r < 4; ++r) lg[tl][r] = dd[r]; }

            float scv[4], tmx[4], p0[4], p1[4], ps[4];
#pragma unroll
            for (int r = 0; r < 4; ++r) tmx[r] = fmaxf(fmaxf(lg[0][r], lg[1][r]), mrun[r]);
            row16_max_x4(tmx[0], tmx[1], tmx[2], tmx[3]);
            constexpr float ES = 0.08838834764831845f * 1.4426950408889634f;
#pragma unroll
            for (int r = 0; r < 4; ++r) { const float mnew = tmx[r], nm = -mnew * ES;
                scv[r] = __builtin_amdgcn_exp2f(fmaf(mrun[r], ES, nm));
                p0[r] = __builtin_amdgcn_exp2f(fmaf(lg[0][r], ES, nm)); p1[r] = __builtin_amdgcn_exp2f(fmaf(lg[1][r], ES, nm)); ps[r] = p0[r] + p1[r]; mrun[r] = mnew; }
            row16_sum_x4(ps[0], ps[1], ps[2], ps[3]);
            unsigned short pb0[4], pb1[4];
#pragma unroll
            for (int r = 0; r < 4; ++r) { lrun[r] = lrun[r] * scv[r] + ps[r]; pb0[r] = f2bf(p0[r]); pb1[r] = f2bf(p1[r]); }
            if (fq < 2) {
#pragma unroll
                for (int r = 0; r < 4; ++r) { Pb[(fq * 4 + r) * DA_PLD + fr] = pb0[r]; Pb[(fq * 4 + r) * DA_PLD + 16 + fr] = pb1[r]; } }
            const bf16x8 pa = *(const LASP bf16x8*)(Pb + (fr & 7) * DA_PLD + fq * 8);
#pragma unroll
            for (int cc = 0; cc < 8; ++cc) {
                const v4s_t lo = __builtin_amdgcn_ds_read_tr16_b64_v4i16((LASP v4s_t*)(img + (pb ^ (32u * cc))));
                const v4s_t hi = __builtin_amdgcn_ds_read_tr16_b64_v4i16((LASP v4s_t*)(img + (((pb ^ 16u) ^ (32u * cc)) + 1024u)));
                const bf16x8 bv = {lo[0], lo[1], lo[2], lo[3], hi[0], hi[1], hi[2], hi[3]};
                f32x4 a = oacc[cc];
#pragma unroll
                for (int r = 0; r < 4; ++r) a[r] *= scv[r];
                oacc[cc] = MFMA16(pa, bv, a);
            }
        }
        if (fq < 2) {
#pragma unroll
            for (int r = 0; r < 4; ++r) { const float inv = __builtin_amdgcn_rcpf(lrun[r]);
#pragma unroll
                for (int cc = 0; cc < 8; ++cc) Ot[q * D_OT_LD + (fq * 4 + r) * 128 + cc * 16 + fr] = f2bf(oacc[cc][r] * inv); } }
    }
}
__device__ __forceinline__ void dsa_upproj_unit(const Params& p, int l, LASP unsigned char* lds, int pos) {
    DSA_UNIT_SETUP
    (void)hist; (void)n; (void)c; (void)sub; (void)sel; (void)ctl; (void)krow0;
    const bf16_t* wu = p.wuv_t + ((size_t)l * 8 + wave) * 64 * 128;
    bf16x8 wf[4][4];
#pragma unroll
    for (int nt = 0; nt < 4; ++nt)
#pragma unroll
        for (int ks = 0; ks < 4; ++ks) wf[nt][ks] = ld_frag_g(wu + (size_t)(nt * 16 + fr) * 128 + ks * 32 + fq * 8);
    __syncthreads();
    bf16x8 oa[4];
#pragma unroll
    for (int ks = 0; ks < 4; ++ks) oa[ks] = *(const LASP bf16x8*)(Ot + fr * D_OT_LD + wave * 128 + ks * 32 + fq * 8);
#pragma unroll
    for (int nt = 0; nt < 4; ++nt) { f32x4 d = {0.f, 0.f, 0.f, 0.f};
#pragma unroll
        for (int ks = 0; ks < 4; ++ks) d = MFMA16(wf[nt][ks], oa[ks], d);
        u32x2 w; w.x = pk_bf16(DBG_DSA_SCALE * d[0], DBG_DSA_SCALE * d[1]); w.y = pk_bf16(DBG_DSA_SCALE * d[2], DBG_DSA_SCALE * d[3]);
        *(u32x2*)(p.yb + (t0 + fr) * 512 + wave * 64 + nt * 16 + fq * 4) = w; }
    __syncthreads();
}
__device__ void phase_dsa34(const Params& p, int l, LASP unsigned char* lds, int wg, int nwg) {
    for (int pos = wg; pos < 4096; pos += nwg) { dsa_select_unit(p, l, lds, pos); dsa_attend_query(p, l, lds, pos); dsa_upproj_unit(p, l, lds, pos); }
}

#ifndef DBG_DOUBLE
#define DBG_DOUBLE 0
#endif
constexpr int R_W = 0, R_A = 8192, R_B = 16384, R_K2 = 24576, R_R = 32768, R_V = 40960, R_Y = 43008, R_BUF = 45056;
#ifndef SCAN_PRIO
#define SCAN_PRIO 0
#endif
#ifndef PREP_PRIO
#define PREP_PRIO 0
#endif
constexpr int R_WM = 90112, R_AM = 99328, R_CONST = 108544, R_STG = 110848, R_STG_SZ = 4352;
__device__ __forceinline__ f32x4 lerp4(u32x2 cur, u32x2 prv, f32x4 mu) {
    f32x4 c = {bflo(cur.x), bfhi(cur.x), bflo(cur.y), bfhi(cur.y)}, q = {bflo(prv.x), bfhi(prv.x), bflo(prv.y), bfhi(prv.y)};
    return c + (q - c) * mu;
}
__device__ __forceinline__ void lerp8(const u32x4 cur, const u32x4 prv, const f32x4 m0, const f32x4 m1, f32x4& o0, f32x4& o1) {
    const f32x4 c0 = {bflo(cur.x), bfhi(cur.x), bflo(cur.y), bfhi(cur.y)}, c1 = {bflo(cur.z), bfhi(cur.z), bflo(cur.w), bfhi(cur.w)};
    const f32x4 q0 = {bflo(prv.x), bfhi(prv.x), bflo(prv.y), bfhi(prv.y)}, q1 = {bflo(prv.z), bfhi(prv.z), bflo(prv.w), bfhi(prv.w)};
    o0 = c0 + (q0 - c0) * m0; o1 = c1 + (q1 - c1) * m1;
}
__device__ __forceinline__ float fast_tanh(float x) { return fmaf(-2.0f, __builtin_amdgcn_rcpf(1.0f + __builtin_amdgcn_exp2f(2.8853900817779268f * x)), 1.0f); }
struct RwRaw { u32x4 cr, pr, ck, pk, cw, pw, ca, pa, cv, pv; };
__device__ __forceinline__ void rwkv_scan_setup(const Params& p, int l, LASP unsigned char* lds, int u) {
    const int tid = threadIdx.x, lane = tid & 63, wave = tid >> 6, fr = lane & 15, fq = lane >> 4;
    LASP bf16_t* sWm = (LASP bf16_t*)(lds + R_WM); LASP bf16_t* sAm = (LASP bf16_t*)(lds + R_AM); LASP float* sC = (LASP float*)(lds + R_CONST);
    const int rg = u & 3, h = (u >> 2) & 7, b = u >> 5;
    const size_t row0 = (size_t)b * SEQ;
    (void)tid; (void)lane; (void)wave; (void)fr; (void)fq; (void)sWm; (void)sAm; (void)sC; (void)rg; (void)h; (void)row0; (void)l;
        __syncthreads();
        for (int i = tid; i < 64 * 8; i += NTHR) { const int j = i >> 3, c8 = i & 7;
            *(LASP u32x4*)(sWm + j * 72 + c8 * 8) = *(const u32x4*)(p.ww2_t + ((size_t)l * 512 + h * 64 + j) * 64 + c8 * 8);
            *(LASP u32x4*)(sAm + j * 72 + c8 * 8) = *(const u32x4*)(p.wa2_t + ((size_t)l * 512 + h * 64 + j) * 64 + c8 * 8); }
        { const float* mu = p.rw_mu + (size_t)l * 1792;
          if (tid < 64) { sC[tid] = mu[PC_R + h * 64 + tid]; sC[64 + tid] = mu[PC_K + h * 64 + tid]; sC[128 + tid] = mu[PC_WLR + tid]; sC[192 + tid] = mu[PC_ALR + tid]; }
          if (tid < 16) sC[256 + tid] = mu[PC_V + h * 64 + 16 * rg + tid];
          if (tid < 64) { const size_t o = (size_t)l * 512 + h * 64 + tid; sC[272 + tid] = p.rw_k_k[o]; sC[336 + tid] = p.rw_k_a[o]; sC[400 + tid] = p.rw_w0[o]; sC[464 + tid] = p.rw_a0[o]; } }
        __syncthreads();
}
__device__ __forceinline__ void rwkv_scan_waves(const Params& p, int l, LASP unsigned char* lds, int u) {
    const int tid = threadIdx.x, lane = tid & 63, wave = tid >> 6, fr = lane & 15, fq = lane >> 4;
    LASP bf16_t* sWm = (LASP bf16_t*)(lds + R_WM); LASP bf16_t* sAm = (LASP bf16_t*)(lds + R_AM); LASP float* sC = (LASP float*)(lds + R_CONST);
    const int rg = u & 3, h = (u >> 2) & 7, b = u >> 5;
    const size_t row0 = (size_t)b * SEQ;
    (void)tid; (void)lane; (void)wave; (void)fr; (void)fq; (void)sWm; (void)sAm; (void)sC; (void)rg; (void)h; (void)row0; (void)l;
            __builtin_amdgcn_s_setprio(SCAN_PRIO);
            f32x4 S4 = {0.f, 0.f, 0.f, 0.f}; float yacc = 0.f;
            const int rl = wave * 4 + fq;
            __syncthreads();
            for (int blk = 0; blk < SEQ / 32; ++blk) {
                LASP unsigned char* bf = lds + (blk & 1) * R_BUF;
                LASP float* sW = (LASP float*)(bf + R_W); LASP float* sA = (LASP float*)(bf + R_A); LASP float* sB = (LASP float*)(bf + R_B);
                LASP float* sK2 = (LASP float*)(bf + R_K2); LASP float* sR = (LASP float*)(bf + R_R); LASP float* sV = (LASP float*)(bf + R_V); LASP float* sY = (LASP float*)(bf + R_Y);
                f32x4 w4 = *(const LASP f32x4*)(sW + 4 * fr), a4 = *(const LASP f32x4*)(sA + 4 * fr), b4 = *(const LASP f32x4*)(sB + 4 * fr);
                f32x4 k4 = *(const LASP f32x4*)(sK2 + 4 * fr), r4 = *(const LASP f32x4*)(sR + 4 * fr); float v = sV[rl];
                float sa = S4[0] * a4[0] + S4[1] * a4[1] + S4[2] * a4[2] + S4[3] * a4[3];
                sa = row16_sum(sa);
                f32x4 tv = S4 * w4 + k4 * v;
#pragma unroll 4
                for (int tt = 0; tt < 32; ++tt) {
                    const int tn = tt < 31 ? tt + 1 : 31;
                    const f32x4 w4n = *(const LASP f32x4*)(sW + tn * 64 + 4 * fr), a4n = *(const LASP f32x4*)(sA + tn * 64 + 4 * fr), b4n = *(const LASP f32x4*)(sB + tn * 64 + 4 * fr);
                    const f32x4 k4n = *(const LASP f32x4*)(sK2 + tn * 64 + 4 * fr), r4n = *(const LASP f32x4*)(sR + tn * 64 + 4 * fr); const float vn = sV[tn * 16 + rl];
                    S4 = tv + b4 * sa;
                    const f32x4 py = S4 * r4, ps = S4 * a4n;
                    float y = (py[0] + py[2]) + (py[1] + py[3]), sp = (ps[0] + ps[2]) + (ps[1] + ps[3]);
                    tv = S4 * w4n + k4n * vn;
                    sp += dppf<0xB1>(sp); y += dppf<0xB1>(y); sp += dppf<0x4E>(sp); y += dppf<0x4E>(y);
                    sp += dppf<0x141>(sp); y += dppf<0x141>(y); sp += dppf<0x140>(sp); y += dppf<0x140>(y);
                    sa = sp;
                    yacc = (fr == (tt & 15)) ? y : yacc;
                    if ((tt & 15) == 15) { sY[(tt - 15 + fr) * 16 + rl] = yacc; }
                    b4 = b4n; r4 = r4n;
                }
                __syncthreads();
            }
            __builtin_amdgcn_s_setprio(0);
            __syncthreads();
}
__device__ __forceinline__ void rwkv_prep_waves(const Params& p, int l, LASP unsigned char* lds, int u) {
    const int tid = threadIdx.x, lane = tid & 63, wave = tid >> 6, fr = lane & 15, fq = lane >> 4;
    LASP bf16_t* sWm = (LASP bf16_t*)(lds + R_WM); LASP bf16_t* sAm = (LASP bf16_t*)(lds + R_AM); LASP float* sC = (LASP float*)(lds + R_CONST);
    const int rg = u & 3, h = (u >> 2) & 7, b = u >> 5;
    const size_t row0 = (size_t)b * SEQ;
    (void)tid; (void)lane; (void)wave; (void)fr; (void)fq; (void)sWm; (void)sAm; (void)sC; (void)rg; (void)h; (void)row0; (void)l;
            __builtin_amdgcn_s_setprio(PREP_PRIO);
            const int pw = wave - 4, s8 = lane >> 3, c8 = lane & 7;
            LASP unsigned char* stg = lds + R_STG + pw * R_STG_SZ;
            LASP bf16_t* sPw = (LASP bf16_t*)stg; LASP bf16_t* sPa = (LASP bf16_t*)(stg + 1152); LASP float* sKt = (LASP float*)(stg + 2304);
            const u32x4 z4 = {0u, 0u, 0u, 0u};
            auto load_raw = [&](int blk, RwRaw& R) {
                const int t = blk * 32 + pw * 8 + s8; const bf16_t* cur = p.PC + (row0 + t) * PC_LD; const bf16_t* prv = cur - PC_LD; const bool hasp = t > 0;
                R.cr = *(const u32x4*)(cur + PC_R + h * 64 + 8 * c8); R.ck = *(const u32x4*)(cur + PC_K + h * 64 + 8 * c8);
                R.cw = *(const u32x4*)(cur + PC_WLR + 8 * c8); R.ca = *(const u32x4*)(cur + PC_ALR + 8 * c8);
                R.pr = hasp ? *(const u32x4*)(prv + PC_R + h * 64 + 8 * c8) : z4; R.pk = hasp ? *(const u32x4*)(prv + PC_K + h * 64 + 8 * c8) : z4;
                R.pw = hasp ? *(const u32x4*)(prv + PC_WLR + 8 * c8) : z4; R.pa = hasp ? *(const u32x4*)(prv + PC_ALR + 8 * c8) : z4;
                R.cv = z4; R.pv = z4;
                if (c8 < 2) { R.cv = *(const u32x4*)(cur + PC_V + h * 64 + 16 * rg + 8 * c8); if (hasp) R.pv = *(const u32x4*)(prv + PC_V + h * 64 + 16 * rg + 8 * c8); } };
            auto stageA = [&](int blk, const RwRaw& R) {
                LASP unsigned char* bf = lds + (blk & 1) * R_BUF;
                LASP float* sW = (LASP float*)(bf + R_W); LASP float* sA = (LASP float*)(bf + R_A); LASP float* sB = (LASP float*)(bf + R_B);
                LASP float* sK2 = (LASP float*)(bf + R_K2); LASP float* sR = (LASP float*)(bf + R_R); LASP float* sV = (LASP float*)(bf + R_V);
                const int t = pw * 8 + s8;
                { f32x4 o0, o1;
                  lerp8(R.cr, R.pr, *(const LASP f32x4*)(sC + 8 * c8), *(const LASP f32x4*)(sC + 8 * c8 + 4), o0, o1); *(LASP f32x4*)(sR + t * 64 + 8 * c8) = o0; *(LASP f32x4*)(sR + t * 64 + 8 * c8 + 4) = o1;
                  lerp8(R.ck, R.pk, *(const LASP f32x4*)(sC + 64 + 8 * c8), *(const LASP f32x4*)(sC + 64 + 8 * c8 + 4), o0, o1); *(LASP f32x4*)(sKt + s8 * 64 + 8 * c8) = o0; *(LASP f32x4*)(sKt + s8 * 64 + 8 * c8 + 4) = o1;
                  lerp8(R.cw, R.pw, *(const LASP f32x4*)(sC + 128 + 8 * c8), *(const LASP f32x4*)(sC + 128 + 8 * c8 + 4), o0, o1);
                  { u32x4 tw; tw.x = pk_bf16(fast_tanh(o0[0]), fast_tanh(o0[1])); tw.y = pk_bf16(fast_tanh(o0[2]), fast_tanh(o0[3])); tw.z = pk_bf16(fast_tanh(o1[0]), fast_tanh(o1[1])); tw.w = pk_bf16(fast_tanh(o1[2]), fast_tanh(o1[3]));
                    *(LASP u32x4*)(sPw + s8 * 72 + 8 * c8) = tw; }
                  lerp8(R.ca, R.pa, *(const LASP f32x4*)(sC + 192 + 8 * c8), *(const LASP f32x4*)(sC + 192 + 8 * c8 + 4), o0, o1);
                  { u32x4 ta; ta.x = pk_bf16(o0[0], o0[1]); ta.y = pk_bf16(o0[2], o0[3]); ta.z = pk_bf16(o1[0], o1[1]); ta.w = pk_bf16(o1[2], o1[3]); *(LASP u32x4*)(sPa + s8 * 72 + 8 * c8) = ta; }
                  if (c8 < 2) { lerp8(R.cv, R.pv, *(const LASP f32x4*)(sC + 256 + 8 * c8), *(const LASP f32x4*)(sC + 256 + 8 * c8 + 4), o0, o1); *(LASP f32x4*)(sV + t * 16 + 8 * c8) = o0; *(LASP f32x4*)(sV + t * 16 + 8 * c8 + 4) = o1; } }
                asm volatile("s_waitcnt lgkmcnt(0)" ::: "memory"); };
            auto stageBC = [&](int blk) {
                LASP unsigned char* bf = lds + (blk & 1) * R_BUF;
                LASP float* sW = (LASP float*)(bf + R_W); LASP float* sA = (LASP float*)(bf + R_A); LASP float* sB = (LASP float*)(bf + R_B); LASP float* sK2 = (LASP float*)(bf + R_K2);
                bf16x8 aw[2], aa[2];
#pragma unroll
                for (int ks = 0; ks < 2; ++ks) { aw[ks] = *(const LASP bf16x8*)(sPw + (fr & 7) * 72 + ks * 32 + fq * 8); aa[ks] = *(const LASP bf16x8*)(sPa + (fr & 7) * 72 + ks * 32 + fq * 8); }
                float ss[4] = {0.f, 0.f, 0.f, 0.f};
                const bool hi = fq >= 2;
                const int jb = (hi ? 32 : 0) + fr, tb8 = (fq & 1) * 4;
                LASP unsigned char* ebase = bf + ((pw * 8 + tb8) * 64 + jb) * 4; const LASP float* ktbase = sKt + tb8 * 64 + jb; const LASP float* cbase = sC + jb;
                float kkv[2][4], rtv[2][4];
#pragma unroll
                for (int nn = 0; nn < 2; ++nn) {
                    f32x4 dz0 = {0.f, 0.f, 0.f, 0.f}, da0 = dz0, dz1 = dz0, da1 = dz0;
#pragma unroll
                    for (int ks = 0; ks < 2; ++ks) {
                        dz0 = MFMA16(aw[ks], *(const LASP bf16x8*)(sWm + (nn * 16 + fr) * 72 + ks * 32 + fq * 8), dz0); da0 = MFMA16(aa[ks], *(const LASP bf16x8*)(sAm + (nn * 16 + fr) * 72 + ks * 32 + fq * 8), da0);
                        dz1 = MFMA16(aw[ks], *(const LASP bf16x8*)(sWm + ((nn + 2) * 16 + fr) * 72 + ks * 32 + fq * 8), dz1); da1 = MFMA16(aa[ks], *(const LASP bf16x8*)(sAm + ((nn + 2) * 16 + fr) * 72 + ks * 32 + fq * 8), da1); }
                    LASP unsigned char* eb = ebase + nn * 64; const LASP float* kt = ktbase + nn * 16; const LASP float* cb = cbase + nn * 16;
                    const float kkc = cb[272], w0c = cb[400], a0c = cb[464];
#pragma unroll
                    for (int r = 0; r < 4; ++r) {
                        const float dzr = hi ? dz1[r] : dz0[r], dar = hi ? da1[r] : da0[r];
                        const float dec = __builtin_amdgcn_exp2f(-0.8750387749145276f * sigmoidf_(w0c + dzr));
                        const float kk = kt[r * 64] * kkc; ss[r] += kk * kk;
                        *(LASP float*)(eb + r * 256 + R_W) = dec; rtv[nn][r] = sigmoidf_(a0c + dar); kkv[nn][r] = kk; } }
#pragma unroll
                for (int r = 0; r < 4; ++r) { float t = row16_sum(ss[r]); t += __shfl_xor(t, 32); ss[r] = rsqrtf(t + 1e-12f); }
                asm volatile("s_waitcnt lgkmcnt(0)" ::: "memory");
#pragma unroll
                for (int nn = 0; nn < 2; ++nn) { LASP unsigned char* eb = ebase + nn * 64; const LASP float* kt = ktbase + nn * 16; const float kac = cbase[nn * 16 + 336];
#pragma unroll
                    for (int r = 0; r < 4; ++r) { const float kn = kkv[nn][r] * ss[r], ar = rtv[nn][r];
                        *(LASP float*)(eb + r * 256 + R_A) = -kn; *(LASP float*)(eb + r * 256 + R_B) = kn * ar; *(LASP float*)(eb + r * 256 + R_K2) = kt[r * 64] * ((ar - 1.0f) * kac + 1.0f); } }
            };
            auto yout = [&](int blk) {
                const LASP float* sY = (const LASP float*)(lds + (blk & 1) * R_BUF + R_Y); const int id = pw * 64 + lane;
#pragma unroll
                for (int k = 0; k < 2; ++k) { const int t = (id >> 4) + 16 * k, i = id & 15; p.yc[(row0 + blk * 32 + t) * 512 + h * 64 + 16 * rg + i] = f2bf(sY[t * 16 + i]); } };
            RwRaw R;
            load_raw(0, R);
            stageA(0, R); load_raw(1, R); stageBC(0);
            __syncthreads();
#pragma unroll 1
            for (int blk = 0; blk < SEQ / 32; ++blk) {
                if (blk >= 1) yout(blk - 1);
#if DBG_DOUBLE & 8192
                if (blk + 1 < SEQ / 32) { stageA(blk + 1, R); stageBC(blk + 1); stageBC(blk + 1); if (blk + 2 < SEQ / 32) load_raw(blk + 2, R); }
#elif DBG_DOUBLE & 16384
                if (blk + 1 < SEQ / 32) { stageA(blk + 1, R); stageA(blk + 1, R); stageBC(blk + 1); if (blk + 2 < SEQ / 32) load_raw(blk + 2, R); }
#else
                if (blk + 1 < SEQ / 32) { stageA(blk + 1, R); if (blk + 2 < SEQ / 32) load_raw(blk + 2, R); stageBC(blk + 1); }
#endif
                __syncthreads();
            }
            yout(SEQ / 32 - 1);
            __builtin_amdgcn_s_setprio(0);
            __syncthreads();
}
__device__ void phase_rwkv_scan(const Params& p, int l, LASP unsigned char* lds, int wg, int nwg) {
    for (int u = wg; u < NB * 8 * 4; u += nwg) { rwkv_scan_setup(p, l, lds, u); if ((threadIdx.x >> 6) < 4) rwkv_scan_waves(p, l, lds, u); else rwkv_prep_waves(p, l, lds, u); }
}

constexpr int R3_A = 0, R3_G = 65536, R3_PA = 131072, R3_PG = 135680;
__device__ __forceinline__ void rwkv_post_ab(const Params& p, int l, LASP unsigned char* lds, int u) {
    LASP float* sAr = (LASP float*)(lds + R3_A); LASP float* sG = (LASP float*)(lds + R3_G);
    LASP bf16_t* sPa = (LASP bf16_t*)(lds + R3_PA); LASP bf16_t* sPg = (LASP bf16_t*)(lds + R3_PG);
    const int tid = threadIdx.x, lane = tid & 63, wave = tid >> 6, fr = lane & 15, fq = lane >> 4;
    const float* mu = p.rw_mu + (size_t)l * 1792;
        const size_t tr0 = (size_t)u * 32;
        const int pt = tid >> 4, cq = tid & 15;
        const size_t tr = tr0 + pt; const bool hasp = (tr & (SEQ - 1)) != 0;
        const bf16_t* cur = p.PC + tr * PC_LD; const bf16_t* prv = cur - PC_LD; const u32x2 z2 = {0u, 0u};
        (void)sAr; (void)sG; (void)wave; (void)lane;
        { const u32x2 ca = *(const u32x2*)(cur + PC_ALR + 4 * cq), pa = hasp ? *(const u32x2*)(prv + PC_ALR + 4 * cq) : z2;
          const f32x4 a4 = lerp4(ca, pa, *(const f32x4*)(mu + PC_ALR + 4 * cq));
          u32x2 ta; ta.x = pk_bf16(a4[0], a4[1]); ta.y = pk_bf16(a4[2], a4[3]); *(LASP u32x2*)(sPa + pt * 72 + 4 * cq) = ta;
#pragma unroll
          for (int g2 = 0; g2 < 2; ++g2) { const int col = 8 * cq + 4 * g2;
              const u32x2 cg = *(const u32x2*)(cur + PC_GLR + col), pg = hasp ? *(const u32x2*)(prv + PC_GLR + col) : z2;
              const f32x4 g4 = lerp4(cg, pg, *(const f32x4*)(mu + PC_GLR + col));
              u32x2 tg; tg.x = pk_bf16(sigmoidf_(g4[0]), sigmoidf_(g4[1])); tg.y = pk_bf16(sigmoidf_(g4[2]), sigmoidf_(g4[3])); *(LASP u32x2*)(sPg + pt * 136 + col) = tg; } }
        __syncthreads();
        { bf16x8 aa[2][2], ag[2][4];
#pragma unroll
          for (int m2 = 0; m2 < 2; ++m2) {
#pragma unroll
              for (int ks = 0; ks < 2; ++ks) aa[m2][ks] = *(const LASP bf16x8*)(sPa + (m2 * 16 + fr) * 72 + ks * 32 + fq * 8);
#pragma unroll
              for (int ks = 0; ks < 4; ++ks) ag[m2][ks] = *(const LASP bf16x8*)(sPg + (m2 * 16 + fr) * 136 + ks * 32 + fq * 8); }
#pragma unroll 1
          for (int ni = 0; ni < 4; ++ni) { const int n = (wave + 8 * ni) * 16 + fr;
              bf16x8 bwa[2], bwg[4];
#pragma unroll
              for (int ks = 0; ks < 2; ++ks) bwa[ks] = ld_frag_g(p.wa2_t + ((size_t)l * 512 + n) * 64 + ks * 32 + fq * 8);
#pragma unroll
              for (int ks = 0; ks < 4; ++ks) bwg[ks] = ld_frag_g(p.wg2_t + ((size_t)l * 512 + n) * 128 + ks * 32 + fq * 8);
              const float a0n = p.rw_a0[(size_t)l * 512 + n];
#pragma unroll
              for (int m2 = 0; m2 < 2; ++m2) { f32x4 da = {0.f, 0.f, 0.f, 0.f}, dg = {0.f, 0.f, 0.f, 0.f};
#pragma unroll
                  for (int ks = 0; ks < 2; ++ks) da = MFMA16(aa[m2][ks], bwa[ks], da);
#pragma unroll
                  for (int ks = 0; ks < 4; ++ks) dg = MFMA16(ag[m2][ks], bwg[ks], dg);
#pragma unroll
                  for (int r = 0; r < 4; ++r) { const int t = m2 * 16 + fq * 4 + r; sAr[t * 512 + n] = sigmoidf_(a0n + da[r]); sG[t * 512 + n] = dg[r]; } } } }
        __syncthreads();
}
__device__ __forceinline__ void rwkv_post_c(const Params& p, int l, LASP unsigned char* lds, int u) {
    LASP float* sAr = (LASP float*)(lds + R3_A); LASP float* sG = (LASP float*)(lds + R3_G);
    LASP bf16_t* sPa = (LASP bf16_t*)(lds + R3_PA); LASP bf16_t* sPg = (LASP bf16_t*)(lds + R3_PG);
    const int tid = threadIdx.x, lane = tid & 63, wave = tid >> 6, fr = lane & 15, fq = lane >> 4;
    const float* mu = p.rw_mu + (size_t)l * 1792;
        const size_t tr0 = (size_t)u * 32;
        const int pt = tid >> 4, cq = tid & 15;
        const size_t tr = tr0 + pt; const bool hasp = (tr & (SEQ - 1)) != 0;
        const bf16_t* cur = p.PC + tr * PC_LD; const bf16_t* prv = cur - PC_LD; const u32x2 z2 = {0u, 0u};
        (void)sPa; (void)sPg; (void)wave; (void)lane; (void)fr; (void)fq;
        struct HeadRaw { u32x2 cr, ck, cv, pr, pk, pv, yw; };
        auto load_head = [&](int h, HeadRaw& R) { const int col = h * 64 + 4 * cq;
            R.cr = *(const u32x2*)(cur + PC_R + col); R.ck = *(const u32x2*)(cur + PC_K + col); R.cv = *(const u32x2*)(cur + PC_V + col);
            R.pr = hasp ? *(const u32x2*)(prv + PC_R + col) : z2; R.pk = hasp ? *(const u32x2*)(prv + PC_K + col) : z2; R.pv = hasp ? *(const u32x2*)(prv + PC_V + col) : z2;
            R.yw = *(const u32x2*)(p.yc + tr * 512 + col); };
        HeadRaw Rn; load_head(0, Rn);
#pragma unroll 1
        for (int h = 0; h < 8; ++h) { const int col = h * 64 + 4 * cq;
            const HeadRaw R = Rn;
            if (h < 7) load_head(h + 1, Rn);
            const f32x4 r4 = lerp4(R.cr, R.pr, *(const f32x4*)(mu + PC_R + col)), k4 = lerp4(R.ck, R.pk, *(const f32x4*)(mu + PC_K + col)), v4 = lerp4(R.cv, R.pv, *(const f32x4*)(mu + PC_V + col));
            const f32x4 ar = *(const LASP f32x4*)(sAr + pt * 512 + col), g4 = *(const LASP f32x4*)(sG + pt * 512 + col);
            const f32x4 ka4 = *(const f32x4*)(p.rw_k_a + (size_t)l * 512 + col), rk4 = *(const f32x4*)(p.rw_r_k + (size_t)l * 512 + col);
            const f32x4 k2 = k4 * ((ar - 1.0f) * ka4 + 1.0f);
            const f32x4 bt = r4 * k2 * rk4; float bonus = row16_sum(bt[0] + bt[1] + bt[2] + bt[3]);
            const u32x2 yw = R.yw;
            const f32x4 y4 = {bflo(yw.x), bfhi(yw.x), bflo(yw.y), bfhi(yw.y)};
            const float mean = row16_sum(y4[0] + y4[1] + y4[2] + y4[3]) * (1.0f / 64.0f);
            const f32x4 dy = y4 - mean; const float var = row16_sum(dy[0] * dy[0] + dy[1] * dy[1] + dy[2] * dy[2] + dy[3] * dy[3]) * (1.0f / 64.0f);
            const float rstd = rsqrtf(var + 64e-5f);
            const f32x4 lg4 = *(const f32x4*)(p.rw_ln_g + (size_t)l * 512 + col), lb4 = *(const f32x4*)(p.rw_ln_b + (size_t)l * 512 + col);
            const f32x4 o = ((dy * rstd) * lg4 + lb4 + v4 * bonus) * g4;
            u32x2 w; w.x = pk_bf16(o[0], o[1]); w.y = pk_bf16(o[2], o[3]);
            *(u32x2*)(p.yc + tr * 512 + col) = w; }
        __syncthreads();
}
__device__ void phase_rwkv_post(const Params& p, int l, LASP unsigned char* lds, int wg, int nwg) {
    for (int u = wg; u < NTOK / 32; u += nwg) { rwkv_post_ab(p, l, lds, u); rwkv_post_c(p, l, lds, u); }
}

__device__ void phase_peer_tables(const Params& p, int l, int wg, int nwg) {
    const int lane = threadIdx.x & 63, wave = threadIdx.x >> 6;
    unsigned char* t8 = (unsigned char*)p.tu; float* tsc = (float*)((unsigned char*)p.tu + (size_t)2 * 16384 * 1024);
    for (int r = wg * 8 + wave; r < 2 * 16384; r += nwg * 8) {
        const int tb = r >> 14, row = r & 16383;
        const float* src = (tb ? p.peer_v : p.peer_u) + ((size_t)l * 16384 + row) * 1024 + 16 * lane;
        f32x4 v[4]; float am = 0.f;
#pragma unroll
        for (int i = 0; i < 4; ++i) { v[i] = *(const f32x4*)(src + 4 * i); am = fmaxf(am, fmaxf(fmaxf(fabsf(v[i][0]), fabsf(v[i][1])), fmaxf(fabsf(v[i][2]), fabsf(v[i][3])))); }
#pragma unroll
        for (int o = 32; o >= 1; o >>= 1) am = fmaxf(am, __shfl_xor(am, o));
        int ex = 0; if (am > 0.f) (void)frexpf(am, &ex);
        const float sc = ldexpf(1.0f, 8 - ex), inv = ldexpf(1.0f, ex - 8);
        u32x4 w;
#pragma unroll
        for (int i = 0; i < 4; ++i) { int q = 0; q = __builtin_amdgcn_cvt_pk_fp8_f32(v[i][0] * sc, v[i][1] * sc, q, false); q = __builtin_amdgcn_cvt_pk_fp8_f32(v[i][2] * sc, v[i][3] * sc, q, true); w[i] = (unsigned)q; }
        *(u32x4*)(t8 + (size_t)tb * 16384 * 1024 + (size_t)(lane >> 3) * 16384 * 128 + (size_t)row * 128 + 16 * (lane & 7)) = w;
        if (lane == 0) tsc[r] = inv;
    }
}
__device__ __forceinline__ float pk_val(unsigned key) { return fkey_inv(key & 0xffffff80u); }
__device__ void phase_peer_select(const Params& p, int l, LASP unsigned char* lds, int wg, int nwg) {
    LASP unsigned* top = (LASP unsigned*)lds;
    const int tid = threadIdx.x, lane = tid & 63, wave = tid >> 6, fr = lane & 15, fq = lane >> 4;
    int ca, cb; bool cvalid = lane < 50;
    { const int c = lane;
      if (c < 16) { ca = 0; cb = c; } else if (c < 24) { ca = 1; cb = c - 16; } else if (c < 29) { ca = 2; cb = c - 24; } else if (c < 33) { ca = 3; cb = c - 29; }
      else if (c < 36) { ca = 4; cb = c - 33; } else if (c < 38) { ca = 5; cb = c - 36; } else if (c < 40) { ca = 6; cb = c - 38; } else if (c < 42) { ca = 7; cb = c - 40; }
      else if (c < 50) { ca = c - 42 + 8; cb = 0; } else { ca = 0; cb = 0; } }
    for (int u = wg; u < NTOK / 64; u += nwg) {
        const size_t t0 = (size_t)u * 64;
#pragma unroll 1
        for (int pi = 0; pi < 2; ++pi) { const int hp = wave * 2 + pi;
            const bf16_t* kb = p.pkeys + ((size_t)l * 16 + hp) * 128 * 64;
            bf16x8 bk[8][2];
#pragma unroll
            for (int nt = 0; nt < 8; ++nt)
#pragma unroll
                for (int ks = 0; ks < 2; ++ks) bk[nt][ks] = ld_frag_g(kb + (size_t)(nt * 16 + fr) * 64 + ks * 32 + fq * 8);
#pragma unroll 1
            for (int mt = 0; mt < 4; ++mt) {
                bf16x8 qa[2];
#pragma unroll
                for (int ks = 0; ks < 2; ++ks) qa[ks] = ld_frag_g(p.qp + (t0 + mt * 16 + fr) * 1024 + hp * 64 + ks * 32 + fq * 8);
                unsigned key[8][4];
#pragma unroll
                for (int nt = 0; nt < 8; ++nt) { f32x4 d = {0.f, 0.f, 0.f, 0.f}; d = MFMA16(qa[0], bk[nt][0], d); d = MFMA16(qa[1], bk[nt][1], d);
#pragma unroll
                    for (int r = 0; r < 4; ++r) key[nt][r] = (fkey(d[r]) & 0xffffff80u) | (unsigned)(127 - (nt * 16 + fr)); }
#define PE_CE(a, b) { const unsigned hi_ = key[a][r] > key[b][r] ? key[a][r] : key[b][r], lo_ = key[a][r] > key[b][r] ? key[b][r] : key[a][r]; key[a][r] = hi_; key[b][r] = lo_; }
#pragma unroll
                for (int r = 0; r < 4; ++r) {
                    PE_CE(0, 1) PE_CE(2, 3) PE_CE(4, 5) PE_CE(6, 7)
                    PE_CE(0, 2) PE_CE(1, 3) PE_CE(4, 6) PE_CE(5, 7)
                    PE_CE(1, 2) PE_CE(5, 6)
                    PE_CE(0, 4) PE_CE(1, 5) PE_CE(2, 6) PE_CE(3, 7)
                    PE_CE(2, 4) PE_CE(3, 5)
                    PE_CE(1, 2) PE_CE(3, 4) PE_CE(5, 6) }
#undef PE_CE
                unsigned mine[4] = {0u, 0u, 0u, 0u};
#pragma unroll 1
                for (int it = 0; it < 16; ++it) {
                    unsigned mx[4];
                    row16_maxu_x4(mx, key[0][0], key[0][1], key[0][2], key[0][3]);
#pragma unroll
                    for (int r = 0; r < 4; ++r) { const unsigned m = mx[r];
                        if (fr == it) mine[r] = m;
                        const bool win = key[0][r] == m;
#pragma unroll
                        for (int nt = 0; nt < 7; ++nt) key[nt][r] = win ? key[nt + 1][r] : key[nt][r];
                        key[7][r] = win ? 0u : key[7][r]; }
                }
#pragma unroll
                for (int r = 0; r < 4; ++r) top[((mt * 16 + fq * 4 + r) * 16 + hp) * 16 + fr] = mine[r];
            }
        }
        __syncthreads();
        { const int t = tid >> 3, h = tid & 7;
          const LASP unsigned* l1 = top + (t * 16 + h * 2) * 16; const LASP unsigned* l2 = l1 + 16;
          float v1[16];
#pragma unroll
          for (int a = 0; a < 16; ++a) v1[a] = pk_val(l1[a]);
          unsigned long long ptrs = 0ull;
          float wsum[16]; unsigned wab[16];
#pragma unroll
          for (int rd = 0; rd < 16; ++rd) {
              float best = -INFINITY; unsigned bab = 0u;
#pragma unroll
              for (int a = 0; a < 16; ++a) {
                  if (a <= rd) {
                      const unsigned b = (unsigned)(ptrs >> (4 * a)) & 15u; const unsigned lim = 16u / (unsigned)(a + 1);
                      const float c = b < lim ? v1[a] + pk_val(l2[b]) : -INFINITY;
                      if (c > best) { best = c; bab = ((unsigned)a << 4) | b; } } }
              wsum[rd] = best; wab[rd] = bab;
              ptrs += 1ull << (4 * (bab >> 4));
          }
          float den = 0.f; float ex[16];
#pragma unroll
          for (int k = 0; k < 16; ++k) { ex[k] = __expf(wsum[k] - wsum[0]); den += ex[k]; }
          const float rd_ = __builtin_amdgcn_rcpf(den);
          const size_t o = (t0 + t) * 128 + h * 16;
          unsigned ew[8];
#pragma unroll
          for (int k = 0; k < 16; ++k) { const unsigned a = wab[k] >> 4, b = wab[k] & 15u; const unsigned e = ((127u - (l1[a] & 127u)) << 7) | (127u - (l2[b] & 127u));
              if (k & 1) ew[k >> 1] |= e << 16; else ew[k >> 1] = e; }
          *(u32x4*)(p.pe_idx + o) = (u32x4){ew[0], ew[1], ew[2], ew[3]}; *(u32x4*)(p.pe_idx + o + 8) = (u32x4){ew[4], ew[5], ew[6], ew[7]};
#pragma unroll
          for (int k4 = 0; k4 < 4; ++k4) *(f32x4*)(p.pe_gate + o + 4 * k4) = (f32x4){ex[4 * k4] * rd_, ex[4 * k4 + 1] * rd_, ex[4 * k4 + 2] * rd_, ex[4 * k4 + 3] * rd_};
        }
        __syncthreads();
    }
}
__device__ __forceinline__ void fp8x16_to_f32(const u32x4& w, float (&f)[16]) {
#pragma unroll
    for (int i = 0; i < 4; ++i) { const f32x2 a = __builtin_amdgcn_cvt_pk_f32_fp8((int)w[i], false), b = __builtin_amdgcn_cvt_pk_f32_fp8((int)w[i], true); f[4 * i] = a[0]; f[4 * i + 1] = a[1]; f[4 * i + 2] = b[0]; f[4 * i + 3] = b[1]; }
}
template <bool DRY> __device__ void phase_peer_gather(const Params& p, int l, int wg, int nwg) {
    const int lane = threadIdx.x & 63, wave = threadIdx.x >> 6;
    const float* gate = p.mod + (size_t)l * 8 * 6144 + 5120;
    const unsigned char* tu8 = (const unsigned char*)p.tu; const unsigned char* tv8 = tu8 + (size_t)16384 * 1024; const float* tsc = (const float*)(tu8 + (size_t)2 * 16384 * 1024);
    for (int tok = wg * 8 + wave; tok < NTOK; tok += nwg * 8) {
        float xv[16];
        { const u32x4 a = *(const u32x4*)(p.hbuf + (size_t)tok * 1024 + 16 * lane), b = *(const u32x4*)(p.hbuf + (size_t)tok * 1024 + 16 * lane + 8);
          xv[0] = bflo(a.x); xv[1] = bfhi(a.x); xv[2] = bflo(a.y); xv[3] = bfhi(a.y); xv[4] = bflo(a.z); xv[5] = bfhi(a.z); xv[6] = bflo(a.w); xv[7] = bfhi(a.w);
          xv[8] = bflo(b.x); xv[9] = bfhi(b.x); xv[10] = bflo(b.y); xv[11] = bfhi(b.y); xv[12] = bflo(b.z); xv[13] = bfhi(b.z); xv[14] = bflo(b.w); xv[15] = bfhi(b.w); }
        const unsigned e_lo = p.pe_idx[(size_t)tok * 128 + lane], e_hi = p.pe_idx[(size_t)tok * 128 + 64 + lane];
        const float g_lo = p.pe_gate[(size_t)tok * 128 + lane] , g_hi = p.pe_gate[(size_t)tok * 128 + 64 + lane];
        const float su_lo = tsc[e_lo], su_hi = tsc[e_hi], sv_lo = tsc[16384 + e_lo], sv_hi = tsc[16384 + e_hi];
        float d_lo = 0.f, d_hi = 0.f;
#pragma unroll 1
        for (int i0 = 0; i0 < 128; i0 += 8) {
            u32x4 ua[8];
#pragma unroll
            for (int j = 0; j < 8; ++j) { const int i = i0 + j; const unsigned e = (unsigned)__builtin_amdgcn_readlane((int)(i0 < 64 ? e_lo : e_hi), i & 63); ua[j] = *(const u32x4*)(tu8 + (size_t)e * 1024 + 16 * lane); }
#pragma unroll
            for (int j = 0; j < 8; ++j) { const int i = i0 + j; float uf[16]; fp8x16_to_f32(ua[j], uf);
                float s = uf[0] * xv[0];
#pragma unroll
                for (int k = 1; k < 16; ++k) s = fmaf(uf[k], xv[k], s);
                s = row16_sum(s); s += __shfl_xor(s, 16); s += __shfl_xor(s, 32);
                if (i0 < 64) { if (lane == (i & 63)) d_lo = s; } else { if (lane == (i & 63)) d_hi = s; } }
        }
        d_lo *= su_lo; d_hi *= su_hi;
        const float w_lo = sv_lo * g_lo * 0.5f * d_lo * (1.0f + erff(d_lo * 0.70710678118654752f)), w_hi = sv_hi * g_hi * 0.5f * d_hi * (1.0f + erff(d_hi * 0.70710678118654752f));
        float ov[16];
#pragma unroll
        for (int j = 0; j < 16; ++j) ov[j] = 0.f;
#pragma unroll 1
        for (int i0 = 0; i0 < 128; i0 += 8) {
            u32x4 va[8]; float ww[8];
#pragma unroll
            for (int j = 0; j < 8; ++j) { const int i = i0 + j; const unsigned e = (unsigned)__builtin_amdgcn_readlane((int)(i0 < 64 ? e_lo : e_hi), i & 63);
                ww[j] = __int_as_float(__builtin_amdgcn_readlane(__float_as_int(i0 < 64 ? w_lo : w_hi), i & 63));
                va[j] = *(const u32x4*)(tv8 + (size_t)e * 1024 + 16 * lane); }
#pragma unroll
            for (int j = 0; j < 8; ++j) { float vf[16]; fp8x16_to_f32(va[j], vf);
#pragma unroll
                for (int k = 0; k < 16; ++k) ov[k] = fmaf(ww[j], vf[k], ov[k]); }
        }
        const float* gp = gate + (size_t)(tok >> 13) * 6144; float* xr = DRY ? (float*)p.qp + (size_t)(tok & 32767) * 1024 : p.out + (size_t)tok * 1024;
#pragma unroll
        for (int q4 = 0; q4 < 4; ++q4) { const int col = 16 * lane + 4 * q4;
            const f32x4 gg = *(const f32x4*)(gp + col); f32x4 xx = *(const f32x4*)(xr + col);
            xx[0] = fmaf(gg[0], ov[q4 * 4 + 0], xx[0]); xx[1] = fmaf(gg[1], ov[q4 * 4 + 1], xx[1]); xx[2] = fmaf(gg[2], ov[q4 * 4 + 2], xx[2]); xx[3] = fmaf(gg[3], ov[q4 * 4 + 3], xx[3]);
            *(f32x4*)(xr + col) = xx; }
    }
}

typedef __bf16 bf2_t __attribute__((ext_vector_type(2)));
__device__ __forceinline__ float fp8_dot16(const u32x4& w, const u32x4& xa, const u32x4& xb) {
    const unsigned xs[8] = {xa.x, xa.y, xa.z, xa.w, xb.x, xb.y, xb.z, xb.w};
    unsigned u[8];
#pragma unroll
    for (int i = 0; i < 4; ++i) { u[2 * i] = __builtin_bit_cast(unsigned, __builtin_amdgcn_cvt_scalef32_pk_bf16_fp8((int)w[i], 1.0f, false)); u[2 * i + 1] = __builtin_bit_cast(unsigned, __builtin_amdgcn_cvt_scalef32_pk_bf16_fp8((int)w[i], 1.0f, true)); }
    float acc = 0.f;
    asm("v_dot2c_f32_bf16 %0, %1, %9\n\tv_dot2c_f32_bf16 %0, %2, %10\n\tv_dot2c_f32_bf16 %0, %3, %11\n\tv_dot2c_f32_bf16 %0, %4, %12\n\t"
        "v_dot2c_f32_bf16 %0, %5, %13\n\tv_dot2c_f32_bf16 %0, %6, %14\n\tv_dot2c_f32_bf16 %0, %7, %15\n\tv_dot2c_f32_bf16 %0, %8, %16\n\ts_nop 1"
        : "+v"(acc) : "v"(u[0]), "v"(u[1]), "v"(u[2]), "v"(u[3]), "v"(u[4]), "v"(u[5]), "v"(u[6]), "v"(u[7]), "v"(xs[0]), "v"(xs[1]), "v"(xs[2]), "v"(xs[3]), "v"(xs[4]), "v"(xs[5]), "v"(xs[6]), "v"(xs[7]));
    return acc;
}
constexpr int PS_IDS = 131072;
#ifndef PSA
#define PSA 8
#endif
#ifndef PSB
#define PSB 4
#endif
#define PS_COMMON \
    LASP float* acc = (LASP float*)lds; \
    const int tid = threadIdx.x, lane = tid & 63, wave = tid >> 6, g = lane >> 3, c = lane & 7; \
    LASP unsigned short* idl = (LASP unsigned short*)(lds + PS_IDS) + wave * 1024 + g * 128; \
    const unsigned char* tu8 = (const unsigned char*)p.tu; const unsigned char* tv8 = tu8 + (size_t)16384 * 1024; const float* tsc = (const float*)(tu8 + (size_t)2 * 16384 * 1024); \
    (void)tid; (void)tu8; (void)tv8; (void)tsc; (void)acc; (void)l;
template <int NB_> __device__ __forceinline__ void ps_load4(const unsigned char* tab, const LASP unsigned short* idl, int jb, int off, u32x4 (&r)[NB_]) {
    unsigned idw[NB_ / 2];
#pragma unroll
    for (int j = 0; j < NB_ / 2; ++j) idw[j] = *(const LASP unsigned*)(idl + jb * NB_ + 2 * j);
#pragma unroll
    for (int j = 0; j < NB_; ++j) { const unsigned e = (j & 1) ? (idw[j >> 1] >> 16) : (idw[j >> 1] & 0xffffu); r[j] = *(const u32x4*)(tab + (size_t)e * 128 + off); }
}
__device__ __forceinline__ void peer_slab_a(const Params& p, int l, LASP unsigned char* lds, int u) {
    PS_COMMON
#pragma unroll 1
    for (int s = 0; s < 8; ++s) {
#pragma unroll 1
        for (int it = 0; it < 4; ++it) { const int tt = wave * 32 + it * 8 + g; const size_t t = (size_t)u * 256 + tt; const int off = s * 128 + c * 16;
            { const u32x4 i0 = *(const u32x4*)(p.pe_idx + t * 128 + c * 16), i1 = *(const u32x4*)(p.pe_idx + t * 128 + c * 16 + 8);
              *(LASP u32x4*)(idl + c * 16) = i0; *(LASP u32x4*)(idl + c * 16 + 8) = i1; }
            const u32x4 xa = *(const u32x4*)(p.hbuf + t * 1024 + off), xb = *(const u32x4*)(p.hbuf + t * 1024 + off + 8);
            asm volatile("s_waitcnt lgkmcnt(0)" ::: "memory");
            auto use4 = [&](int jb, const u32x4 (&ua)[PSA]) {
                float mine0 = 0.f;
#pragma unroll
                for (int j = 0; j < PSA; ++j) {
                    float d = fp8_dot16(ua[j], xa, xb);
                    d += dppf<0xB1>(d); d += dppf<0x4E>(d); d += dppf<0x141>(d);
                    if ((c & (PSA - 1)) == j) mine0 = d; }
                if (c < PSA) { LASP float* ap = acc + tt * 128 + jb * PSA + c; if (s == 0) ap[0] = mine0; else ap[0] += mine0; } };
            u32x4 ra[PSA], rb[PSA];
            const int toff = s * (16384 * 128) + c * 16;
            ps_load4(tu8, idl, 0, toff, ra);
#pragma unroll 1
            for (int jb = 0; jb < 128 / PSA - 2; jb += 2) {
                ps_load4(tu8, idl, jb + 1, toff, rb);
                use4(jb, ra);
                ps_load4(tu8, idl, jb + 2, toff, ra);
                use4(jb + 1, rb);
            }
            ps_load4(tu8, idl, 128 / PSA - 1, toff, rb);
            use4(128 / PSA - 2, ra);
            use4(128 / PSA - 1, rb);
        }
    }
    __syncthreads();
    for (int i = tid; i < 256 * 128; i += NTHR) { const size_t t = (size_t)u * 256 + (i >> 7); const int k = i & 127;
        const unsigned e = p.pe_idx[t * 128 + k]; const float d = acc[i] * tsc[e];
        acc[i] = tsc[16384 + e] * p.pe_gate[t * 128 + k] * 0.5f * d * (1.0f + erff(d * 0.70710678118654752f)); }
    __syncthreads();
}
__device__ __forceinline__ void peer_slab_b(const Params& p, int l, LASP unsigned char* lds, int u) {
    PS_COMMON
    const float* gate = p.mod + (size_t)l * 8 * 6144 + 5120;
#pragma unroll 1
    for (int s = 0; s < 8; ++s) {
#pragma unroll 1
        for (int it = 0; it < 4; ++it) { const int tt = wave * 32 + it * 8 + g; const size_t t = (size_t)u * 256 + tt; const int off = s * 128 + c * 16;
            { const u32x4 i0 = *(const u32x4*)(p.pe_idx + t * 128 + c * 16), i1 = *(const u32x4*)(p.pe_idx + t * 128 + c * 16 + 8);
              *(LASP u32x4*)(idl + c * 16) = i0; *(LASP u32x4*)(idl + c * 16 + 8) = i1; }
            float ov[16];
#pragma unroll
            for (int k = 0; k < 16; ++k) ov[k] = 0.f;
            asm volatile("s_waitcnt lgkmcnt(0)" ::: "memory");
            auto use4 = [&](int jb, const u32x4 (&va)[PSB]) {
                float wq[PSB];
#pragma unroll
                for (int j = 0; j < PSB; ++j) wq[j] = acc[tt * 128 + jb * PSB + j];
#pragma unroll
                for (int j = 0; j < PSB; ++j) { float vf[16]; fp8x16_to_f32(va[j], vf); const float w = wq[j];
#pragma unroll
                    for (int k = 0; k < 16; ++k) ov[k] = fmaf(w, vf[k], ov[k]); } };
            u32x4 ra[PSB], rb[PSB];
            const int toff = s * (16384 * 128) + c * 16;
            ps_load4(tv8, idl, 0, toff, ra);
#pragma unroll 1
            for (int jb = 0; jb < 128 / PSB - 2; jb += 2) {
                ps_load4(tv8, idl, jb + 1, toff, rb);
                use4(jb, ra);
                ps_load4(tv8, idl, jb + 2, toff, ra);
                use4(jb + 1, rb);
            }
            ps_load4(tv8, idl, 128 / PSB - 1, toff, rb);
            use4(128 / PSB - 2, ra);
            use4(128 / PSB - 1, rb);
            const float* gp = gate + (size_t)(t >> 13) * 6144 + off; float* xr = p.out + t * 1024 + off;
#pragma unroll
            for (int q4 = 0; q4 < 4; ++q4) { const f32x4 gg = *(const f32x4*)(gp + 4 * q4); f32x4 xx = *(const f32x4*)(xr + 4 * q4);
                xx[0] = fmaf(gg[0], ov[q4 * 4 + 0], xx[0]); xx[1] = fmaf(gg[1], ov[q4 * 4 + 1], xx[1]); xx[2] = fmaf(gg[2], ov[q4 * 4 + 2], xx[2]); xx[3] = fmaf(gg[3], ov[q4 * 4 + 3], xx[3]);
                *(f32x4*)(xr + 4 * q4) = xx; }
        }
    }
    __syncthreads();
}
__device__ void phase_peer_gather_slab(const Params& p, int l, LASP unsigned char* lds, int wg, int nwg) {
    for (int u = wg; u < NTOK / 256; u += nwg) { peer_slab_a(p, l, lds, u); peer_slab_b(p, l, lds, u); }
}

#if MK_ONE_LAUNCH
#define PHASE_INLINE __attribute__((noinline))
#else
#define PHASE_INLINE __forceinline__
#endif
#ifndef E3_SLAB
#define E3_SLAB 1
#endif
enum { PH_W = 0, PH_A1, PH_A2, PH_G1, PH_G2, PH_G3, PH_D1, PH_D2, PH_D34, PH_R2, PH_R3, PH_M, PH_O, PH_A1F, PH_E1, PH_E2, PH_E3, PH_FIN, PH_W1, PH_W2, PH_W3, PH_W4, PH_E3DRY, PH_COUNT };
enum { UN_DSEL = 0, UN_DATT, UN_R3AB, UN_R3C, UN_R2SETUP, UN_R2SCAN, UN_R2PREP, UN_E3A, UN_E3B, UN_DUP };

template <int PH> __device__ __forceinline__ void run_phase(const Params& p, int l, LASP unsigned char* lds, int wg, int nwg) {
    const float* modl = p.mod + (size_t)l * 8 * 6144;
    const float* xin = l == 0 ? p.x : p.out;
    if constexpr (PH == PH_W) phase_weights<0>(p, lds, wg, nwg);
    else if constexpr (PH == PH_W1) phase_weights<1>(p, lds, wg, nwg);
    else if constexpr (PH == PH_W2) phase_weights<2>(p, lds, wg, nwg);
    else if constexpr (PH == PH_W3) phase_weights<3>(p, lds, wg, nwg);
    else if constexpr (PH == PH_W4) phase_weights<4>(p, lds, wg, nwg);
    else if constexpr (PH == PH_A1) phase_adaln(xin, p.g_mix + (size_t)l * 1024, modl, 0, 1024, p.hbuf, wg, nwg);
    else if constexpr (PH == PH_A2) { pg8::EpiP E; E.GQ = p.GQ; E.GK = p.GK; E.GV = p.GV; E.GR = p.GR; E.PB = p.PB; E.PC = p.PC;
        run_gemm(lds, p.hbuf, p.win_t + (size_t)l * 3840 * 1024, NTOK, 3840, 1024, E, wg, nwg); }
    else if constexpr (PH == PH_G1) phase_gla1(p, l, lds, wg, nwg);
    else if constexpr (PH == PH_G2) phase_gla2(p, wg, nwg);
    else if constexpr (PH == PH_G3) phase_gla3(p, l, lds, wg, nwg);
    else if constexpr (PH == PH_D1) phase_dsa1(p, l, wg, nwg);
    else if constexpr (PH == PH_D2) { pg8::EpiStore<0> E; E.O = p.qd; E.ldc = 1024; run_gemm(lds, p.qn, p.wuq_t + (size_t)l * 1024 * 256, NTOK, 1024, 256, E, wg, nwg);
        pg8::EpiStore<0> E2; E2.O = p.qi; E2.ldc = 256; run_gemm(lds, p.qn, p.wiq_t + (size_t)l * 256 * 256, NTOK, 256, 256, E2, wg, nwg); }
    else if constexpr (PH == PH_D34) phase_dsa34(p, l, lds, wg, nwg);
    else if constexpr (PH == PH_R2) phase_rwkv_scan(p, l, lds, wg, nwg);
    else if constexpr (PH == PH_R3) phase_rwkv_post(p, l, lds, wg, nwg);
    else if constexpr (PH == PH_M) {
        pg8::EpiStore<1> EG; EG.O = p.Gtmp; EG.ldc = 1024;
        const bf16_t* wg_l = p.wg_t + (size_t)l * 3072 * 1024; const bf16_t* wb_l = p.wb_t + (size_t)l * 3 * 1024 * 512;
        run_gemm(lds, p.hbuf, wg_l, NTOK, 1024, 1024, EG, wg, nwg);
        { pg8::EpiMerge<1> EM; EM.G = p.Gtmp; EM.O = p.merged; EM.ldc = 1024; run_gemm(lds, p.ya, wb_l, NTOK, 1024, 512, EM, wg, nwg); }
        run_gemm(lds, p.hbuf, wg_l + (size_t)1024 * 1024, NTOK, 1024, 1024, EG, wg, nwg);
        { pg8::EpiMerge<0> EM; EM.G = p.Gtmp; EM.O = p.merged; EM.ldc = 1024; run_gemm(lds, p.yb, wb_l + (size_t)1024 * 512, NTOK, 1024, 512, EM, wg, nwg); }
        run_gemm(lds, p.hbuf, wg_l + (size_t)2 * 1024 * 1024, NTOK, 1024, 1024, EG, wg, nwg);
        { pg8::EpiMerge<0> EM; EM.G = p.Gtmp; EM.O = p.merged; EM.ldc = 1024; run_gemm(lds, p.yc, wb_l + (size_t)2 * 1024 * 512, NTOK, 1024, 512, EM, wg, nwg); } }
    else if constexpr (PH == PH_O) { pg8::EpiResid E; E.xin = xin; E.xout = p.out; E.gate = modl + 2048; run_gemm(lds, p.merged, p.wo_t + (size_t)l * 1024 * 1024, NTOK, 1024, 1024, E, wg, nwg); }
    else if constexpr (PH == PH_A1F) { phase_adaln(p.out, p.g_ffn + (size_t)l * 1024, modl, 3072, 4096, p.hbuf, wg, nwg); phase_peer_tables(p, l, wg, nwg); }
    else if constexpr (PH == PH_E1) { pg8::EpiStore<0> E; E.O = p.qp; E.ldc = 1024; run_gemm(lds, p.hbuf, p.wq_t + (size_t)l * 1024 * 1024, NTOK, 1024, 1024, E, wg, nwg); }
    else if constexpr (PH == PH_E2) phase_peer_select(p, l, lds, wg, nwg);
    else if constexpr (PH == PH_E3) { if (E3_SLAB) phase_peer_gather_slab(p, l, lds, wg, nwg); else phase_peer_gather<false>(p, l, wg, nwg); }
    else if constexpr (PH == PH_E3DRY) phase_peer_gather<true>(p, l, wg, nwg);
    else if constexpr (PH == PH_FIN) phase_final(p.out, p.g_final, wg, nwg);
}

extern __shared__ __attribute__((aligned(16))) unsigned char smem_dyn[];
#ifndef DBG_MODE
#define DBG_MODE 0
#endif
#ifndef DBG_DOUBLE
#define DBG_DOUBLE 0
#endif
#ifndef DBG_LAYERS
#define DBG_LAYERS NLAYER
#endif
__global__ void __launch_bounds__(NTHR, 2) k_dbg_copy(const float* x, float* out) {
    for (size_t i = (size_t)blockIdx.x * NTHR + threadIdx.x; i < (size_t)NTOK * 1024 / 4; i += (size_t)gridDim.x * NTHR) ((f32x4*)out)[i] = ((const f32x4*)x)[i];
}

__global__ void __launch_bounds__(NTHR, 2) k_dbg_dump(const bf16_t* buf, size_t n, float* out) {
    const size_t NOUT = (size_t)NTOK * 1024;
    for (size_t i = (size_t)blockIdx.x * NTHR + threadIdx.x; i < NOUT; i += (size_t)gridDim.x * NTHR) {
        float s = 0.f; if (n >= NOUT) { for (size_t j = i; j < n; j += NOUT) s += bf2f(buf[j]); } else s = bf2f(buf[i % n]);
        out[i] = s; }
}
#ifndef DBG_A2BUF
#define DBG_A2BUF p.PC
#define DBG_A2N 1792
#endif
#ifndef DBG_G1BUF
#define DBG_G1BUF p.GS
#define DBG_G1N ((size_t)NTOK * 512)
#endif
#ifndef DBG_STOP
#define DBG_STOP PH_O
#endif
#if MK_ONE_LAUNCH
typedef const __attribute__((address_space(4))) Params* KParams;
__device__ __forceinline__ KParams kparams_from(unsigned lo_, unsigned hi_) {
    const unsigned lo = (unsigned)__builtin_amdgcn_readfirstlane((int)lo_), hi = (unsigned)__builtin_amdgcn_readfirstlane((int)hi_);
    return (KParams)(((unsigned long long)hi << 32) | lo);
}
struct ParamsPtrs { void* w[sizeof(Params) / 8]; };
static_assert(sizeof(ParamsPtrs) == sizeof(Params), "Params must be a whole number of pointers");
__device__ __forceinline__ Params load_kparams(KParams pp) {
    typedef const __attribute__((address_space(4))) unsigned long long* KQ; const KQ q = (KQ)pp; ParamsPtrs r;
#pragma unroll
    for (int i = 0; i < (int)(sizeof(Params) / 8); ++i) r.w[i] = (void*)(__attribute__((address_space(1))) void*)q[i];
    return __builtin_bit_cast(Params, r);
}
template <int PH> __device__ __attribute__((noinline)) void phase_call(int l_, LASP unsigned char* lds_, unsigned plo, unsigned phi) {
    const int l = __builtin_amdgcn_readfirstlane(l_);
    LASP unsigned char* lds = (LASP unsigned char*)(unsigned)__builtin_amdgcn_readfirstlane((int)(unsigned)(size_t)lds_);
    const KParams pp = kparams_from(plo, phi);
    const Params p = load_kparams(pp);
    run_phase<PH>(p, l, lds, (int)blockIdx.x, (int)gridDim.x);
}
template <int UN> __device__ __attribute__((noinline)) void unit_call(int l_, LASP unsigned char* lds_, int u_, unsigned plo, unsigned phi) {
    const int l = __builtin_amdgcn_readfirstlane(l_), u = __builtin_amdgcn_readfirstlane(u_);
    LASP unsigned char* lds = (LASP unsigned char*)(unsigned)__builtin_amdgcn_readfirstlane((int)(unsigned)(size_t)lds_);
    const KParams pp = kparams_from(plo, phi);
    const Params p = load_kparams(pp);
    if constexpr (UN == UN_DSEL) dsa_select_unit(p, l, lds, u);
    else if constexpr (UN == UN_DATT) dsa_attend_query(p, l, lds, u);
    else if constexpr (UN == UN_DUP) dsa_upproj_unit(p, l, lds, u);
    else if constexpr (UN == UN_R3AB) rwkv_post_ab(p, l, lds, u);
    else if constexpr (UN == UN_R3C) rwkv_post_c(p, l, lds, u);
    else if constexpr (UN == UN_R2SETUP) rwkv_scan_setup(p, l, lds, u);
    else if constexpr (UN == UN_R2SCAN) rwkv_scan_waves(p, l, lds, u);
    else if constexpr (UN == UN_R2PREP) rwkv_prep_waves(p, l, lds, u);
    else if constexpr (UN == UN_E3A) peer_slab_a(p, l, lds, u);
    else peer_slab_b(p, l, lds, u);
}
constexpr int NSTEP = 22;
struct GemmStep { const bf16_t* A; const bf16_t* Bt; int N, K; pg8::EpiGen E; };
__device__ __forceinline__ bool make_gemm_step(const Params& p, int l, int s, GemmStep& g) {
    const float* modl = p.mod + (size_t)l * 8 * 6144;
    pg8::EpiGen& E = g.E;
    E.kind = 1; E.ldc = 1024; E.O = nullptr; E.G = p.Gtmp; E.GQ = p.GQ; E.GK = p.GK; E.GV = p.GV; E.GR = p.GR; E.PB = p.PB; E.PC = p.PC; E.xin = l == 0 ? p.x : p.out; E.xout = p.out; E.gate = modl + 2048;
    const bf16_t* wg_l = p.wg_t + (size_t)l * 3072 * 1024; const bf16_t* wb_l = p.wb_t + (size_t)l * 3 * 1024 * 512;
    g.N = 1024; g.K = 1024; g.A = p.hbuf; g.Bt = nullptr;
    switch (s) {
    case 1: g.Bt = p.win_t + (size_t)l * 3840 * 1024; g.N = 3840; E.kind = 0; return true;
    case 6: g.A = p.qn; g.Bt = p.wuq_t + (size_t)l * 1024 * 256; g.K = 256; E.O = p.qd; return true;
    case 7: g.A = p.qn; g.Bt = p.wiq_t + (size_t)l * 256 * 256; g.N = 256; g.K = 256; E.O = p.qi; E.ldc = 256; return true;
    case 11: g.Bt = wg_l; E.kind = 2; E.O = p.Gtmp; return true;
    case 12: g.A = p.ya; g.Bt = wb_l; g.K = 512; E.kind = 3; E.O = p.merged; return true;
    case 13: g.Bt = wg_l + (size_t)1024 * 1024; E.kind = 2; E.O = p.Gtmp; return true;
    case 14: g.A = p.yb; g.Bt = wb_l + (size_t)1024 * 512; g.K = 512; E.kind = 4; E.O = p.merged; return true;
    case 15: g.Bt = wg_l + (size_t)2 * 1024 * 1024; E.kind = 2; E.O = p.Gtmp; return true;
    case 16: g.A = p.yc; g.Bt = wb_l + (size_t)2 * 1024 * 512; g.K = 512; E.kind = 4; E.O = p.merged; return true;
    case 17: g.A = p.merged; g.Bt = p.wo_t + (size_t)l * 1024 * 1024; E.kind = 5; return true;
    case 19: g.Bt = p.wq_t + (size_t)l * 1024 * 1024; E.O = p.qp; return true;
    default: return false; }
}
__global__ void __launch_bounds__(NTHR, 2) mega_fwd(Params p) {
    LASP unsigned char* lds = (LASP unsigned char*)smem_dyn;
    if (threadIdx.x < 4) ((LASP unsigned*)(lds + LDS_BAR_OFF))[threadIdx.x] = 0u;
    __syncthreads();
    const XcdBarrier bar = xcd_barrier_post(p.bar, (volatile LAS unsigned*)(lds + LDS_BAR_OFF));
    const int wg = blockIdx.x, nwg = gridDim.x;
    const unsigned long long kpa = (unsigned long long)__builtin_amdgcn_kernarg_segment_ptr(); const unsigned kplo = (unsigned)kpa, kphi = (unsigned)(kpa >> 32);
#if DBG_DOUBLE & 2048
    phase_call<PH_W>(0, lds, kplo, kphi); phase_call<PH_W1>(0, lds, kplo, kphi); phase_call<PH_W2>(0, lds, kplo, kphi); phase_call<PH_W3>(0, lds, kplo, kphi); phase_call<PH_W4>(0, lds, kplo, kphi);
#endif
    phase_call<PH_W>(0, lds, kplo, kphi); phase_call<PH_W1>(0, lds, kplo, kphi); phase_call<PH_W2>(0, lds, kplo, kphi); phase_call<PH_W3>(0, lds, kplo, kphi); phase_call<PH_W4>(0, lds, kplo, kphi); xcd_barrier(bar);
#pragma unroll 1
    for (int ls = 0; ls < NLAYER * NSTEP; ++ls) {
        const int l = ls / NSTEP, s = ls % NSTEP;
        GemmStep g;
        if (make_gemm_step(p, l, s, g)) {
#if DBG_DOUBLE & 1
            if (s != 17 && s != 14 && s != 16) { pg8::Gemm gg; gg.A = g.A; gg.Bt = g.Bt; gg.M = NTOK; gg.N = g.N; gg.K = g.K; pg8::StaticOrder S; S.init(NTOK, g.N, nwg, wg);
                pg8::gemm_phase<pg8::EpiGen, pg8::StaticOrder, false>(lds, gg, S, g.E, nullptr); __syncthreads(); }
#endif
            pg8::Gemm gg; gg.A = g.A; gg.Bt = g.Bt; gg.M = NTOK; gg.N = g.N; gg.K = g.K;
            pg8::StaticOrder S; S.init(NTOK, g.N, nwg, wg);
#if DBG_DOUBLE & 0x3C0000
            int reps = 1; const int k0 = g.E.kind;
            if ((DBG_DOUBLE & 0x40000) && (s == 11 || s == 13 || s == 15)) { reps = 2; g.E.kind = 6; }
            if ((DBG_DOUBLE & 0x80000) && (s == 11 || s == 13 || s == 15)) { reps = 2; }
            if ((DBG_DOUBLE & 0x100000) && (s == 12 || s == 14 || s == 16)) { reps = 2; g.E.kind = 6; }
            if ((DBG_DOUBLE & 0x200000) && (s == 12 || s == 14 || s == 16)) { reps = 2; g.E.kind = 7; }
            for (int rep = 0; rep < reps; ++rep) { if (rep == reps - 1) g.E.kind = k0;
                pg8::gemm_phase<pg8::EpiGen, pg8::StaticOrder, false>(lds, gg, S, g.E, nullptr); __syncthreads(); }
#else
            pg8::gemm_phase<pg8::EpiGen, pg8::StaticOrder, false>(lds, gg, S, g.E, nullptr);
            __syncthreads();
#endif
        } else {
#if DBG_DOUBLE & 2
            if (s == 8) for (int pos = wg; pos < 4096; pos += nwg) { unit_call<UN_DSEL>(l, lds, pos, kplo, kphi); unit_call<UN_DATT>(l, lds, pos, kplo, kphi); unit_call<UN_DUP>(l, lds, pos, kplo, kphi); }
#endif
#if DBG_DOUBLE & 4
            if (s == 9) for (int u = wg; u < NB * 8 * 4; u += nwg) { unit_call<UN_R2SETUP>(l, lds, u, kplo, kphi);
                if ((threadIdx.x >> 6) < 4) unit_call<UN_R2SCAN>(l, lds, u, kplo, kphi); else unit_call<UN_R2PREP>(l, lds, u, kplo, kphi); }
#endif
#if DBG_DOUBLE & 8
            if (s == 20) phase_call<PH_E2>(l, lds, kplo, kphi);
#endif
#if DBG_DOUBLE & 16
            if (s == 21) phase_call<PH_E3DRY>(l, lds, kplo, kphi);
#endif
#if DBG_DOUBLE & 32
            if (s == 0) phase_call<PH_A1>(l, lds, kplo, kphi);
            if (s == 2) phase_call<PH_G1>(l, lds, kplo, kphi);
            if (s == 4) phase_call<PH_G3>(l, lds, kplo, kphi);
            if (s == 5) phase_call<PH_D1>(l, lds, kplo, kphi);
            if (s == 18) phase_call<PH_A1F>(l, lds, kplo, kphi);
#endif
            switch (s) {
            case 0: phase_call<PH_A1>(l, lds, kplo, kphi); break;
            case 2: phase_call<PH_G1>(l, lds, kplo, kphi); break;
            case 3: phase_call<PH_G2>(l, lds, kplo, kphi); break;
            case 4: phase_call<PH_G3>(l, lds, kplo, kphi); break;
            case 5: phase_call<PH_D1>(l, lds, kplo, kphi); break;
            case 8: for (int pos = wg; pos < 4096; pos += nwg) {
#if DBG_DOUBLE & 64
                unit_call<UN_DSEL>(l, lds, pos, kplo, kphi);
#endif
                unit_call<UN_DSEL>(l, lds, pos, kplo, kphi);
#if DBG_DOUBLE & 128
                unit_call<UN_DATT>(l, lds, pos, kplo, kphi);
#endif
                unit_call<UN_DATT>(l, lds, pos, kplo, kphi); unit_call<UN_DUP>(l, lds, pos, kplo, kphi); } break;
            case 9: for (int u = wg; u < NB * 8 * 4; u += nwg) { unit_call<UN_R2SETUP>(l, lds, u, kplo, kphi);
                if ((threadIdx.x >> 6) < 4) unit_call<UN_R2SCAN>(l, lds, u, kplo, kphi); else unit_call<UN_R2PREP>(l, lds, u, kplo, kphi); } break;
            case 10: for (int u = wg; u < NTOK / 32; u += nwg) {
#if DBG_DOUBLE & 4096
                unit_call<UN_R3AB>(l, lds, u, kplo, kphi);
#endif
                unit_call<UN_R3AB>(l, lds, u, kplo, kphi); unit_call<UN_R3C>(l, lds, u, kplo, kphi); } break;
            case 18: phase_call<PH_A1F>(l, lds, kplo, kphi); break;
            case 20: phase_call<PH_E2>(l, lds, kplo, kphi); break;
            default: if (E3_SLAB) { for (int u = wg; u < NTOK / 256; u += nwg) {
#if DBG_DOUBLE & 0x400000
                         unit_call<UN_E3A>(l, lds, u, kplo, kphi);
#endif
                         unit_call<UN_E3A>(l, lds, u, kplo, kphi); unit_call<UN_E3B>(l, lds, u, kplo, kphi); } }
                     else phase_call<PH_E3>(l, lds, kplo, kphi);
                     break; }
        }
        const bool nobar = (s == 6) || (s >= 11 && s <= 15);
        if (!nobar) xcd_barrier(bar);
#if DBG_DOUBLE & 32768
        if (!nobar) xcd_barrier(bar);
#endif
    }
    phase_call<PH_FIN>(0, lds, kplo, kphi);
}
#else
template <int PH> __global__ void __launch_bounds__(NTHR, 2) k_phase(Params p, int l) {
    LASP unsigned char* lds = (LASP unsigned char*)smem_dyn;
    run_phase<PH>(p, l, lds, blockIdx.x, gridDim.x);
}
template <int PH> static void launch_phase(const Params& p, int l, int grid, hipStream_t stream) {
    static bool attr = false;
    if (!attr) { hipFuncSetAttribute((const void*)k_phase<PH>, hipFuncAttributeMaxDynamicSharedMemorySize, LDS_BYTES); attr = true; }
    hipLaunchKernelGGL(k_phase<PH>, dim3(grid), dim3(NTHR), LDS_BYTES, stream, p, l);
}
#endif

static size_t carve(size_t& off, size_t bytes) { const size_t o = off; off += (bytes + 255) & ~(size_t)255; return o; }

extern "C" void kernel_launch(void* const* d_in, const int* in_sizes, int n_in, void* d_out, int out_size, void* d_ws, size_t ws_size, hipStream_t stream) {
    (void)in_sizes; (void)out_size;
    if (n_in != 33) { fprintf(stderr, "kernel_launch: expected 33 inputs, got %d\n", n_in); return; }
    Params p; memset(&p, 0, sizeof(p));
    const float* const* in = (const float* const*)d_in;
    p.x = in[0]; p.c = in[1]; p.w_ada = in[2]; p.b_ada = in[3]; p.g_mix = in[4]; p.g_ffn = in[5]; p.w_in = in[6]; p.gla_w_a2 = in[7]; p.gla_b_a = in[8]; p.gla_g_o = in[9];
    p.dsa_g_qc = in[10]; p.dsa_w_uq = in[11]; p.dsa_w_iq = in[12]; p.dsa_g_kv = in[13]; p.dsa_w_uv = in[14];
    p.rw_mu = in[15]; p.rw_w0 = in[16]; p.rw_w_w2 = in[17]; p.rw_a0 = in[18]; p.rw_w_a2 = in[19]; p.rw_w_g2 = in[20]; p.rw_k_k = in[21]; p.rw_k_a = in[22]; p.rw_r_k = in[23];
    p.rw_ln_g = in[24]; p.rw_ln_b = in[25]; p.w_branch = in[26]; p.w_out = in[27]; p.peer_w_q = in[28]; p.peer_keys = in[29]; p.peer_u = in[30]; p.peer_v = in[31]; p.g_final = in[32];
    p.out = (float*)d_out;
    char* ws = (char*)d_ws; size_t off = 0;
    const size_t TB2 = (size_t)NTOK * 2;
    p.bar = (unsigned*)(ws + carve(off, 16384));
    p.mod = (float*)(ws + carve(off, (size_t)NLAYER * 8 * 6144 * 4));
    p.win_t = (bf16_t*)(ws + carve(off, (size_t)NLAYER * 3840 * 1024 * 2));
    p.wg_t = (bf16_t*)(ws + carve(off, (size_t)NLAYER * 3072 * 1024 * 2));
    p.wb_t = (bf16_t*)(ws + carve(off, (size_t)NLAYER * 3 * 1024 * 512 * 2));
    p.wo_t = (bf16_t*)(ws + carve(off, (size_t)NLAYER * 1024 * 1024 * 2));
    p.wq_t = (bf16_t*)(ws + carve(off, (size_t)NLAYER * 1024 * 1024 * 2));
    p.wuq_t = (bf16_t*)(ws + carve(off, (size_t)NLAYER * 1024 * 256 * 2));
    p.wiq_t = (bf16_t*)(ws + carve(off, (size_t)NLAYER * 256 * 256 * 2));
    p.wuv_t = (bf16_t*)(ws + carve(off, (size_t)NLAYER * 8 * 64 * 128 * 2));
    p.pkeys = (bf16_t*)(ws + carve(off, (size_t)NLAYER * 8 * 2 * 128 * 64 * 2));
    p.ww2_t = (bf16_t*)(ws + carve(off, (size_t)NLAYER * 512 * 64 * 2));
    p.wa2_t = (bf16_t*)(ws + carve(off, (size_t)NLAYER * 512 * 64 * 2));
    p.wg2_t = (bf16_t*)(ws + carve(off, (size_t)NLAYER * 512 * 128 * 2));
    p.hbuf = (bf16_t*)(ws + carve(off, TB2 * 1024));
    char* R1 = ws + carve(off, TB2 * 1536);
    p.GQ = (bf16_t*)R1; p.GK = (bf16_t*)(R1 + TB2 * 256); p.GR = (bf16_t*)(R1 + TB2 * 512); p.GS = (bf16_t*)(R1 + TB2 * 1024);
    p.GV = (bf16_t*)(ws + carve(off, TB2 * 512));
    p.PB = (bf16_t*)(ws + carve(off, TB2 * 512));
    p.PC = (bf16_t*)(ws + carve(off, TB2 * 1792));
    p.yb = (bf16_t*)(ws + carve(off, TB2 * 512));
    p.yc = (bf16_t*)(ws + carve(off, TB2 * 512));
    p.kvn = (bf16_t*)(ws + carve(off, TB2 * 128));
    p.gdec = (float*)(ws + carve(off, (size_t)NB * NCHUNK * 4 * 64 * 4));
    p.qd = (bf16_t*)R1; p.qi = (bf16_t*)(R1 + TB2 * 1024); p.qn = (bf16_t*)(R1 + TB2 * 1280);
    p.ya = p.GV; p.Gtmp = (bf16_t*)R1; p.merged = p.PC;
    p.qp = (bf16_t*)R1; p.tu = (bf16_t*)(R1 + TB2 * 1024); p.tv = (bf16_t*)(R1 + TB2 * 1280);
    p.pe_idx = (unsigned short*)p.PC; p.pe_gate = (float*)((char*)p.PC + (size_t)NTOK * 128 * 2);
    if (off > ws_size) { fprintf(stderr, "kernel_launch: workspace too small: need %zu, have %zu\n", off, ws_size); return; }
    static int grid = 0;
    if (!grid) { int dev = 0, cus = 0; hipGetDevice(&dev); hipDeviceGetAttribute(&cus, hipDeviceAttributeMultiprocessorCount, dev); grid = cus > 0 ? cus : 256; if (grid > 256) grid = 256; }
#if MK_ONE_LAUNCH
    static bool attr = false;
    if (!attr) { if (hipFuncSetAttribute((const void*)mega_fwd, hipFuncAttributeMaxDynamicSharedMemorySize, LDS_BYTES) != hipSuccess) fprintf(stderr, "kernel_launch: hipFuncSetAttribute failed\n"); attr = true; }
    hipMemsetAsync(p.bar, 0, 16384, stream);
    hipLaunchKernelGGL(mega_fwd, dim3(grid), dim3(NTHR), LDS_BYTES, stream, p);
#else
#if DBG_MODE == 1
    hipLaunchKernelGGL(k_dbg_copy, dim3(grid), dim3(NTHR), 0, stream, p.x, p.out);
    launch_phase<PH_FIN>(p, 0, grid, stream);
    return;
#endif
#if DBG_MODE == 2
    {   launch_phase<PH_W>(p, 0, grid, stream); launch_phase<PH_W1>(p, 0, grid, stream); launch_phase<PH_W2>(p, 0, grid, stream); launch_phase<PH_W3>(p, 0, grid, stream); launch_phase<PH_W4>(p, 0, grid, stream);
        const bf16_t* db = nullptr; size_t dn = 0; const int l = 0;
        launch_phase<PH_A1>(p, l, grid, stream); db = p.hbuf; dn = (size_t)NTOK * 1024;
        if (DBG_STOP >= PH_A2) { launch_phase<PH_A2>(p, l, grid, stream); db = DBG_A2BUF; dn = (size_t)NTOK * DBG_A2N; }
        if (DBG_STOP >= PH_G1) { launch_phase<PH_G1>(p, l, grid, stream); db = DBG_G1BUF; dn = DBG_G1N; }
        if (DBG_STOP >= PH_G2) { launch_phase<PH_G2>(p, l, grid, stream); db = p.GS; dn = (size_t)NTOK * 512; }
        if (DBG_STOP >= PH_G3) { launch_phase<PH_G3>(p, l, grid, stream); db = p.ya; dn = (size_t)NTOK * 512; }
        if (DBG_STOP >= PH_D1) { launch_phase<PH_D1>(p, l, grid, stream); db = p.qn; dn = (size_t)NTOK * 256; }
        if (DBG_STOP >= PH_D2) { launch_phase<PH_D2>(p, l, grid, stream); db = p.qd; dn = (size_t)NTOK * 1280; }
        if (DBG_STOP >= PH_D34) { launch_phase<PH_D34>(p, l, grid, stream); db = p.yb; dn = (size_t)NTOK * 512; }
        if (DBG_STOP >= PH_R2) { launch_phase<PH_R2>(p, l, grid, stream); db = p.yc; dn = (size_t)NTOK * 512; }
        if (DBG_STOP >= PH_R3) { launch_phase<PH_R3>(p, l, grid, stream); db = p.yc; dn = (size_t)NTOK * 512; }
        if (DBG_STOP >= PH_M) { launch_phase<PH_M>(p, l, grid, stream); db = p.merged; dn = (size_t)NTOK * 1024; }
        if (DBG_STOP >= PH_O) { launch_phase<PH_O>(p, l, grid, stream); db = nullptr; }
        if (DBG_STOP >= PH_A1F) { launch_phase<PH_A1F>(p, l, grid, stream); }
        if (DBG_STOP >= PH_E1) { launch_phase<PH_E1>(p, l, grid, stream); db = p.qp; dn = (size_t)NTOK * 1024; }
        if (DBG_STOP >= PH_E2) { launch_phase<PH_E2>(p, l, grid, stream); db = (const bf16_t*)p.pe_gate; dn = (size_t)NTOK * 256; }
        if (DBG_STOP >= PH_E3) { launch_phase<PH_E3>(p, l, grid, stream); db = nullptr; }
        if (db) hipLaunchKernelGGL(k_dbg_dump, dim3(grid), dim3(NTHR), 0, stream, db, dn, p.out);
        return; }
#endif
    launch_phase<PH_W>(p, 0, grid, stream); launch_phase<PH_W1>(p, 0, grid, stream); launch_phase<PH_W2>(p, 0, grid, stream); launch_phase<PH_W3>(p, 0, grid, stream); launch_phase<PH_W4>(p, 0, grid, stream);
    for (int l = 0; l < DBG_LAYERS; ++l) {
        launch_phase<PH_A1>(p, l, grid, stream); launch_phase<PH_A2>(p, l, grid, stream);
        launch_phase<PH_G1>(p, l, grid, stream); launch_phase<PH_G2>(p, l, grid, stream); launch_phase<PH_G3>(p, l, grid, stream);
        launch_phase<PH_D1>(p, l, grid, stream); launch_phase<PH_D2>(p, l, grid, stream); launch_phase<PH_D34>(p, l, grid, stream);
        launch_phase<PH_R2>(p, l, grid, stream); launch_phase<PH_R3>(p, l, grid, stream);
        launch_phase<PH_M>(p, l, grid, stream); launch_phase<PH_O>(p, l, grid, stream);
        launch_phase<PH_A1F>(p, l, grid, stream); launch_phase<PH_E1>(p, l, grid, stream); launch_phase<PH_E2>(p, l, grid, stream); launch_phase<PH_E3>(p, l, grid, stream);
    }
    launch_phase<PH_FIN>(p, 0, grid, stream);
#endif
}
```

```cpp
#include <hip/hip_runtime.h>
#include <stdint.h>
#include <stdio.h>
#include <string.h>

#ifndef MK_ONE_LAUNCH
#define MK_ONE_LAUNCH 1
#endif

typedef unsigned short bf16_t;
typedef short bf16x8 __attribute__((ext_vector_type(8)));
typedef float f32x4 __attribute__((ext_vector_type(4)));
typedef float f32x2 __attribute__((ext_vector_type(2)));
typedef unsigned u32x4 __attribute__((ext_vector_type(4)));
typedef unsigned u32x2 __attribute__((ext_vector_type(2)));

#define XB_TMO      128
#define XB_XCNT(j)  (256  + 64 * (j))
#define XB_XSUB(j)  (1280 + 64 * (j))
#define XB_XGEN(j)  (2304 + 64 * (j))
#define XB_TOP      3328
#define XB_TOPGEN   3392
#define XCD_BAR_WORDS 3456
#define XB_SPIN_CAP (1u << 24)
#define LAS __attribute__((address_space(3)))

__device__ __forceinline__ unsigned xb_ld(unsigned* p)              { return __hip_atomic_load(p, __ATOMIC_RELAXED, __HIP_MEMORY_SCOPE_AGENT); }
__device__ __forceinline__ unsigned xb_add(unsigned* p, unsigned v) { return __hip_atomic_fetch_add(p, v, __ATOMIC_RELAXED, __HIP_MEMORY_SCOPE_AGENT); }
__device__ __forceinline__ unsigned xb_xcc_id() { return (unsigned)__builtin_amdgcn_s_getreg((3 << 11) | 20) & 0xFu; }
#define XB_SPIN(cond, bar) do { unsigned _sp = 0; while (cond) { __builtin_amdgcn_s_sleep(1); \
    if ((++_sp & 255u) == 0u) { if (xb_ld(&(bar)[XB_TMO])) break; if (_sp > XB_SPIN_CAP) { atomicAdd(&(bar)[XB_TMO], 1u); break; } } } } while (0)

struct XcdBarrier {
    unsigned* bar; unsigned x;
    volatile LAS unsigned* st;
};

__device__ __forceinline__ XcdBarrier xcd_barrier_post(unsigned* bar, volatile LAS unsigned* st) {
    XcdBarrier b; b.bar = bar; b.x = xb_xcc_id(); b.st = st;
    if (threadIdx.x == 0) (void)xb_add(&bar[XB_XCNT(b.x)], 1u);
    return b;
}
__device__ __forceinline__ void xcd_barrier_complete(unsigned* bar, unsigned x, unsigned& nloc, unsigned& nx) {
    const unsigned G = gridDim.x * gridDim.y * gridDim.z;
    unsigned sum, cnt, mine, sp = 0u;
    for (;;) {
        sum = 0u; cnt = 0u; mine = 0u;
#pragma unroll
        for (unsigned j = 0; j < 16; ++j) { const unsigned c = xb_ld(&bar[XB_XCNT(j)]); sum += c; cnt += (c > 0u) ? 1u : 0u; mine = (j == x) ? c : mine; }
        if (sum == G) break;
        __builtin_amdgcn_s_sleep(1);
        if ((++sp & 255u) == 0u) { if (xb_ld(&bar[XB_TMO])) break; if (sp > XB_SPIN_CAP) { atomicAdd(&bar[XB_TMO], 1u); break; } }
    }
    nloc = mine > 0u ? mine : 1u; nx = cnt > 0u ? cnt : 1u;
}

__device__ __forceinline__ void xcd_barrier(const XcdBarrier& b) {
    asm volatile("s_waitcnt vmcnt(0)" ::: "memory");
    __syncthreads();
    if (threadIdx.x == 0) {
        unsigned* bar = b.bar;
        __builtin_amdgcn_s_waitcnt(0);
        unsigned nloc = b.st[0], nx = b.st[1];
        if (nloc == 0u) { xcd_barrier_complete(bar, b.x, nloc, nx); b.st[0] = nloc; b.st[1] = nx; }
        const unsigned old = xb_add(&bar[XB_XSUB(b.x)], 1u);
        const unsigned gen = old / nloc;
        if (old + 1u == (gen + 1u) * nloc) {
            __builtin_amdgcn_fence(__ATOMIC_RELEASE, "agent");
            asm volatile("s_waitcnt vmcnt(0)" ::: "memory");
            const unsigned og = xb_add(&bar[XB_TOP], 1u);
            const unsigned tg = og / nx;
            if (og + 1u == (tg + 1u) * nx) xb_add(&bar[XB_TOPGEN], 1u);
            else XB_SPIN(xb_ld(&bar[XB_TOPGEN]) == tg, bar);
            __builtin_amdgcn_fence(__ATOMIC_ACQUIRE, "agent");
            xb_add(&bar[XB_XGEN(b.x)], 1u);
            asm volatile("s_waitcnt vmcnt(0)" ::: "memory");
        } else {
            XB_SPIN(xb_ld(&bar[XB_XGEN(b.x)]) == gen, bar);
            __builtin_amdgcn_fence(__ATOMIC_ACQUIRE, "agent");
            asm volatile("s_waitcnt vmcnt(0)" ::: "memory");
        }
    }
    __syncthreads();
}
namespace pg8 {
#define PG8_LAS __attribute__((address_space(3)))
typedef unsigned short bf16_t;
typedef short bf16x8 __attribute__((ext_vector_type(8)));
typedef float f32x4 __attribute__((ext_vector_type(4)));
typedef unsigned u32x4 __attribute__((ext_vector_type(4)));
constexpr int BM = 256, BK = 64, HALF = 128, HTB = HALF * BK * 2  , STAGE_BYTES = 8 * HTB, NXCD = 8, WGM = 8;

__host__ __device__ __forceinline__ int lds_byte(int r, int c) { const int st = (r >> 4) * 2 + (c >> 5), rr = r & 15, cc = c & 31, ob = rr * 64 + cc * 2; return st * 1024 + (ob ^ (((ob >> 9) & 1) << 5)); }
__host__ __device__ __forceinline__ void stage_rc(int b, int& R, int& C) { const int st = b / 1024, sb = b % 1024, swz = sb ^ (((sb >> 9) & 1) << 5); R = (st >> 1) * 16 + swz / 64; C = (st & 1) * 32 + (swz % 64) / 2; }
__host__ __device__ __forceinline__ int perm32(int rho) { const int n = rho >> 4, i = rho & 15; return 8 * (i >> 2) + 4 * n + (i & 3); }

struct Unit { int pm, pn; };
struct Gemm { const bf16_t* A; const bf16_t* Bt; int M, N, K; };

struct StaticOrder {
    int nM, nN, nwg, G, c;
    __host__ __device__ void init(int M, int N, int G_, int c_) { nM = M / BM; nN = N / BM; nwg = nM * nN; G = G_; c = c_; }
    __host__ __device__ bool next(int i, Unit& u) const {
        const long L = (long)i * G + c; if (L >= nwg) return false;
        int wgid = (int)L; { const int q = nwg / NXCD, r = nwg % NXCD, xcd = wgid % NXCD, off = wgid / NXCD; wgid = (xcd < r ? xcd * (q + 1) : r * (q + 1) + (xcd - r) * q) + off; }
        const int nig = WGM * nN, gid = wgid / nig, fm = gid * WGM, gsz = (nM - fm) < WGM ? (nM - fm) : WGM;
        u.pm = fm + ((wgid % nig) % gsz); u.pn = (wgid % nig) / gsz; return true;
    }
    __device__ __forceinline__ void a_ready(const Unit&) const {}
    __device__ __forceinline__ void done(const Unit&) const {}
};
struct CountedOrder : StaticOrder {
    const unsigned* ready; unsigned need; unsigned* tmo;
    __device__ __forceinline__ void a_ready(const Unit& u) const {
        if (threadIdx.x < 64) {
            const unsigned long long t0 = __builtin_amdgcn_s_memrealtime(); unsigned polls = 0;
            while ((unsigned)__builtin_amdgcn_readfirstlane(__hip_atomic_load(ready + 64 * u.pm, __ATOMIC_RELAXED, __HIP_MEMORY_SCOPE_AGENT)) < need) {
                if ((++polls & 255u) == 0u && __builtin_amdgcn_readfirstlane(__hip_atomic_load(tmo, __ATOMIC_RELAXED, __HIP_MEMORY_SCOPE_AGENT)) != 0u) break;
                if (__builtin_amdgcn_s_memrealtime() - t0 > 2000000ull) {
                    if (threadIdx.x == 0) { unsigned expect = 0u; __hip_atomic_compare_exchange_strong(tmo + 1, &expect, 0x600u | (unsigned)(u.pm & 0xff), __ATOMIC_RELAXED, __ATOMIC_RELAXED, __HIP_MEMORY_SCOPE_AGENT); __hip_atomic_store(tmo, 1u, __ATOMIC_RELAXED, __HIP_MEMORY_SCOPE_AGENT); }
                    break; }
                __builtin_amdgcn_s_sleep(2); }
            __builtin_amdgcn_fence(__ATOMIC_ACQUIRE, "agent");
            asm volatile("s_waitcnt vmcnt(0)" ::: "memory");
        }
#if !defined(BROKEN_HOOK_NO_BARRIER)
        asm volatile("" ::: "memory"); __builtin_amdgcn_s_barrier(); asm volatile("" ::: "memory");
#endif
    }
};

typedef __bf16 bf16x2_t __attribute__((ext_vector_type(2)));
__device__ __forceinline__ unsigned cvt_pk_bf16(float lo, float hi) { typedef float f2_t __attribute__((ext_vector_type(2))); const f2_t v = {lo, hi}; const bf16x2_t b = __builtin_convertvector(v, bf16x2_t); return __builtin_bit_cast(unsigned, b); }
typedef float f32x2 __attribute__((ext_vector_type(2)));
__device__ __forceinline__ f32x2 gelu_pk(f32x2 v) {
    const f32x2 av = __builtin_elementwise_abs(v), d = av * 0.2316418882f + 1.0f;
    f32x2 t; t.x = __builtin_amdgcn_rcpf(d.x); t.y = __builtin_amdgcn_rcpf(d.y);
    f32x2 q = t * 0.5307027145f + (-0.7265760135f); q = q * t + 0.7107068705f; q = q * t + (-0.142248368f); q = q * t + 0.127414796f; q = q * t;
    const f32x2 s = (v * v) * (-0.72134752044f);
    f32x2 e; e.x = __builtin_amdgcn_exp2f(s.x); e.y = __builtin_amdgcn_exp2f(s.y);
    const f32x2 m = v * (q * e), r = v - m;
    f32x2 o; o.x = v.x < 0.f ? m.x : r.x; o.y = v.y < 0.f ? m.y : r.y; return o;
}

struct EpiF32 {
    static constexpr bool PERM = false, AFTER_DRAIN = false;
    float* C; int ldc; const float* bias;
    __device__ __forceinline__ void operator()(const f32x4 (&acc)[2][2][4][2], const Unit& u, int wr, int wc, int fr, int fq) const {
        const int row0 = u.pm * BM + wr * 64 + fr, col0 = u.pn * BM + wc * 32 + 4 * fq;
        f32x4 bv[2][2];
#pragma unroll
        for (int bj = 0; bj < 2; ++bj)
#pragma unroll
            for (int n = 0; n < 2; ++n) bv[bj][n] = bias ? *(const f32x4*)(bias + col0 + bj * HALF + n * 16) : (f32x4){0.f, 0.f, 0.f, 0.f};
#pragma unroll
        for (int ai = 0; ai < 2; ++ai)
#pragma unroll
            for (int m = 0; m < 4; ++m) { float* rowp = C + (size_t)(row0 + ai * HALF + m * 16) * ldc + col0;
#pragma unroll
                for (int bj = 0; bj < 2; ++bj)
#pragma unroll
                    for (int n = 0; n < 2; ++n) *(f32x4*)(rowp + bj * HALF + n * 16) = acc[ai][bj][m][n] + bv[bj][n]; }
    }
};
template <int ACT  > struct EpiBf16 {
    static constexpr bool PERM = true, AFTER_DRAIN = false;
    bf16_t* O; int ldc; const float* bias; int split_cols; size_t split_stride;
    __device__ __forceinline__ void operator()(const f32x4 (&acc)[2][2][4][2], const Unit& u, int wr, int wc, int fr, int fq) const {
        const int row0 = u.pm * BM + wr * 64 + fr; int colt = u.pn * BM; bf16_t* base = O;
        if (split_cols) { const int t = colt / split_cols; base += (size_t)t * split_stride; colt -= t * split_cols; }
        const int col0 = colt + wc * 32 + 8 * fq, bcol0 = u.pn * BM + wc * 32 + 8 * fq;
        f32x4 bv[2][2];
#pragma unroll
        for (int bj = 0; bj < 2; ++bj)
#pragma unroll
            for (int n = 0; n < 2; ++n) bv[bj][n] = bias ? *(const f32x4*)(bias + bcol0 + bj * HALF + 4 * n) : (f32x4){0.f, 0.f, 0.f, 0.f};
#pragma unroll
        for (int ai = 0; ai < 2; ++ai)
#pragma unroll
            for (int m = 0; m < 4; ++m) { bf16_t* rowp = base + (size_t)(row0 + ai * HALF + m * 16) * ldc + col0;
#pragma unroll
                for (int bj = 0; bj < 2; ++bj) { f32x4 v0 = acc[ai][bj][m][0] + bv[bj][0], v1 = acc[ai][bj][m][1] + bv[bj][1];
                    if (ACT == 1) { f32x2 a = gelu_pk((f32x2){v0[0], v0[1]}), b = gelu_pk((f32x2){v0[2], v0[3]}), c = gelu_pk((f32x2){v1[0], v1[1]}), d = gelu_pk((f32x2){v1[2], v1[3]});
                        v0 = (f32x4){a.x, a.y, b.x, b.y}; v1 = (f32x4){c.x, c.y, d.x, d.y}; }
                    if (ACT == 2) {
#pragma unroll
                        for (int j = 0; j < 4; ++j) { v0[j] = 0.5f * v0[j] * (1.0f + erff(v0[j] * 0.70710678f)); v1[j] = 0.5f * v1[j] * (1.0f + erff(v1[j] * 0.70710678f)); } }
                    u32x4 w; w.x = cvt_pk_bf16(v0[0], v0[1]); w.y = cvt_pk_bf16(v0[2], v0[3]); w.z = cvt_pk_bf16(v1[0], v1[1]); w.w = cvt_pk_bf16(v1[2], v1[3]);
                    *(u32x4*)(rowp + bj * HALF) = w; } }
    }
};
template <class Epi, class Sched, bool STAMP = false>
__device__ __forceinline__ void gemm_phase(PG8_LAS unsigned char* lds, const Gemm g, const Sched& S, const Epi& E, unsigned long long* stamps) {
    const int tid = threadIdx.x, wid = __builtin_amdgcn_readfirstlane(tid >> 6), lane = tid & 63, wr = wid >> 2, wc = wid & 3, fr = lane & 15, fq = lane >> 4;
    const int K = g.K, nt = K / BK;
    int ts_lo = 0, ts_hi = 0, nts = 0; const unsigned long long rt_entry = STAMP ? (unsigned long long)wall_clock64() : 0ull;
#define PG8_STAMP() do { if (STAMP && wid == 0 && nts < 64) { const unsigned long long _c = (unsigned long long)clock64(); \
        ts_lo = (lane == nts) ? (int)(unsigned)_c : ts_lo; ts_hi = (lane == nts) ? (int)(unsigned)(_c >> 32) : ts_hi; ++nts; } } while (0)
    PG8_STAMP();
    unsigned voffA[2], voffB[2];
#pragma unroll
    for (int i = 0; i < 2; ++i) { int R, C; stage_rc(tid * 16 + i * 8192, R, C); const int Rb = Epi::PERM ? ((R & ~31) + perm32(R & 31)) : R;
        voffA[i] = (unsigned)(R * K + C) * 2u; voffB[i] = (unsigned)(Rb * K + C) * 2u; }
    const size_t kstep = (size_t)(BK * 2);
    const size_t hstep = (size_t)HALF * K * 2;
    const size_t tstep = 2 * hstep;
    const unsigned ldsw = (unsigned)wid * 1024u;
    const int aoff = lds_byte(wr * 64 + fr, fq * 8), boff = lds_byte(wc * 32 + fr, fq * 8);
#define PG8_SA(b, h) (((b) * 2 + (h)) * HTB)
#define PG8_SB(b, h) ((4 + (b) * 2 + (h)) * HTB)
#define PG8_STAGE(bufoff, gbase, voff) do { _Pragma("unroll") for (int _i = 0; _i < 2; ++_i) \
        __builtin_amdgcn_global_load_lds((const unsigned*)((const char*)(gbase) + (voff)[_i]), (PG8_LAS unsigned*)(lds + (bufoff) + ldsw + _i * 8192), 16, 0, 0); } while (0)
#define PG8_LDA(dst, b, h) do { _Pragma("unroll") for (int m = 0; m < 4; ++m) _Pragma("unroll") for (int k = 0; k < 2; ++k) dst[m][k] = *(const PG8_LAS bf16x8*)(lds + PG8_SA(b, h) + aoff + m * 2048 + k * 1024); } while (0)
#define PG8_LDB(dst, b, h) do { _Pragma("unroll") for (int n = 0; n < 2; ++n) _Pragma("unroll") for (int k = 0; k < 2; ++k) dst[n][k] = *(const PG8_LAS bf16x8*)(lds + PG8_SB(b, h) + boff + n * 2048 + k * 1024); } while (0)
#define PG8_MMA(ai, bj, At, Bt) do { __builtin_amdgcn_s_setprio(1); _Pragma("unroll") for (int m = 0; m < 4; ++m) _Pragma("unroll") for (int n = 0; n < 2; ++n) _Pragma("unroll") for (int k = 0; k < 2; ++k) \
        acc[ai][bj][m][n] = __builtin_amdgcn_mfma_f32_16x16x32_bf16(Bt[n][k], At[m][k], acc[ai][bj][m][n], 0, 0, 0); __builtin_amdgcn_s_setprio(0); } while (0)
#define PG8_WAIT_V(n) asm volatile("s_waitcnt vmcnt(" #n ")" ::: "memory")
#define PG8_WAIT_L(n) asm volatile("s_waitcnt lgkmcnt(" #n ")" ::: "memory")
#define PG8_BAR __builtin_amdgcn_s_barrier()
#define PG8_SCHED __builtin_amdgcn_sched_barrier(0)
    Unit cur, nxt; int ui = 0;
    if (!S.next(0, cur)) return;
    f32x4 acc[2][2][4][2];
#pragma unroll
    for (int a = 0; a < 2; ++a)
#pragma unroll
        for (int b = 0; b < 2; ++b)
#pragma unroll
            for (int m = 0; m < 4; ++m)
#pragma unroll
                for (int n = 0; n < 2; ++n) acc[a][b][m][n] = (f32x4){0.f, 0.f, 0.f, 0.f};
    bf16x8 At[4][2], B0[2][2], B1[2][2];
    const char* cA = (const char*)g.A + (size_t)cur.pm * tstep; const char* cB = (const char*)g.Bt + (size_t)cur.pn * tstep;
    S.a_ready(cur);
    PG8_STAGE(PG8_SB(0, 0), cB, voffB); PG8_STAGE(PG8_SA(0, 0), cA, voffA); PG8_STAGE(PG8_SB(0, 1), cB + hstep, voffB); PG8_STAGE(PG8_SA(0, 1), cA + hstep, voffA);
    if (wr == 1) PG8_BAR;
    PG8_WAIT_V(4); PG8_BAR;
    PG8_STAGE(PG8_SB(1, 0), cB + kstep, voffB); PG8_STAGE(PG8_SA(1, 0), cA + kstep, voffA); PG8_STAGE(PG8_SB(1, 1), cB + hstep + kstep, voffB);
    PG8_WAIT_V(6); PG8_BAR;
    PG8_STAMP();
    for (;;) {
        const bool has_next = S.next(ui + 1, nxt);
        const char* nA = has_next ? (const char*)g.A + (size_t)nxt.pm * tstep : cA; const char* nB = has_next ? (const char*)g.Bt + (size_t)nxt.pn * tstep : cB;
        for (int t = 0; t < nt; t += 2) {
            const bool last = (t == nt - 2);
            const char* a1 = cA + (size_t)(t + 1) * kstep;
            const char* a2 = last ? nA : cA + (size_t)(t + 2) * kstep; const char* b2 = last ? nB : cB + (size_t)(t + 2) * kstep;
            const char* a3 = a2 + kstep; const char* b3 = b2 + kstep;
            if (last && has_next) S.a_ready(nxt);
            PG8_LDB(B0, 0, 0); PG8_SCHED; PG8_LDA(At, 0, 0); PG8_STAGE(PG8_SA(1, 1), a1 + hstep, voffA);
            PG8_WAIT_L(8); PG8_BAR; PG8_WAIT_L(0); PG8_MMA(0, 0, At, B0); PG8_BAR; PG8_SCHED;
            PG8_LDB(B1, 0, 1); PG8_STAGE(PG8_SB(0, 0), b2, voffB);
            PG8_BAR; PG8_WAIT_L(0); PG8_MMA(0, 1, At, B1); PG8_BAR;
            PG8_LDA(At, 0, 1); PG8_STAGE(PG8_SA(0, 0), a2, voffA);
            PG8_BAR; PG8_WAIT_L(0); PG8_MMA(1, 0, At, B0); PG8_BAR; PG8_SCHED;
            PG8_STAGE(PG8_SB(0, 1), b2 + hstep, voffB);
            PG8_WAIT_V(6); PG8_BAR; PG8_MMA(1, 1, At, B1); PG8_BAR;
            PG8_LDB(B0, 1, 0); PG8_SCHED; PG8_LDA(At, 1, 0); PG8_STAGE(PG8_SA(0, 1), a2 + hstep, voffA);
            PG8_WAIT_L(8); PG8_BAR; PG8_WAIT_L(0); PG8_MMA(0, 0, At, B0); PG8_BAR; PG8_SCHED;
            PG8_LDB(B1, 1, 1); PG8_STAGE(PG8_SB(1, 0), b3, voffB);
            PG8_BAR; PG8_WAIT_L(0); PG8_MMA(0, 1, At, B1); PG8_BAR;
            PG8_LDA(At, 1, 1); PG8_STAGE(PG8_SA(1, 0), a3, voffA);
            PG8_BAR; PG8_WAIT_L(0); PG8_MMA(1, 0, At, B0); PG8_BAR; PG8_SCHED;
            PG8_STAGE(PG8_SB(1, 1), b3 + hstep, voffB);
            PG8_WAIT_V(6); PG8_BAR; PG8_MMA(1, 1, At, B1); PG8_BAR;
        }
        PG8_STAMP();
        if constexpr (!Epi::AFTER_DRAIN) { E(acc, cur, wr, wc, fr, fq); S.done(cur); }
        PG8_STAMP();
        if (!has_next) break;
#pragma unroll
        for (int a = 0; a < 2; ++a)
#pragma unroll
            for (int b = 0; b < 2; ++b)
#pragma unroll
                for (int m = 0; m < 4; ++m)
#pragma unroll
                    for (int n = 0; n < 2; ++n) acc[a][b][m][n] = (f32x4){0.f, 0.f, 0.f, 0.f};
        cur = nxt; cA = nA; cB = nB; ++ui;
    }
    PG8_WAIT_V(0);
    if (wr == 0) PG8_BAR;
    PG8_BAR;
    if constexpr (Epi::AFTER_DRAIN) { E.fused(acc, cur, wr, wc, fr, fq, lds, wid, lane); S.done(cur); }
    PG8_STAMP();
    if (STAMP && wid == 0) { stamps[lane] = lane < nts ? (((unsigned long long)(unsigned)ts_hi << 32) | (unsigned)ts_lo) : 0ull;
        if (lane == 62) stamps[62] = rt_entry; if (lane == 63) stamps[63] = (unsigned long long)wall_clock64(); }
#undef PG8_STAMP
#undef PG8_SA
#undef PG8_SB
#undef PG8_STAGE
#undef PG8_LDA
#undef PG8_LDB
#undef PG8_MMA
#undef PG8_WAIT_V
#undef PG8_WAIT_L
#undef PG8_BAR
#undef PG8_SCHED
}
}

constexpr int NB = 8, SEQ = 8192, DM = 1024, NTOK = NB * SEQ, NLAYER = 4, NCHUNK = 128;
constexpr int IN_W = 6868;
constexpr int NTHR = 512;
constexpr int LDS_BYTES = 160 * 1024;
constexpr int LDS_BAR_OFF = LDS_BYTES - 16;
#define LASP __attribute__((address_space(3)))

constexpr int PB_QC = 0, PB_KVC = 256, PB_IK = 384, PB_GALR = 448, PB_IW = 464, PB_LD = 512;
constexpr int PC_R = 0, PC_K = 512, PC_V = 1024, PC_WLR = 1536, PC_ALR = 1600, PC_GLR = 1664, PC_LD = 1792;

struct Params {
    const float *x, *c, *w_ada, *b_ada, *g_mix, *g_ffn, *w_in, *gla_w_a2, *gla_b_a, *gla_g_o, *dsa_g_qc, *dsa_w_uq, *dsa_w_iq, *dsa_g_kv, *dsa_w_uv;
    const float *rw_mu, *rw_w0, *rw_w_w2, *rw_a0, *rw_w_a2, *rw_w_g2, *rw_k_k, *rw_k_a, *rw_r_k, *rw_ln_g, *rw_ln_b, *w_branch, *w_out, *peer_w_q, *peer_keys, *peer_u, *peer_v, *g_final;
    float* out;
    unsigned* bar;
    float* mod;
    bf16_t *win_t, *wg_t, *wb_t, *wo_t, *wq_t, *wuq_t, *wiq_t, *wuv_t, *pkeys, *ww2_t, *wa2_t, *wg2_t;
    bf16_t *hbuf, *GQ, *GK, *GR, *GS, *GV, *PB, *PC, *yb, *yc, *kvn;
    float* gdec;
    bf16_t *qd, *qi, *qn, *ya, *Gtmp, *merged, *qp, *tu, *tv;
    unsigned short* pe_idx; float* pe_gate;
};

typedef __bf16 bf16x2_t __attribute__((ext_vector_type(2)));
__device__ __forceinline__ unsigned pk_bf16(float lo, float hi) { const f32x2 v = {lo, hi}; const bf16x2_t b = __builtin_convertvector(v, bf16x2_t); return __builtin_bit_cast(unsigned, b); }
__device__ __forceinline__ bf16_t f2bf(float f) { return (bf16_t)(pk_bf16(f, 0.f) & 0xffffu); }
__device__ __forceinline__ float bf2f(bf16_t v) { return __uint_as_float(((unsigned)v) << 16); }
__device__ __forceinline__ float bflo(unsigned u) { return __uint_as_float(u << 16); }
__device__ __forceinline__ float bfhi(unsigned u) { return __uint_as_float(u & 0xffff0000u); }
__device__ __forceinline__ float sigmoidf_(float x) { return __builtin_amdgcn_rcpf(1.0f + __expf(-x)); }
__device__ __forceinline__ float siluf_(float x) { return x * __builtin_amdgcn_rcpf(1.0f + __expf(-x)); }
__device__ __forceinline__ float softplusf_(float x) { return fmaxf(x, 0.f) + log1pf(__expf(-fabsf(x))); }
__device__ __forceinline__ float wave_sum(float v) {
#pragma unroll
    for (int o = 32; o >= 1; o >>= 1) v += __shfl_xor(v, o);
    return v;
}
template <int CTRL> __device__ __forceinline__ float dppf(float v) { return __int_as_float(__builtin_amdgcn_update_dpp(0, __float_as_int(v), CTRL, 0xF, 0xF, true)); }
template <int CTRL> __device__ __forceinline__ unsigned dppu(unsigned v) { return (unsigned)__builtin_amdgcn_update_dpp(0, (int)v, CTRL, 0xF, 0xF, true); }
__device__ __forceinline__ float row16_sum(float v) { v += dppf<0xB1>(v); v += dppf<0x4E>(v); v += dppf<0x141>(v); v += dppf<0x140>(v); return v; }
__device__ __forceinline__ float row16_max(float v) { v = fmaxf(v, dppf<0xB1>(v)); v = fmaxf(v, dppf<0x4E>(v)); v = fmaxf(v, dppf<0x141>(v)); v = fmaxf(v, dppf<0x140>(v)); return v; }
#define R16_STEP4(op, ctrl) \
    op " %0, %0, %0 " ctrl " row_mask:0xf bank_mask:0xf bound_ctrl:1\n\t" op " %1, %1, %1 " ctrl " row_mask:0xf bank_mask:0xf bound_ctrl:1\n\t" \
    op " %2, %2, %2 " ctrl " row_mask:0xf bank_mask:0xf bound_ctrl:1\n\t" op " %3, %3, %3 " ctrl " row_mask:0xf bank_mask:0xf bound_ctrl:1\n\t"
#define R16_ALL4(op) "s_nop 1\n\t" R16_STEP4(op, "quad_perm:[1,0,3,2]") R16_STEP4(op, "quad_perm:[2,3,0,1]") R16_STEP4(op, "row_half_mirror") R16_STEP4(op, "row_mirror") "s_nop 1"
__device__ __forceinline__ void row16_max_x4(float& a, float& b, float& c, float& d) { asm(R16_ALL4("v_max_f32_dpp") : "+v"(a), "+v"(b), "+v"(c), "+v"(d)); }
#define R16_STEP4_IN(op, ctrl) \
    op " %0, %4, %4 " ctrl " row_mask:0xf bank_mask:0xf bound_ctrl:1\n\t" op " %1, %5, %5 " ctrl " row_mask:0xf bank_mask:0xf bound_ctrl:1\n\t" \
    op " %2, %6, %6 " ctrl " row_mask:0xf bank_mask:0xf bound_ctrl:1\n\t" op " %3, %7, %7 " ctrl " row_mask:0xf bank_mask:0xf bound_ctrl:1\n\t"
__device__ __forceinline__ void row16_maxu_x4(unsigned (&o)[4], unsigned a, unsigned b, unsigned c, unsigned d) {
    asm("s_nop 1\n\t" R16_STEP4_IN("v_max_u32_dpp", "quad_perm:[1,0,3,2]") R16_STEP4("v_max_u32_dpp", "quad_perm:[2,3,0,1]") R16_STEP4("v_max_u32_dpp", "row_half_mirror") R16_STEP4("v_max_u32_dpp", "row_mirror") "s_nop 1"
        : "=&v"(o[0]), "=&v"(o[1]), "=&v"(o[2]), "=&v"(o[3]) : "v"(a), "v"(b), "v"(c), "v"(d)); }
__device__ __forceinline__ void row16_sum_x4(float& a, float& b, float& c, float& d) { asm(R16_ALL4("v_add_f32_dpp") : "+v"(a), "+v"(b), "+v"(c), "+v"(d)); }
__device__ __forceinline__ unsigned row16_maxu(unsigned v) { unsigned t; t = dppu<0xB1>(v); v = v > t ? v : t; t = dppu<0x4E>(v); v = v > t ? v : t; t = dppu<0x141>(v); v = v > t ? v : t; t = dppu<0x140>(v); v = v > t ? v : t; return v; }
__device__ __forceinline__ unsigned wave_scan_incl(unsigned v) {
    v += (unsigned)__builtin_amdgcn_update_dpp(0, (int)v, 0x111, 0xF, 0xF, false);
    v += (unsigned)__builtin_amdgcn_update_dpp(0, (int)v, 0x112, 0xF, 0xF, false);
    v += (unsigned)__builtin_amdgcn_update_dpp(0, (int)v, 0x114, 0xF, 0xF, false);
    v += (unsigned)__builtin_amdgcn_update_dpp(0, (int)v, 0x118, 0xF, 0xF, false);
    v += (unsigned)__builtin_amdgcn_update_dpp(0, (int)v, 0x142, 0xA, 0xF, false);
    v += (unsigned)__builtin_amdgcn_update_dpp(0, (int)v, 0x143, 0xC, 0xF, false);
    return v;
}
__device__ __forceinline__ unsigned fkey(float f) { unsigned u = __float_as_uint(f); if (f == 0.f) u = 0u; return (u & 0x80000000u) ? ~u : (u | 0x80000000u); }
__device__ __forceinline__ float fkey_inv(unsigned k) { const unsigned u = (k & 0x80000000u) ? (k & 0x7fffffffu) : ~k; return __uint_as_float(u); }

__device__ __forceinline__ bf16x8 ld_frag_g(const bf16_t* p) { return *(const bf16x8*)p; }
#define MFMA16(a, b, c) __builtin_amdgcn_mfma_f32_16x16x32_bf16((a), (b), (c), 0, 0, 0)

namespace pg8 {
struct EpiP {
    static constexpr bool PERM = true, AFTER_DRAIN = false;
    bf16_t *GQ, *GK, *GV, *GR, *PB, *PC;
    __device__ __forceinline__ void operator()(const f32x4 (&acc)[2][2][4][2], const Unit& u, int wr, int wc, int fr, int fq) const {
        const int pn = u.pn; bf16_t* base; int ldc, cb;
        if (pn == 0) { base = GQ; ldc = 256; cb = 0; } else if (pn == 1) { base = GK; ldc = 256; cb = 0; }
        else if (pn < 4) { base = GV; ldc = 512; cb = (pn - 2) * 256; } else if (pn < 6) { base = GR; ldc = 512; cb = (pn - 4) * 256; }
        else if (pn < 8) { base = PB; ldc = 512; cb = (pn - 6) * 256; } else { base = PC; ldc = 1792; cb = (pn - 8) * 256; }
        const int row0 = u.pm * BM + wr * 64 + fr, col0 = cb + wc * 32 + 8 * fq;
#pragma unroll
        for (int ai = 0; ai < 2; ++ai)
#pragma unroll
            for (int m = 0; m < 4; ++m) { bf16_t* rowp = base + (size_t)(row0 + ai * HALF + m * 16) * ldc + col0;
#pragma unroll
                for (int bj = 0; bj < 2; ++bj) { const f32x4 v0 = acc[ai][bj][m][0], v1 = acc[ai][bj][m][1];
                    u32x4 w; w.x = cvt_pk_bf16(v0[0], v0[1]); w.y = cvt_pk_bf16(v0[2], v0[3]); w.z = cvt_pk_bf16(v1[0], v1[1]); w.w = cvt_pk_bf16(v1[2], v1[3]);
                    *(u32x4*)(rowp + bj * HALF) = w; } }
    }
};
template <int SIG> struct EpiStore {
    static constexpr bool PERM = true, AFTER_DRAIN = false;
    bf16_t* O; int ldc;
    __device__ __forceinline__ void operator()(const f32x4 (&acc)[2][2][4][2], const Unit& u, int wr, int wc, int fr, int fq) const {
        const int row0 = u.pm * BM + wr * 64 + fr, col0 = u.pn * BM + wc * 32 + 8 * fq;
#pragma unroll
        for (int ai = 0; ai < 2; ++ai)
#pragma unroll
            for (int m = 0; m < 4; ++m) { bf16_t* rowp = O + (size_t)(row0 + ai * HALF + m * 16) * ldc + col0;
#pragma unroll
                for (int bj = 0; bj < 2; ++bj) { f32x4 v0 = acc[ai][bj][m][0], v1 = acc[ai][bj][m][1];
                    if (SIG) {
#pragma unroll
                        for (int j = 0; j < 4; ++j) { v0[j] = __builtin_amdgcn_rcpf(1.0f + __expf(-v0[j])); v1[j] = __builtin_amdgcn_rcpf(1.0f + __expf(-v1[j])); } }
                    u32x4 w; w.x = cvt_pk_bf16(v0[0], v0[1]); w.y = cvt_pk_bf16(v0[2], v0[3]); w.z = cvt_pk_bf16(v1[0], v1[1]); w.w = cvt_pk_bf16(v1[2], v1[3]);
                    *(u32x4*)(rowp + bj * HALF) = w; } }
    }
};
template <int FIRST> struct EpiMerge {
    static constexpr bool PERM = true, AFTER_DRAIN = false;
    const bf16_t* G; bf16_t* O; int ldc;
    __device__ __forceinline__ void operator()(const f32x4 (&acc)[2][2][4][2], const Unit& u, int wr, int wc, int fr, int fq) const {
        const int row0 = u.pm * BM + wr * 64 + fr, col0 = u.pn * BM + wc * 32 + 8 * fq;
#pragma unroll
        for (int ai = 0; ai < 2; ++ai)
#pragma unroll
            for (int m = 0; m < 4; ++m) { const size_t off = (size_t)(row0 + ai * HALF + m * 16) * ldc + col0;
#pragma unroll
                for (int bj = 0; bj < 2; ++bj) { const f32x4 v0 = acc[ai][bj][m][0], v1 = acc[ai][bj][m][1];
                    const u32x4 g = *(const u32x4*)(G + off + bj * HALF);
                    float o[8];
                    o[0] = __uint_as_float(g.x << 16) * v0[0]; o[1] = __uint_as_float(g.x & 0xffff0000u) * v0[1]; o[2] = __uint_as_float(g.y << 16) * v0[2]; o[3] = __uint_as_float(g.y & 0xffff0000u) * v0[3];
                    o[4] = __uint_as_float(g.z << 16) * v1[0]; o[5] = __uint_as_float(g.z & 0xffff0000u) * v1[1]; o[6] = __uint_as_float(g.w << 16) * v1[2]; o[7] = __uint_as_float(g.w & 0xffff0000u) * v1[3];
                    if (!FIRST) { const u32x4 p = *(const u32x4*)(O + off + bj * HALF);
                        o[0] += __uint_as_float(p.x << 16); o[1] += __uint_as_float(p.x & 0xffff0000u); o[2] += __uint_as_float(p.y << 16); o[3] += __uint_as_float(p.y & 0xffff0000u);
                        o[4] += __uint_as_float(p.z << 16); o[5] += __uint_as_float(p.z & 0xffff0000u); o[6] += __uint_as_float(p.w << 16); o[7] += __uint_as_float(p.w & 0xffff0000u); }
                    u32x4 w; w.x = cvt_pk_bf16(o[0], o[1]); w.y = cvt_pk_bf16(o[2], o[3]); w.z = cvt_pk_bf16(o[4], o[5]); w.w = cvt_pk_bf16(o[6], o[7]);
                    *(u32x4*)(O + off + bj * HALF) = w; } }
    }
};
struct EpiResid {
    static constexpr bool PERM = false, AFTER_DRAIN = false;
    const float* xin; float* xout; const float* gate;
    __device__ __forceinline__ void operator()(const f32x4 (&acc)[2][2][4][2], const Unit& u, int wr, int wc, int fr, int fq) const {
        const int row0 = u.pm * BM + wr * 64 + fr, col0 = u.pn * BM + wc * 32 + 4 * fq;
        const float* gp = gate + (size_t)((u.pm * BM) >> 13) * 6144;
        f32x4 gv[2][2];
#pragma unroll
        for (int bj = 0; bj < 2; ++bj)
#pragma unroll
            for (int n = 0; n < 2; ++n) gv[bj][n] = *(const f32x4*)(gp + col0 + bj * HALF + n * 16);
#pragma unroll
        for (int ai = 0; ai < 2; ++ai)
#pragma unroll
            for (int m = 0; m < 4; ++m) { const size_t off = (size_t)(row0 + ai * HALF + m * 16) * 1024 + col0;
#pragma unroll
                for (int bj = 0; bj < 2; ++bj)
#pragma unroll
                    for (int n = 0; n < 2; ++n) { const f32x4 xi = *(const f32x4*)(xin + off + bj * HALF + n * 16);
                        *(f32x4*)(xout + off + bj * HALF + n * 16) = xi + gv[bj][n] * acc[ai][bj][m][n]; } }
    }
};

#ifndef EPI_DEPTH
#define EPI_DEPTH 2
#endif
#ifndef EPI_DEPTH34
#define EPI_DEPTH34 3
#endif
#ifndef EPI_DEPTH5
#define EPI_DEPTH5 EPI_DEPTH
#endif
struct EpiGen {
    static constexpr bool PERM = true, AFTER_DRAIN = false;
    int kind; int ldc;
    bf16_t* O; const bf16_t* G;
    bf16_t *GQ, *GK, *GV, *GR, *PB, *PC;
    const float* xin; float* xout; const float* gate;
    __device__ __forceinline__ void operator()(const f32x4 (&acc)[2][2][4][2], const Unit& u, int wr, int wc, int fr, int fq) const {
        const int row0 = u.pm * BM + wr * 64 + fr;
#ifdef DBG_DOUBLE
        if (kind == 6) return;
        const float pmul = kind == 7 ? 0.f : 1.f;
#define EPI_PMUL(x) ((x) * pmul)
#define EPI_K4(k) ((k) <= 4 || (k) == 7)
#else
#define EPI_PMUL(x) (x)
#define EPI_K4(k) ((k) <= 4)
#endif
        if (kind <= 2) {
            bf16_t* base = O; int ld = ldc, cb = u.pn * BM;
            if (kind == 0) { const int pn = u.pn;
                if (pn == 0) { base = GQ; ld = 256; cb = 0; } else if (pn == 1) { base = GK; ld = 256; cb = 0; }
                else if (pn < 4) { base = GV; ld = 512; cb = (pn - 2) * 256; } else if (pn < 6) { base = GR; ld = 512; cb = (pn - 4) * 256; }
                else if (pn < 8) { base = PB; ld = 512; cb = (pn - 6) * 256; } else { base = PC; ld = 1792; cb = (pn - 8) * 256; } }
            const int col0 = cb + wc * 32 + 8 * fq; const bool sig = kind == 2;
#pragma unroll
            for (int ai = 0; ai < 2; ++ai)
#pragma unroll
                for (int m = 0; m < 4; ++m) { bf16_t* rowp = base + (size_t)(row0 + ai * HALF + m * 16) * ld + col0;
#pragma unroll
                    for (int bj = 0; bj < 2; ++bj) { f32x4 v0 = acc[ai][bj][m][0], v1 = acc[ai][bj][m][1];
                        if (sig) {
#pragma unroll
                            for (int j = 0; j < 4; ++j) { v0[j] = __builtin_amdgcn_rcpf(1.0f + __expf(-v0[j])); v1[j] = __builtin_amdgcn_rcpf(1.0f + __expf(-v1[j])); } }
                        u32x4 w; w.x = cvt_pk_bf16(v0[0], v0[1]); w.y = cvt_pk_bf16(v0[2], v0[3]); w.z = cvt_pk_bf16(v1[0], v1[1]); w.w = cvt_pk_bf16(v1[2], v1[3]);
                        *(u32x4*)(rowp + bj * HALF) = w; } }
        } else if (EPI_K4(kind)) {
            const int col0 = u.pn * BM + wc * 32 + 8 * fq; const bool first = kind == 3;
            const u32x4 z4 = {0u, 0u, 0u, 0u};
            u32x4 gq[EPI_DEPTH34][2], pq[EPI_DEPTH34][2];
#define EPI_LD34(am_, slot_) do { const int ai2 = (am_) >> 2, m2 = (am_) & 3; const size_t off2 = (size_t)(row0 + ai2 * HALF + m2 * 16) * 1024 + col0; \
                _Pragma("unroll") for (int bj = 0; bj < 2; ++bj) { gq[slot_][bj] = *(const u32x4*)(G + off2 + bj * HALF); pq[slot_][bj] = first ? z4 : *(const u32x4*)(O + off2 + bj * HALF); } } while (0)
#pragma unroll
            for (int d = 0; d < EPI_DEPTH34; ++d) EPI_LD34(d, d);
#pragma unroll
            for (int am = 0; am < 8; ++am) { const int ai = am >> 2, m = am & 3; const size_t off = (size_t)(row0 + ai * HALF + m * 16) * 1024 + col0;
                u32x4 gc[2], pc[2];
#pragma unroll
                for (int bj = 0; bj < 2; ++bj) { gc[bj] = gq[am % EPI_DEPTH34][bj]; pc[bj] = pq[am % EPI_DEPTH34][bj]; }
                if (am + EPI_DEPTH34 < 8) EPI_LD34(am + EPI_DEPTH34, am % EPI_DEPTH34);
#pragma unroll
                for (int bj = 0; bj < 2; ++bj) { const f32x4 v0 = acc[ai][bj][m][0], v1 = acc[ai][bj][m][1]; const u32x4 g = gc[bj], p = pc[bj];
                    float o[8];
                    o[0] = __uint_as_float(g.x << 16) * EPI_PMUL(v0[0]) + __uint_as_float(p.x << 16); o[1] = __uint_as_float(g.x & 0xffff0000u) * EPI_PMUL(v0[1]) + __uint_as_float(p.x & 0xffff0000u);
                    o[2] = __uint_as_float(g.y << 16) * EPI_PMUL(v0[2]) + __uint_as_float(p.y << 16); o[3] = __uint_as_float(g.y & 0xffff0000u) * EPI_PMUL(v0[3]) + __uint_as_float(p.y & 0xffff0000u);
                    o[4] = __uint_as_float(g.z << 16) * EPI_PMUL(v1[0]) + __uint_as_float(p.z << 16); o[5] = __uint_as_float(g.z & 0xffff0000u) * EPI_PMUL(v1[1]) + __uint_as_float(p.z & 0xffff0000u);
                    o[6] = __uint_as_float(g.w << 16) * EPI_PMUL(v1[2]) + __uint_as_float(p.w << 16); o[7] = __uint_as_float(g.w & 0xffff0000u) * EPI_PMUL(v1[3]) + __uint_as_float(p.w & 0xffff0000u);
                    u32x4 w; w.x = cvt_pk_bf16(o[0], o[1]); w.y = cvt_pk_bf16(o[2], o[3]); w.z = cvt_pk_bf16(o[4], o[5]); w.w = cvt_pk_bf16(o[6], o[7]);
                    *(u32x4*)(O + off + bj * HALF) = w; } }
        } else {
            const int col0 = u.pn * BM + wc * 32 + 8 * fq;
            const float* gp = gate + (size_t)((u.pm * BM) >> 13) * 6144;
            f32x4 gv[2][2];
#pragma unroll
            for (int bj = 0; bj < 2; ++bj)
#pragma unroll
                for (int n = 0; n < 2; ++n) gv[bj][n] = *(const f32x4*)(gp + col0 + bj * HALF + n * 4);
            f32x4 xq[EPI_DEPTH5][2][2];
#define EPI_LD5(am_, slot_) do { const int ai2 = (am_) >> 2, m2 = (am_) & 3; const size_t off2 = (size_t)(row0 + ai2 * HALF + m2 * 16) * 1024 + col0; \
                _Pragma("unroll") for (int bj = 0; bj < 2; ++bj) _Pragma("unroll") for (int n = 0; n < 2; ++n) xq[slot_][bj][n] = *(const f32x4*)(xin + off2 + bj * HALF + n * 4); } while (0)
#pragma unroll
            for (int d = 0; d < EPI_DEPTH5; ++d) EPI_LD5(d, d);
#pragma unroll
            for (int am = 0; am < 8; ++am) { const int ai = am >> 2, m = am & 3; const size_t off = (size_t)(row0 + ai * HALF + m * 16) * 1024 + col0;
                f32x4 xc[2][2];
#pragma unroll
                for (int bj = 0; bj < 2; ++bj)
#pragma unroll
                    for (int n = 0; n < 2; ++n) xc[bj][n] = xq[am % EPI_DEPTH5][bj][n];
                if (am + EPI_DEPTH5 < 8) EPI_LD5(am + EPI_DEPTH5, am % EPI_DEPTH5);
#pragma unroll
                for (int bj = 0; bj < 2; ++bj)
#pragma unroll
                    for (int n = 0; n < 2; ++n) *(f32x4*)(xout + off + bj * HALF + n * 4) = xc[bj][n] + gv[bj][n] * acc[ai][bj][m][n]; }
        }
    }
};
}

template <class Epi> __device__ __forceinline__ void run_gemm(LASP unsigned char* lds, const bf16_t* A, const bf16_t* Bt, int M, int N, int K, const Epi& E, int wg, int nwg) {
    pg8::Gemm g; g.A = A; g.Bt = Bt; g.M = M; g.N = N; g.K = K;
    pg8::StaticOrder S; S.init(M, N, nwg, wg);
    pg8::gemm_phase<Epi, pg8::StaticOrder, false>(lds, g, S, E, nullptr);
    __syncthreads();
}

__device__ __forceinline__ int pmap(int n) {
    if (n < 1024) return n;
    if (n < 1536) return 1040 + (n - 1024);
    if (n < 1792) return 1552 + (n - 1536);
    if (n < 1920) return 1808 + (n - 1792);
    if (n < 1984) return 1936 + (n - 1920);
    if (n < 2000) return 1024 + (n - 1984);
    if (n < 2004) return 2000 + (n - 2000);
    if (n < 2048) return -1;
    return 2004 + (n - 2048);
}
__device__ __forceinline__ void tcvt_tile(const float* src, int ldsrc, bf16_t* dst, int K, int n0, int k0, int mode, LASP float* tile) {
    const int tid = threadIdx.x, j = tid & 63, i = tid >> 6;
    const int n = n0 + j; const int c = mode == 0 ? n : (mode == 1 ? pmap(n) : n + 3796);
#pragma unroll
    for (int ii = 0; ii < 8; ++ii) { const int kk = ii * 8 + i; tile[kk * 65 + j] = c >= 0 ? src[(size_t)(k0 + kk) * ldsrc + c] : 0.f; }
    __syncthreads();
#pragma unroll
    for (int it = 0; it < 8; ++it) { const int jj = it * 8 + (tid >> 6), kk = tid & 63; dst[(size_t)(n0 + jj) * K + k0 + kk] = f2bf(tile[kk * 65 + jj]); }
    __syncthreads();
}
constexpr int W_TILES_L = 960 + 768 + 384 + 256 + 256 + 64 + 16 + 16 + 8 + 8 + 16;
constexpr int W_TILES = W_TILES_L * NLAYER, W_MOD_UNITS = 384, W_PK_UNITS = 128;
template <int PART> __device__ __forceinline__ void phase_weights(const Params& p, LASP unsigned char* lds, int wg, int nwg) {
    LASP float* tile = (LASP float*)lds;
    const int tid = threadIdx.x;
    if constexpr (PART == 0) {
        for (int id = wg; id < NLAYER * 1728; id += nwg) { const int l = id / 1728; int t = id % 1728;
            if (t < 960) tcvt_tile(p.w_in + (size_t)l * 1024 * IN_W, IN_W, p.win_t + (size_t)l * 3840 * 1024, 1024, (t % 60) * 64, (t / 60) * 64, 1, tile);
            else { t -= 960; tcvt_tile(p.w_in + (size_t)l * 1024 * IN_W, IN_W, p.wg_t + (size_t)l * 3072 * 1024, 1024, (t % 48) * 64, (t / 48) * 64, 2, tile); } }
    } else if constexpr (PART == 1) {
        for (int id = wg; id < NLAYER * 896; id += nwg) { const int l = id / 896; int t = id % 896;
            if (t < 384) { const int j = t / 128, r = t % 128; tcvt_tile(p.w_branch + (size_t)(l * 3 + j) * 512 * 1024, 1024, p.wb_t + (size_t)(l * 3 + j) * 1024 * 512, 512, (r % 16) * 64, (r / 16) * 64, 0, tile); }
            else if (t < 640) { t -= 384; tcvt_tile(p.w_out + (size_t)l * 1024 * 1024, 1024, p.wo_t + (size_t)l * 1024 * 1024, 1024, (t % 16) * 64, (t / 16) * 64, 0, tile); }
            else { t -= 640; tcvt_tile(p.peer_w_q + (size_t)l * 1024 * 1024, 1024, p.wq_t + (size_t)l * 1024 * 1024, 1024, (t % 16) * 64, (t / 16) * 64, 0, tile); } }
    } else if constexpr (PART == 2) {
        for (int id = wg; id < NLAYER * 96; id += nwg) { const int l = id / 96; int t = id % 96;
            if (t < 64) tcvt_tile(p.dsa_w_uq + (size_t)l * 256 * 1024, 1024, p.wuq_t + (size_t)l * 1024 * 256, 256, (t % 16) * 64, (t / 16) * 64, 0, tile);
            else if (t < 80) { t -= 64; tcvt_tile(p.dsa_w_iq + (size_t)l * 256 * 256, 256, p.wiq_t + (size_t)l * 256 * 256, 256, (t % 4) * 64, (t / 4) * 64, 0, tile); }
            else { t -= 80; const int h = t / 2, kt = t % 2; tcvt_tile(p.dsa_w_uv + (size_t)(l * 8 + h) * 128 * 64, 64, p.wuv_t + (size_t)(l * 8 + h) * 64 * 128, 128, 0, kt * 64, 0, tile); } }
    } else if constexpr (PART == 3) {
        for (int id = wg; id < NLAYER * 32; id += nwg) { const int l = id / 32; int t = id % 32;
            if (t < 8) tcvt_tile(p.rw_w_w2 + (size_t)l * 64 * 512, 512, p.ww2_t + (size_t)l * 512 * 64, 64, t * 64, 0, 0, tile);
            else if (t < 16) { t -= 8; tcvt_tile(p.rw_w_a2 + (size_t)l * 64 * 512, 512, p.wa2_t + (size_t)l * 512 * 64, 64, t * 64, 0, 0, tile); }
            else { t -= 16; tcvt_tile(p.rw_w_g2 + (size_t)l * 128 * 512, 512, p.wg2_t + (size_t)l * 512 * 128, 128, (t % 8) * 64, (t / 8) * 64, 0, tile); } }
    } else {
        for (int u = wg; u < W_PK_UNITS; u += nwg) {
            const size_t e = (size_t)u * 4096 + (size_t)tid * 8;
            const f32x4 a = *(const f32x4*)(p.peer_keys + e), b = *(const f32x4*)(p.peer_keys + e + 4);
            u32x4 w; w.x = pk_bf16(a[0], a[1]); w.y = pk_bf16(a[2], a[3]); w.z = pk_bf16(b[0], b[1]); w.w = pk_bf16(b[2], b[3]);
            *(u32x4*)(p.pkeys + e) = w;
        }
        bool have = false;
        for (int u = wg; u < W_MOD_UNITS; u += nwg) {
            LASP float* cond = (LASP float*)lds;
            LASP float* red = (LASP float*)(lds + 32768);
            if (!have) { for (int i = tid; i < 8 * 1024; i += NTHR) cond[i] = siluf_(p.c[i]); have = true; }
            __syncthreads();
            const int l = u / 96, cb = u % 96, col = cb * 64 + (tid & 63), ks = tid >> 6;
            float acc[8];
#pragma unroll
            for (int b = 0; b < 8; ++b) acc[b] = 0.f;
            const float* wp = p.w_ada + (size_t)l * 1024 * 6144 + col;
            for (int k = ks * 128; k < ks * 128 + 128; ++k) { const float w = wp[(size_t)k * 6144];
#pragma unroll
                for (int b = 0; b < 8; ++b) acc[b] = fmaf(w, cond[b * 1024 + k], acc[b]); }
#pragma unroll
            for (int b = 0; b < 8; ++b) red[(ks * 8 + b) * 64 + (tid & 63)] = acc[b];
            __syncthreads();
            { const int b = tid >> 6, cc = tid & 63; float s = 0.f;
#pragma unroll
              for (int k2 = 0; k2 < 8; ++k2) s += red[(k2 * 8 + b) * 64 + cc];
              p.mod[((size_t)l * 8 + b) * 6144 + cb * 64 + cc] = s + p.b_ada[(size_t)l * 6144 + cb * 64 + cc]; }
            __syncthreads();
        }
    }
}

__device__ void phase_adaln(const float* x, const float* g, const float* modl  , int sh_off, int sc_off, bf16_t* h, int wg, int nwg) {
    const int lane = threadIdx.x & 63, wave = threadIdx.x >> 6;
    int tok = wg * 8 + wave;
    f32x4 vn[4];
    if (tok < NTOK) { const f32x4* xr = (const f32x4*)(x + (size_t)tok * 1024);
#pragma unroll
        for (int i = 0; i < 4; ++i) vn[i] = xr[lane + 64 * i]; }
    for (; tok < NTOK; tok += nwg * 8) {
        f32x4 v[4]; float ss = 0.f;
#pragma unroll
        for (int i = 0; i < 4; ++i) { v[i] = vn[i]; ss += v[i][0] * v[i][0] + v[i][1] * v[i][1] + v[i][2] * v[i][2] + v[i][3] * v[i][3]; }
        if (tok + nwg * 8 < NTOK) { const f32x4* xr = (const f32x4*)(x + (size_t)(tok + nwg * 8) * 1024);
#pragma unroll
            for (int i = 0; i < 4; ++i) vn[i] = xr[lane + 64 * i]; }
        ss = wave_sum(ss);
        const float rstd = rsqrtf(ss * (1.0f / 1024.0f) + 1e-6f);
        const float* mb = modl + (size_t)(tok >> 13) * 6144;
#pragma unroll
        for (int i = 0; i < 4; ++i) { const int col = 4 * (lane + 64 * i);
            const f32x4 gg = *(const f32x4*)(g + col), sc = *(const f32x4*)(mb + sc_off + col), sh = *(const f32x4*)(mb + sh_off + col);
            f32x4 o = (v[i] * rstd) * gg; o = o * (sc + 1.0f) + sh;
            u32x2 w; w.x = pk_bf16(o[0], o[1]); w.y = pk_bf16(o[2], o[3]);
            *(u32x2*)(h + (size_t)tok * 1024 + col) = w; }
    }
}
__device__ void phase_final(float* x, const float* g, int wg, int nwg) {
    const int lane = threadIdx.x & 63, wave = threadIdx.x >> 6;
    for (int tok = wg * 8 + wave; tok < NTOK; tok += nwg * 8) {
        f32x4* xr = (f32x4*)(x + (size_t)tok * 1024);
        f32x4 v[4]; float ss = 0.f;
#pragma unroll
        for (int i = 0; i < 4; ++i) { v[i] = xr[lane + 64 * i]; ss += v[i][0] * v[i][0] + v[i][1] * v[i][1] + v[i][2] * v[i][2] + v[i][3] * v[i][3]; }
        ss = wave_sum(ss);
        const float rstd = rsqrtf(ss * (1.0f / 1024.0f) + 1e-6f);
#pragma unroll
        for (int i = 0; i < 4; ++i) { const f32x4 gg = *(const f32x4*)(g + 4 * (lane + 64 * i)); xr[lane + 64 * i] = (v[i] * rstd) * gg; }
    }
}

__device__ void phase_gla1(const Params& p, int l, LASP unsigned char* lds, int wg, int nwg) {
    LASP float* alr = (LASP float*)lds;
    LASP float* part = (LASP float*)(lds + 4096);
    LASP bf16_t* kdT = (LASP bf16_t*)(lds + 8192);
    LASP bf16_t* vT = (LASP bf16_t*)(lds + 8192 + 9216);
    const int tid = threadIdx.x, lane = tid & 63, wave = tid >> 6;
    const int k = tid & 63, tq = tid >> 6;
    constexpr int NU = NB * NCHUNK * 4;
    bf16_t alr_n[2], gk_n[8]; u32x4 va_n, vb_n;
    auto ldu = [&](int u) { const int h = u & 3, c = (u >> 2) & 127, b = u >> 9; const size_t t0 = (size_t)b * SEQ + (size_t)c * 64;
#pragma unroll
        for (int j = 0; j < 2; ++j) { const int i = tid + j * NTHR; alr_n[j] = p.PB[(t0 + (i >> 4)) * PB_LD + PB_GALR + (i & 15)]; }
        { const int t = tid >> 3, vq = tid & 7; const bf16_t* vp = p.GV + (t0 + t) * 512 + h * 128 + vq * 16; va_n = *(const u32x4*)vp; vb_n = *(const u32x4*)(vp + 8); }
#pragma unroll
        for (int i = 0; i < 8; ++i) gk_n[i] = p.GK[(t0 + tq * 8 + i) * 256 + h * 64 + k]; };
    float wa[16]; float ba = 0.f; int hcur = -1;
#pragma unroll
    for (int r = 0; r < 16; ++r) wa[r] = 0.f;
    if (wg < NU) ldu(wg);
    for (int u = wg; u < NU; u += nwg) {
        const int h = u & 3;
        bf16_t alr_c[2], gk_c[8];
#pragma unroll
        for (int j = 0; j < 2; ++j) alr_c[j] = alr_n[j];
#pragma unroll
        for (int i = 0; i < 8; ++i) gk_c[i] = gk_n[i];
        const u32x4 a = va_n, bq = vb_n;
        if (h != hcur) { hcur = h;
#pragma unroll
            for (int r = 0; r < 16; ++r) wa[r] = p.gla_w_a2[((size_t)l * 16 + r) * 256 + h * 64 + k];
            ba = p.gla_b_a[(size_t)l * 256 + h * 64 + k]; }
        ldu(u + nwg < NU ? u + nwg : u);
#pragma unroll
        for (int j = 0; j < 2; ++j) alr[tid + j * NTHR] = bf2f(alr_c[j]);
        { const int t = tid >> 3, vq = tid & 7;
          const unsigned w[8] = {a.x, a.y, a.z, a.w, bq.x, bq.y, bq.z, bq.w};
#pragma unroll
          for (int j = 0; j < 8; ++j) { vT[(vq * 16 + 2 * j) * 72 + t] = (bf16_t)(w[j] & 0xffffu); vT[(vq * 16 + 2 * j + 1) * 72 + t] = (bf16_t)(w[j] >> 16); } }
        __syncthreads();
        float cum[8]; float run = 0.f;
#pragma unroll
        for (int i = 0; i < 8; ++i) { const int t = tq * 8 + i; float g = ba;
#pragma unroll
            for (int r = 0; r < 16; ++r) g = fmaf(alr[t * 16 + r], wa[r], g);
            const float ls = fminf(g, 0.f) - log1pf(__expf(-fabsf(g)));
            run += ls * (1.0f / 16.0f); cum[i] = run; }
        part[tq * 64 + k] = run;
        __syncthreads();
        float off = 0.f, tot = 0.f;
#pragma unroll
        for (int q = 0; q < 8; ++q) { const float v = part[q * 64 + k]; tot += v; if (q < tq) off += v; }
#pragma unroll
        for (int i = 0; i < 8; ++i) { const int t = tq * 8 + i; const float kv = bf2f(gk_c[i]);
            kdT[k * 72 + t] = f2bf(kv * __expf(tot - (off + cum[i]))); }
        if (tq == 0) p.gdec[(size_t)u * 64 + k] = __expf(tot);
        __syncthreads();
        { const int fr = lane & 15, fq = lane >> 4;
          bf16x8 bfr[2];
#pragma unroll
          for (int ks = 0; ks < 2; ++ks) bfr[ks] = *(const LASP bf16x8*)(vT + (wave * 16 + fr) * 72 + ks * 32 + fq * 8);
          bf16_t* gs = p.GS + (size_t)u * 8192 + (size_t)(wave * 16 + fr) * 64;
#pragma unroll
          for (int mt = 0; mt < 4; ++mt) { f32x4 acc = {0.f, 0.f, 0.f, 0.f};
#pragma unroll
              for (int ks = 0; ks < 2; ++ks) { const bf16x8 afr = *(const LASP bf16x8*)(kdT + (mt * 16 + fr) * 72 + ks * 32 + fq * 8); acc = MFMA16(afr, bfr[ks], acc); }
              u32x2 w; w.x = pk_bf16(acc[0], acc[1]); w.y = pk_bf16(acc[2], acc[3]);
              *(u32x2*)(gs + mt * 16 + fq * 4) = w; } }
        __syncthreads();
    }
}
__device__ void phase_gla2(const Params& p, int wg, int nwg) {
    for (int e = wg * NTHR + threadIdx.x; e < NB * 4 * 128 * 32; e += nwg * NTHR) {
        const int kp = e & 31, v = (e >> 5) & 127, h = (e >> 12) & 3, b = e >> 14;
        float s0 = 0.f, s1 = 0.f;
        for (int c0 = 0; c0 < NCHUNK; c0 += 4) {
            unsigned uv[4]; f32x2 dv[4];
#pragma unroll
            for (int j = 0; j < 4; ++j) { const size_t u = ((size_t)b * NCHUNK + c0 + j) * 4 + h; uv[j] = *(const unsigned*)(p.GS + u * 8192 + v * 64 + 2 * kp); dv[j] = *(const f32x2*)(p.gdec + u * 64 + 2 * kp); }
#pragma unroll
            for (int j = 0; j < 4; ++j) { const size_t u = ((size_t)b * NCHUNK + c0 + j) * 4 + h;
                s0 = fmaf(dv[j][0], s0, bflo(uv[j])); s1 = fmaf(dv[j][1], s1, bfhi(uv[j]));
                *(unsigned*)(p.GS + u * 8192 + v * 64 + 2 * kp) = pk_bf16(s0, s1); }
        }
    }
}
__device__ void phase_gla3(const Params& p, int l, LASP unsigned char* lds, int wg, int nwg) {
    LASP float* ssq = (LASP float*)lds;
    const int tid = threadIdx.x, lane = tid & 63, wave = tid >> 6, fr = lane & 15, fq = lane >> 4;
    const int nt = wave & 3, vh = wave >> 2;
    for (int u = wg; u < NB * NCHUNK * 4; u += nwg) {
        const int h = u & 3, c = (u >> 2) & 127, b = u >> 9; const size_t t0 = (size_t)b * SEQ + (size_t)c * 64;
        bf16x8 bq[2];
#pragma unroll
        for (int ks = 0; ks < 2; ++ks) bq[ks] = ld_frag_g(p.GQ + (t0 + nt * 16 + fr) * 256 + h * 64 + ks * 32 + fq * 8);
        f32x4 acc[4];
#pragma unroll
        for (int mi = 0; mi < 4; ++mi) { acc[mi] = (f32x4){0.f, 0.f, 0.f, 0.f};
#pragma unroll
            for (int ks = 0; ks < 2; ++ks) { const bf16x8 a = ld_frag_g(p.GS + (size_t)u * 8192 + (size_t)((vh * 4 + mi) * 16 + fr) * 64 + ks * 32 + fq * 8); acc[mi] = MFMA16(a, bq[ks], acc[mi]); } }
        float ss = 0.f;
#pragma unroll
        for (int mi = 0; mi < 4; ++mi) ss += acc[mi][0] * acc[mi][0] + acc[mi][1] * acc[mi][1] + acc[mi][2] * acc[mi][2] + acc[mi][3] * acc[mi][3];
        ss += __shfl_xor(ss, 16); ss += __shfl_xor(ss, 32);
        if (fq == 0) ssq[vh * 64 + nt * 16 + fr] = ss;
        __syncthreads();
        const float tot = ssq[nt * 16 + fr] + ssq[64 + nt * 16 + fr];
        const float sc = 0.125f * rsqrtf(tot * (1.0f / 8192.0f) + 1e-6f);
        const size_t trow = t0 + nt * 16 + fr;
#pragma unroll
        for (int mi = 0; mi < 4; ++mi) { const int v0 = (vh * 4 + mi) * 16 + fq * 4;
            const u32x2 rr = *(const u32x2*)(p.GR + trow * 512 + h * 128 + v0);
            const f32x4 go = *(const f32x4*)(p.gla_g_o + (size_t)l * 128 + v0);
            const float o0 = acc[mi][0] * sc * go[0] * siluf_(bflo(rr.x)), o1 = acc[mi][1] * sc * go[1] * siluf_(bfhi(rr.x));
            const float o2 = acc[mi][2] * sc * go[2] * siluf_(bflo(rr.y)), o3 = acc[mi][3] * sc * go[3] * siluf_(bfhi(rr.y));
            u32x2 w; w.x = pk_bf16(o0, o1); w.y = pk_bf16(o2, o3);
            *(u32x2*)(p.ya + trow * 512 + h * 128 + v0) = w; }
        __syncthreads();
    }
}

#ifndef DSA_FORCE_SLOW
#define DSA_FORCE_SLOW 0
#endif
#ifndef DBG_DOUBLE
#define DBG_DOUBLE 0
#endif
#ifndef DBG_DSA_SCALE
#define DBG_DSA_SCALE 1.0f
#endif
__device__ void phase_dsa1(const Params& p, int l, int wg, int nwg) {
    const int lane = threadIdx.x & 63, wave = threadIdx.x >> 6;
    for (int tok = wg * 8 + wave; tok < NTOK; tok += nwg * 8) {
        const bf16_t* row = p.PB + (size_t)tok * PB_LD;
        const u32x2 q = *(const u32x2*)(row + PB_QC + 4 * lane);
        const unsigned kv = *(const unsigned*)(row + PB_KVC + 2 * lane);
        const float q0 = bflo(q.x), q1 = bfhi(q.x), q2 = bflo(q.y), q3 = bfhi(q.y), k0 = bflo(kv), k1 = bfhi(kv);
        const float sq = wave_sum(q0 * q0 + q1 * q1 + q2 * q2 + q3 * q3), sk = wave_sum(k0 * k0 + k1 * k1);
        const float rq = rsqrtf(sq * (1.0f / 256.0f) + 1e-6f), rk = rsqrtf(sk * (1.0f / 128.0f) + 1e-6f);
        const f32x4 gq = *(const f32x4*)(p.dsa_g_qc + (size_t)l * 256 + 4 * lane); const f32x2 gk = *(const f32x2*)(p.dsa_g_kv + (size_t)l * 128 + 2 * lane);
        u32x2 w; w.x = pk_bf16(q0 * rq * gq[0], q1 * rq * gq[1]); w.y = pk_bf16(q2 * rq * gq[2], q3 * rq * gq[3]);
        *(u32x2*)(p.qn + (size_t)tok * 256 + 4 * lane) = w;
        *(unsigned*)(p.kvn + (size_t)tok * 128 + 2 * lane) = pk_bf16(k0 * rk * gk[0], k1 * rk * gk[1]);
    }
}

constexpr int D_HIST = 0, D_CIDX = 65536, D_WH = 98304, D_MSK = 131072, D_SEL = 147456, D_CTL = 155648, D_OT = 106496, D_OT_LD = 1032, DSA_CAP = 1024;
__device__ __forceinline__ unsigned lds_add(LASP unsigned* p, unsigned v) { return __hip_atomic_fetch_add(p, v, __ATOMIC_RELAXED, __HIP_MEMORY_SCOPE_WORKGROUP); }
__device__ __forceinline__ void lds_or(LASP unsigned* p, unsigned v) { (void)__hip_atomic_fetch_or(p, v, __ATOMIC_RELAXED, __HIP_MEMORY_SCOPE_WORKGROUP); }
struct DsaQ { bf16x8 qa[4][2]; f32x2 w01[4], w23[4]; };

__device__ __forceinline__ void dsa_score(const DsaQ& Q, const bf16x8& kb0, const bf16x8& kb1, float (&sc)[4]) {
    f32x2 s01 = {0.f, 0.f}, s23 = {0.f, 0.f};
#pragma unroll
    for (int hh = 0; hh < 4; ++hh) { f32x4 d = {0.f, 0.f, 0.f, 0.f}; d = MFMA16(Q.qa[hh][0], kb0, d); d = MFMA16(Q.qa[hh][1], kb1, d);
#pragma unroll
        for (int r = 0; r < 4; ++r) d[r] = __int_as_float(max(__float_as_int(d[r]), 0));
        const f32x2 d01 = {d[0], d[1]}, d23 = {d[2], d[3]};
        s01 = __builtin_elementwise_fma(Q.w01[hh], d01, s01); s23 = __builtin_elementwise_fma(Q.w23[hh], d23, s23); }
    sc[0] = s01[0]; sc[1] = s01[1]; sc[2] = s23[0]; sc[3] = s23[1];
}
__device__ __forceinline__ unsigned dkey(float f) { const unsigned u = __float_as_uint(f); return u ^ ((unsigned)((int)u >> 31) | 0x80000000u); }
__device__ __forceinline__ unsigned dbin(float f) { const unsigned u = __float_as_uint(f); const unsigned m = (unsigned)((int)u >> 31); return (u >> 21) ^ ((m & 0x3ffu) | 0x400u); }
template <class F> __device__ __forceinline__ void dsa_tiles(const bf16_t* ik0, int ntile, int wave, int fr, int fq, F&& f) {
    const bf16_t* base = ik0 + (size_t)fr * PB_LD + fq * 8;
    const int last = ntile - 1;
#define DT_LD(x0, x1, k) do { const int k_ = (k); const bf16_t* kp = base + (size_t)(k_ < ntile ? k_ : last) * 16 * PB_LD; x0 = ld_frag_g(kp); x1 = ld_frag_g(kp + 32); } while (0)
    bf16x8 a0, a1, b0, b1, c0, c1;
    int kt = wave;
    DT_LD(a0, a1, kt); DT_LD(b0, b1, kt + 8); DT_LD(c0, c1, kt + 16);
    for (; kt < ntile; kt += 24) {
        f(kt, a0, a1); DT_LD(a0, a1, kt + 24);
        if (kt + 8 < ntile) f(kt + 8, b0, b1);
        DT_LD(b0, b1, kt + 32);
        if (kt + 16 < ntile) f(kt + 16, c0, c1);
        DT_LD(c0, c1, kt + 40);
    }
#undef DT_LD
}
__device__ __forceinline__ void wave_find_bin(const LASP unsigned* hist, unsigned need, int lane, unsigned& bin_out, unsigned& above_out, unsigned& inbin_out) {
    unsigned loc = 0;
#pragma unroll
    for (int j = 0; j < 4; ++j) { const u32x4 w4 = *(const LASP u32x4*)(hist + 1008 - 16 * lane + 4 * j);
        loc += (w4.x & 0xffffu) + (w4.x >> 16) + (w4.y & 0xffffu) + (w4.y >> 16) + (w4.z & 0xffffu) + (w4.z >> 16) + (w4.w & 0xffffu) + (w4.w >> 16); }
    const unsigned incl = wave_scan_incl(loc);
    const unsigned excl = incl - loc;
    const bool mine = (excl < need) && (incl >= need);
    const unsigned long long m = __ballot(mine);
    const int L = m ? (int)__builtin_ctzll(m) : 63;
    const unsigned base = (unsigned)__builtin_amdgcn_readlane((int)excl, L);
    unsigned c2 = 0; const unsigned bin = 2047u - 32u * (unsigned)L - (unsigned)(lane & 31);
    { const unsigned w = hist[bin >> 1]; c2 = (bin & 1u) ? (w >> 16) : (w & 0xffffu); if (lane >= 32) c2 = 0; }
    const unsigned inc2 = wave_scan_incl(c2);
    const unsigned ex2 = inc2 - c2;
    const bool mine2 = (lane < 32) && (base + ex2 < need) && (base + inc2 >= need);
    const unsigned long long m2 = __ballot(mine2);
    const int L2 = m2 ? (int)__builtin_ctzll(m2) : 31;
    bin_out = 2047u - 32u * (unsigned)L - (unsigned)L2;
    above_out = base + (unsigned)__builtin_amdgcn_readlane((int)ex2, L2);
    inbin_out = (unsigned)__builtin_amdgcn_readlane((int)c2, L2);
}

#define DSA_UNIT_SETUP \
    LASP unsigned* hist = (LASP unsigned*)(lds + D_HIST); \
    LASP unsigned short* sel = (LASP unsigned short*)(lds + D_SEL); \
    LASP bf16_t* Ot = (LASP bf16_t*)(lds + D_OT); \
    LASP unsigned* ctl = (LASP unsigned*)(lds + D_CTL); \
    const int tid = threadIdx.x, lane = tid & 63, wave = tid >> 6, fr = lane & 15, fq = lane >> 4; \
    const int uw = pos & 255, uk = pos >> 8, ur = uw >> 3; const int uix = (uk & 1) ? 32 * uk + 31 - ur : 32 * uk + ur; \
    const int sub = uix & 3, b = uw & 7, c = 127 - (uix >> 2); \
    const int n = 64 * (c + 1); const size_t krow0 = (size_t)b * SEQ; const size_t t0 = krow0 + (size_t)c * 64 + sub * 16; \
    (void)0;
__device__ __forceinline__ void dsa_select_unit(const Params& p, int l, LASP unsigned char* lds, int pos) {
    DSA_UNIT_SETUP
    (void)Ot; (void)l;
    if (tid < 128) ctl[tid] = 0u;
    if (n <= 256) {
        for (int i = tid; i < 16 * 256; i += NTHR) sel[i] = (unsigned short)(i & 255);
        __syncthreads();
        if (tid < 16) ctl[tid] = (unsigned)n;
        __syncthreads();
        return;
    }
    LASP unsigned* ckey = (LASP unsigned*)(lds + D_HIST);
    LASP unsigned short* cidx = (LASP unsigned short*)(lds + D_CIDX);
    LASP unsigned short* msk = (LASP unsigned short*)(lds + D_MSK);
    DsaQ Q;
#pragma unroll
    for (int hh = 0; hh < 4; ++hh)
#pragma unroll
        for (int ks = 0; ks < 2; ++ks) Q.qa[hh][ks] = ld_frag_g(p.qi + (t0 + fr) * 256 + hh * 64 + ks * 32 + fq * 8);
    { u32x2 w[4];
#pragma unroll
      for (int r = 0; r < 4; ++r) w[r] = *(const u32x2*)(p.PB + (t0 + fq * 4 + r) * PB_LD + PB_IW);
      Q.w01[0] = (f32x2){bflo(w[0].x), bflo(w[1].x)}; Q.w01[1] = (f32x2){bfhi(w[0].x), bfhi(w[1].x)}; Q.w01[2] = (f32x2){bflo(w[0].y), bflo(w[1].y)}; Q.w01[3] = (f32x2){bfhi(w[0].y), bfhi(w[1].y)};
      Q.w23[0] = (f32x2){bflo(w[2].x), bflo(w[3].x)}; Q.w23[1] = (f32x2){bfhi(w[2].x), bfhi(w[3].x)}; Q.w23[2] = (f32x2){bflo(w[2].y), bflo(w[3].y)}; Q.w23[3] = (f32x2){bfhi(w[2].y), bfhi(w[3].y)}; }
    const bf16_t* ik0 = p.PB + krow0 * PB_LD + PB_IK;
    const int ntile = n >> 4;
    { const u32x4 z4 = {0u, 0u, 0u, 0u};
      for (int i = tid; i < 16 * 1024 / 4; i += NTHR) ((LASP u32x4*)hist)[i] = z4;
      for (int i = tid; i < 16 * 512 * 2 / 16; i += NTHR) ((LASP u32x4*)msk)[i] = z4; }
    __syncthreads();
    dsa_tiles(ik0, ntile, wave, fr, fq, [&](int, const bf16x8& kb0, const bf16x8& kb1) {
        float sc[4]; dsa_score(Q, kb0, kb1, sc);
#pragma unroll
        for (int r = 0; r < 4; ++r) { const unsigned key = dkey(sc[r]); lds_add(&hist[(fq * 4 + r) * 1024 + ((key >> 22) & 0x3ffu)], 1u + ((key >> 21) & 1u) * 65535u); } });
#if DBG_DOUBLE & 512
    { LASP unsigned* h2 = (LASP unsigned*)(lds + D_WH);
      dsa_tiles(ik0, ntile, wave, fr, fq, [&](int, const bf16x8& kb0, const bf16x8& kb1) {
        float sc[4]; dsa_score(Q, kb0, kb1, sc);
#pragma unroll
        for (int r = 0; r < 4; ++r) { const unsigned bin = dbin(sc[r]); lds_add(&h2[((fq * 4 + r) & 7) * 1024 + (bin >> 1)], (bin & 1u) ? 65536u : 1u); } }); }
#endif
#if DBG_DOUBLE & 1024
    { float accs = 0.f;
      dsa_tiles(ik0, ntile, wave, fr, fq, [&](int, const bf16x8& kb0, const bf16x8& kb1) {
        float sc[4]; dsa_score(Q, kb0, kb1, sc); accs += sc[0] + sc[1] + sc[2] + sc[3]; });
      if (accs == 123.456f) ctl[120] = 1u; }
#endif
    __syncthreads();
#pragma unroll
    for (int qi2 = 0; qi2 < 2; ++qi2) { const int q = wave * 2 + qi2;
        unsigned bin, above, inbin; wave_find_bin(hist + q * 1024, 256u, lane, bin, above, inbin);
        if (lane == 0) { ctl[16 + q] = bin; ctl[32 + q] = 256u - above; if (inbin > (unsigned)DSA_CAP || DSA_FORCE_SLOW) ctl[97] = 1u; } }
    __syncthreads();
    if (!ctl[97]) {
        float elo[4], ehi[4];
#pragma unroll
        for (int r = 0; r < 4; ++r) { const unsigned tb = ctl[16 + fq * 4 + r]; elo[r] = fkey_inv(tb << 21); ehi[r] = tb >= 2047u ? INFINITY : fkey_inv((tb + 1u) << 21); }
        dsa_tiles(ik0, ntile, wave, fr, fq, [&](int kt, const bf16x8& kb0, const bf16x8& kb1) {
            float sc[4]; dsa_score(Q, kb0, kb1, sc);
            unsigned pc[4]; bool cand[4]; unsigned long long tm[4];
#pragma unroll
            for (int r = 0; r < 4; ++r) { const bool above = sc[r] >= ehi[r];
                tm[r] = __ballot(above);
                cand[r] = (sc[r] >= elo[r]) && !above; }
            if ((tm[0] | tm[1] | tm[2] | tm[3]) != 0ull) {
#pragma unroll
                for (int r = 0; r < 4; ++r) if (fr == 0) msk[(fq * 4 + r) * 512 + kt] = (unsigned short)((tm[r] >> (16 * fq)) & 0xffffull); }
            if (__ballot(cand[0] || cand[1] || cand[2] || cand[3]) != 0ull) {
#pragma unroll
                for (int r = 0; r < 4; ++r) pc[r] = cand[r] ? lds_add(&ctl[112 + fq * 4 + r], 1u) : 0xffffffffu;
#pragma unroll
                for (int r = 0; r < 4; ++r) if (cand[r] && pc[r] < (unsigned)DSA_CAP) { const int q = fq * 4 + r; ckey[q * DSA_CAP + pc[r]] = dkey(sc[r]); cidx[q * DSA_CAP + pc[r]] = (unsigned short)(kt * 16 + fr); } } });
        __syncthreads();
        LASP unsigned* wh = (LASP unsigned*)(lds + D_WH) + wave * 1024;
#if DBG_DOUBLE & 65536
        for (int rep_ = 0; rep_ < 2; ++rep_)
#endif
#pragma unroll 1
        for (int qi2 = 0; qi2 < 2; ++qi2) { const int q = wave * 2 + qi2;
            unsigned m = ctl[112 + q]; m = m > (unsigned)DSA_CAP ? (unsigned)DSA_CAP : m; unsigned need = ctl[32 + q];
            const LASP unsigned* ck = ckey + q * DSA_CAP; const LASP unsigned short* ci = cidx + q * DSA_CAP;
            unsigned pmask = 0u, pval = 0u, inb = 0u;
#pragma unroll 1
            for (int lvl = 0; lvl < 2; ++lvl) { const unsigned shift = lvl == 0 ? 10u : 0u, nbm = lvl == 0 ? 0x7ffu : 0x3ffu;
#pragma unroll
                for (int k = 0; k < 4; ++k) ((LASP u32x4*)wh)[lane + 64 * k] = (u32x4){0u, 0u, 0u, 0u};
                for (unsigned i = lane; i < m; i += 64) { const unsigned key = ck[i]; if ((key & pmask) == pval) { const unsigned bin = (key >> shift) & nbm; lds_add(&wh[bin >> 1], (bin & 1u) ? 65536u : 1u); } }
                unsigned bin, above; wave_find_bin(wh, need, lane, bin, above, inb);
                pval |= bin << shift; pmask |= nbm << shift; need -= above; }
            unsigned sthr = 0xffffu;
            if (need < inb) {
#pragma unroll
                for (int k = 0; k < 4; ++k) ((LASP u32x4*)wh)[lane + 64 * k] = (u32x4){0u, 0u, 0u, 0u};
                for (unsigned i = lane; i < m; i += 64) { if ((ck[i] & 0x1fffffu) == pval) { const unsigned bin = 2047u - ((unsigned)ci[i] >> 2); lds_add(&wh[bin >> 1], (bin & 1u) ? 65536u : 1u); } }
                unsigned binC, aboveC, inC; wave_find_bin(wh, need, lane, binC, aboveC, inC);
                const unsigned needC = need - aboveC;
#pragma unroll
                for (int k = 0; k < 4; ++k) ((LASP u32x4*)wh)[lane + 64 * k] = (u32x4){0u, 0u, 0u, 0u};
                for (unsigned i = lane; i < m; i += 64) { const unsigned s = ci[i]; if ((ck[i] & 0x1fffffu) == pval && (2047u - (s >> 2)) == binC) { const unsigned bin = 2047u - (s & 3u); lds_add(&wh[bin >> 1], (bin & 1u) ? 65536u : 1u); } }
                unsigned binD, aboveD, inD; wave_find_bin(wh, needC, lane, binD, aboveD, inD);
                sthr = ((2047u - binC) << 2) | (2047u - binD);
            }
            for (unsigned i = lane; i < m; i += 64) { const unsigned k21 = ck[i] & 0x1fffffu, si = ci[i];
                if (k21 > pval || (k21 == pval && si <= sthr)) { const unsigned widx = (unsigned)q * 512u + (si >> 4); lds_or((LASP unsigned*)msk + (widx >> 1), 1u << (16u * (widx & 1u) + (si & 15u))); } } }
        __syncthreads();
    } else {
        for (int pass = 1; pass < 3; ++pass) {
            for (int i = tid; i < 16 * 1024; i += NTHR) hist[i] = 0u;
            __syncthreads();
            dsa_tiles(ik0, ntile, wave, fr, fq, [&](int, const bf16x8& kb0, const bf16x8& kb1) {
                float sc[4]; dsa_score(Q, kb0, kb1, sc);
#pragma unroll
                for (int r = 0; r < 4; ++r) { const int q = fq * 4 + r; const unsigned key = dkey(sc[r]); unsigned bin; bool on;
                    if (pass == 1) { bin = (key >> 10) & 0x7ffu; on = (key >> 21) == ctl[16 + q]; }
                    else { bin = key & 0x3ffu; on = (key >> 10) == ctl[16 + q]; }
                    if (on) lds_add(&hist[q * 1024 + (bin >> 1)], (bin & 1u) ? 65536u : 1u); } });
            __syncthreads();
#pragma unroll
            for (int qi2 = 0; qi2 < 2; ++qi2) { const int q = wave * 2 + qi2;
                const unsigned need = ctl[32 + q];
                unsigned bin, above, inbin; wave_find_bin(hist + q * 1024, need, lane, bin, above, inbin);
                if (lane == 0) { const unsigned pre = ctl[16 + q];
                    ctl[16 + q] = pass == 1 ? ((pre << 11) | bin) : ((pre << 10) | bin);
                    ctl[32 + q] = need - above;
                    if (pass == 2) { const unsigned fl = (need - above < inbin) ? 1u : 0u; ctl[48 + q] = fl; if (fl) ctl[96] = 1u; } } }
            __syncthreads();
        }
        if (ctl[96]) {
            for (int i = tid; i < 16 * 1024; i += NTHR) hist[i] = 0u;
            __syncthreads();
            dsa_tiles(ik0, ntile, wave, fr, fq, [&](int kt, const bf16x8& kb0, const bf16x8& kb1) {
                float sc[4]; dsa_score(Q, kb0, kb1, sc);
#pragma unroll
                for (int r = 0; r < 4; ++r) { const int q = fq * 4 + r; const unsigned key = dkey(sc[r]);
                    if (ctl[48 + q] && key == ctl[16 + q]) { const unsigned s = (unsigned)(kt * 16 + fr); const unsigned bin = 2047u - (s >> 2); lds_add(&hist[q * 1024 + (bin >> 1)], (bin & 1u) ? 65536u : 1u); } } });
            __syncthreads();
#pragma unroll
            for (int qi2 = 0; qi2 < 2; ++qi2) { const int q = wave * 2 + qi2;
                if (ctl[48 + q]) { unsigned bin, above, inbin; wave_find_bin(hist + q * 1024, ctl[32 + q], lane, bin, above, inbin);
                    if (lane == 0) { ctl[64 + q] = bin; ctl[80 + q] = ctl[32 + q] - above; } } }
            __syncthreads();
        }
        dsa_tiles(ik0, ntile, wave, fr, fq, [&](int kt, const bf16x8& kb0, const bf16x8& kb1) {
            float sc[4]; dsa_score(Q, kb0, kb1, sc);
#pragma unroll
            for (int r = 0; r < 4; ++r) { const int q = fq * 4 + r; const unsigned key = dkey(sc[r]); const unsigned thr = ctl[16 + q];
                const unsigned s = (unsigned)(kt * 16 + fr);
                bool take = key > thr; const bool eq = key == thr; const bool fl = ctl[48 + q] != 0u;
                if (!fl) take = take || eq;
                const unsigned ibin = 2047u - (s >> 2), tb = ctl[64 + q];
                const bool eqb = eq && fl && (ibin == tb);
                const unsigned long long em = __ballot(eqb);
                if (eq && fl) {
                    if (ibin > tb) take = true;
                    else if (ibin == tb) { const unsigned long long low = em & (((1ull << lane) - 1ull) & ~((1ull << (lane & ~3)) - 1ull)); take = (unsigned)__popcll(low) < ctl[80 + q]; } }
                const unsigned long long tm = __ballot(take);
                if (fr == 0) msk[q * 512 + kt] = (unsigned short)((tm >> (16 * fq)) & 0xffffull); } });
        __syncthreads();
    }
#if DBG_DOUBLE & 131072
    for (int rep_ = 0; rep_ < 2; ++rep_)
#endif
#pragma unroll 1
    for (int qi2 = 0; qi2 < 2; ++qi2) { const int q = wave * 2 + qi2;
        LASP unsigned* pre = (LASP unsigned*)(lds + D_WH) + wave * 1024;
        const LASP unsigned* mskw = (const LASP unsigned*)msk + q * 256;
        const u32x4 mw = *(const LASP u32x4*)(mskw + lane * 4);
        const unsigned c0 = (unsigned)__popc(mw.x), c1 = (unsigned)__popc(mw.y), c2 = (unsigned)__popc(mw.z), c3 = (unsigned)__popc(mw.w), c8 = c0 + c1 + c2 + c3;
        const unsigned incl = wave_scan_incl(c8), base = incl - c8;
        { u32x4 pv; pv.x = base + c0; pv.y = pv.x + c1; pv.z = pv.y + c2; pv.w = incl; *(LASP u32x4*)(pre + lane * 4) = pv; }
        asm volatile("s_waitcnt lgkmcnt(0)" ::: "memory");
        const unsigned total = (unsigned)__builtin_amdgcn_readlane((int)incl, 63);
#pragma unroll
        for (int i = 0; i < 4; ++i) { const unsigned j = (unsigned)lane + 64u * i;
            unsigned w = 0;
#pragma unroll
            for (unsigned step = 128; step >= 1; step >>= 1) { const unsigned pvw = pre[w + step - 1]; w += pvw <= j ? step : 0u; }
            if (j < total) {
                unsigned r = j - (w ? pre[w - 1] : 0u), x = mskw[w], pos = 0;
                { const unsigned t = (unsigned)__popc(x & 0xffffu); const bool up = r >= t; pos += up ? 16u : 0u; r -= up ? t : 0u; x = up ? x >> 16 : x; }
                { const unsigned t = (unsigned)__popc(x & 0xffu); const bool up = r >= t; pos += up ? 8u : 0u; r -= up ? t : 0u; x = up ? x >> 8 : x; }
                { const unsigned t = (unsigned)__popc(x & 0xfu); const bool up = r >= t; pos += up ? 4u : 0u; r -= up ? t : 0u; x = up ? x >> 4 : x; }
                { const unsigned t = (unsigned)__popc(x & 0x3u); const bool up = r >= t; pos += up ? 2u : 0u; r -= up ? t : 0u; x = up ? x >> 2 : x; }
                pos += (r >= (x & 1u)) ? 1u : 0u;
                sel[q * 256 + j] = (unsigned short)(w * 32u + pos); } }
        if (lane == 63) ctl[q] = incl > 256u ? 256u : incl; }
    __syncthreads();
}
constexpr int DA_WAVE = 13312, DA_PB = 8192, DA_PLD = 40, DA_QA = 8832;
typedef short v4s_t __attribute__((ext_vector_type(4)));
__device__ __forceinline__ unsigned da_off(unsigned row, unsigned ch) { return 256u * row + 16u * (ch ^ (((row & 3u) << 2) | ((row >> 2) & 3u))); }
__device__ __forceinline__ void dsa_attend_query(const Params& p, int l, LASP unsigned char* lds, int pos) {
    DSA_UNIT_SETUP
    (void)hist; (void)n; (void)c; (void)sub;
    LASP unsigned char* img = lds + wave * DA_WAVE;
    LASP bf16_t* Pb = (LASP bf16_t*)(img + DA_PB);
    const unsigned ufr = (unsigned)fr, ufq = (unsigned)fq;
    const unsigned wbase = 2048u * ufq + 16u * (ufr ^ ((ufq & 1u) << 1));
    const unsigned lbase = 256u * ufr + 16u * (ufq ^ (((ufr & 3u) << 2) | ((ufr >> 2) & 3u)));
    const unsigned pbase = 256u * (8u * ufq + (ufr >> 2)) + 16u * (((ufr & 3u) >> 1) ^ (((ufr >> 2) << 2) | ((ufq & 1u) << 1))) + 8u * (ufr & 1u);
    u32x4 rw[8];
    const char* kvb = (const char*)(p.kvn + krow0 * 128);
    auto gather = [&](int qq, int ch) {
        const u32x4 iw = *(const LASP u32x4*)(sel + qq * 256 + ch * 32 + fq * 8);
        const unsigned iv[4] = {iw.x, iw.y, iw.z, iw.w};
#pragma unroll
        for (int i = 0; i < 8; ++i) { const unsigned idx = ((i & 1) ? (iv[i >> 1] >> 16) : iv[i >> 1]) & 0x1fffu;
            rw[i] = *(const u32x4*)(kvb + ((idx << 8) | (ufr << 4))); } };
    bf16x8 qf[4];
    auto ldq = [&](int qq) {
#pragma unroll
        for (int ks = 0; ks < 4; ++ks) qf[ks] = ld_frag_g(p.qd + (t0 + qq) * 1024 + (fr & 7) * 128 + ks * 32 + fq * 8); };
    ldq(wave * 2); gather(wave * 2, 0);
#pragma unroll 1
    for (int qi2 = 0; qi2 < 2; ++qi2) {
        const int q = wave * 2 + qi2;
        unsigned cnt = (unsigned)__builtin_amdgcn_readfirstlane((int)ctl[q]); cnt = cnt > 256u ? 256u : cnt;
        const int nch = (int)(cnt >> 5);
#pragma unroll
        for (int ks = 0; ks < 4; ++ks) *(LASP bf16x8*)(img + DA_QA + ks * 1024 + lane * 16) = qf[ks];
        float mrun[4] = {-INFINITY, -INFINITY, -INFINITY, -INFINITY}, lrun[4] = {0.f, 0.f, 0.f, 0.f};
        f32x4 oacc[8];
#pragma unroll
        for (int cc = 0; cc < 8; ++cc) oacc[cc] = (f32x4){0.f, 0.f, 0.f, 0.f};
#pragma unroll 1
        for (int ch = 0; ch < nch; ++ch) {
            unsigned wb = wbase, lb = lbase, pb = pbase; asm volatile("" : "+v"(wb), "+v"(lb), "+v"(pb));
#pragma unroll
            for (int i = 0; i < 8; ++i) { const unsigned ci = (unsigned)(((i & 3) << 2) | (i >> 2)); *(LASP u32x4*)(img + ((wb ^ (16u * ci)) + 256u * i)) = rw[i]; }
            { const bool more = ch + 1 < nch; const int qn = more ? q : (wave * 2 + 1), chn = more ? ch + 1 : (qi2 == 0 ? 0 : ch);
              gather(qn, chn);
              if (!more) ldq(wave * 2 + 1); }
            float lg[2][4];
#pragma unroll
            for (int tl = 0; tl < 2; ++tl) { f32x4 dd = {0.f, 0.f, 0.f, 0.f};
#pragma unroll
                for (int ks = 0; ks < 4; ++ks) dd = MFMA16(*(const LASP bf16x8*)(img + DA_QA + ks * 1024 + lane * 16), *(const LASP bf16x8*)(img + ((lb ^ (64u * ks)) + 4096u * tl)), dd);
#pragma unroll
                for (int r = 0; r < 4; ++r) lg[tl][r] = dd[r]; }

            float scv[4], tmx[4], p0[4], p1[4], ps[4];
#pragma unroll
            for (int r = 0; r < 4; ++r) tmx[r] = fmaxf(fmaxf(lg[0][r], lg[1][r]), mrun[r]);
            row16_max_x4(tmx[0], tmx[1], tmx[2], tmx[3]);
            constexpr float ES = 0.08838834764831845f * 1.4426950408889634f;
#pragma unroll
            for (int r = 0; r < 4; ++r) { const float mnew = tmx[r], nm = -mnew * ES;
                scv[r] = __builtin_amdgcn_exp2f(fmaf(mrun[r], ES, nm));
                p0[r] = __builtin_amdgcn_exp2f(fmaf(lg[0][r], ES, nm)); p1[r] = __builtin_amdgcn_exp2f(fmaf(lg[1][r], ES, nm)); ps[r] = p0[r] + p1[r]; mrun[r] = mnew; }
            row16_sum_x4(ps[0], ps[1], ps[2], ps[3]);
            unsigned short pb0[4], pb1[4];
#pragma unroll
            for (int r = 0; r < 4; ++r) { lrun[r] = lrun[r] * scv[r] + ps[r]; pb0[r] = f2bf(p0[r]); pb1[r] = f2bf(p1[r]); }
            if (fq < 2) {
#pragma unroll
                for (int r = 0; r < 4; ++r) { Pb[(fq * 4 + r) * DA_PLD + fr] = pb0[r]; Pb[(fq * 4 + r) * DA_PLD + 16 + fr] = pb1[r]; } }
            const bf16x8 pa = *(const LASP bf16x8*)(Pb + (fr & 7) * DA_PLD + fq * 8);
#pragma unroll
            for (int cc = 0; cc < 8; ++cc) {
                const v4s_t lo = __builtin_amdgcn_ds_read_tr16_b64_v4i16((LASP v4s_t*)(img + (pb ^ (32u * cc))));
                const v4s_t hi = __builtin_amdgcn_ds_read_tr16_b64_v4i16((LASP v4s_t*)(img + (((pb ^ 16u) ^ (32u * cc)) + 1024u)));
                const bf16x8 bv = {lo[0], lo[1], lo[2], lo[3], hi[0], hi[1], hi[2], hi[3]};
                f32x4 a = oacc[cc];
#pragma unroll
                for (int r = 0; r < 4; ++r) a[r] *= scv[r];
                oacc[cc] = MFMA16(pa, bv, a);
            }
        }
        if (fq < 2) {
#pragma unroll
            for (int r = 0; r < 4; ++r) { const float inv = __builtin_amdgcn_rcpf(lrun[r]);
#pragma unroll
                for (int cc = 0; cc < 8; ++cc) Ot[q * D_OT_LD + (fq * 4 + r) * 128 + cc * 16 + fr] = f2bf(oacc[cc][r] * inv); } }
    }
}
__device__ __forceinline__ void dsa_upproj_unit(const Params& p, int l, LASP unsigned char* lds, int pos) {
    DSA_UNIT_SETUP
    (void)hist; (void)n; (void)c; (void)sub; (void)sel; (void)ctl; (void)krow0;
    const bf16_t* wu = p.wuv_t + ((size_t)l * 8 + wave) * 64 * 128;
    bf16x8 wf[4][4];
#pragma unroll
    for (int nt = 0; nt < 4; ++nt)
#pragma unroll
        for (int ks = 0; ks < 4; ++ks) wf[nt][ks] = ld_frag_g(wu + (size_t)(nt * 16 + fr) * 128 + ks * 32 + fq * 8);
    __syncthreads();
    bf16x8 oa[4];
#pragma unroll
    for (int ks = 0; ks < 4; ++ks) oa[ks] = *(const LASP bf16x8*)(Ot + fr * D_OT_LD + wave * 128 + ks * 32 + fq * 8);
#pragma unroll
    for (int nt = 0; nt < 4; ++nt) { f32x4 d = {0.f, 0.f, 0.f, 0.f};
#pragma unroll
        for (int ks = 0; ks < 4; ++ks) d = MFMA16(wf[nt][ks], oa[ks], d);
        u32x2 w; w.x = pk_bf16(DBG_DSA_SCALE * d[0], DBG_DSA_SCALE * d[1]); w.y = pk_bf16(DBG_DSA_SCALE * d[2], DBG_DSA_SCALE * d[3]);
        *(u32x2*)(p.yb + (t0 + fr) * 512 + wave * 64 + nt * 16 + fq * 4) = w; }
    __syncthreads();
}
__device__ void phase_dsa34(const Params& p, int l, LASP unsigned char* lds, int wg, int nwg) {
    for (int pos = wg; pos < 4096; pos += nwg) { dsa_select_unit(p, l, lds, pos); dsa_attend_query(p, l, lds, pos); dsa_upproj_unit(p, l, lds, pos); }
}

#ifndef DBG_DOUBLE
#define DBG_DOUBLE 0
#endif
constexpr int R_W = 0, R_A = 8192, R_B = 16384, R_K2 = 24576, R_R = 32768, R_V = 40960, R_Y = 43008, R_BUF = 45056;
#ifndef SCAN_PRIO
#define SCAN_PRIO 0
#endif
#ifndef PREP_PRIO
#define PREP_PRIO 0
#endif
constexpr int R_WM = 90112, R_AM = 99328, R_CONST = 108544, R_STG = 110848, R_STG_SZ = 4352;
__device__ __forceinline__ f32x4 lerp4(u32x2 cur, u32x2 prv, f32x4 mu) {
    f32x4 c = {bflo(cur.x), bfhi(cur.x), bflo(cur.y), bfhi(cur.y)}, q = {bflo(prv.x), bfhi(prv.x), bflo(prv.y), bfhi(prv.y)};
    return c + (q - c) * mu;
}
__device__ __forceinline__ void lerp8(const u32x4 cur, const u32x4 prv, const f32x4 m0, const f32x4 m1, f32x4& o0, f32x4& o1) {
    const f32x4 c0 = {bflo(cur.x), bfhi(cur.x), bflo(cur.y), bfhi(cur.y)}, c1 = {bflo(cur.z), bfhi(cur.z), bflo(cur.w), bfhi(cur.w)};
    const f32x4 q0 = {bflo(prv.x), bfhi(prv.x), bflo(prv.y), bfhi(prv.y)}, q1 = {bflo(prv.z), bfhi(prv.z), bflo(prv.w), bfhi(prv.w)};
    o0 = c0 + (q0 - c0) * m0; o1 = c1 + (q1 - c1) * m1;
}
__device__ __forceinline__ float fast_tanh(float x) { return fmaf(-2.0f, __builtin_amdgcn_rcpf(1.0f + __builtin_amdgcn_exp2f(2.8853900817779268f * x)), 1.0f); }
struct RwRaw { u32x4 cr, pr, ck, pk, cw, pw, ca, pa, cv, pv; };
__device__ __forceinline__ void rwkv_scan_setup(const Params& p, int l, LASP unsigned char* lds, int u) {
    const int tid = threadIdx.x, lane = tid & 63, wave = tid >> 6, fr = lane & 15, fq = lane >> 4;
    LASP bf16_t* sWm = (LASP bf16_t*)(lds + R_WM); LASP bf16_t* sAm = (LASP bf16_t*)(lds + R_AM); LASP float* sC = (LASP float*)(lds + R_CONST);
    const int rg = u & 3, h = (u >> 2) & 7, b = u >> 5;
    const size_t row0 = (size_t)b * SEQ;
    (void)tid; (void)lane; (void)wave; (void)fr; (void)fq; (void)sWm; (void)sAm; (void)sC; (void)rg; (void)h; (void)row0; (void)l;
        __syncthreads();
        for (int i = tid; i < 64 * 8; i += NTHR) { const int j = i >> 3, c8 = i & 7;
            *(LASP u32x4*)(sWm + j * 72 + c8 * 8) = *(const u32x4*)(p.ww2_t + ((size_t)l * 512 + h * 64 + j) * 64 + c8 * 8);
            *(LASP u32x4*)(sAm + j * 72 + c8 * 8) = *(const u32x4*)(p.wa2_t + ((size_t)l * 512 + h * 64 + j) * 64 + c8 * 8); }
        { const float* mu = p.rw_mu + (size_t)l * 1792;
          if (tid < 64) { sC[tid] = mu[PC_R + h * 64 + tid]; sC[64 + tid] = mu[PC_K + h * 64 + tid]; sC[128 + tid] = mu[PC_WLR + tid]; sC[192 + tid] = mu[PC_ALR + tid]; }
          if (tid < 16) sC[256 + tid] = mu[PC_V + h * 64 + 16 * rg + tid];
          if (tid < 64) { const size_t o = (size_t)l * 512 + h * 64 + tid; sC[272 + tid] = p.rw_k_k[o]; sC[336 + tid] = p.rw_k_a[o]; sC[400 + tid] = p.rw_w0[o]; sC[464 + tid] = p.rw_a0[o]; } }
        __syncthreads();
}
__device__ __forceinline__ void rwkv_scan_waves(const Params& p, int l, LASP unsigned char* lds, int u) {
    const int tid = threadIdx.x, lane = tid & 63, wave = tid >> 6, fr = lane & 15, fq = lane >> 4;
    LASP bf16_t* sWm = (LASP bf16_t*)(lds + R_WM); LASP bf16_t* sAm = (LASP bf16_t*)(lds + R_AM); LASP float* sC = (LASP float*)(lds + R_CONST);
    const int rg = u & 3, h = (u >> 2) & 7, b = u >> 5;
    const size_t row0 = (size_t)b * SEQ;
    (void)tid; (void)lane; (void)wave; (void)fr; (void)fq; (void)sWm; (void)sAm; (void)sC; (void)rg; (void)h; (void)row0; (void)l;
            __builtin_amdgcn_s_setprio(SCAN_PRIO);
            f32x4 S4 = {0.f, 0.f, 0.f, 0.f}; float yacc = 0.f;
            const int rl = wave * 4 + fq;
            __syncthreads();
            for (int blk = 0; blk < SEQ / 32; ++blk) {
                LASP unsigned char* bf = lds + (blk & 1) * R_BUF;
                LASP float* sW = (LASP float*)(bf + R_W); LASP float* sA = (LASP float*)(bf + R_A); LASP float* sB = (LASP float*)(bf + R_B);
                LASP float* sK2 = (LASP float*)(bf + R_K2); LASP float* sR = (LASP float*)(bf + R_R); LASP float* sV = (LASP float*)(bf + R_V); LASP float* sY = (LASP float*)(bf + R_Y);
                f32x4 w4 = *(const LASP f32x4*)(sW + 4 * fr), a4 = *(const LASP f32x4*)(sA + 4 * fr), b4 = *(const LASP f32x4*)(sB + 4 * fr);
                f32x4 k4 = *(const LASP f32x4*)(sK2 + 4 * fr), r4 = *(const LASP f32x4*)(sR + 4 * fr); float v = sV[rl];
                float sa = S4[0] * a4[0] + S4[1] * a4[1] + S4[2] * a4[2] + S4[3] * a4[3];
                sa = row16_sum(sa);
                f32x4 tv = S4 * w4 + k4 * v;
#pragma unroll 8
                for (int tt = 0; tt < 32; ++tt) {
                    const int tn = tt < 31 ? tt + 1 : 31;
                    const f32x4 w4n = *(const LASP f32x4*)(sW + tn * 64 + 4 * fr), a4n = *(const LASP f32x4*)(sA + tn * 64 + 4 * fr), b4n = *(const LASP f32x4*)(sB + tn * 64 + 4 * fr);
                    const f32x4 k4n = *(const LASP f32x4*)(sK2 + tn * 64 + 4 * fr), r4n = *(const LASP f32x4*)(sR + tn * 64 + 4 * fr); const float vn = sV[tn * 16 + rl];
                    S4 = tv + b4 * sa;
                    const f32x4 py = S4 * r4, ps = S4 * a4n;
                    float y = (py[0] + py[2]) + (py[1] + py[3]), sp = (ps[0] + ps[2]) + (ps[1] + ps[3]);
                    tv = S4 * w4n + k4n * vn;
                    sp += dppf<0xB1>(sp); y += dppf<0xB1>(y); sp += dppf<0x4E>(sp); y += dppf<0x4E>(y);
                    sp += dppf<0x141>(sp); y += dppf<0x141>(y); sp += dppf<0x140>(sp); y += dppf<0x140>(y);
                    sa = sp;
                    yacc = (fr == (tt & 15)) ? y : yacc;
                    if ((tt & 15) == 15) { sY[(tt - 15 + fr) * 16 + rl] = yacc; }
                    b4 = b4n; r4 = r4n;
                }
                __syncthreads();
            }
            __builtin_amdgcn_s_setprio(0);
            __syncthreads();
}
__device__ __forceinline__ void rwkv_prep_waves(const Params& p, int l, LASP unsigned char* lds, int u) {
    const int tid = threadIdx.x, lane = tid & 63, wave = tid >> 6, fr = lane & 15, fq = lane >> 4;
    LASP bf16_t* sWm = (LASP bf16_t*)(lds + R_WM); LASP bf16_t* sAm = (LASP bf16_t*)(lds + R_AM); LASP float* sC = (LASP float*)(lds + R_CONST);
    const int rg = u & 3, h = (u >> 2) & 7, b = u >> 5;
    const size_t row0 = (size_t)b * SEQ;
    (void)tid; (void)lane; (void)wave; (void)fr; (void)fq; (void)sWm; (void)sAm; (void)sC; (void)rg; (void)h; (void)row0; (void)l;
            __builtin_amdgcn_s_setprio(PREP_PRIO);
            const int pw = wave - 4, s8 = lane >> 3, c8 = lane & 7;
            LASP unsigned char* stg = lds + R_STG + pw * R_STG_SZ;
            LASP bf16_t* sPw = (LASP bf16_t*)stg; LASP bf16_t* sPa = (LASP bf16_t*)(stg + 1152); LASP float* sKt = (LASP float*)(stg + 2304);
            const u32x4 z4 = {0u, 0u, 0u, 0u};
            auto load_raw = [&](int blk, RwRaw& R) {
                const int t = blk * 32 + pw * 8 + s8; const bf16_t* cur = p.PC + (row0 + t) * PC_LD; const bf16_t* prv = cur - PC_LD; const bool hasp = t > 0;
                R.cr = *(const u32x4*)(cur + PC_R + h * 64 + 8 * c8); R.ck = *(const u32x4*)(cur + PC_K + h * 64 + 8 * c8);
                R.cw = *(const u32x4*)(cur + PC_WLR + 8 * c8); R.ca = *(const u32x4*)(cur + PC_ALR + 8 * c8);
                R.pr = hasp ? *(const u32x4*)(prv + PC_R + h * 64 + 8 * c8) : z4; R.pk = hasp ? *(const u32x4*)(prv + PC_K + h * 64 + 8 * c8) : z4;
                R.pw = hasp ? *(const u32x4*)(prv + PC_WLR + 8 * c8) : z4; R.pa = hasp ? *(const u32x4*)(prv + PC_ALR + 8 * c8) : z4;
                R.cv = z4; R.pv = z4;
                if (c8 < 2) { R.cv = *(const u32x4*)(cur + PC_V + h * 64 + 16 * rg + 8 * c8); if (hasp) R.pv = *(const u32x4*)(prv + PC_V + h * 64 + 16 * rg + 8 * c8); } };
            auto stageA = [&](int blk, const RwRaw& R) {
                LASP unsigned char* bf = lds + (blk & 1) * R_BUF;
                LASP float* sW = (LASP float*)(bf + R_W); LASP float* sA = (LASP float*)(bf + R_A); LASP float* sB = (LASP float*)(bf + R_B);
                LASP float* sK2 = (LASP float*)(bf + R_K2); LASP float* sR = (LASP float*)(bf + R_R); LASP float* sV = (LASP float*)(bf + R_V);
                const int t = pw * 8 + s8;
                { f32x4 o0, o1;
                  lerp8(R.cr, R.pr, *(const LASP f32x4*)(sC + 8 * c8), *(const LASP f32x4*)(sC + 8 * c8 + 4), o0, o1); *(LASP f32x4*)(sR + t * 64 + 8 * c8) = o0; *(LASP f32x4*)(sR + t * 64 + 8 * c8 + 4) = o1;
                  lerp8(R.ck, R.pk, *(const LASP f32x4*)(sC + 64 + 8 * c8), *(const LASP f32x4*)(sC + 64 + 8 * c8 + 4), o0, o1); *(LASP f32x4*)(sKt + s8 * 64 + 8 * c8) = o0; *(LASP f32x4*)(sKt + s8 * 64 + 8 * c8 + 4) = o1;
                  lerp8(R.cw, R.pw, *(const LASP f32x4*)(sC + 128 + 8 * c8), *(const LASP f32x4*)(sC + 128 + 8 * c8 + 4), o0, o1);
                  { u32x4 tw; tw.x = pk_bf16(fast_tanh(o0[0]), fast_tanh(o0[1])); tw.y = pk_bf16(fast_tanh(o0[2]), fast_tanh(o0[3])); tw.z = pk_bf16(fast_tanh(o1[0]), fast_tanh(o1[1])); tw.w = pk_bf16(fast_tanh(o1[2]), fast_tanh(o1[3]));
                    *(LASP u32x4*)(sPw + s8 * 72 + 8 * c8) = tw; }
                  lerp8(R.ca, R.pa, *(const LASP f32x4*)(sC + 192 + 8 * c8), *(const LASP f32x4*)(sC + 192 + 8 * c8 + 4), o0, o1);
                  { u32x4 ta; ta.x = pk_bf16(o0[0], o0[1]); ta.y = pk_bf16(o0[2], o0[3]); ta.z = pk_bf16(o1[0], o1[1]); ta.w = pk_bf16(o1[2], o1[3]); *(LASP u32x4*)(sPa + s8 * 72 + 8 * c8) = ta; }
                  if (c8 < 2) { lerp8(R.cv, R.pv, *(const LASP f32x4*)(sC + 256 + 8 * c8), *(const LASP f32x4*)(sC + 256 + 8 * c8 + 4), o0, o1); *(LASP f32x4*)(sV + t * 16 + 8 * c8) = o0; *(LASP f32x4*)(sV + t * 16 + 8 * c8 + 4) = o1; } }
                asm volatile("s_waitcnt lgkmcnt(0)" ::: "memory"); };
            auto stageBC = [&](int blk) {
                LASP unsigned char* bf = lds + (blk & 1) * R_BUF;
                LASP float* sW = (LASP float*)(bf + R_W); LASP float* sA = (LASP float*)(bf + R_A); LASP float* sB = (LASP float*)(bf + R_B); LASP float* sK2 = (LASP float*)(bf + R_K2);
                bf16x8 aw[2], aa[2];
#pragma unroll
                for (int ks = 0; ks < 2; ++ks) { aw[ks] = *(const LASP bf16x8*)(sPw + (fr & 7) * 72 + ks * 32 + fq * 8); aa[ks] = *(const LASP bf16x8*)(sPa + (fr & 7) * 72 + ks * 32 + fq * 8); }
                float ss[4] = {0.f, 0.f, 0.f, 0.f};
                const bool hi = fq >= 2;
                const int jb = (hi ? 32 : 0) + fr, tb8 = (fq & 1) * 4;
                LASP unsigned char* ebase = bf + ((pw * 8 + tb8) * 64 + jb) * 4; const LASP float* ktbase = sKt + tb8 * 64 + jb; const LASP float* cbase = sC + jb;
                float kkv[2][4], rtv[2][4];
#pragma unroll
                for (int nn = 0; nn < 2; ++nn) {
                    f32x4 dz0 = {0.f, 0.f, 0.f, 0.f}, da0 = dz0, dz1 = dz0, da1 = dz0;
#pragma unroll
                    for (int ks = 0; ks < 2; ++ks) {
                        dz0 = MFMA16(aw[ks], *(const LASP bf16x8*)(sWm + (nn * 16 + fr) * 72 + ks * 32 + fq * 8), dz0); da0 = MFMA16(aa[ks], *(const LASP bf16x8*)(sAm + (nn * 16 + fr) * 72 + ks * 32 + fq * 8), da0);
                        dz1 = MFMA16(aw[ks], *(const LASP bf16x8*)(sWm + ((nn + 2) * 16 + fr) * 72 + ks * 32 + fq * 8), dz1); da1 = MFMA16(aa[ks], *(const LASP bf16x8*)(sAm + ((nn + 2) * 16 + fr) * 72 + ks * 32 + fq * 8), da1); }
                    LASP unsigned char* eb = ebase + nn * 64; const LASP float* kt = ktbase + nn * 16; const LASP float* cb = cbase + nn * 16;
                    const float kkc = cb[272], w0c = cb[400], a0c = cb[464];
#pragma unroll
                    for (int r = 0; r < 4; ++r) {
                        const float dzr = hi ? dz1[r] : dz0[r], dar = hi ? da1[r] : da0[r];
                        const float dec = __builtin_amdgcn_exp2f(-0.8750387749145276f * sigmoidf_(w0c + dzr));
                        const float kk = kt[r * 64] * kkc; ss[r] += kk * kk;
                        *(LASP float*)(eb + r * 256 + R_W) = dec; rtv[nn][r] = sigmoidf_(a0c + dar); kkv[nn][r] = kk; } }
#pragma unroll
                for (int r = 0; r < 4; ++r) { float t = row16_sum(ss[r]); t += __shfl_xor(t, 32); ss[r] = rsqrtf(t + 1e-12f); }
                asm volatile("s_waitcnt lgkmcnt(0)" ::: "memory");
#pragma unroll
                for (int nn = 0; nn < 2; ++nn) { LASP unsigned char* eb = ebase + nn * 64; const LASP float* kt = ktbase + nn * 16; const float kac = cbase[nn * 16 + 336];
#pragma unroll
                    for (int r = 0; r < 4; ++r) { const float kn = kkv[nn][r] * ss[r], ar = rtv[nn][r];
                        *(LASP float*)(eb + r * 256 + R_A) = -kn; *(LASP float*)(eb + r * 256 + R_B) = kn * ar; *(LASP float*)(eb + r * 256 + R_K2) = kt[r * 64] * ((ar - 1.0f) * kac + 1.0f); } }
            };
            auto yout = [&](int blk) {
                const LASP float* sY = (const LASP float*)(lds + (blk & 1) * R_BUF + R_Y); const int id = pw * 64 + lane;
#pragma unroll
                for (int k = 0; k < 2; ++k) { const int t = (id >> 4) + 16 * k, i = id & 15; p.yc[(row0 + blk * 32 + t) * 512 + h * 64 + 16 * rg + i] = f2bf(sY[t * 16 + i]); } };
            RwRaw R;
            load_raw(0, R);
            stageA(0, R); load_raw(1, R); stageBC(0);
            __syncthreads();
#pragma unroll 1
            for (int blk = 0; blk < SEQ / 32; ++blk) {
                if (blk >= 1) yout(blk - 1);
#if DBG_DOUBLE & 8192
                if (blk + 1 < SEQ / 32) { stageA(blk + 1, R); stageBC(blk + 1); stageBC(blk + 1); if (blk + 2 < SEQ / 32) load_raw(blk + 2, R); }
#elif DBG_DOUBLE & 16384
                if (blk + 1 < SEQ / 32) { stageA(blk + 1, R); stageA(blk + 1, R); stageBC(blk + 1); if (blk + 2 < SEQ / 32) load_raw(blk + 2, R); }
#else
                if (blk + 1 < SEQ / 32) { stageA(blk + 1, R); if (blk + 2 < SEQ / 32) load_raw(blk + 2, R); stageBC(blk + 1); }
#endif
                __syncthreads();
            }
            yout(SEQ / 32 - 1);
            __builtin_amdgcn_s_setprio(0);
            __syncthreads();
}
__device__ void phase_rwkv_scan(const Params& p, int l, LASP unsigned char* lds, int wg, int nwg) {
    for (int u = wg; u < NB * 8 * 4; u += nwg) { rwkv_scan_setup(p, l, lds, u); if ((threadIdx.x >> 6) < 4) rwkv_scan_waves(p, l, lds, u); else rwkv_prep_waves(p, l, lds, u); }
}

constexpr int R3_A = 0, R3_G = 65536, R3_PA = 131072, R3_PG = 135680;
__device__ __forceinline__ void rwkv_post_ab(const Params& p, int l, LASP unsigned char* lds, int u) {
    LASP float* sAr = (LASP float*)(lds + R3_A); LASP float* sG = (LASP float*)(lds + R3_G);
    LASP bf16_t* sPa = (LASP bf16_t*)(lds + R3_PA); LASP bf16_t* sPg = (LASP bf16_t*)(lds + R3_PG);
    const int tid = threadIdx.x, lane = tid & 63, wave = tid >> 6, fr = lane & 15, fq = lane >> 4;
    const float* mu = p.rw_mu + (size_t)l * 1792;
        const size_t tr0 = (size_t)u * 32;
        const int pt = tid >> 4, cq = tid & 15;
        const size_t tr = tr0 + pt; const bool hasp = (tr & (SEQ - 1)) != 0;
        const bf16_t* cur = p.PC + tr * PC_LD; const bf16_t* prv = cur - PC_LD; const u32x2 z2 = {0u, 0u};
        (void)sAr; (void)sG; (void)wave; (void)lane;
        { const u32x2 ca = *(const u32x2*)(cur + PC_ALR + 4 * cq), pa = hasp ? *(const u32x2*)(prv + PC_ALR + 4 * cq) : z2;
          const f32x4 a4 = lerp4(ca, pa, *(const f32x4*)(mu + PC_ALR + 4 * cq));
          u32x2 ta; ta.x = pk_bf16(a4[0], a4[1]); ta.y = pk_bf16(a4[2], a4[3]); *(LASP u32x2*)(sPa + pt * 72 + 4 * cq) = ta;
#pragma unroll
          for (int g2 = 0; g2 < 2; ++g2) { const int col = 8 * cq + 4 * g2;
              const u32x2 cg = *(const u32x2*)(cur + PC_GLR + col), pg = hasp ? *(const u32x2*)(prv + PC_GLR + col) : z2;
              const f32x4 g4 = lerp4(cg, pg, *(const f32x4*)(mu + PC_GLR + col));
              u32x2 tg; tg.x = pk_bf16(sigmoidf_(g4[0]), sigmoidf_(g4[1])); tg.y = pk_bf16(sigmoidf_(g4[2]), sigmoidf_(g4[3])); *(LASP u32x2*)(sPg + pt * 136 + col) = tg; } }
        __syncthreads();
        { bf16x8 aa[2][2], ag[2][4];
#pragma unroll
          for (int m2 = 0; m2 < 2; ++m2) {
#pragma unroll
              for (int ks = 0; ks < 2; ++ks) aa[m2][ks] = *(const LASP bf16x8*)(sPa + (m2 * 16 + fr) * 72 + ks * 32 + fq * 8);
#pragma unroll
              for (int ks = 0; ks < 4; ++ks) ag[m2][ks] = *(const LASP bf16x8*)(sPg + (m2 * 16 + fr) * 136 + ks * 32 + fq * 8); }
#pragma unroll 1
          for (int ni = 0; ni < 4; ++ni) { const int n = (wave + 8 * ni) * 16 + fr;
              bf16x8 bwa[2], bwg[4];
#pragma unroll
              for (int ks = 0; ks < 2; ++ks) bwa[ks] = ld_frag_g(p.wa2_t + ((size_t)l * 512 + n) * 64 + ks * 32 + fq * 8);
#pragma unroll
              for (int ks = 0; ks < 4; ++ks) bwg[ks] = ld_frag_g(p.wg2_t + ((size_t)l * 512 + n) * 128 + ks * 32 + fq * 8);
              const float a0n = p.rw_a0[(size_t)l * 512 + n];
#pragma unroll
              for (int m2 = 0; m2 < 2; ++m2) { f32x4 da = {0.f, 0.f, 0.f, 0.f}, dg = {0.f, 0.f, 0.f, 0.f};
#pragma unroll
                  for (int ks = 0; ks < 2; ++ks) da = MFMA16(aa[m2][ks], bwa[ks], da);
#pragma unroll
                  for (int ks = 0; ks < 4; ++ks) dg = MFMA16(ag[m2][ks], bwg[ks], dg);
#pragma unroll
                  for (int r = 0; r < 4; ++r) { const int t = m2 * 16 + fq * 4 + r; sAr[t * 512 + n] = sigmoidf_(a0n + da[r]); sG[t * 512 + n] = dg[r]; } } } }
        __syncthreads();
}
__device__ __forceinline__ void rwkv_post_c(const Params& p, int l, LASP unsigned char* lds, int u) {
    LASP float* sAr = (LASP float*)(lds + R3_A); LASP float* sG = (LASP float*)(lds + R3_G);
    LASP bf16_t* sPa = (LASP bf16_t*)(lds + R3_PA); LASP bf16_t* sPg = (LASP bf16_t*)(lds + R3_PG);
    const int tid = threadIdx.x, lane = tid & 63, wave = tid >> 6, fr = lane & 15, fq = lane >> 4;
    const float* mu = p.rw_mu + (size_t)l * 1792;
        const size_t tr0 = (size_t)u * 32;
        const int pt = tid >> 4, cq = tid & 15;
        const size_t tr = tr0 + pt; const bool hasp = (tr & (SEQ - 1)) != 0;
        const bf16_t* cur = p.PC + tr * PC_LD; const bf16_t* prv = cur - PC_LD; const u32x2 z2 = {0u, 0u};
        (void)sPa; (void)sPg; (void)wave; (void)lane; (void)fr; (void)fq;
        struct HeadRaw { u32x2 cr, ck, cv, pr, pk, pv, yw; };
        auto load_head = [&](int h, HeadRaw& R) { const int col = h * 64 + 4 * cq;
            R.cr = *(const u32x2*)(cur + PC_R + col); R.ck = *(const u32x2*)(cur + PC_K + col); R.cv = *(const u32x2*)(cur + PC_V + col);
            R.pr = hasp ? *(const u32x2*)(prv + PC_R + col) : z2; R.pk = hasp ? *(const u32x2*)(prv + PC_K + col) : z2; R.pv = hasp ? *(const u32x2*)(prv + PC_V + col) : z2;
            R.yw = *(const u32x2*)(p.yc + tr * 512 + col); };
        HeadRaw Rn; load_head(0, Rn);
#pragma unroll 1
        for (int h = 0; h < 8; ++h) { const int col = h * 64 + 4 * cq;
            const HeadRaw R = Rn;
            if (h < 7) load_head(h + 1, Rn);
            const f32x4 r4 = lerp4(R.cr, R.pr, *(const f32x4*)(mu + PC_R + col)), k4 = lerp4(R.ck, R.pk, *(const f32x4*)(mu + PC_K + col)), v4 = lerp4(R.cv, R.pv, *(const f32x4*)(mu + PC_V + col));
            const f32x4 ar = *(const LASP f32x4*)(sAr + pt * 512 + col), g4 = *(const LASP f32x4*)(sG + pt * 512 + col);
            const f32x4 ka4 = *(const f32x4*)(p.rw_k_a + (size_t)l * 512 + col), rk4 = *(const f32x4*)(p.rw_r_k + (size_t)l * 512 + col);
            const f32x4 k2 = k4 * ((ar - 1.0f) * ka4 + 1.0f);
            const f32x4 bt = r4 * k2 * rk4; float bonus = row16_sum(bt[0] + bt[1] + bt[2] + bt[3]);
            const u32x2 yw = R.yw;
            const f32x4 y4 = {bflo(yw.x), bfhi(yw.x), bflo(yw.y), bfhi(yw.y)};
            const float mean = row16_sum(y4[0] + y4[1] + y4[2] + y4[3]) * (1.0f / 64.0f);
            const f32x4 dy = y4 - mean; const float var = row16_sum(dy[0] * dy[0] + dy[1] * dy[1] + dy[2] * dy[2] + dy[3] * dy[3]) * (1.0f / 64.0f);
            const float rstd = rsqrtf(var + 64e-5f);
            const f32x4 lg4 = *(const f32x4*)(p.rw_ln_g + (size_t)l * 512 + col), lb4 = *(const f32x4*)(p.rw_ln_b + (size_t)l * 512 + col);
            const f32x4 o = ((dy * rstd) * lg4 + lb4 + v4 * bonus) * g4;
            u32x2 w; w.x = pk_bf16(o[0], o[1]); w.y = pk_bf16(o[2], o[3]);
            *(u32x2*)(p.yc + tr * 512 + col) = w; }
        __syncthreads();
}
__device__ void phase_rwkv_post(const Params& p, int l, LASP unsigned char* lds, int wg, int nwg) {
    for (int u = wg; u < NTOK / 32; u += nwg) { rwkv_post_ab(p, l, lds, u); rwkv_post_c(p, l, lds, u); }
}

__device__ void phase_peer_tables(const Params& p, int l, int wg, int nwg) {
    const int lane = threadIdx.x & 63, wave = threadIdx.x >> 6;
    unsigned char* t8 = (unsigned char*)p.tu; float* tsc = (float*)((unsigned char*)p.tu + (size_t)2 * 16384 * 1024);
    for (int r = wg * 8 + wave; r < 2 * 16384; r += nwg * 8) {
        const int tb = r >> 14, row = r & 16383;
        const float* src = (tb ? p.peer_v : p.peer_u) + ((size_t)l * 16384 + row) * 1024 + 16 * lane;
        f32x4 v[4]; float am = 0.f;
#pragma unroll
        for (int i = 0; i < 4; ++i) { v[i] = *(const f32x4*)(src + 4 * i); am = fmaxf(am, fmaxf(fmaxf(fabsf(v[i][0]), fabsf(v[i][1])), fmaxf(fabsf(v[i][2]), fabsf(v[i][3])))); }
#pragma unroll
        for (int o = 32; o >= 1; o >>= 1) am = fmaxf(am, __shfl_xor(am, o));
        int ex = 0; if (am > 0.f) (void)frexpf(am, &ex);
        const float sc = ldexpf(1.0f, 8 - ex), inv = ldexpf(1.0f, ex - 8);
        u32x4 w;
#pragma unroll
        for (int i = 0; i < 4; ++i) { int q = 0; q = __builtin_amdgcn_cvt_pk_fp8_f32(v[i][0] * sc, v[i][1] * sc, q, false); q = __builtin_amdgcn_cvt_pk_fp8_f32(v[i][2] * sc, v[i][3] * sc, q, true); w[i] = (unsigned)q; }
        *(u32x4*)(t8 + (size_t)tb * 16384 * 1024 + (size_t)(lane >> 3) * 16384 * 128 + (size_t)row * 128 + 16 * (lane & 7)) = w;
        if (lane == 0) tsc[r] = inv;
    }
}
__device__ __forceinline__ float pk_val(unsigned key) { return fkey_inv(key & 0xffffff80u); }
__device__ void phase_peer_select(const Params& p, int l, LASP unsigned char* lds, int wg, int nwg) {
    LASP unsigned* top = (LASP unsigned*)lds;
    const int tid = threadIdx.x, lane = tid & 63, wave = tid >> 6, fr = lane & 15, fq = lane >> 4;
    int ca, cb; bool cvalid = lane < 50;
    { const int c = lane;
      if (c < 16) { ca = 0; cb = c; } else if (c < 24) { ca = 1; cb = c - 16; } else if (c < 29) { ca = 2; cb = c - 24; } else if (c < 33) { ca = 3; cb = c - 29; }
      else if (c < 36) { ca = 4; cb = c - 33; } else if (c < 38) { ca = 5; cb = c - 36; } else if (c < 40) { ca = 6; cb = c - 38; } else if (c < 42) { ca = 7; cb = c - 40; }
      else if (c < 50) { ca = c - 42 + 8; cb = 0; } else { ca = 0; cb = 0; } }
    for (int u = wg; u < NTOK / 64; u += nwg) {
        const size_t t0 = (size_t)u * 64;
#pragma unroll 1
        for (int pi = 0; pi < 2; ++pi) { const int hp = wave * 2 + pi;
            const bf16_t* kb = p.pkeys + ((size_t)l * 16 + hp) * 128 * 64;
            bf16x8 bk[8][2];
#pragma unroll
            for (int nt = 0; nt < 8; ++nt)
#pragma unroll
                for (int ks = 0; ks < 2; ++ks) bk[nt][ks] = ld_frag_g(kb + (size_t)(nt * 16 + fr) * 64 + ks * 32 + fq * 8);
#pragma unroll 1
            for (int mt = 0; mt < 4; ++mt) {
                bf16x8 qa[2];
#pragma unroll
                for (int ks = 0; ks < 2; ++ks) qa[ks] = ld_frag_g(p.qp + (t0 + mt * 16 + fr) * 1024 + hp * 64 + ks * 32 + fq * 8);
                unsigned key[8][4];
#pragma unroll
                for (int nt = 0; nt < 8; ++nt) { f32x4 d = {0.f, 0.f, 0.f, 0.f}; d = MFMA16(qa[0], bk[nt][0], d); d = MFMA16(qa[1], bk[nt][1], d);
#pragma unroll
                    for (int r = 0; r < 4; ++r) key[nt][r] = (fkey(d[r]) & 0xffffff80u) | (unsigned)(127 - (nt * 16 + fr)); }
#define PE_CE(a, b) { const unsigned hi_ = key[a][r] > key[b][r] ? key[a][r] : key[b][r], lo_ = key[a][r] > key[b][r] ? key[b][r] : key[a][r]; key[a][r] = hi_; key[b][r] = lo_; }
#pragma unroll
                for (int r = 0; r < 4; ++r) {
                    PE_CE(0, 1) PE_CE(2, 3) PE_CE(4, 5) PE_CE(6, 7)
                    PE_CE(0, 2) PE_CE(1, 3) PE_CE(4, 6) PE_CE(5, 7)
                    PE_CE(1, 2) PE_CE(5, 6)
                    PE_CE(0, 4) PE_CE(1, 5) PE_CE(2, 6) PE_CE(3, 7)
                    PE_CE(2, 4) PE_CE(3, 5)
                    PE_CE(1, 2) PE_CE(3, 4) PE_CE(5, 6) }
#undef PE_CE
                unsigned mine[4] = {0u, 0u, 0u, 0u};
#pragma unroll 1
                for (int it = 0; it < 16; ++it) {
                    unsigned mx[4];
                    row16_maxu_x4(mx, key[0][0], key[0][1], key[0][2], key[0][3]);
#pragma unroll
                    for (int r = 0; r < 4; ++r) { const unsigned m = mx[r];
                        if (fr == it) mine[r] = m;
                        const bool win = key[0][r] == m;
#pragma unroll
                        for (int nt = 0; nt < 7; ++nt) key[nt][r] = win ? key[nt + 1][r] : key[nt][r];
                        key[7][r] = win ? 0u : key[7][r]; }
                }
#pragma unroll
                for (int r = 0; r < 4; ++r) top[((mt * 16 + fq * 4 + r) * 16 + hp) * 16 + fr] = mine[r];
            }
        }
        __syncthreads();
        { const int t = tid >> 3, h = tid & 7;
          const LASP unsigned* l1 = top + (t * 16 + h * 2) * 16; const LASP unsigned* l2 = l1 + 16;
          float v1[16];
#pragma unroll
          for (int a = 0; a < 16; ++a) v1[a] = pk_val(l1[a]);
          unsigned long long ptrs = 0ull;
          float wsum[16]; unsigned wab[16];
#pragma unroll
          for (int rd = 0; rd < 16; ++rd) {
              float best = -INFINITY; unsigned bab = 0u;
#pragma unroll
              for (int a = 0; a < 16; ++a) {
                  if (a <= rd) {
                      const unsigned b = (unsigned)(ptrs >> (4 * a)) & 15u; const unsigned lim = 16u / (unsigned)(a + 1);
                      const float c = b < lim ? v1[a] + pk_val(l2[b]) : -INFINITY;
                      if (c > best) { best = c; bab = ((unsigned)a << 4) | b; } } }
              wsum[rd] = best; wab[rd] = bab;
              ptrs += 1ull << (4 * (bab >> 4));
          }
          float den = 0.f; float ex[16];
#pragma unroll
          for (int k = 0; k < 16; ++k) { ex[k] = __expf(wsum[k] - wsum[0]); den += ex[k]; }
          const float rd_ = __builtin_amdgcn_rcpf(den);
          const size_t o = (t0 + t) * 128 + h * 16;
          unsigned ew[8];
#pragma unroll
          for (int k = 0; k < 16; ++k) { const unsigned a = wab[k] >> 4, b = wab[k] & 15u; const unsigned e = ((127u - (l1[a] & 127u)) << 7) | (127u - (l2[b] & 127u));
              if (k & 1) ew[k >> 1] |= e << 16; else ew[k >> 1] = e; }
          *(u32x4*)(p.pe_idx + o) = (u32x4){ew[0], ew[1], ew[2], ew[3]}; *(u32x4*)(p.pe_idx + o + 8) = (u32x4){ew[4], ew[5], ew[6], ew[7]};
#pragma unroll
          for (int k4 = 0; k4 < 4; ++k4) *(f32x4*)(p.pe_gate + o + 4 * k4) = (f32x4){ex[4 * k4] * rd_, ex[4 * k4 + 1] * rd_, ex[4 * k4 + 2] * rd_, ex[4 * k4 + 3] * rd_};
        }
        __syncthreads();
    }
}
__device__ __forceinline__ void fp8x16_to_f32(const u32x4& w, float (&f)[16]) {
#pragma unroll
    for (int i = 0; i < 4; ++i) { const f32x2 a = __builtin_amdgcn_cvt_pk_f32_fp8((int)w[i], false), b = __builtin_amdgcn_cvt_pk_f32_fp8((int)w[i], true); f[4 * i] = a[0]; f[4 * i + 1] = a[1]; f[4 * i + 2] = b[0]; f[4 * i + 3] = b[1]; }
}
template <bool DRY> __device__ void phase_peer_gather(const Params& p, int l, int wg, int nwg) {
    const int lane = threadIdx.x & 63, wave = threadIdx.x >> 6;
    const float* gate = p.mod + (size_t)l * 8 * 6144 + 5120;
    const unsigned char* tu8 = (const unsigned char*)p.tu; const unsigned char* tv8 = tu8 + (size_t)16384 * 1024; const float* tsc = (const float*)(tu8 + (size_t)2 * 16384 * 1024);
    for (int tok = wg * 8 + wave; tok < NTOK; tok += nwg * 8) {
        float xv[16];
        { const u32x4 a = *(const u32x4*)(p.hbuf + (size_t)tok * 1024 + 16 * lane), b = *(const u32x4*)(p.hbuf + (size_t)tok * 1024 + 16 * lane + 8);
          xv[0] = bflo(a.x); xv[1] = bfhi(a.x); xv[2] = bflo(a.y); xv[3] = bfhi(a.y); xv[4] = bflo(a.z); xv[5] = bfhi(a.z); xv[6] = bflo(a.w); xv[7] = bfhi(a.w);
          xv[8] = bflo(b.x); xv[9] = bfhi(b.x); xv[10] = bflo(b.y); xv[11] = bfhi(b.y); xv[12] = bflo(b.z); xv[13] = bfhi(b.z); xv[14] = bflo(b.w); xv[15] = bfhi(b.w); }
        const unsigned e_lo = p.pe_idx[(size_t)tok * 128 + lane], e_hi = p.pe_idx[(size_t)tok * 128 + 64 + lane];
        const float g_lo = p.pe_gate[(size_t)tok * 128 + lane] , g_hi = p.pe_gate[(size_t)tok * 128 + 64 + lane];
        const float su_lo = tsc[e_lo], su_hi = tsc[e_hi], sv_lo = tsc[16384 + e_lo], sv_hi = tsc[16384 + e_hi];
        float d_lo = 0.f, d_hi = 0.f;
#pragma unroll 1
        for (int i0 = 0; i0 < 128; i0 += 8) {
            u32x4 ua[8];
#pragma unroll
            for (int j = 0; j < 8; ++j) { const int i = i0 + j; const unsigned e = (unsigned)__builtin_amdgcn_readlane((int)(i0 < 64 ? e_lo : e_hi), i & 63); ua[j] = *(const u32x4*)(tu8 + (size_t)e * 1024 + 16 * lane); }
#pragma unroll
            for (int j = 0; j < 8; ++j) { const int i = i0 + j; float uf[16]; fp8x16_to_f32(ua[j], uf);
                float s = uf[0] * xv[0];
#pragma unroll
                for (int k = 1; k < 16; ++k) s = fmaf(uf[k], xv[k], s);
                s = row16_sum(s); s += __shfl_xor(s, 16); s += __shfl_xor(s, 32);
                if (i0 < 64) { if (lane == (i & 63)) d_lo = s; } else { if (lane == (i & 63)) d_hi = s; } }
        }
        d_lo *= su_lo; d_hi *= su_hi;
        const float w_lo = sv_lo * g_lo * 0.5f * d_lo * (1.0f + erff(d_lo * 0.70710678118654752f)), w_hi = sv_hi * g_hi * 0.5f * d_hi * (1.0f + erff(d_hi * 0.70710678118654752f));
        float ov[16];
#pragma unroll
        for (int j = 0; j < 16; ++j) ov[j] = 0.f;
#pragma unroll 1
        for (int i0 = 0; i0 < 128; i0 += 8) {
            u32x4 va[8]; float ww[8];
#pragma unroll
            for (int j = 0; j < 8; ++j) { const int i = i0 + j; const unsigned e = (unsigned)__builtin_amdgcn_readlane((int)(i0 < 64 ? e_lo : e_hi), i & 63);
                ww[j] = __int_as_float(__builtin_amdgcn_readlane(__float_as_int(i0 < 64 ? w_lo : w_hi), i & 63));
                va[j] = *(const u32x4*)(tv8 + (size_t)e * 1024 + 16 * lane); }
#pragma unroll
            for (int j = 0; j < 8; ++j) { float vf[16]; fp8x16_to_f32(va[j], vf);
#pragma unroll
                for (int k = 0; k < 16; ++k) ov[k] = fmaf(ww[j], vf[k], ov[k]); }
        }
        const float* gp = gate + (size_t)(tok >> 13) * 6144; float* xr = DRY ? (float*)p.qp + (size_t)(tok & 32767) * 1024 : p.out + (size_t)tok * 1024;
#pragma unroll
        for (int q4 = 0; q4 < 4; ++q4) { const int col = 16 * lane + 4 * q4;
            const f32x4 gg = *(const f32x4*)(gp + col); f32x4 xx = *(const f32x4*)(xr + col);
            xx[0] = fmaf(gg[0], ov[q4 * 4 + 0], xx[0]); xx[1] = fmaf(gg[1], ov[q4 * 4 + 1], xx[1]); xx[2] = fmaf(gg[2], ov[q4 * 4 + 2], xx[2]); xx[3] = fmaf(gg[3], ov[q4 * 4 + 3], xx[3]);
            *(f32x4*)(xr + col) = xx; }
    }
}

typedef __bf16 bf2_t __attribute__((ext_vector_type(2)));
__device__ __forceinline__ float fp8_dot16(const u32x4& w, const u32x4& xa, const u32x4& xb) {
    const unsigned xs[8] = {xa.x, xa.y, xa.z, xa.w, xb.x, xb.y, xb.z, xb.w};
    unsigned u[8];
#pragma unroll
    for (int i = 0; i < 4; ++i) { u[2 * i] = __builtin_bit_cast(unsigned, __builtin_amdgcn_cvt_scalef32_pk_bf16_fp8((int)w[i], 1.0f, false)); u[2 * i + 1] = __builtin_bit_cast(unsigned, __builtin_amdgcn_cvt_scalef32_pk_bf16_fp8((int)w[i], 1.0f, true)); }
    float acc = 0.f;
    asm("v_dot2c_f32_bf16 %0, %1, %9\n\tv_dot2c_f32_bf16 %0, %2, %10\n\tv_dot2c_f32_bf16 %0, %3, %11\n\tv_dot2c_f32_bf16 %0, %4, %12\n\t"
        "v_dot2c_f32_bf16 %0, %5, %13\n\tv_dot2c_f32_bf16 %0, %6, %14\n\tv_dot2c_f32_bf16 %0, %7, %15\n\tv_dot2c_f32_bf16 %0, %8, %16\n\ts_nop 1"
        : "+v"(acc) : "v"(u[0]), "v"(u[1]), "v"(u[2]), "v"(u[3]), "v"(u[4]), "v"(u[5]), "v"(u[6]), "v"(u[7]), "v"(xs[0]), "v"(xs[1]), "v"(xs[2]), "v"(xs[3]), "v"(xs[4]), "v"(xs[5]), "v"(xs[6]), "v"(xs[7]));
    return acc;
}
constexpr int PS_IDS = 131072;
#ifndef PSA
#define PSA 8
#endif
#ifndef PSB
#define PSB 4
#endif
#define PS_COMMON \
    LASP float* acc = (LASP float*)lds; \
    const int tid = threadIdx.x, lane = tid & 63, wave = tid >> 6, g = lane >> 3, c = lane & 7; \
    LASP unsigned short* idl = (LASP unsigned short*)(lds + PS_IDS) + wave * 1024 + g * 128; \
    const unsigned char* tu8 = (const unsigned char*)p.tu; const unsigned char* tv8 = tu8 + (size_t)16384 * 1024; const float* tsc = (const float*)(tu8 + (size_t)2 * 16384 * 1024); \
    (void)tid; (void)tu8; (void)tv8; (void)tsc; (void)acc; (void)l;
template <int NB_> __device__ __forceinline__ void ps_load4(const unsigned char* tab, const LASP unsigned short* idl, int jb, int off, u32x4 (&r)[NB_]) {
    unsigned idw[NB_ / 2];
#pragma unroll
    for (int j = 0; j < NB_ / 2; ++j) idw[j] = *(const LASP unsigned*)(idl + jb * NB_ + 2 * j);
#pragma unroll
    for (int j = 0; j < NB_; ++j) { const unsigned e = (j & 1) ? (idw[j >> 1] >> 16) : (idw[j >> 1] & 0xffffu); r[j] = *(const u32x4*)(tab + (size_t)e * 128 + off); }
}
__device__ __forceinline__ void peer_slab_a(const Params& p, int l, LASP unsigned char* lds, int u) {
    PS_COMMON
#pragma unroll 1
    for (int s = 0; s < 8; ++s) {
#pragma unroll 1
        for (int it = 0; it < 4; ++it) { const int tt = wave * 32 + it * 8 + g; const size_t t = (size_t)u * 256 + tt; const int off = s * 128 + c * 16;
            { const u32x4 i0 = *(const u32x4*)(p.pe_idx + t * 128 + c * 16), i1 = *(const u32x4*)(p.pe_idx + t * 128 + c * 16 + 8);
              *(LASP u32x4*)(idl + c * 16) = i0; *(LASP u32x4*)(idl + c * 16 + 8) = i1; }
            const u32x4 xa = *(const u32x4*)(p.hbuf + t * 1024 + off), xb = *(const u32x4*)(p.hbuf + t * 1024 + off + 8);
            asm volatile("s_waitcnt lgkmcnt(0)" ::: "memory");
            auto use4 = [&](int jb, const u32x4 (&ua)[PSA]) {
                float mine0 = 0.f;
#pragma unroll
                for (int j = 0; j < PSA; ++j) {
                    float d = fp8_dot16(ua[j], xa, xb);
                    d += dppf<0xB1>(d); d += dppf<0x4E>(d); d += dppf<0x141>(d);
                    if ((c & (PSA - 1)) == j) mine0 = d; }
                if (c < PSA) { LASP float* ap = acc + tt * 128 + jb * PSA + c; if (s == 0) ap[0] = mine0; else ap[0] += mine0; } };
            u32x4 ra[PSA], rb[PSA];
            const int toff = s * (16384 * 128) + c * 16;
            ps_load4(tu8, idl, 0, toff, ra);
#pragma unroll 1
            for (int jb = 0; jb < 128 / PSA - 2; jb += 2) {
                ps_load4(tu8, idl, jb + 1, toff, rb);
                use4(jb, ra);
                ps_load4(tu8, idl, jb + 2, toff, ra);
                use4(jb + 1, rb);
            }
            ps_load4(tu8, idl, 128 / PSA - 1, toff, rb);
            use4(128 / PSA - 2, ra);
            use4(128 / PSA - 1, rb);
        }
    }
    __syncthreads();
    for (int i = tid; i < 256 * 128; i += NTHR) { const size_t t = (size_t)u * 256 + (i >> 7); const int k = i & 127;
        const unsigned e = p.pe_idx[t * 128 + k]; const float d = acc[i] * tsc[e];
        acc[i] = tsc[16384 + e] * p.pe_gate[t * 128 + k] * 0.5f * d * (1.0f + erff(d * 0.70710678118654752f)); }
    __syncthreads();
}
__device__ __forceinline__ void peer_slab_b(const Params& p, int l, LASP unsigned char* lds, int u) {
    PS_COMMON
    const float* gate = p.mod + (size_t)l * 8 * 6144 + 5120;
#pragma unroll 1
    for (int s = 0; s < 8; ++s) {
#pragma unroll 1
        for (int it = 0; it < 4; ++it) { const int tt = wave * 32 + it * 8 + g; const size_t t = (size_t)u * 256 + tt; const int off = s * 128 + c * 16;
            { const u32x4 i0 = *(const u32x4*)(p.pe_idx + t * 128 + c * 16), i1 = *(const u32x4*)(p.pe_idx + t * 128 + c * 16 + 8);
              *(LASP u32x4*)(idl + c * 16) = i0; *(LASP u32x4*)(idl + c * 16 + 8) = i1; }
            float ov[16];
#pragma unroll
            for (int k = 0; k < 16; ++k) ov[k] = 0.f;
            asm volatile("s_waitcnt lgkmcnt(0)" ::: "memory");
            auto use4 = [&](int jb, const u32x4 (&va)[PSB]) {
                float wq[PSB];
#pragma unroll
                for (int j = 0; j < PSB; ++j) wq[j] = acc[tt * 128 + jb * PSB + j];
#pragma unroll
                for (int j = 0; j < PSB; ++j) { float vf[16]; fp8x16_to_f32(va[j], vf); const float w = wq[j];
#pragma unroll
                    for (int k = 0; k < 16; ++k) ov[k] = fmaf(w, vf[k], ov[k]); } };
            u32x4 ra[PSB], rb[PSB];
            const int toff = s * (16384 * 128) + c * 16;
            ps_load4(tv8, idl, 0, toff, ra);
#pragma unroll 1
            for (int jb = 0; jb < 128 / PSB - 2; jb += 2) {
                ps_load4(tv8, idl, jb + 1, toff, rb);
                use4(jb, ra);
                ps_load4(tv8, idl, jb + 2, toff, ra);
                use4(jb + 1, rb);
            }
            ps_load4(tv8, idl, 128 / PSB - 1, toff, rb);
            use4(128 / PSB - 2, ra);
            use4(128 / PSB - 1, rb);
            const float* gp = gate + (size_t)(t >> 13) * 6144 + off; float* xr = p.out + t * 1024 + off;
#pragma unroll
            for (int q4 = 0; q4 < 4; ++q4) { const f32x4 gg = *(const f32x4*)(gp + 4 * q4); f32x4 xx = *(const f32x4*)(xr + 4 * q4);
                xx[0] = fmaf(gg[0], ov[q4 * 4 + 0], xx[0]); xx[1] = fmaf(gg[1], ov[q4 * 4 + 1], xx[1]); xx[2] = fmaf(gg[2], ov[q4 * 4 + 2], xx[2]); xx[3] = fmaf(gg[3], ov[q4 * 4 + 3], xx[3]);
                *(f32x4*)(xr + 4 * q4) = xx; }
        }
    }
    __syncthreads();
}
__device__ void phase_peer_gather_slab(const Params& p, int l, LASP unsigned char* lds, int wg, int nwg) {
    for (int u = wg; u < NTOK / 256; u += nwg) { peer_slab_a(p, l, lds, u); peer_slab_b(p, l, lds, u); }
}

#if MK_ONE_LAUNCH
#define PHASE_INLINE __attribute__((noinline))
#else
#define PHASE_INLINE __forceinline__
#endif
#ifndef E3_SLAB
#define E3_SLAB 1
#endif
enum { PH_W = 0, PH_A1, PH_A2, PH_G1, PH_G2, PH_G3, PH_D1, PH_D2, PH_D34, PH_R2, PH_R3, PH_M, PH_O, PH_A1F, PH_E1, PH_E2, PH_E3, PH_FIN, PH_W1, PH_W2, PH_W3, PH_W4, PH_E3DRY, PH_COUNT };
enum { UN_DSEL = 0, UN_DATT, UN_R3AB, UN_R3C, UN_R2SETUP, UN_R2SCAN, UN_R2PREP, UN_E3A, UN_E3B, UN_DUP };

template <int PH> __device__ __forceinline__ void run_phase(const Params& p, int l, LASP unsigned char* lds, int wg, int nwg) {
    const float* modl = p.mod + (size_t)l * 8 * 6144;
    const float* xin = l == 0 ? p.x : p.out;
    if constexpr (PH == PH_W) phase_weights<0>(p, lds, wg, nwg);
    else if constexpr (PH == PH_W1) phase_weights<1>(p, lds, wg, nwg);
    else if constexpr (PH == PH_W2) phase_weights<2>(p, lds, wg, nwg);
    else if constexpr (PH == PH_W3) phase_weights<3>(p, lds, wg, nwg);
    else if constexpr (PH == PH_W4) phase_weights<4>(p, lds, wg, nwg);
    else if constexpr (PH == PH_A1) phase_adaln(xin, p.g_mix + (size_t)l * 1024, modl, 0, 1024, p.hbuf, wg, nwg);
    else if constexpr (PH == PH_A2) { pg8::EpiP E; E.GQ = p.GQ; E.GK = p.GK; E.GV = p.GV; E.GR = p.GR; E.PB = p.PB; E.PC = p.PC;
        run_gemm(lds, p.hbuf, p.win_t + (size_t)l * 3840 * 1024, NTOK, 3840, 1024, E, wg, nwg); }
    else if constexpr (PH == PH_G1) phase_gla1(p, l, lds, wg, nwg);
    else if constexpr (PH == PH_G2) phase_gla2(p, wg, nwg);
    else if constexpr (PH == PH_G3) phase_gla3(p, l, lds, wg, nwg);
    else if constexpr (PH == PH_D1) phase_dsa1(p, l, wg, nwg);
    else if constexpr (PH == PH_D2) { pg8::EpiStore<0> E; E.O = p.qd; E.ldc = 1024; run_gemm(lds, p.qn, p.wuq_t + (size_t)l * 1024 * 256, NTOK, 1024, 256, E, wg, nwg);
        pg8::EpiStore<0> E2; E2.O = p.qi; E2.ldc = 256; run_gemm(lds, p.qn, p.wiq_t + (size_t)l * 256 * 256, NTOK, 256, 256, E2, wg, nwg); }
    else if constexpr (PH == PH_D34) phase_dsa34(p, l, lds, wg, nwg);
    else if constexpr (PH == PH_R2) phase_rwkv_scan(p, l, lds, wg, nwg);
    else if constexpr (PH == PH_R3) phase_rwkv_post(p, l, lds, wg, nwg);
    else if constexpr (PH == PH_M) {
        pg8::EpiStore<1> EG; EG.O = p.Gtmp; EG.ldc = 1024;
        const bf16_t* wg_l = p.wg_t + (size_t)l * 3072 * 1024; const bf16_t* wb_l = p.wb_t + (size_t)l * 3 * 1024 * 512;
        run_gemm(lds, p.hbuf, wg_l, NTOK, 1024, 1024, EG, wg, nwg);
        { pg8::EpiMerge<1> EM; EM.G = p.Gtmp; EM.O = p.merged; EM.ldc = 1024; run_gemm(lds, p.ya, wb_l, NTOK, 1024, 512, EM, wg, nwg); }
        run_gemm(lds, p.hbuf, wg_l + (size_t)1024 * 1024, NTOK, 1024, 1024, EG, wg, nwg);
        { pg8::EpiMerge<0> EM; EM.G = p.Gtmp; EM.O = p.merged; EM.ldc = 1024; run_gemm(lds, p.yb, wb_l + (size_t)1024 * 512, NTOK, 1024, 512, EM, wg, nwg); }
        run_gemm(lds, p.hbuf, wg_l + (size_t)2 * 1024 * 1024, NTOK, 1024, 1024, EG, wg, nwg);
        { pg8::EpiMerge<0> EM; EM.G = p.Gtmp; EM.O = p.merged; EM.ldc = 1024; run_gemm(lds, p.yc, wb_l + (size_t)2 * 1024 * 512, NTOK, 1024, 512, EM, wg, nwg); } }
    else if constexpr (PH == PH_O) { pg8::EpiResid E; E.xin = xin; E.xout = p.out; E.gate = modl + 2048; run_gemm(lds, p.merged, p.wo_t + (size_t)l * 1024 * 1024, NTOK, 1024, 1024, E, wg, nwg); }
    else if constexpr (PH == PH_A1F) { phase_adaln(p.out, p.g_ffn + (size_t)l * 1024, modl, 3072, 4096, p.hbuf, wg, nwg); phase_peer_tables(p, l, wg, nwg); }
    else if constexpr (PH == PH_E1) { pg8::EpiStore<0> E; E.O = p.qp; E.ldc = 1024; run_gemm(lds, p.hbuf, p.wq_t + (size_t)l * 1024 * 1024, NTOK, 1024, 1024, E, wg, nwg); }
    else if constexpr (PH == PH_E2) phase_peer_select(p, l, lds, wg, nwg);
    else if constexpr (PH == PH_E3) { if (E3_SLAB) phase_peer_gather_slab(p, l, lds, wg, nwg); else phase_peer_gather<false>(p, l, wg, nwg); }
    else if constexpr (PH == PH_E3DRY) phase_peer_gather<true>(p, l, wg, nwg);
    else if constexpr (PH == PH_FIN) phase_final(p.out, p.g_final, wg, nwg);
}

extern __shared__ __attribute__((aligned(16))) unsigned char smem_dyn[];
#ifndef DBG_MODE
#define DBG_MODE 0
#endif
#ifndef DBG_DOUBLE
#define DBG_DOUBLE 0
#endif
#ifndef DBG_LAYERS
#define DBG_LAYERS NLAYER
#endif
__global__ void __launch_bounds__(NTHR, 2) k_dbg_copy(const float* x, float* out) {
    for (size_t i = (size_t)blockIdx.x * NTHR + threadIdx.x; i < (size_t)NTOK * 1024 / 4; i += (size_t)gridDim.x * NTHR) ((f32x4*)out)[i] = ((const f32x4*)x)[i];
}

__global__ void __launch_bounds__(NTHR, 2) k_dbg_dump(const bf16_t* buf, size_t n, float* out) {
    const size_t NOUT = (size_t)NTOK * 1024;
    for (size_t i = (size_t)blockIdx.x * NTHR + threadIdx.x; i < NOUT; i += (size_t)gridDim.x * NTHR) {
        float s = 0.f; if (n >= NOUT) { for (size_t j = i; j < n; j += NOUT) s += bf2f(buf[j]); } else s = bf2f(buf[i % n]);
        out[i] = s; }
}
#ifndef DBG_A2BUF
#define DBG_A2BUF p.PC
#define DBG_A2N 1792
#endif
#ifndef DBG_G1BUF
#define DBG_G1BUF p.GS
#define DBG_G1N ((size_t)NTOK * 512)
#endif
#ifndef DBG_STOP
#define DBG_STOP PH_O
#endif
#if MK_ONE_LAUNCH
typedef const __attribute__((address_space(4))) Params* KParams;
__device__ __forceinline__ KParams kparams_from(unsigned lo_, unsigned hi_) {
    const unsigned lo = (unsigned)__builtin_amdgcn_readfirstlane((int)lo_), hi = (unsigned)__builtin_amdgcn_readfirstlane((int)hi_);
    return (KParams)(((unsigned long long)hi << 32) | lo);
}
struct ParamsPtrs { void* w[sizeof(Params) / 8]; };
static_assert(sizeof(ParamsPtrs) == sizeof(Params), "Params must be a whole number of pointers");
__device__ __forceinline__ Params load_kparams(KParams pp) {
    typedef const __attribute__((address_space(4))) unsigned long long* KQ; const KQ q = (KQ)pp; ParamsPtrs r;
#pragma unroll
    for (int i = 0; i < (int)(sizeof(Params) / 8); ++i) r.w[i] = (void*)(__attribute__((address_space(1))) void*)q[i];
    return __builtin_bit_cast(Params, r);
}
template <int PH> __device__ __attribute__((noinline)) void phase_call(int l_, LASP unsigned char* lds_, unsigned plo, unsigned phi) {
    const int l = __builtin_amdgcn_readfirstlane(l_);
    LASP unsigned char* lds = (LASP unsigned char*)(unsigned)__builtin_amdgcn_readfirstlane((int)(unsigned)(size_t)lds_);
    const KParams pp = kparams_from(plo, phi);
    const Params p = load_kparams(pp);
    run_phase<PH>(p, l, lds, (int)blockIdx.x, (int)gridDim.x);
}
template <int UN> __device__ __attribute__((noinline)) void unit_call(int l_, LASP unsigned char* lds_, int u_, unsigned plo, unsigned phi) {
    const int l = __builtin_amdgcn_readfirstlane(l_), u = __builtin_amdgcn_readfirstlane(u_);
    LASP unsigned char* lds = (LASP unsigned char*)(unsigned)__builtin_amdgcn_readfirstlane((int)(unsigned)(size_t)lds_);
    const KParams pp = kparams_from(plo, phi);
    const Params p = load_kparams(pp);
    if constexpr (UN == UN_DSEL) dsa_select_unit(p, l, lds, u);
    else if constexpr (UN == UN_DATT) dsa_attend_query(p, l, lds, u);
    else if constexpr (UN == UN_DUP) dsa_upproj_unit(p, l, lds, u);
    else if constexpr (UN == UN_R3AB) rwkv_post_ab(p, l, lds, u);
    else if constexpr (UN == UN_R3C) rwkv_post_c(p, l, lds, u);
    else if constexpr (UN == UN_R2SETUP) rwkv_scan_setup(p, l, lds, u);
    else if constexpr (UN == UN_R2SCAN) rwkv_scan_waves(p, l, lds, u);
    else if constexpr (UN == UN_R2PREP) rwkv_prep_waves(p, l, lds, u);
    else if constexpr (UN == UN_E3A) peer_slab_a(p, l, lds, u);
    else peer_slab_b(p, l, lds, u);
}
constexpr int NSTEP = 22;
struct GemmStep { const bf16_t* A; const bf16_t* Bt; int N, K; pg8::EpiGen E; };
__device__ __forceinline__ bool make_gemm_step(const Params& p, int l, int s, GemmStep& g) {
    const float* modl = p.mod + (size_t)l * 8 * 6144;
    pg8::EpiGen& E = g.E;
    E.kind = 1; E.ldc = 1024; E.O = nullptr; E.G = p.Gtmp; E.GQ = p.GQ; E.GK = p.GK; E.GV = p.GV; E.GR = p.GR; E.PB = p.PB; E.PC = p.PC; E.xin = l == 0 ? p.x : p.out; E.xout = p.out; E.gate = modl + 2048;
    const bf16_t* wg_l = p.wg_t + (size_t)l * 3072 * 1024; const bf16_t* wb_l = p.wb_t + (size_t)l * 3 * 1024 * 512;
    g.N = 1024; g.K = 1024; g.A = p.hbuf; g.Bt = nullptr;
    switch (s) {
    case 1: g.Bt = p.win_t + (size_t)l * 3840 * 1024; g.N = 3840; E.kind = 0; return true;
    case 6: g.A = p.qn; g.Bt = p.wuq_t + (size_t)l * 1024 * 256; g.K = 256; E.O = p.qd; return true;
    case 7: g.A = p.qn; g.Bt = p.wiq_t + (size_t)l * 256 * 256; g.N = 256; g.K = 256; E.O = p.qi; E.ldc = 256; return true;
    case 11: g.Bt = wg_l; E.kind = 2; E.O = p.Gtmp; return true;
    case 12: g.A = p.ya; g.Bt = wb_l; g.K = 512; E.kind = 3; E.O = p.merged; return true;
    case 13: g.Bt = wg_l + (size_t)1024 * 1024; E.kind = 2; E.O = p.Gtmp; return true;
    case 14: g.A = p.yb; g.Bt = wb_l + (size_t)1024 * 512; g.K = 512; E.kind = 4; E.O = p.merged; return true;
    case 15: g.Bt = wg_l + (size_t)2 * 1024 * 1024; E.kind = 2; E.O = p.Gtmp; return true;
    case 16: g.A = p.yc; g.Bt = wb_l + (size_t)2 * 1024 * 512; g.K = 512; E.kind = 4; E.O = p.merged; return true;
    case 17: g.A = p.merged; g.Bt = p.wo_t + (size_t)l * 1024 * 1024; E.kind = 5; return true;
    case 19: g.Bt = p.wq_t + (size_t)l * 1024 * 1024; E.O = p.qp; return true;
    default: return false; }
}
__global__ void __launch_bounds__(NTHR, 2) mega_fwd(Params p) {
    LASP unsigned char* lds = (LASP unsigned char*)smem_dyn;
    if (threadIdx.x < 4) ((LASP unsigned*)(lds + LDS_BAR_OFF))[threadIdx.x] = 0u;
    __syncthreads();
    const XcdBarrier bar = xcd_barrier_post(p.bar, (volatile LAS unsigned*)(lds + LDS_BAR_OFF));
    const int wg = blockIdx.x, nwg = gridDim.x;
    const unsigned long long kpa = (unsigned long long)__builtin_amdgcn_kernarg_segment_ptr(); const unsigned kplo = (unsigned)kpa, kphi = (unsigned)(kpa >> 32);
#if DBG_DOUBLE & 2048
    phase_call<PH_W>(0, lds, kplo, kphi); phase_call<PH_W1>(0, lds, kplo, kphi); phase_call<PH_W2>(0, lds, kplo, kphi); phase_call<PH_W3>(0, lds, kplo, kphi); phase_call<PH_W4>(0, lds, kplo, kphi);
#endif
    phase_call<PH_W>(0, lds, kplo, kphi); phase_call<PH_W1>(0, lds, kplo, kphi); phase_call<PH_W2>(0, lds, kplo, kphi); phase_call<PH_W3>(0, lds, kplo, kphi); phase_call<PH_W4>(0, lds, kplo, kphi); xcd_barrier(bar);
#pragma unroll 1
    for (int ls = 0; ls < NLAYER * NSTEP; ++ls) {
        const int l = ls / NSTEP, s = ls % NSTEP;
        GemmStep g;
        if (make_gemm_step(p, l, s, g)) {
#if DBG_DOUBLE & 1
            if (s != 17 && s != 14 && s != 16) { pg8::Gemm gg; gg.A = g.A; gg.Bt = g.Bt; gg.M = NTOK; gg.N = g.N; gg.K = g.K; pg8::StaticOrder S; S.init(NTOK, g.N, nwg, wg);
                pg8::gemm_phase<pg8::EpiGen, pg8::StaticOrder, false>(lds, gg, S, g.E, nullptr); __syncthreads(); }
#endif
            pg8::Gemm gg; gg.A = g.A; gg.Bt = g.Bt; gg.M = NTOK; gg.N = g.N; gg.K = g.K;
            pg8::StaticOrder S; S.init(NTOK, g.N, nwg, wg);
#if DBG_DOUBLE & 0x3C0000
            int reps = 1; const int k0 = g.E.kind;
            if ((DBG_DOUBLE & 0x40000) && (s == 11 || s == 13 || s == 15)) { reps = 2; g.E.kind = 6; }
            if ((DBG_DOUBLE & 0x80000) && (s == 11 || s == 13 || s == 15)) { reps = 2; }
            if ((DBG_DOUBLE & 0x100000) && (s == 12 || s == 14 || s == 16)) { reps = 2; g.E.kind = 6; }
            if ((DBG_DOUBLE & 0x200000) && (s == 12 || s == 14 || s == 16)) { reps = 2; g.E.kind = 7; }
            for (int rep = 0; rep < reps; ++rep) { if (rep == reps - 1) g.E.kind = k0;
                pg8::gemm_phase<pg8::EpiGen, pg8::StaticOrder, false>(lds, gg, S, g.E, nullptr); __syncthreads(); }
#else
            pg8::gemm_phase<pg8::EpiGen, pg8::StaticOrder, false>(lds, gg, S, g.E, nullptr);
            __syncthreads();
#endif
        } else {
#if DBG_DOUBLE & 2
            if (s == 8) for (int pos = wg; pos < 4096; pos += nwg) { unit_call<UN_DSEL>(l, lds, pos, kplo, kphi); unit_call<UN_DATT>(l, lds, pos, kplo, kphi); unit_call<UN_DUP>(l, lds, pos, kplo, kphi); }
#endif
#if DBG_DOUBLE & 4
            if (s == 9) for (int u = wg; u < NB * 8 * 4; u += nwg) { unit_call<UN_R2SETUP>(l, lds, u, kplo, kphi);
                if ((threadIdx.x >> 6) < 4) unit_call<UN_R2SCAN>(l, lds, u, kplo, kphi); else unit_call<UN_R2PREP>(l, lds, u, kplo, kphi); }
#endif
#if DBG_DOUBLE & 8
            if (s == 20) phase_call<PH_E2>(l, lds, kplo, kphi);
#endif
#if DBG_DOUBLE & 16
            if (s == 21) phase_call<PH_E3DRY>(l, lds, kplo, kphi);
#endif
#if DBG_DOUBLE & 32
            if (s == 0) phase_call<PH_A1>(l, lds, kplo, kphi);
            if (s == 2) phase_call<PH_G1>(l, lds, kplo, kphi);
            if (s == 4) phase_call<PH_G3>(l, lds, kplo, kphi);
            if (s == 5) phase_call<PH_D1>(l, lds, kplo, kphi);
            if (s == 18) phase_call<PH_A1F>(l, lds, kplo, kphi);
#endif
            switch (s) {
            case 0: phase_call<PH_A1>(l, lds, kplo, kphi); break;
            case 2: phase_call<PH_G1>(l, lds, kplo, kphi); break;
            case 3: phase_call<PH_G2>(l, lds, kplo, kphi); break;
            case 4: phase_call<PH_G3>(l, lds, kplo, kphi); break;
            case 5: phase_call<PH_D1>(l, lds, kplo, kphi); break;
            case 8: for (int pos = wg; pos < 4096; pos += nwg) {
#if DBG_DOUBLE & 64
                unit_call<UN_DSEL>(l, lds, pos, kplo, kphi);
#endif
                unit_call<UN_DSEL>(l, lds, pos, kplo, kphi);
#if DBG_DOUBLE & 128
                unit_call<UN_DATT>(l, lds, pos, kplo, kphi);
#endif
                unit_call<UN_DATT>(l, lds, pos, kplo, kphi); unit_call<UN_DUP>(l, lds, pos, kplo, kphi); } break;
            case 9: for (int u = wg; u < NB * 8 * 4; u += nwg) { unit_call<UN_R2SETUP>(l, lds, u, kplo, kphi);
                if ((threadIdx.x >> 6) < 4) unit_call<UN_R2SCAN>(l, lds, u, kplo, kphi); else unit_call<UN_R2PREP>(l, lds, u, kplo, kphi); } break;
            case 10: for (int u = wg; u < NTOK / 32; u += nwg) {
#if DBG_DOUBLE & 4096
                unit_call<UN_R3AB>(l, lds, u, kplo, kphi);
#endif
                unit_call<UN_R3AB>(l, lds, u, kplo, kphi); unit_call<UN_R3C>(l, lds, u, kplo, kphi); } break;
            case 18: phase_call<PH_A1F>(l, lds, kplo, kphi); break;
            case 20: phase_call<PH_E2>(l, lds, kplo, kphi); break;
            default: if (E3_SLAB) { for (int u = wg; u < NTOK / 256; u += nwg) {
#if DBG_DOUBLE & 0x400000
                         unit_call<UN_E3A>(l, lds, u, kplo, kphi);
#endif
                         unit_call<UN_E3A>(l, lds, u, kplo, kphi); unit_call<UN_E3B>(l, lds, u, kplo, kphi); } }
                     else phase_call<PH_E3>(l, lds, kplo, kphi);
                     break; }
        }
        const bool nobar = (s == 6) || (s >= 11 && s <= 15);
        if (!nobar) xcd_barrier(bar);
#if DBG_DOUBLE & 32768
        if (!nobar) xcd_barrier(bar);
#endif
    }
    phase_call<PH_FIN>(0, lds, kplo, kphi);
}
#else
template <int PH> __global__ void __launch_bounds__(NTHR, 2) k_phase(Params p, int l) {
    LASP unsigned char* lds = (LASP unsigned char*)smem_dyn;
    run_phase<PH>(p, l, lds, blockIdx.x, gridDim.x);
}
template <int PH> static void launch_phase(const Params& p, int l, int grid, hipStream_t stream) {
    static bool attr = false;
    if (!attr) { hipFuncSetAttribute((const void*)k_phase<PH>, hipFuncAttributeMaxDynamicSharedMemorySize, LDS_BYTES); attr = true; }
    hipLaunchKernelGGL(k_phase<PH>, dim3(grid), dim3(NTHR), LDS_BYTES, stream, p, l);
}
#endif

static size_t carve(size_t& off, size_t bytes) { const size_t o = off; off += (bytes + 255) & ~(size_t)255; return o; }

extern "C" void kernel_launch(void* const* d_in, const int* in_sizes, int n_in, void* d_out, int out_size, void* d_ws, size_t ws_size, hipStream_t stream) {
    (void)in_sizes; (void)out_size;
    if (n_in != 33) { fprintf(stderr, "kernel_launch: expected 33 inputs, got %d\n", n_in); return; }
    Params p; memset(&p, 0, sizeof(p));
    const float* const* in = (const float* const*)d_in;
    p.x = in[0]; p.c = in[1]; p.w_ada = in[2]; p.b_ada = in[3]; p.g_mix = in[4]; p.g_ffn = in[5]; p.w_in = in[6]; p.gla_w_a2 = in[7]; p.gla_b_a = in[8]; p.gla_g_o = in[9];
    p.dsa_g_qc = in[10]; p.dsa_w_uq = in[11]; p.dsa_w_iq = in[12]; p.dsa_g_kv = in[13]; p.dsa_w_uv = in[14];
    p.rw_mu = in[15]; p.rw_w0 = in[16]; p.rw_w_w2 = in[17]; p.rw_a0 = in[18]; p.rw_w_a2 = in[19]; p.rw_w_g2 = in[20]; p.rw_k_k = in[21]; p.rw_k_a = in[22]; p.rw_r_k = in[23];
    p.rw_ln_g = in[24]; p.rw_ln_b = in[25]; p.w_branch = in[26]; p.w_out = in[27]; p.peer_w_q = in[28]; p.peer_keys = in[29]; p.peer_u = in[30]; p.peer_v = in[31]; p.g_final = in[32];
    p.out = (float*)d_out;
    char* ws = (char*)d_ws; size_t off = 0;
    const size_t TB2 = (size_t)NTOK * 2;
    p.bar = (unsigned*)(ws + carve(off, 16384));
    p.mod = (float*)(ws + carve(off, (size_t)NLAYER * 8 * 6144 * 4));
    p.win_t = (bf16_t*)(ws + carve(off, (size_t)NLAYER * 3840 * 1024 * 2));
    p.wg_t = (bf16_t*)(ws + carve(off, (size_t)NLAYER * 3072 * 1024 * 2));
    p.wb_t = (bf16_t*)(ws + carve(off, (size_t)NLAYER * 3 * 1024 * 512 * 2));
    p.wo_t = (bf16_t*)(ws + carve(off, (size_t)NLAYER * 1024 * 1024 * 2));
    p.wq_t = (bf16_t*)(ws + carve(off, (size_t)NLAYER * 1024 * 1024 * 2));
    p.wuq_t = (bf16_t*)(ws + carve(off, (size_t)NLAYER * 1024 * 256 * 2));
    p.wiq_t = (bf16_t*)(ws + carve(off, (size_t)NLAYER * 256 * 256 * 2));
    p.wuv_t = (bf16_t*)(ws + carve(off, (size_t)NLAYER * 8 * 64 * 128 * 2));
    p.pkeys = (bf16_t*)(ws + carve(off, (size_t)NLAYER * 8 * 2 * 128 * 64 * 2));
    p.ww2_t = (bf16_t*)(ws + carve(off, (size_t)NLAYER * 512 * 64 * 2));
    p.wa2_t = (bf16_t*)(ws + carve(off, (size_t)NLAYER * 512 * 64 * 2));
    p.wg2_t = (bf16_t*)(ws + carve(off, (size_t)NLAYER * 512 * 128 * 2));
    p.hbuf = (bf16_t*)(ws + carve(off, TB2 * 1024));
    char* R1 = ws + carve(off, TB2 * 1536);
    p.GQ = (bf16_t*)R1; p.GK = (bf16_t*)(R1 + TB2 * 256); p.GR = (bf16_t*)(R1 + TB2 * 512); p.GS = (bf16_t*)(R1 + TB2 * 1024);
    p.GV = (bf16_t*)(ws + carve(off, TB2 * 512));
    p.PB = (bf16_t*)(ws + carve(off, TB2 * 512));
    p.PC = (bf16_t*)(ws + carve(off, TB2 * 1792));
    p.yb = (bf16_t*)(ws + carve(off, TB2 * 512));
    p.yc = (bf16_t*)(ws + carve(off, TB2 * 512));
    p.kvn = (bf16_t*)(ws + carve(off, TB2 * 128));
    p.gdec = (float*)(ws + carve(off, (size_t)NB * NCHUNK * 4 * 64 * 4));
    p.qd = (bf16_t*)R1; p.qi = (bf16_t*)(R1 + TB2 * 1024); p.qn = (bf16_t*)(R1 + TB2 * 1280);
    p.ya = p.GV; p.Gtmp = (bf16_t*)R1; p.merged = p.PC;
    p.qp = (bf16_t*)R1; p.tu = (bf16_t*)(R1 + TB2 * 1024); p.tv = (bf16_t*)(R1 + TB2 * 1280);
    p.pe_idx = (unsigned short*)p.PC; p.pe_gate = (float*)((char*)p.PC + (size_t)NTOK * 128 * 2);
    if (off > ws_size) { fprintf(stderr, "kernel_launch: workspace too small: need %zu, have %zu\n", off, ws_size); return; }
    static int grid = 0;
    if (!grid) { int dev = 0, cus = 0; hipGetDevice(&dev); hipDeviceGetAttribute(&cus, hipDeviceAttributeMultiprocessorCount, dev); grid = cus > 0 ? cus : 256; if (grid > 256) grid = 256; }
#if MK_ONE_LAUNCH
    static bool attr = false;
    if (!attr) { if (hipFuncSetAttribute((const void*)mega_fwd, hipFuncAttributeMaxDynamicSharedMemorySize, LDS_BYTES) != hipSuccess) fprintf(stderr, "kernel_launch: hipFuncSetAttribute failed\n"); attr = true; }
    hipMemsetAsync(p.bar, 0, 16384, stream);
    hipLaunchKernelGGL(mega_fwd, dim3(grid), dim3(NTHR), LDS_BYTES, stream, p);
#else
#if DBG_MODE == 1
    hipLaunchKernelGGL(k_dbg_copy, dim3(grid), dim3(NTHR), 0, stream, p.x, p.out);
    launch_phase<PH_FIN>(p, 0, grid, stream);
    return;
#endif
#if DBG_MODE == 2
    {   launch_phase<PH_W>(p, 0, grid, stream); launch_phase<PH_W1>(p, 0, grid, stream); launch_phase<PH_W2>(p, 0, grid, stream); launch_phase<PH_W3>(p, 0, grid, stream); launch_phase<PH_W4>(p, 0, grid, stream);
        const bf16_t* db = nullptr; size_t dn = 0; const int l = 0;
        launch_phase<PH_A1>(p, l, grid, stream); db = p.hbuf; dn = (size_t)NTOK * 1024;
        if (DBG_STOP >= PH_A2) { launch_phase<PH_A2>(p, l, grid, stream); db = DBG_A2BUF; dn = (size_t)NTOK * DBG_A2N; }
        if (DBG_STOP >= PH_G1) { launch_phase<PH_G1>(p, l, grid, stream); db = DBG_G1BUF; dn = DBG_G1N; }
        if (DBG_STOP >= PH_G2) { launch_phase<PH_G2>(p, l, grid, stream); db = p.GS; dn = (size_t)NTOK * 512; }
        if (DBG_STOP >= PH_G3) { launch_phase<PH_G3>(p, l, grid, stream); db = p.ya; dn = (size_t)NTOK * 512; }
        if (DBG_STOP >= PH_D1) { launch_phase<PH_D1>(p, l, grid, stream); db = p.qn; dn = (size_t)NTOK * 256; }
        if (DBG_STOP >= PH_D2) { launch_phase<PH_D2>(p, l, grid, stream); db = p.qd; dn = (size_t)NTOK * 1280; }
        if (DBG_STOP >= PH_D34) { launch_phase<PH_D34>(p, l, grid, stream); db = p.yb; dn = (size_t)NTOK * 512; }
        if (DBG_STOP >= PH_R2) { launch_phase<PH_R2>(p, l, grid, stream); db = p.yc; dn = (size_t)NTOK * 512; }
        if (DBG_STOP >= PH_R3) { launch_phase<PH_R3>(p, l, grid, stream); db = p.yc; dn = (size_t)NTOK * 512; }
        if (DBG_STOP >= PH_M) { launch_phase<PH_M>(p, l, grid, stream); db = p.merged; dn = (size_t)NTOK * 1024; }
        if (DBG_STOP >= PH_O) { launch_phase<PH_O>(p, l, grid, stream); db = nullptr; }
        if (DBG_STOP >= PH_A1F) { launch_phase<PH_A1F>(p, l, grid, stream); }
        if (DBG_STOP >= PH_E1) { launch_phase<PH_E1>(p, l, grid, stream); db = p.qp; dn = (size_t)NTOK * 1024; }
        if (DBG_STOP >= PH_E2) { launch_phase<PH_E2>(p, l, grid, stream); db = (const bf16_t*)p.pe_gate; dn = (size_t)NTOK * 256; }
        if (DBG_STOP >= PH_E3) { launch_phase<PH_E3>(p, l, grid, stream); db = nullptr; }
        if (db) hipLaunchKernelGGL(k_dbg_dump, dim3(grid), dim3(NTHR), 0, stream, db, dn, p.out);
        return; }
#endif
    launch_phase<PH_W>(p, 0, grid, stream); launch_phase<PH_W1>(p, 0, grid, stream); launch_phase<PH_W2>(p, 0, grid, stream); launch_phase<PH_W3>(p, 0, grid, stream); launch_phase<PH_W4>(p, 0, grid, stream);
    for (int l = 0; l < DBG_LAYERS; ++l) {
        launch_phase<PH_A1>(p, l, grid, stream); launch_phase<PH_A2>(p, l, grid, stream);
        launch_phase<PH_G1>(p, l, grid, stream); launch_phase<PH_G2>(p, l, grid, stream); launch_phase<PH_G3>(p, l, grid, stream);
        launch_phase<PH_D1>(p, l, grid, stream); launch_phase<PH_D2>(p, l, grid, stream); launch_phase<PH_D34>(p, l, grid, stream);
        launch_phase<PH_R2>(p, l, grid, stream); launch_phase<PH_R3>(p, l, grid, stream);
        launch_phase<PH_M>(p, l, grid, stream); launch_phase<PH_O>(p, l, grid, stream);
        launch_phase<PH_A1F>(p, l, grid, stream); launch_phase<PH_E1>(p, l, grid, stream); launch_phase<PH_E2>(p, l, grid, stream); launch_phase<PH_E3>(p, l, grid, stream);
    }
    launch_phase<PH_FIN>(p, 0, grid, stream);
#endif
}
```
